# Optimizing an MI355X kernel written in HIP

```python
import jax, jax.numpy as jnp
from jax import lax
import numpy as np

D_MODEL = 1024
BATCH = 4
SEQ = 4096
DEPTH = 2

GRID_W = 64
CTX_LEN = 256

RWKV_HEADS = 8
RWKV_HEAD_DIM = 64
RWKV_WIDTH = RWKV_HEADS * RWKV_HEAD_DIM
DECAY_LORA = 64
AAA_LORA = 64
GATE_LORA = 128
N_DIR = 2
GN_EPS = 64e-5

MLA_HEADS = 8
QK_NOPE = 64
QK_ROPE = 32
QK_HEAD = QK_NOPE + QK_ROPE
V_HEAD = 64
MLA_WIDTH = MLA_HEADS * V_HEAD
Q_LORA = 384
KV_LORA = 128
ROPE_AXIS = QK_ROPE // 2
ROPE_THETA = 10000.0
Q_BLOCK = 128

FNO_GROUPS = 8
FNO_GROUP_DIM = 64
FNO_WIDTH = FNO_GROUPS * FNO_GROUP_DIM

N_BRANCH = 3
N_RWKV_IN = 3 * RWKV_WIDTH + N_DIR * DECAY_LORA + N_DIR * AAA_LORA + GATE_LORA
N_MLA_IN = Q_LORA + KV_LORA + QK_ROPE
N_IN = N_RWKV_IN + N_MLA_IN + FNO_WIDTH + N_BRANCH * D_MODEL
IN_SPLITS = (N_RWKV_IN, N_RWKV_IN + N_MLA_IN, N_RWKV_IN + N_MLA_IN + FNO_WIDTH)
RWKV_SPLITS = (RWKV_WIDTH, 2 * RWKV_WIDTH, 3 * RWKV_WIDTH,
               3 * RWKV_WIDTH + N_DIR * DECAY_LORA,
               3 * RWKV_WIDTH + N_DIR * DECAY_LORA + N_DIR * AAA_LORA)

FFN_HIDDEN = ((8 * D_MODEL + 3 * 256 - 1) // (3 * 256)) * 256
RMS_EPS = 1e-6

kernel_name = "hybrid_rwkv7_mla_fnet_dit_block"


def rms_norm(x, g):
    xf = x.astype(jnp.float32)
    y = xf * lax.rsqrt(jnp.mean(xf * xf, axis=-1, keepdims=True) + RMS_EPS)
    return (y * g.astype(jnp.float32)).astype(x.dtype)


def modulate(h, shift, scale):
    return h * (1.0 + scale) + shift


def centred_shift_mix(z, mu_prev, mu_next):
    z_prev = jnp.pad(z, ((0, 0), (1, 0), (0, 0)))[:, :-1]
    z_next = jnp.pad(z, ((0, 0), (0, 1), (0, 0)))[:, 1:]
    return z + (z_prev - z) * mu_prev + (z_next - z) * mu_next


def rwkv_features(z, p):
    z = centred_shift_mix(z, p["mu_prev"], p["mu_next"])
    B, T, _ = z.shape
    r, k, v, zw, za, zg = jnp.split(z, RWKV_SPLITS, axis=-1)
    heads = lambda t: t.reshape(B, T, RWKV_HEADS, RWKV_HEAD_DIM)
    dir_heads = lambda t: t.reshape(B, T, N_DIR, RWKV_HEADS, RWKV_HEAD_DIM)
    zw = jnp.tanh(zw.reshape(B, T, N_DIR, DECAY_LORA))
    w_log = -jax.nn.softplus(-(p["w0"] + jnp.einsum("btdr,drc->btdc", zw, p["w2"]))) - 0.5
    decay = jnp.exp(-jnp.exp(w_log.astype(jnp.float32)))
    a = jax.nn.sigmoid(p["a0"] + jnp.einsum("btdr,drc->btdc", za.reshape(B, T, N_DIR, AAA_LORA), p["a2"]))
    g = jax.nn.sigmoid(zg) @ p["g2"]
    kk = heads(k * p["k_k"]).astype(jnp.float32)
    kk = kk / jnp.maximum(jnp.sqrt(jnp.sum(kk * kk, axis=-1, keepdims=True)), 1e-12)
    k_dir = k[:, :, None, :] * (1.0 + (a - 1.0) * p["k_a"])
    b_dir = kk[:, :, None] * dir_heads(a).astype(jnp.float32)
    return dict(r=heads(r), v=heads(v), kk=kk, g=g, decay=dir_heads(decay), k=dir_heads(k_dir), b=b_dir)


def rwkv_scan(state0, f, d, reverse):
    seq = (f["r"], f["decay"][:, :, d], f["k"][:, :, d], f["v"], f["kk"], f["b"][:, :, d])
    xs = tuple(jnp.moveaxis(t.astype(jnp.float32), 1, 0) for t in seq)

    def step(S, inp):
        r_t, w_t, k_t, v_t, kk_t, b_t = inp
        sa = -jnp.einsum("bhvk,bhk->bhv", S, kk_t)
        S = S * w_t[:, :, None, :] + sa[..., None] * b_t[:, :, None, :] + v_t[..., None] * k_t[:, :, None, :]
        return S, jnp.einsum("bhvk,bhk->bhv", S, r_t)

    S, ys = lax.scan(step, state0, xs, reverse=reverse)
    return S, jnp.moveaxis(ys, 0, 1)


def rwkv_output(y, f, p):
    B, T = y.shape[:2]
    mu = jnp.mean(y, axis=-1, keepdims=True)
    var = jnp.mean(jnp.square(y - mu), axis=-1, keepdims=True)
    yn = ((y - mu) * lax.rsqrt(var + GN_EPS)).reshape(B, T, RWKV_WIDTH) * p["gn_w"] + p["gn_b"]
    k_sum = f["k"].sum(axis=2)
    bonus = jnp.sum(f["r"] * p["r_k"] * k_sum, axis=-1, keepdims=True) * f["v"]
    o = (yn + bonus.reshape(B, T, RWKV_WIDTH)) * f["g"]
    return o.astype(f["g"].dtype) @ p["w_rwkv_o"]


def axial_rope_angles(n_tokens):
    rows = n_tokens // GRID_W
    row = jnp.broadcast_to(jnp.arange(rows)[:, None], (rows, GRID_W)).reshape(-1).astype(jnp.float32)
    col = jnp.broadcast_to(jnp.arange(GRID_W)[None, :], (rows, GRID_W)).reshape(-1).astype(jnp.float32)
    inv_freq = ROPE_THETA ** (-jnp.arange(0, ROPE_AXIS, 2, dtype=jnp.float32) / ROPE_AXIS)
    return row[:, None] * inv_freq, col[:, None] * inv_freq


def rotate_half(t, ang):
    t1, t2 = jnp.split(t, 2, axis=-1)
    cos = jnp.cos(ang)[:, None, :].astype(t.dtype)
    sin = jnp.sin(ang)[:, None, :].astype(t.dtype)
    return jnp.concatenate([t1 * cos - t2 * sin, t2 * cos + t1 * sin], axis=-1)


def apply_axial_rope(t, angles):
    ang_row, ang_col = angles
    t_nope, t_row, t_col = jnp.split(t, (QK_NOPE, QK_NOPE + ROPE_AXIS), axis=-1)
    return jnp.concatenate([t_nope, rotate_half(t_row, ang_row), rotate_half(t_col, ang_col)], axis=-1)


def mla_qkv(z, p, angles):
    B, T, _ = z.shape
    c_q, c_kv, k_rope = jnp.split(z, (Q_LORA, Q_LORA + KV_LORA), axis=-1)
    q = (rms_norm(c_q, p["g_cq"]) @ p["w_uq"]).reshape(B, T, MLA_HEADS, QK_HEAD)
    kv = (rms_norm(c_kv, p["g_ckv"]) @ p["w_ukv"]).reshape(B, T, MLA_HEADS, QK_NOPE + V_HEAD)
    k_nope, v = jnp.split(kv, (QK_NOPE,), axis=-1)
    k = jnp.concatenate([k_nope, jnp.broadcast_to(k_rope[:, :, None, :], (B, T, MLA_HEADS, QK_ROPE))], axis=-1)
    q = rms_norm(q, p["g_qn"])
    k = rms_norm(k, p["g_kn"])
    if angles is not None:
        q = apply_axial_rope(q, angles)
        k = apply_axial_rope(k, angles)
    return q, k, v


def block_attention(q, k, v):
    B, T, H, Dk = q.shape
    scale = Dk ** -0.5
    qb = q.reshape(B, T // Q_BLOCK, Q_BLOCK, H, Dk).transpose(1, 0, 2, 3, 4)

    def one_block(q_blk):
        s = jnp.einsum("bqhd,bkhd->bhqk", q_blk, k).astype(jnp.float32) * scale
        pr = jax.nn.softmax(s, axis=-1)
        return jnp.einsum("bhqk,bkhd->bqhd", pr.astype(v.dtype), v)

    o = lax.map(one_block, qb)
    return o.transpose(1, 0, 2, 3, 4).reshape(B, T, H * v.shape[-1])


def fourier_mix(z):
    B, T, _ = z.shape
    zg = z.astype(jnp.float32).reshape(B, T, FNO_GROUPS, FNO_GROUP_DIM)
    y = jnp.fft.fft2(zg, axes=(1, 3), norm="ortho").real
    return y.reshape(B, T, FNO_WIDTH).astype(z.dtype)


def merge_branches(z_gate, a_o, b_o, c_o, w_out):
    B, T, _ = z_gate.shape
    g = jax.nn.sigmoid(z_gate.reshape(B, T, N_BRANCH, D_MODEL))
    return (g[:, :, 0] * a_o + g[:, :, 1] * b_o + g[:, :, 2] * c_o) @ w_out


def swiglu(h, w_in, w_out):
    gate, up = jnp.split(h @ w_in, 2, axis=-1)
    return (jax.nn.silu(gate) * up) @ w_out


def setup_inputs(seed: int = 0) -> dict:
    key = jax.random.key(seed)
    ks = iter(jax.random.split(key, 64))
    L, D = DEPTH, D_MODEL
    f32 = jnp.float32
    nrm = lambda shape, s: jax.random.normal(next(ks), shape, f32) * s
    uni = lambda shape, lo, hi: jax.random.uniform(next(ks), shape, f32, lo, hi)
    return {
        "x": nrm((BATCH, SEQ, D), 1.0),
        "c": nrm((BATCH, D), 1.0),
        "ctx": nrm((BATCH, CTX_LEN, D), 1.0),
        "c_ctx": nrm((D,), 1.0),
        "w_mod": nrm((L, D, 6 * D), 0.02),
        "b_mod": nrm((L, 6 * D), 0.01),
        "g_norm1": 1.0 + nrm((L, D), 0.02),
        "w_in": nrm((L, D, N_IN), D ** -0.5),
        "mu_prev": uni((L, N_RWKV_IN), 0.0, 0.5),
        "mu_next": uni((L, N_RWKV_IN), 0.0, 0.5),
        "w0": uni((L, N_DIR, RWKV_WIDTH), -5.0, 1.0),
        "w2": nrm((L, N_DIR, DECAY_LORA, RWKV_WIDTH), 0.1 * DECAY_LORA ** -0.5),
        "a0": nrm((L, N_DIR, RWKV_WIDTH), 0.1),
        "a2": nrm((L, N_DIR, AAA_LORA, RWKV_WIDTH), 0.5 * AAA_LORA ** -0.5),
        "k_k": 0.85 + nrm((L, RWKV_WIDTH), 0.02),
        "k_a": 1.0 + nrm((L, RWKV_WIDTH), 0.02),
        "r_k": nrm((L, RWKV_HEADS, RWKV_HEAD_DIM), 0.1),
        "g2": nrm((L, GATE_LORA, RWKV_WIDTH), GATE_LORA ** -0.5),
        "gn_w": 1.0 + nrm((L, RWKV_WIDTH), 0.02),
        "gn_b": nrm((L, RWKV_WIDTH), 0.02),
        "w_rwkv_o": nrm((L, RWKV_WIDTH, D), RWKV_WIDTH ** -0.5),
        "g_cq": 1.0 + nrm((L, Q_LORA), 0.02),
        "g_ckv": 1.0 + nrm((L, KV_LORA), 0.02),
        "w_uq": nrm((L, Q_LORA, MLA_HEADS * QK_HEAD), Q_LORA ** -0.5),
        "w_ukv": nrm((L, KV_LORA, MLA_HEADS * (QK_NOPE + V_HEAD)), KV_LORA ** -0.5),
        "g_qn": 1.0 + nrm((L, QK_HEAD), 0.02),
        "g_kn": 1.0 + nrm((L, QK_HEAD), 0.02),
        "w_mla_o": nrm((L, MLA_WIDTH, D), MLA_WIDTH ** -0.5),
        "w_fno": nrm((L, FNO_WIDTH, D), FNO_WIDTH ** -0.5),
        "w_out": nrm((L, D, D), D ** -0.5),
        "g_norm2": 1.0 + nrm((L, D), 0.02),
        "w_ffn_in": nrm((L, D, 2 * FFN_HIDDEN), D ** -0.5),
        "w_ffn_out": nrm((L, FFN_HIDDEN, D), FFN_HIDDEN ** -0.5),
    }


def reference(x, c, ctx, c_ctx, w_mod, b_mod, g_norm1, w_in, mu_prev, mu_next, w0, w2, a0, a2,
              k_k, k_a, r_k, g2, gn_w, gn_b, w_rwkv_o, g_cq, g_ckv, w_uq, w_ukv, g_qn, g_kn,
              w_mla_o, w_fno, w_out, g_norm2, w_ffn_in, w_ffn_out):
    layer_params = dict(w_mod=w_mod, b_mod=b_mod, g_norm1=g_norm1, w_in=w_in, mu_prev=mu_prev,
                        mu_next=mu_next, w0=w0, w2=w2, a0=a0, a2=a2, k_k=k_k, k_a=k_a, r_k=r_k,
                        g2=g2, gn_w=gn_w, gn_b=gn_b, w_rwkv_o=w_rwkv_o, g_cq=g_cq, g_ckv=g_ckv,
                        w_uq=w_uq, w_ukv=w_ukv, g_qn=g_qn, g_kn=g_kn, w_mla_o=w_mla_o, w_fno=w_fno,
                        w_out=w_out, g_norm2=g_norm2, w_ffn_in=w_ffn_in, w_ffn_out=w_ffn_out)
    B, S, _ = x.shape
    angles = axial_rope_angles(S)
    zero_state = jnp.zeros((B, RWKV_HEADS, RWKV_HEAD_DIM, RWKV_HEAD_DIM), jnp.float32)
    cs = ctx
    for layer in range(DEPTH):
        p = {name: arr[layer] for name, arr in layer_params.items()}
        last = layer == DEPTH - 1
        mod_x = [m[:, None, :] for m in jnp.split(jax.nn.silu(c) @ p["w_mod"] + p["b_mod"], 6, axis=-1)]
        mod_c = jnp.split(jax.nn.silu(c_ctx) @ p["w_mod"] + p["b_mod"], 6, axis=-1)

        hc = modulate(rms_norm(cs, p["g_norm1"]), mod_c[0], mod_c[1])
        hx = modulate(rms_norm(x, p["g_norm1"]), mod_x[0], mod_x[1])
        zr_c, zm_c, zf_c, zg_c = jnp.split(hc @ p["w_in"], IN_SPLITS, axis=-1)
        zr_x, zm_x, zf_x, zg_x = jnp.split(hx @ p["w_in"], IN_SPLITS, axis=-1)

        fc = rwkv_features(zr_c, p)
        fx = rwkv_features(zr_x, p)
        s_fwd_c, y_fwd_c = rwkv_scan(zero_state, fc, 0, reverse=False)
        s_bwd_c, y_bwd_c = rwkv_scan(zero_state, fc, 1, reverse=True)
        _, y_fwd_x = rwkv_scan(s_fwd_c, fx, 0, reverse=False)
        _, y_bwd_x = rwkv_scan(s_bwd_c, fx, 1, reverse=True)
        a_x = rwkv_output(y_fwd_x + y_bwd_x, fx, p)

        q_c, k_c, v_c = mla_qkv(zm_c, p, None)
        q_x, k_x, v_x = mla_qkv(zm_x, p, angles)
        b_x = block_attention(q_x, jnp.concatenate([k_c, k_x], axis=1),
                              jnp.concatenate([v_c, v_x], axis=1)) @ p["w_mla_o"]

        f_x = fourier_mix(zf_x) @ p["w_fno"]

        x_mid = x + mod_x[2] * merge_branches(zg_x, a_x, b_x, f_x, p["w_out"])
        hx2 = modulate(rms_norm(x_mid, p["g_norm2"]), mod_x[3], mod_x[4])
        x_new = x_mid + mod_x[5] * swiglu(hx2, p["w_ffn_in"], p["w_ffn_out"])

        if not last:
            a_c = rwkv_output(y_fwd_c + y_bwd_c, fc, p)
            b_c = block_attention(q_c, k_c, v_c) @ p["w_mla_o"]
            f_c = fourier_mix(zf_c) @ p["w_fno"]
            c_mid = cs + mod_c[2] * merge_branches(zg_c, a_c, b_c, f_c, p["w_out"])
            hc2 = modulate(rms_norm(c_mid, p["g_norm2"]), mod_c[3], mod_c[4])
            cs = c_mid + mod_c[5] * swiglu(hc2, p["w_ffn_in"], p["w_ffn_out"])
        x = x_new
    return x
```

```cpp
#include <hip/hip_runtime.h>
#include <hip/hip_cooperative_groups.h>
#include <stdint.h>
#include <stdio.h>
namespace cg = cooperative_groups;

#ifndef SINGLE
#define SINGLE 1
#endif

#ifndef ONLYP
#define ONLYP -1
#endif
#define PON(x) (ONLYP < 0 || ONLYP == (x))

typedef unsigned short bf16_t;
typedef __attribute__((ext_vector_type(8))) short bf16x8;
typedef __attribute__((ext_vector_type(16))) float f32x16;
typedef __attribute__((ext_vector_type(4))) unsigned int u32x4;

#define NX 16384
#define NCX 1024
#define NTOK 17408
#define NPH 29
#define LDS_BYTES 77824

static constexpr size_t UU = 17825792ull;
static constexpr size_t OFF_HBUF = 0;
static constexpr size_t OFF_RKV = 2 * UU;
static constexpr size_t OFF_KK = 5 * UU;
static constexpr size_t OFF_ZR = 6 * UU;
static constexpr size_t OFF_LORA = 12 * UU + UU / 4;
static constexpr size_t OFF_LD = 6 * UU;
static constexpr size_t OFF_A = 8 * UU;
static constexpr size_t OFF_G = 10 * UU;
static constexpr size_t OFF_YF = 11 * UU;
static constexpr size_t OFF_YB = 12 * UU;
static constexpr size_t OFF_RWO = 5 * UU;
static constexpr size_t OFF_ZF = 2 * UU;
static constexpr size_t OFF_ZM = 3 * UU;
static constexpr size_t OFF_Q = 6 * UU;
static constexpr size_t OFF_K = 7 * UU + UU / 2;
static constexpr size_t OFF_VT = 9 * UU;
static constexpr size_t OFF_FFT1 = 10 * UU;
static constexpr size_t OFF_ATT = 12 * UU;
static constexpr size_t OFF_Y = 3 * UU;
static constexpr size_t OFF_M = 6 * UU;
static constexpr size_t OFF_ACT = 2 * UU;
static constexpr size_t OFF_WFFN = 9 * UU;
static constexpr size_t OFF_WMIX = 13 * UU;
static constexpr size_t WE_IN = 0;
static constexpr size_t WE_W2 = WE_IN + 6048ull * 1024;
static constexpr size_t WE_A2 = WE_W2 + 65536;
static constexpr size_t WE_G2 = WE_A2 + 65536;
static constexpr size_t WE_RO = WE_G2 + 65536;
static constexpr size_t WE_MO = WE_RO + 524288;
static constexpr size_t WE_FO = WE_MO + 524288;
static constexpr size_t WE_UQ = WE_FO + 1048576;
static constexpr size_t WE_UKV = WE_UQ + 294912;
static constexpr size_t WE_OUT = WE_UKV + 131072;
static constexpr size_t WE_END = WE_OUT + 1048576;
static constexpr size_t WF_IN = 0;
static constexpr size_t WF_OUT = 5632ull * 1024;
static constexpr size_t OFF_SMALL = OFF_WMIX + WE_END * 2;
static constexpr size_t OFF_CS = OFF_SMALL;
static constexpr size_t OFF_MOD = OFF_CS + 4194304;
static constexpr size_t OFF_TW = OFF_MOD + 245760;
static constexpr size_t OFF_F1 = OFF_TW + 32768;
static constexpr size_t OFF_F2 = OFF_F1 + 16384;
static constexpr size_t OFF_F256 = OFF_F2 + 32768;
static constexpr size_t OFF_ROPE = OFF_F256 + 262144;
static constexpr size_t OFF_END = OFF_ROPE + 524288;

struct Cx {
  char* ws;
  float* out;
  int tid;
};

struct Params {
  const float* in[33];
  float* out;
  char* ws;
};

__device__ __forceinline__ float bf2f(bf16_t v) { return __uint_as_float(((uint32_t)v) << 16); }
__device__ __forceinline__ bf16_t f2bf(float f) {
  uint32_t u = __float_as_uint(f);
  u += 0x7fffu + ((u >> 16) & 1u);
  return (bf16_t)(u >> 16);
}
__device__ __forceinline__ uint32_t pack2(float a, float b) { return (uint32_t)f2bf(a) | ((uint32_t)f2bf(b) << 16); }
__device__ __forceinline__ float lo16(uint32_t u) { return __uint_as_float(u << 16); }
__device__ __forceinline__ float hi16(uint32_t u) { return __uint_as_float(u & 0xffff0000u); }
__device__ __forceinline__ float sigmoidf_(float v) { return 1.f / (1.f + __expf(-v)); }
__device__ __forceinline__ int mod_row(int row) { return row < NX ? (row >> 12) : 4; }

template <int BM, int BN, int WGM, int WGN, bool TRB>
struct Gemm {
  static constexpr int WM = BM / WGM, WN = BN / WGN, MT = WM / 32, NTL = WN / 32;
  static constexpr int CA = BM * 8 / 256, CB = BN * 8 / 256;
  static constexpr int SA_ELEMS = BM * 72, SB_ELEMS = BN * 72;

  __device__ static __forceinline__ void zero(f32x16 (&acc)[MT][NTL]) {
#pragma unroll
    for (int i = 0; i < MT; ++i)
#pragma unroll
      for (int j = 0; j < NTL; ++j)
#pragma unroll
        for (int r = 0; r < 16; ++r) acc[i][j][r] = 0.f;
  }

  __device__ static __forceinline__ void run(const Cx& X, const bf16_t* __restrict__ A, int lda, const bf16_t* __restrict__ B, int ldb,
                                             int K, char* smem, f32x16 (&acc)[MT][NTL]) {
    const int tid = X.tid, lane = tid & 63, w = tid >> 6;
    const int wm = w / WGN, wn = w % WGN;
    bf16_t* sA = (bf16_t*)smem;
    bf16_t* sB = sA + 2 * SA_ELEMS;
    uint4 ra0, ra1, ra2, ra3, rb0, rb1, rb2 = make_uint4(0, 0, 0, 0), rb3 = make_uint4(0, 0, 0, 0);
    static_assert(CA == 4 && CB >= 2 && CB <= 4, "tile loader shape");
    const int nk = K >> 6;
#define LDA_(i, k0) (*(const uint4*)(A + (size_t)((tid + 256 * (i)) >> 3) * lda + (k0) + ((tid + 256 * (i)) & 7) * 8))
#define LDB_(i, k0)                                                                                                        \
  (!TRB ? *(const uint4*)(B + (size_t)((tid + 256 * (i)) >> 3) * ldb + (k0) + ((tid + 256 * (i)) & 7) * 8)                 \
        : *(const uint4*)(B + (size_t)((k0) + (tid + 256 * (i)) / (BN / 8)) * ldb + ((tid + 256 * (i)) % (BN / 8)) * 8))
#define GLOAD(k0)                                                                      \
  {                                                                                    \
    ra0 = LDA_(0, k0); ra1 = LDA_(1, k0); ra2 = LDA_(2, k0); ra3 = LDA_(3, k0);        \
    rb0 = LDB_(0, k0); rb1 = LDB_(1, k0);                                              \
    if (CB > 2) rb2 = LDB_(2, k0);                                                     \
    if (CB > 3) rb3 = LDB_(3, k0);                                                     \
  }
#define STA_(i, buf, v) *(uint4*)(sA + (buf)*SA_ELEMS + ((tid + 256 * (i)) >> 3) * 72 + ((tid + 256 * (i)) & 7) * 8) = v
#define STB_(i, buf, v)                                                                                       \
  {                                                                                                           \
    const int c_ = tid + 256 * (i);                                                                           \
    if (!TRB) *(uint4*)(sB + (buf)*SB_ELEMS + (c_ >> 3) * 72 + (c_ & 7) * 8) = v;                             \
    else {                                                                                                    \
      bf16_t* p = sB + (buf)*SB_ELEMS + (c_ % (BN / 8)) * 8 * 72 + c_ / (BN / 8);                             \
      p[0] = (bf16_t)(v.x & 0xffff); p[72] = (bf16_t)(v.x >> 16);                                             \
      p[144] = (bf16_t)(v.y & 0xffff); p[216] = (bf16_t)(v.y >> 16);                                          \
      p[288] = (bf16_t)(v.z & 0xffff); p[360] = (bf16_t)(v.z >> 16);                                          \
      p[432] = (bf16_t)(v.w & 0xffff); p[504] = (bf16_t)(v.w >> 16);                                          \
    }                                                                                                         \
  }
#define SSTORE(buf)                                                                    \
  {                                                                                    \
    STA_(0, buf, ra0); STA_(1, buf, ra1); STA_(2, buf, ra2); STA_(3, buf, ra3);        \
    STB_(0, buf, rb0); STB_(1, buf, rb1);                                              \
    if (CB > 2) STB_(2, buf, rb2);                                                     \
    if (CB > 3) STB_(3, buf, rb3);                                                     \
  }
    GLOAD(0);
    SSTORE(0);
    __syncthreads();
    for (int kt = 0; kt < nk; ++kt) {
      const int buf = kt & 1;
      if (kt + 1 < nk) GLOAD((kt + 1) * 64);
      const bf16_t* pa = sA + buf * SA_ELEMS + (wm * WM + (lane & 31)) * 72 + (lane >> 5) * 8;
      const bf16_t* pb = sB + buf * SB_ELEMS + (wn * WN + (lane & 31)) * 72 + (lane >> 5) * 8;
#pragma unroll
      for (int ks = 0; ks < 4; ++ks) {
        bf16x8 af[MT], bfr[NTL];
#pragma unroll
        for (int i = 0; i < MT; ++i) af[i] = *(const bf16x8*)(pa + i * 32 * 72 + ks * 16);
#pragma unroll
        for (int j = 0; j < NTL; ++j) bfr[j] = *(const bf16x8*)(pb + j * 32 * 72 + ks * 16);
#pragma unroll
        for (int i = 0; i < MT; ++i)
#pragma unroll
          for (int j = 0; j < NTL; ++j) acc[i][j] = __builtin_amdgcn_mfma_f32_32x32x16_bf16(af[i], bfr[j], acc[i][j], 0, 0, 0);
      }
      if (kt + 1 < nk) SSTORE(buf ^ 1);
      __syncthreads();
    }
#undef GLOAD
#undef SSTORE
#undef LDA_
#undef LDB_
#undef STA_
#undef STB_
  }
};

typedef Gemm<128, 128, 2, 2, false> G22;
typedef Gemm<128, 128, 2, 2, true> G22T;
typedef Gemm<128, 64, 2, 2, false> GMG;
typedef Gemm<128, 96, 4, 1, false> GQ;
typedef Gemm<128, 128, 4, 1, false> GKV;

#define ROW_OF(reg) (((reg) & 3) + 8 * ((reg) >> 2) + 4 * (lane >> 5))

__device__ void job_mod(const Params& P, const Cx& X, char* smem, int job) {
  float* sc = (float*)smem;
  const int tid = X.tid;
  for (int i = tid; i < 5 * 1024; i += 256) {
    int r = i >> 10, k = i & 1023;
    float v = r < 4 ? P.in[1][r * 1024 + k] : P.in[3][k];
    sc[i] = v / (1.f + expf(-v));
  }
  __syncthreads();
  const int l = job / 96, n = (job % 96) * 64 + (tid & 63), w = tid >> 6;
  const float* W = P.in[4] + (size_t)l * 1024 * 6144;
  float a0 = 0, a1 = 0, a2 = 0, a3 = 0, a4 = 0;
#pragma unroll 4
  for (int k = w * 256; k < w * 256 + 256; ++k) {
    float wv = W[(size_t)k * 6144 + n];
    a0 += sc[k] * wv; a1 += sc[1024 + k] * wv; a2 += sc[2048 + k] * wv; a3 += sc[3072 + k] * wv; a4 += sc[4096 + k] * wv;
  }
  float* red = sc + 5 * 1024;
  red[(w * 5 + 0) * 64 + (tid & 63)] = a0; red[(w * 5 + 1) * 64 + (tid & 63)] = a1; red[(w * 5 + 2) * 64 + (tid & 63)] = a2;
  red[(w * 5 + 3) * 64 + (tid & 63)] = a3; red[(w * 5 + 4) * 64 + (tid & 63)] = a4;
  __syncthreads();
  float* modv = (float*)(X.ws + OFF_MOD);
  for (int i = tid; i < 320; i += 256) {
    int r = i >> 6, c = i & 63;
    int nn = (job % 96) * 64 + c;
    float s = red[(0 * 5 + r) * 64 + c] + red[(1 * 5 + r) * 64 + c] + red[(2 * 5 + r) * 64 + c] + red[(3 * 5 + r) * 64 + c];
    modv[(size_t)(l * 5 + r) * 6144 + nn] = s + P.in[5][l * 6144 + nn];
  }
  __syncthreads();
}

__device__ void job_tables(const Params& P, const Cx& X, int job) {
  float2* tw = (float2*)(X.ws + OFF_TW);
  bf16_t* F1 = (bf16_t*)(X.ws + OFF_F1);
  bf16_t* F2 = (bf16_t*)(X.ws + OFF_F2);
  bf16_t* F256 = (bf16_t*)(X.ws + OFF_F256);
  float2* rope = (float2*)(X.ws + OFF_ROPE);
  for (int e = job * 4096 + X.tid; e < job * 4096 + 4096; e += 256) {
    int i = e;
    if (i < 4096) { tw[i] = make_float2(cospif(i / 2048.f), sinpif(i / 2048.f)); continue; }
    i -= 4096;
    if (i < 8192) {
      int R = i >> 6, t1 = i & 63;
      int f1 = (R >> 6) * 32 + (R & 31);
      int ph = (f1 * t1) & 63;
      F1[i] = f2bf(((R >> 5) & 1) ? -sinpif(ph / 32.f) : cospif(ph / 32.f));
      continue;
    }
    i -= 8192;
    if (i < 16384) {
      int m = i >> 7, k = i & 127;
      int f2 = m & 63, q = m >> 6, t2 = k & 63, p = k >> 6;
      int ph = (f2 * t2) & 63;
      float c = cospif(ph / 32.f), s = sinpif(ph / 32.f);
      float v = (q == 0) ? (p == 0 ? c : s) : (p == 0 ? -s : c);
      F2[i] = f2bf(v);
      continue;
    }
    i -= 16384;
    if (i < 131072) {
      int m = i >> 8, t = i & 255;
      int f = m & 255, q = m >> 8;
      int ph = (f * t) & 255;
      F256[i] = f2bf(q == 0 ? cospif(ph / 128.f) : -sinpif(ph / 128.f));
      continue;
    }
    i -= 131072;
    if (i < 65536) {
      int t = i >> 4, j = i & 15;
      float invf = powf(10000.f, -(float)(j & 7) / 8.f);
      float pos = (j < 8) ? (float)(t >> 6) : (float)(t & 63);
      float ang = pos * invf;
      rope[i] = make_float2(cosf(ang), sinf(ang));
    }
  }
}

__device__ void cw_tile(const Cx& X, const float* __restrict__ src, int N, int lds_, bf16_t* __restrict__ dst, int ldd, const float* scale,
                        int perm, int tk, int tn, char* smem) {
  float* tile = (float*)smem;
  const int tid = X.tid;
  const int c = tid & 63, r0 = tid >> 6;
  const int ng = tn * 64 + c;
#pragma unroll 4
  for (int i = 0; i < 16; ++i) {
    int r = r0 + 4 * i;
    float v = (ng < N) ? src[(size_t)(tk * 64 + r) * lds_ + ng] : 0.f;
    if (scale) v *= scale[tk * 64 + r];
    tile[r * 65 + c] = v;
  }
  __syncthreads();
#pragma unroll 4
  for (int i = 0; i < 16; ++i) {
    int nn = r0 + 4 * i;
    int n2 = tn * 64 + nn;
    if (n2 < N) {
      int drow = n2;
      if (perm) {
        int u = n2 < 2816 ? n2 : n2 - 2816;
        drow = (u >> 5) * 64 + (n2 < 2816 ? 0 : 32) + (u & 31);
      }
      dst[(size_t)drow * ldd + tk * 64 + c] = f2bf(tile[c * 65 + nn]);
    }
  }
  __syncthreads();
}

__device__ void fold_job(const Params& P, const Cx& X, int layer, int fj, char* smem) {
  float* wt = (float*)smem;
  float* ct = wt + 4096;
  const int tid = X.tid;
  const int g = fj >> 4, n0 = (fj & 15) * 64;
  const float* src = P.in[28] + (size_t)layer * 512 * 1024;
  for (int i = tid; i < 4096; i += 256) wt[i] = src[(size_t)(g * 64 + (i >> 6)) * 1024 + n0 + (i & 63)];
  if (tid < 64) { ct[tid] = cospif(tid / 32.f); ct[64 + tid] = sinpif(tid / 32.f); }
  __syncthreads();
  bf16_t* dst = (bf16_t*)(X.ws + OFF_WMIX) + WE_FO;
  const int c = tid & 63, nq = tid >> 6;
#pragma unroll 1
  for (int ni = 0; ni < 16; ++ni) {
    int n = nq * 16 + ni;
    float sr = 0.f, si = 0.f;
#pragma unroll 4
    for (int cp = 0; cp < 64; ++cp) {
      float wv = wt[cp * 64 + n];
      int ph = (c * cp) & 63;
      sr += ct[ph] * wv;
      si += ct[64 + ph] * wv;
    }
    dst[(size_t)(n0 + n) * 1024 + g * 64 + c] = f2bf(sr * (1.f / 512.f));
    dst[(size_t)(n0 + n) * 1024 + 512 + g * 64 + c] = f2bf(si * (1.f / 512.f));
  }
  __syncthreads();
}

#define NCW1 2312
__device__ void cw_mixer_job(const Params& P, const Cx& X, int layer, int j, char* smem) {
  bf16_t* W = (bf16_t*)(X.ws + OFF_WMIX);
  if (j < 1520) { cw_tile(X, P.in[7] + (size_t)layer * 1024 * 6048, 6048, 6048, W + WE_IN, 1024, nullptr, 0, j / 95, j % 95, smem); return; }
  j -= 1520;
  if (j < 16) { int d = j >> 3; cw_tile(X, P.in[11] + (size_t)(layer * 2 + d) * 64 * 512, 512, 512, W + WE_W2 + d * 32768, 64, nullptr, 0, 0, j & 7, smem); return; }
  j -= 16;
  if (j < 16) { int d = j >> 3; cw_tile(X, P.in[13] + (size_t)(layer * 2 + d) * 64 * 512, 512, 512, W + WE_A2 + d * 32768, 64, nullptr, 0, 0, j & 7, smem); return; }
  j -= 16;
  if (j < 16) { cw_tile(X, P.in[17] + (size_t)layer * 128 * 512, 512, 512, W + WE_G2, 128, nullptr, 0, j >> 3, j & 7, smem); return; }
  j -= 16;
  if (j < 128) { cw_tile(X, P.in[20] + (size_t)layer * 512 * 1024, 1024, 1024, W + WE_RO, 512, nullptr, 0, j >> 4, j & 15, smem); return; }
  j -= 128;
  if (j < 128) { cw_tile(X, P.in[27] + (size_t)layer * 512 * 1024, 1024, 1024, W + WE_MO, 512, nullptr, 0, j >> 4, j & 15, smem); return; }
  j -= 128;
  if (j < 72) { cw_tile(X, P.in[23] + (size_t)layer * 384 * 768, 768, 768, W + WE_UQ, 384, P.in[21] + layer * 384, 0, j / 12, j % 12, smem); return; }
  j -= 72;
  if (j < 32) { cw_tile(X, P.in[24] + (size_t)layer * 128 * 1024, 1024, 1024, W + WE_UKV, 128, P.in[22] + layer * 128, 0, j >> 4, j & 15, smem); return; }
  j -= 32;
  if (j < 256) { cw_tile(X, P.in[29] + (size_t)layer * 1024 * 1024, 1024, 1024, W + WE_OUT, 1024, nullptr, 0, j >> 4, j & 15, smem); return; }
  j -= 256;
  fold_job(P, X, layer, j, smem);
}
#define NCW2 2112
__device__ void cw_ffn_job(const Params& P, const Cx& X, int layer, int j, char* smem) {
  bf16_t* W = (bf16_t*)(X.ws + OFF_WFFN);
  if (j < 1408) { cw_tile(X, P.in[31] + (size_t)layer * 1024 * 5632, 5632, 5632, W + WF_IN, 1024, nullptr, 1, j / 88, j % 88, smem); return; }
  j -= 1408;
  cw_tile(X, P.in[32] + (size_t)layer * 2816 * 1024, 1024, 1024, W + WF_OUT, 2816, nullptr, 0, j >> 4, j & 15, smem);
}

__device__ void norm_job(const Params& P, const Cx& X, int layer, int which, int job) {
  const int lane = X.tid & 63, w = X.tid >> 6;
  const int row = job * 4 + w;
  const float* src;
  if (which == 0) {
    if (row < NX) src = (layer == 0 ? P.in[0] : X.out) + (size_t)row * 1024;
    else src = (layer == 0 ? P.in[2] : (const float*)(X.ws + OFF_CS)) + (size_t)(row - NX) * 1024;
  } else {
    if (row < NX) src = X.out + (size_t)row * 1024;
    else src = (const float*)(X.ws + OFF_CS) + (size_t)(row - NX) * 1024;
  }
  const float* g = (which == 0 ? P.in[6] : P.in[30]) + layer * 1024;
  const float* modv = (const float*)(X.ws + OFF_MOD) + (size_t)(layer * 5 + mod_row(row)) * 6144;
  const float* shift = modv + (which == 0 ? 0 : 3072);
  const float* scale = modv + (which == 0 ? 1024 : 4096);
  float4 v[4];
  float ss = 0.f;
#pragma unroll
  for (int i = 0; i < 4; ++i) {
    v[i] = ((const float4*)src)[lane + 64 * i];
    ss += v[i].x * v[i].x + v[i].y * v[i].y + v[i].z * v[i].z + v[i].w * v[i].w;
  }
#pragma unroll
  for (int o = 32; o >= 1; o >>= 1) ss += __shfl_xor(ss, o);
  const float rstd = rsqrtf(ss * (1.f / 1024.f) + 1e-6f);
  bf16_t* dst = (bf16_t*)(X.ws + OFF_HBUF) + (size_t)row * 1024;
#pragma unroll
  for (int i = 0; i < 4; ++i) {
    int col = 4 * (lane + 64 * i);
    float4 gg = *(const float4*)(g + col), sh = *(const float4*)(shift + col), sc = *(const float4*)(scale + col);
    float y0 = v[i].x * rstd * gg.x * (1.f + sc.x) + sh.x;
    float y1 = v[i].y * rstd * gg.y * (1.f + sc.y) + sh.y;
    float y2 = v[i].z * rstd * gg.z * (1.f + sc.z) + sh.z;
    float y3 = v[i].w * rstd * gg.w * (1.f + sc.w) + sh.w;
    uint2 o;
    o.x = pack2(y0, y1); o.y = pack2(y2, y3);
    *(uint2*)(dst + col) = o;
  }
}

__device__ void g1a_tile(const Params& P, const Cx& X, int t, char* smem) {
  const int lane = X.tid & 63, w = X.tid >> 6;
  const int mt = t % 136, nt = t / 136;
  const int m0 = mt * 128, n0 = nt * 128;
  f32x16 acc[2][2];
  G22::zero(acc);
  G22::run(X, (const bf16_t*)(X.ws + OFF_HBUF) + (size_t)m0 * 1024, 1024, (const bf16_t*)(X.ws + OFF_WMIX) + WE_IN + (size_t)n0 * 1024, 1024, 1024, smem, acc);
  bf16_t* zr = (bf16_t*)(X.ws + OFF_ZR);
  const int row0 = m0 + (w >> 1) * 64, col0 = n0 + (w & 1) * 64;
#pragma unroll
  for (int i = 0; i < 2; ++i)
#pragma unroll
    for (int j = 0; j < 2; ++j)
#pragma unroll
      for (int r = 0; r < 16; ++r) {
        int row = row0 + i * 32 + ROW_OF(r), col = col0 + j * 32 + (lane & 31);
        zr[(size_t)row * 1920 + col] = f2bf(acc[i][j][r]);
      }
}
__device__ void g1b_tile(const Params& P, const Cx& X, int t, char* smem) {
  const int lane = X.tid & 63, w = X.tid >> 6;
  const int mt = t % 136, nt = t / 136;
  const int m0 = mt * 128, n0 = nt * 128;
  f32x16 acc[2][2];
  G22::zero(acc);
  G22::run(X, (const bf16_t*)(X.ws + OFF_HBUF) + (size_t)m0 * 1024, 1024, (const bf16_t*)(X.ws + OFF_WMIX) + WE_IN + (size_t)(1920 + n0) * 1024, 1024, 1024, smem, acc);
  bf16_t* zm = (bf16_t*)(X.ws + OFF_ZM);
  bf16_t* zf = (bf16_t*)(X.ws + OFF_ZF);
  const int row0 = m0 + (w >> 1) * 64, col0 = n0 + (w & 1) * 64;
#pragma unroll
  for (int i = 0; i < 2; ++i)
#pragma unroll
    for (int j = 0; j < 2; ++j)
#pragma unroll
      for (int r = 0; r < 16; ++r) {
        int row = row0 + i * 32 + ROW_OF(r), col = col0 + j * 32 + (lane & 31);
        bf16_t v = f2bf(acc[i][j][r]);
        if (col < 544) zm[(size_t)row * 544 + col] = v;
        else if (col < 1056) zf[(size_t)row * 512 + (col - 544)] = v;
      }
}

__device__ void r1a_row(const Params& P, const Cx& X, int layer, int row) {
  const int tid = X.tid;
  const int ch = tid < 240 ? tid : 239;
  const int col0 = ch * 8;
  const bf16_t* zr = (const bf16_t*)(X.ws + OFF_ZR);
  bool hp, hn;
  if (row < NX) { int t = row & 4095; hp = t > 0; hn = t < 4095; }
  else { int j = (row - NX) & 255; hp = j > 0; hn = j < 255; }
  uint4 zc = *(const uint4*)(zr + (size_t)row * 1920 + col0);
  uint4 zp = make_uint4(0, 0, 0, 0), zn = make_uint4(0, 0, 0, 0);
  if (hp) zp = *(const uint4*)(zr + (size_t)(row - 1) * 1920 + col0);
  if (hn) zn = *(const uint4*)(zr + (size_t)(row + 1) * 1920 + col0);
  const float* mup = P.in[8] + layer * 1920 + col0;
  const float* mun = P.in[9] + layer * 1920 + col0;
  float zs[8];
  {
    const uint32_t c4[4] = {zc.x, zc.y, zc.z, zc.w}, p4[4] = {zp.x, zp.y, zp.z, zp.w}, n4[4] = {zn.x, zn.y, zn.z, zn.w};
#pragma unroll
    for (int i = 0; i < 4; ++i) {
      float c0 = lo16(c4[i]), c1 = hi16(c4[i]);
      zs[2 * i] = c0 + (lo16(p4[i]) - c0) * mup[2 * i] + (lo16(n4[i]) - c0) * mun[2 * i];
      zs[2 * i + 1] = c1 + (hi16(p4[i]) - c1) * mup[2 * i + 1] + (hi16(n4[i]) - c1) * mun[2 * i + 1];
    }
  }
  float ss = 0.f;
  float kv[8];
  const bool isk = (col0 >= 512 && col0 < 1024);
  {
    const float* kk_w = P.in[14] + layer * 512 + (isk ? col0 - 512 : 0);
#pragma unroll
    for (int i = 0; i < 8; ++i) { kv[i] = zs[i] * kk_w[i]; ss += kv[i] * kv[i]; }
  }
  ss += __shfl_xor(ss, 1); ss += __shfl_xor(ss, 2); ss += __shfl_xor(ss, 4);
  if (tid < 240) {
    uint4 o;
    if (col0 < 1536) {
      o.x = pack2(zs[0], zs[1]); o.y = pack2(zs[2], zs[3]); o.z = pack2(zs[4], zs[5]); o.w = pack2(zs[6], zs[7]);
      *(uint4*)((bf16_t*)(X.ws + OFF_RKV) + (size_t)row * 1536 + col0) = o;
      if (isk) {
        float inv = 1.f / fmaxf(sqrtf(ss), 1e-12f);
        o.x = pack2(kv[0] * inv, kv[1] * inv); o.y = pack2(kv[2] * inv, kv[3] * inv);
        o.z = pack2(kv[4] * inv, kv[5] * inv); o.w = pack2(kv[6] * inv, kv[7] * inv);
        *(uint4*)((bf16_t*)(X.ws + OFF_KK) + (size_t)row * 512 + (col0 - 512)) = o;
      }
    } else {
      float t[8];
      if (col0 < 1664) {
#pragma unroll
        for (int i = 0; i < 8; ++i) t[i] = tanhf(zs[i]);
      } else if (col0 < 1792) {
#pragma unroll
        for (int i = 0; i < 8; ++i) t[i] = zs[i];
      } else {
#pragma unroll
        for (int i = 0; i < 8; ++i) t[i] = 1.f / (1.f + expf(-zs[i]));
      }
      o.x = pack2(t[0], t[1]); o.y = pack2(t[2], t[3]); o.z = pack2(t[4], t[5]); o.w = pack2(t[6], t[7]);
      *(uint4*)((bf16_t*)(X.ws + OFF_LORA) + (size_t)row * 384 + (col0 - 1536)) = o;
    }
  }
}

__device__ void r1b_tile(const Params& P, const Cx& X, int layer, int t, char* smem) {
  const int lane = X.tid & 63, w = X.tid >> 6;
  const int mt = t % 136, rest = t / 136;
  const int nt = rest & 3, type = rest >> 2;
  const int m0 = mt * 128, n0 = nt * 128;
  const bf16_t* lora = (const bf16_t*)(X.ws + OFF_LORA) + (size_t)m0 * 384;
  const bf16_t* W = (const bf16_t*)(X.ws + OFF_WMIX);
  f32x16 acc[2][2];
  G22::zero(acc);
  if (type < 2) G22::run(X, lora + type * 64, 384, W + WE_W2 + type * 32768 + (size_t)n0 * 64, 64, 64, smem, acc);
  else if (type < 4) G22::run(X, lora + 128 + (type - 2) * 64, 384, W + WE_A2 + (type - 2) * 32768 + (size_t)n0 * 64, 64, 64, smem, acc);
  else G22::run(X, lora + 256, 384, W + WE_G2 + (size_t)n0 * 128, 128, 128, smem, acc);
  const int row0 = m0 + (w >> 1) * 64, col0 = n0 + (w & 1) * 64;
  bf16_t* ld = (bf16_t*)(X.ws + OFF_LD);
  bf16_t* ab = (bf16_t*)(X.ws + OFF_A);
  bf16_t* gb = (bf16_t*)(X.ws + OFF_G);
#pragma unroll
  for (int j = 0; j < 2; ++j) {
    const int col = col0 + j * 32 + (lane & 31);
    float bias = 0.f;
    if (type < 2) bias = P.in[10][(layer * 2 + type) * 512 + col];
    else if (type < 4) bias = P.in[12][(layer * 2 + type - 2) * 512 + col];
#pragma unroll
    for (int i = 0; i < 2; ++i)
#pragma unroll
      for (int r = 0; r < 16; ++r) {
        int row = row0 + i * 32 + ROW_OF(r);
        float v = acc[i][j][r] + bias;
        if (type < 2) ld[(size_t)row * 1024 + type * 512 + col] = f2bf(-0.60653066f / (1.f + __expf(-v)));
        else if (type < 4) ab[(size_t)row * 1024 + (type - 2) * 512 + col] = f2bf(1.f / (1.f + __expf(-v)));
        else gb[(size_t)row * 512 + col] = f2bf(v);
      }
  }
}

template <int CTRL>
__device__ __forceinline__ float dpp_f(float x) {
  return __int_as_float(__builtin_amdgcn_update_dpp(0, __float_as_int(x), CTRL, 0xf, 0xf, false));
}
__device__ __forceinline__ float red16(float x) {
  x += dpp_f<0x128>(x);
  x += dpp_f<0x124>(x);
  x += dpp_f<0x4E>(x);
  x += dpp_f<0xB1>(x);
  return x;
}
__device__ __forceinline__ int scan_tokrow(int b, int dir, int i) {
  if (i < 256) return NX + b * 256 + (dir ? 255 - i : i);
  int t = i - 256;
  return b * 4096 + (dir ? 4095 - t : t);
}
__device__ void scan_job(const Params& P, const Cx& X, int layer, int bj, char* smem) {
  const int tid = X.tid, lane = tid & 63, w = tid >> 6;
  const int s = bj >> 2, rq = bj & 3;
  const int dir = s >> 5, b = (s & 31) >> 3, h = s & 7;
  float* sv = (float*)smem;
  float* sy = sv + 2 * 16 * 6 * 64;
  const bf16_t* rkv = (const bf16_t*)(X.ws + OFF_RKV);
  const bf16_t* kkb = (const bf16_t*)(X.ws + OFF_KK);
  const bf16_t* ab = (const bf16_t*)(X.ws + OFF_A);
  const bf16_t* ldb = (const bf16_t*)(X.ws + OFF_LD);
  bf16_t* yout = (bf16_t*)(X.ws + (dir ? OFF_YB : OFF_YF));
  const int lst = tid >> 4, lch = (tid & 15) * 4;
  const float4 ka4 = *(const float4*)(P.in[15] + layer * 512 + h * 64 + lch);
  uint2 pr, pk, pv, pkk, pa, pl;
#define SLOAD(chunk)                                                          \
  {                                                                           \
    int row = scan_tokrow(b, dir, (chunk)*16 + lst);                          \
    const bf16_t* p0 = rkv + (size_t)row * 1536 + h * 64 + lch;               \
    pr = *(const uint2*)p0; pk = *(const uint2*)(p0 + 512); pv = *(const uint2*)(p0 + 1024); \
    pkk = *(const uint2*)(kkb + (size_t)row * 512 + h * 64 + lch);            \
    pa = *(const uint2*)(ab + (size_t)row * 1024 + dir * 512 + h * 64 + lch); \
    pl = *(const uint2*)(ldb + (size_t)row * 1024 + dir * 512 + h * 64 + lch);\
  }
#define SSTORE2(buf)                                                          \
  {                                                                           \
    float* d = sv + ((buf)*16 + lst) * 384 + lch;                             \
    float a0 = lo16(pa.x), a1 = hi16(pa.x), a2 = lo16(pa.y), a3 = hi16(pa.y); \
    float k0 = lo16(pk.x), k1 = hi16(pk.x), k2 = lo16(pk.y), k3 = hi16(pk.y); \
    float q0 = lo16(pkk.x), q1 = hi16(pkk.x), q2 = lo16(pkk.y), q3 = hi16(pkk.y); \
    *(float4*)(d) = make_float4(q0, q1, q2, q3);                              \
    *(float4*)(d + 64) = make_float4(__expf(lo16(pl.x)), __expf(hi16(pl.x)), __expf(lo16(pl.y)), __expf(hi16(pl.y))); \
    *(float4*)(d + 128) = make_float4(q0 * a0, q1 * a1, q2 * a2, q3 * a3);    \
    *(float4*)(d + 192) = make_float4(k0 * (1.f + (a0 - 1.f) * ka4.x), k1 * (1.f + (a1 - 1.f) * ka4.y), k2 * (1.f + (a2 - 1.f) * ka4.z), k3 * (1.f + (a3 - 1.f) * ka4.w)); \
    *(float4*)(d + 256) = make_float4(lo16(pr.x), hi16(pr.x), lo16(pr.y), hi16(pr.y)); \
    *(float4*)(d + 320) = make_float4(lo16(pv.x), hi16(pv.x), lo16(pv.y), hi16(pv.y)); \
  }
  SLOAD(0);
  SSTORE2(0);
  __syncthreads();
  const int rl = w * 4 + (lane >> 4), ci = (lane & 15) * 4;
  const int vrow = rq * 16 + rl;
  float S0 = 0.f, S1 = 0.f, S2 = 0.f, S3 = 0.f;
  for (int chunk = 0; chunk < 272; ++chunk) {
    const int buf = chunk & 1;
    if (chunk + 1 < 272) SLOAD(chunk + 1);
    const float* base = sv + buf * 16 * 384;
#pragma unroll 4
    for (int st = 0; st < 16; ++st) {
      const float* d = base + st * 384;
      float4 kk4 = *(const float4*)(d + ci);
      float4 w4 = *(const float4*)(d + 64 + ci);
      float4 b4 = *(const float4*)(d + 128 + ci);
      float4 kd4 = *(const float4*)(d + 192 + ci);
      float4 r4 = *(const float4*)(d + 256 + ci);
      float vv = d[320 + vrow];
      float sa = S0 * kk4.x + S1 * kk4.y + S2 * kk4.z + S3 * kk4.w;
      sa = -red16(sa);
      S0 = S0 * w4.x + vv * kd4.x; S1 = S1 * w4.y + vv * kd4.y; S2 = S2 * w4.z + vv * kd4.z; S3 = S3 * w4.w + vv * kd4.w;
      S0 += sa * b4.x; S1 += sa * b4.y; S2 += sa * b4.z; S3 += sa * b4.w;
      float y = S0 * r4.x + S1 * r4.y + S2 * r4.z + S3 * r4.w;
      y = red16(y);
      if ((lane & 15) == 0) sy[(buf * 16 + st) * 16 + rl] = y;
    }
    if (chunk + 1 < 272) SSTORE2(buf ^ 1);
    __syncthreads();
    {
      int st = tid >> 4, r = tid & 15;
      int row = scan_tokrow(b, dir, chunk * 16 + st);
      yout[(size_t)row * 512 + h * 64 + rq * 16 + r] = f2bf(sy[(buf * 16 + st) * 16 + r]);
    }
  }
#undef SLOAD
#undef SSTORE2
  __syncthreads();
}

__device__ void s2_job(const Params& P, const Cx& X, int layer, int job) {
  const int tid = X.tid;
  const int row = job * 4 + (tid >> 6);
  const int c0 = (tid & 63) * 8;
  const bf16_t* rkv = (const bf16_t*)(X.ws + OFF_RKV) + (size_t)row * 1536;
  uint4 ur = *(const uint4*)(rkv + c0), uk = *(const uint4*)(rkv + 512 + c0), uv = *(const uint4*)(rkv + 1024 + c0);
  uint4 ua0 = *(const uint4*)((const bf16_t*)(X.ws + OFF_A) + (size_t)row * 1024 + c0);
  uint4 ua1 = *(const uint4*)((const bf16_t*)(X.ws + OFF_A) + (size_t)row * 1024 + 512 + c0);
  uint4 ug = *(const uint4*)((const bf16_t*)(X.ws + OFF_G) + (size_t)row * 512 + c0);
  uint4 uyf = *(const uint4*)((const bf16_t*)(X.ws + OFF_YF) + (size_t)row * 512 + c0);
  uint4 uyb = *(const uint4*)((const bf16_t*)(X.ws + OFF_YB) + (size_t)row * 512 + c0);
  const uint32_t r4[4] = {ur.x, ur.y, ur.z, ur.w}, k4[4] = {uk.x, uk.y, uk.z, uk.w}, v4[4] = {uv.x, uv.y, uv.z, uv.w};
  const uint32_t a04[4] = {ua0.x, ua0.y, ua0.z, ua0.w}, a14[4] = {ua1.x, ua1.y, ua1.z, ua1.w}, g4[4] = {ug.x, ug.y, ug.z, ug.w};
  const uint32_t yf4[4] = {uyf.x, uyf.y, uyf.z, uyf.w}, yb4[4] = {uyb.x, uyb.y, uyb.z, uyb.w};
  float y[8], vv[8], gg[8];
  float sum = 0.f, bon = 0.f;
  const float* rk = P.in[16] + layer * 512 + c0;
  const float* ka = P.in[15] + layer * 512 + c0;
#pragma unroll
  for (int i = 0; i < 4; ++i) {
#pragma unroll
    for (int hh = 0; hh < 2; ++hh) {
      int e = 2 * i + hh;
      float r = hh ? hi16(r4[i]) : lo16(r4[i]);
      float k = hh ? hi16(k4[i]) : lo16(k4[i]);
      float a0 = hh ? hi16(a04[i]) : lo16(a04[i]);
      float a1 = hh ? hi16(a14[i]) : lo16(a14[i]);
      y[e] = (hh ? hi16(yf4[i]) : lo16(yf4[i])) + (hh ? hi16(yb4[i]) : lo16(yb4[i]));
      vv[e] = hh ? hi16(v4[i]) : lo16(v4[i]);
      gg[e] = hh ? hi16(g4[i]) : lo16(g4[i]);
      sum += y[e];
      float ksum = k * (2.f + (a0 + a1 - 2.f) * ka[e]);
      bon += r * rk[e] * ksum;
    }
  }
  sum += __shfl_xor(sum, 1); sum += __shfl_xor(sum, 2); sum += __shfl_xor(sum, 4);
  bon += __shfl_xor(bon, 1); bon += __shfl_xor(bon, 2); bon += __shfl_xor(bon, 4);
  const float mu = sum * (1.f / 64.f);
  float var = 0.f;
#pragma unroll
  for (int e = 0; e < 8; ++e) { float d = y[e] - mu; var += d * d; }
  var += __shfl_xor(var, 1); var += __shfl_xor(var, 2); var += __shfl_xor(var, 4);
  const float rs = rsqrtf(var * (1.f / 64.f) + 64e-5f);
  const float* gw = P.in[18] + layer * 512 + c0;
  const float* gbi = P.in[19] + layer * 512 + c0;
  float o[8];
#pragma unroll
  for (int e = 0; e < 8; ++e) o[e] = ((y[e] - mu) * rs * gw[e] + gbi[e] + bon * vv[e]) * gg[e];
  uint4 ou;
  ou.x = pack2(o[0], o[1]); ou.y = pack2(o[2], o[3]); ou.z = pack2(o[4], o[5]); ou.w = pack2(o[6], o[7]);
  *(uint4*)((bf16_t*)(X.ws + OFF_RWO) + (size_t)row * 512 + c0) = ou;
}

__device__ __forceinline__ float red32(float x) {
  x += __shfl_xor(x, 1); x += __shfl_xor(x, 2); x += __shfl_xor(x, 4); x += __shfl_xor(x, 8); x += __shfl_xor(x, 16);
  return x;
}
#define QSCALE 0.14724444f
__device__ void q1_q_tile(const Params& P, const Cx& X, int layer, int t, char* smem) {
  const int tid = X.tid, lane = tid & 63, w = tid >> 6;
  const int mt = t % 136, head = t / 136;
  const int m0 = mt * 128;
  const bf16_t* zm = (const bf16_t*)(X.ws + OFF_ZM);
  float* srs = (float*)(smem + 73728);
  {
    int r = tid >> 1, hf = tid & 1;
    const bf16_t* p = zm + (size_t)(m0 + r) * 544 + hf * 192;
    float ss = 0.f;
    for (int i = 0; i < 24; ++i) {
      uint4 u = *(const uint4*)(p + i * 8);
      ss += lo16(u.x) * lo16(u.x) + hi16(u.x) * hi16(u.x) + lo16(u.y) * lo16(u.y) + hi16(u.y) * hi16(u.y) +
            lo16(u.z) * lo16(u.z) + hi16(u.z) * hi16(u.z) + lo16(u.w) * lo16(u.w) + hi16(u.w) * hi16(u.w);
    }
    ss += __shfl_xor(ss, 1);
    if (hf == 0) srs[r] = rsqrtf(ss * (1.f / 384.f) + 1e-6f);
  }
  f32x16 acc[1][3];
  GQ::zero(acc);
  GQ::run(X, zm + (size_t)m0 * 544, 544, (const bf16_t*)(X.ws + OFF_WMIX) + WE_UQ + (size_t)head * 96 * 384, 384, 384, smem, acc);
  const int l5 = lane & 31;
  const float* gq = P.in[25] + layer * 96;
  const float g0 = gq[l5], g1 = gq[32 + l5], g2 = gq[64 + l5];
  const float2* rope = (const float2*)(X.ws + OFF_ROPE);
  bf16_t* qb = (bf16_t*)(X.ws + OFF_Q);
#pragma unroll
  for (int r = 0; r < 16; ++r) {
    const int rl = w * 32 + ROW_OF(r);
    const int row = m0 + rl;
    const float rs = srs[rl];
    float x0 = acc[0][0][r] * rs, x1 = acc[0][1][r] * rs, x2 = acc[0][2][r] * rs;
    float ss = red32(x0 * x0 + x1 * x1 + x2 * x2);
    float rq = rsqrtf(ss * (1.f / 96.f) + 1e-6f);
    x0 *= rq * g0; x1 *= rq * g1; x2 *= rq * g2;
    bf16_t* dst;
    if (row < NX) {
      int tt = row & 4095, bb = row >> 12;
      float2 cs = rope[tt * 16 + (l5 >> 4) * 8 + (l5 & 7)];
      float other = __shfl_xor(x2, 8);
      x2 = (l5 & 8) ? x2 * cs.x + other * cs.y : x2 * cs.x - other * cs.y;
      dst = qb + ((size_t)(bb * 8 + head) * 4096 + tt) * 96;
    } else {
      int j = (row - NX) & 255, bb = (row - NX) >> 8;
      dst = qb + (size_t)NX * 768 + ((size_t)(bb * 8 + head) * 256 + j) * 96;
    }
    dst[l5] = f2bf(x0 * QSCALE); dst[32 + l5] = f2bf(x1 * QSCALE); dst[64 + l5] = f2bf(x2 * QSCALE);
  }
}
__device__ void q1_kv_tile(const Params& P, const Cx& X, int layer, int t, char* smem) {
  const int tid = X.tid, lane = tid & 63, w = tid >> 6;
  const int mt = t % 136, head = t / 136;
  const int m0 = mt * 128;
  const bf16_t* zm = (const bf16_t*)(X.ws + OFF_ZM);
  float* srs = (float*)(smem + 73728);
  {
    int r = tid >> 1, hf = tid & 1;
    const bf16_t* p = zm + (size_t)(m0 + r) * 544 + 384 + hf * 64;
    float ss = 0.f;
    for (int i = 0; i < 8; ++i) {
      uint4 u = *(const uint4*)(p + i * 8);
      ss += lo16(u.x) * lo16(u.x) + hi16(u.x) * hi16(u.x) + lo16(u.y) * lo16(u.y) + hi16(u.y) * hi16(u.y) +
            lo16(u.z) * lo16(u.z) + hi16(u.z) * hi16(u.z) + lo16(u.w) * lo16(u.w) + hi16(u.w) * hi16(u.w);
    }
    ss += __shfl_xor(ss, 1);
    if (hf == 0) srs[r] = rsqrtf(ss * (1.f / 128.f) + 1e-6f);
  }
  f32x16 acc[1][4];
  GKV::zero(acc);
  GKV::run(X, zm + (size_t)m0 * 544 + 384, 544, (const bf16_t*)(X.ws + OFF_WMIX) + WE_UKV + (size_t)head * 128 * 128, 128, 128, smem, acc);
  const int l5 = lane & 31;
  const float* gk = P.in[26] + layer * 96;
  const float g0 = gk[l5], g1 = gk[32 + l5], g2 = gk[64 + l5];
  const float2* rope = (const float2*)(X.ws + OFF_ROPE);
  bf16_t* kb = (bf16_t*)(X.ws + OFF_K);
  bf16_t* vt = (bf16_t*)(X.ws + OFF_VT);
  const bool isx = m0 < NX;
  const int bb = isx ? (m0 >> 12) : ((m0 - NX) >> 8);
  float vv0[16], vv1[16];
#pragma unroll
  for (int r = 0; r < 16; ++r) {
    const int rl = w * 32 + ROW_OF(r);
    const int row = m0 + rl;
    const float rs = srs[rl];
    float k0 = acc[0][0][r] * rs, k1 = acc[0][1][r] * rs;
    float kr = bf2f(zm[(size_t)row * 544 + 512 + l5]);
    float ss = red32(k0 * k0 + k1 * k1 + kr * kr);
    float rk = rsqrtf(ss * (1.f / 96.f) + 1e-6f);
    k0 *= rk * g0; k1 *= rk * g1; kr *= rk * g2;
    int key;
    if (isx) {
      int tt = row & 4095;
      float2 cs = rope[tt * 16 + (l5 >> 4) * 8 + (l5 & 7)];
      float other = __shfl_xor(kr, 8);
      kr = (l5 & 8) ? kr * cs.x + other * cs.y : kr * cs.x - other * cs.y;
      key = 256 + tt;
    } else {
      key = (row - NX) & 255;
    }
    bf16_t* dst = kb + ((size_t)(bb * 8 + head) * 4352 + key) * 96;
    dst[l5] = f2bf(k0); dst[32 + l5] = f2bf(k1); dst[64 + l5] = f2bf(kr);
    vv0[r] = acc[0][2][r] * rs;
    vv1[r] = acc[0][3][r] * rs;
  }
#pragma unroll
  for (int g = 0; g < 4; ++g) {
    const int rl = w * 32 + 8 * g + 4 * (lane >> 5);
    const int row = m0 + rl;
    const int key = isx ? 256 + (row & 4095) : ((row - NX) & 255);
    uint2 o0, o1;
    o0.x = pack2(vv0[4 * g], vv0[4 * g + 1]); o0.y = pack2(vv0[4 * g + 2], vv0[4 * g + 3]);
    o1.x = pack2(vv1[4 * g], vv1[4 * g + 1]); o1.y = pack2(vv1[4 * g + 2], vv1[4 * g + 3]);
    *(uint2*)(vt + ((size_t)(bb * 8 + head) * 64 + l5) * 4352 + key) = o0;
    *(uint2*)(vt + ((size_t)(bb * 8 + head) * 64 + 32 + l5) * 4352 + key) = o1;
  }
}

__device__ void fft1_tile(const Params& P, const Cx& X, int t, char* smem) {
  const int lane = X.tid & 63, w = X.tid >> 6;
  const int b = t >> 8, ntile = t & 255;
  const int n0 = ntile * 128;
  f32x16 acc[2][2];
  G22T::zero(acc);
  G22T::run(X, (const bf16_t*)(X.ws + OFF_F1), 64, (const bf16_t*)(X.ws + OFF_ZF) + (size_t)b * 4096 * 512 + n0, 32768, 64, smem, acc);
  const float2* tw = (const float2*)(X.ws + OFF_TW);
  bf16_t* out = (bf16_t*)(X.ws + OFF_FFT1);
  const int wm = w >> 1, wn = w & 1;
  const int t2 = n0 >> 9;
#pragma unroll
  for (int j = 0; j < 2; ++j) {
    const int ch = (n0 & 511) + wn * 64 + j * 32 + (lane & 31);
#pragma unroll
    for (int r = 0; r < 16; ++r) {
      const int f1 = wm * 32 + ROW_OF(r);
      float re = acc[0][j][r], im = acc[1][j][r];
      float2 cs = tw[t2 * f1];
      float re2 = re * cs.x + im * cs.y, im2 = im * cs.x - re * cs.y;
      size_t base = ((size_t)(b * 64 + f1) * 128) * 512 + ch;
      out[base + (size_t)t2 * 512] = f2bf(re2);
      out[base + (size_t)(64 + t2) * 512] = f2bf(im2);
    }
  }
}
__device__ void fft2_tile(const Params& P, const Cx& X, int t, char* smem) {
  const int lane = X.tid & 63, w = X.tid >> 6;
  const int bf = t >> 2, ntile = t & 3;
  const int b = bf >> 6, f1 = bf & 63;
  const int n0 = ntile * 128;
  f32x16 acc[2][2];
  G22T::zero(acc);
  G22T::run(X, (const bf16_t*)(X.ws + OFF_F2), 128, (const bf16_t*)(X.ws + OFF_FFT1) + (size_t)bf * 128 * 512 + n0, 512, 128, smem, acc);
  bf16_t* Y = (bf16_t*)(X.ws + OFF_Y);
  const int wm = w >> 1, wn = w & 1;
#pragma unroll
  for (int i = 0; i < 2; ++i)
#pragma unroll
    for (int j = 0; j < 2; ++j)
#pragma unroll
      for (int r = 0; r < 16; ++r) {
        int m = wm * 64 + i * 32 + ROW_OF(r);
        int f2 = m & 63, q = m >> 6;
        int ch = n0 + wn * 64 + j * 32 + (lane & 31);
        Y[(size_t)(b * 4096 + f1 + 64 * f2) * 1024 + q * 512 + ch] = f2bf(acc[i][j][r]);
      }
}
__device__ void ctxdft_tile(const Params& P, const Cx& X, int t, char* smem) {
  const int lane = X.tid & 63, w = X.tid >> 6;
  const int b = t >> 4, mt = (t >> 2) & 3, ntile = t & 3;
  const int n0 = ntile * 128;
  f32x16 acc[2][2];
  G22T::zero(acc);
  G22T::run(X, (const bf16_t*)(X.ws + OFF_F256) + (size_t)mt * 128 * 256, 256, (const bf16_t*)(X.ws + OFF_ZF) + (size_t)(NX + b * 256) * 512 + n0, 512, 256, smem, acc);
  bf16_t* Y = (bf16_t*)(X.ws + OFF_Y);
  const int wm = w >> 1, wn = w & 1;
#pragma unroll
  for (int i = 0; i < 2; ++i)
#pragma unroll
    for (int j = 0; j < 2; ++j)
#pragma unroll
      for (int r = 0; r < 16; ++r) {
        int m = mt * 128 + wm * 64 + i * 32 + ROW_OF(r);
        int f = m & 255, q = m >> 8;
        int ch = n0 + wn * 64 + j * 32 + (lane & 31);
        Y[(size_t)(NX + b * 256 + f) * 1024 + q * 512 + ch] = f2bf(acc[i][j][r] * 4.f);
      }
}

__device__ void attn_item(const Params& P, const Cx& X, int it, bool isctx, char* smem) {
  const int tid = X.tid, lane = tid & 63, w = tid >> 6;
  int b, h, qb, nkt, qrow0;
  const bf16_t* qbase;
  if (!isctx) {
    b = it >> 8; h = (it >> 5) & 7; qb = it & 31; nkt = 68;
    qbase = (const bf16_t*)(X.ws + OFF_Q) + ((size_t)(b * 8 + h) * 4096 + qb * 128) * 96;
    qrow0 = b * 4096 + qb * 128;
  } else {
    b = it >> 4; h = (it >> 1) & 7; qb = it & 1; nkt = 4;
    qbase = (const bf16_t*)(X.ws + OFF_Q) + (size_t)NX * 768 + ((size_t)(b * 8 + h) * 256 + qb * 128) * 96;
    qrow0 = NX + b * 256 + qb * 128;
  }
  const bf16_t* kbase = (const bf16_t*)(X.ws + OFF_K) + (size_t)(b * 8 + h) * 4352 * 96;
  const bf16_t* vbase = (const bf16_t*)(X.ws + OFF_VT) + (size_t)(b * 8 + h) * 64 * 4352;
  bf16_t* sK = (bf16_t*)smem;
  bf16_t* sV = sK + 2 * 64 * 104;
  const int l5 = lane & 31, hh = lane >> 5;
  const bf16_t* qp = qbase + (size_t)(w * 32 + l5) * 96 + hh * 8;
  const bf16x8 qf0 = *(const bf16x8*)(qp), qf1 = *(const bf16x8*)(qp + 16), qf2 = *(const bf16x8*)(qp + 32);
  const bf16x8 qf3 = *(const bf16x8*)(qp + 48), qf4 = *(const bf16x8*)(qp + 64), qf5 = *(const bf16x8*)(qp + 80);
  uint4 rk0, rk1, rk2, rv0, rv1;
#define LK_(i, kt) (*(const uint4*)(kbase + (size_t)((kt)*64 + (tid + 256 * (i)) / 12) * 96 + ((tid + 256 * (i)) % 12) * 8))
#define LV_(i, kt) (*(const uint4*)(vbase + (size_t)((tid + 256 * (i)) >> 3) * 4352 + (kt)*64 + ((tid + 256 * (i)) & 7) * 8))
#define ALOAD(kt) { rk0 = LK_(0, kt); rk1 = LK_(1, kt); rk2 = LK_(2, kt); rv0 = LV_(0, kt); rv1 = LV_(1, kt); }
#define SK_(i, buf, v) *(uint4*)(sK + (buf)*64 * 104 + ((tid + 256 * (i)) / 12) * 104 + ((tid + 256 * (i)) % 12) * 8) = v
#define SV_(i, buf, v) *(uint4*)(sV + (buf)*64 * 72 + ((tid + 256 * (i)) >> 3) * 72 + ((tid + 256 * (i)) & 7) * 8) = v
#define ASTORE(buf) { SK_(0, buf, rk0); SK_(1, buf, rk1); SK_(2, buf, rk2); SV_(0, buf, rv0); SV_(1, buf, rv1); }
  f32x16 o[2];
#pragma unroll
  for (int r = 0; r < 16; ++r) { o[0][r] = 0.f; o[1][r] = 0.f; }
  float mrun = -1e30f, lrun = 0.f;
  ALOAD(0);
  ASTORE(0);
  __syncthreads();
  for (int kt = 0; kt < nkt; ++kt) {
    const int buf = kt & 1;
    if (kt + 1 < nkt) ALOAD(kt + 1);
    f32x16 s[2];
#pragma unroll
    for (int r = 0; r < 16; ++r) { s[0][r] = 0.f; s[1][r] = 0.f; }
    const bf16_t* pk = sK + buf * 64 * 104 + l5 * 104 + hh * 8;
#define QK(mt, ks, qq) s[mt] = __builtin_amdgcn_mfma_f32_32x32x16_bf16(*(const bf16x8*)(pk + (mt)*32 * 104 + (ks)*16), qq, s[mt], 0, 0, 0)
    QK(0, 0, qf0); QK(0, 1, qf1); QK(0, 2, qf2); QK(0, 3, qf3); QK(0, 4, qf4); QK(0, 5, qf5);
    QK(1, 0, qf0); QK(1, 1, qf1); QK(1, 2, qf2); QK(1, 3, qf3); QK(1, 4, qf4); QK(1, 5, qf5);
#undef QK
    float mx = s[0][0];
#pragma unroll
    for (int r = 0; r < 16; ++r) { mx = fmaxf(mx, s[0][r]); mx = fmaxf(mx, s[1][r]); }
    mx = fmaxf(mx, __shfl_xor(mx, 32));
    const float mnew = fmaxf(mrun, mx);
    const float alpha = exp2f(mrun - mnew);
    mrun = mnew;
    float psum = 0.f;
#pragma unroll
    for (int r = 0; r < 16; ++r) {
      s[0][r] = exp2f(s[0][r] - mnew); s[1][r] = exp2f(s[1][r] - mnew);
      psum += s[0][r] + s[1][r];
    }
    lrun = lrun * alpha + psum;
#pragma unroll
    for (int r = 0; r < 16; ++r) { o[0][r] *= alpha; o[1][r] *= alpha; }
    const bf16_t* pv = sV + buf * 64 * 72 + l5 * 72 + 4 * hh;
#pragma unroll
    for (int mt = 0; mt < 2; ++mt)
#pragma unroll
      for (int s2 = 0; s2 < 2; ++s2) {
        u32x4 pu;
        pu[0] = pack2(s[mt][8 * s2 + 0], s[mt][8 * s2 + 1]);
        pu[1] = pack2(s[mt][8 * s2 + 2], s[mt][8 * s2 + 3]);
        pu[2] = pack2(s[mt][8 * s2 + 4], s[mt][8 * s2 + 5]);
        pu[3] = pack2(s[mt][8 * s2 + 6], s[mt][8 * s2 + 7]);
        const bf16x8 pfv = __builtin_bit_cast(bf16x8, pu);
#pragma unroll
        for (int dt = 0; dt < 2; ++dt) {
          const bf16_t* p = pv + dt * 32 * 72 + mt * 32 + s2 * 16;
          uint2 v0 = *(const uint2*)(p), v1 = *(const uint2*)(p + 8);
          u32x4 vu;
          vu[0] = v0.x; vu[1] = v0.y; vu[2] = v1.x; vu[3] = v1.y;
          o[dt] = __builtin_amdgcn_mfma_f32_32x32x16_bf16(__builtin_bit_cast(bf16x8, vu), pfv, o[dt], 0, 0, 0);
        }
      }
    if (kt + 1 < nkt) ASTORE(buf ^ 1);
    __syncthreads();
  }
#undef ALOAD
#undef ASTORE
#undef LK_
#undef LV_
#undef SK_
#undef SV_
  lrun += __shfl_xor(lrun, 32);
  const float inv = 1.f / lrun;
  bf16_t* dst = (bf16_t*)(X.ws + OFF_ATT) + (size_t)(qrow0 + w * 32 + l5) * 512 + h * 64;
#pragma unroll
  for (int dt = 0; dt < 2; ++dt)
#pragma unroll
    for (int g = 0; g < 4; ++g) {
      uint2 u;
      u.x = pack2(o[dt][4 * g] * inv, o[dt][4 * g + 1] * inv);
      u.y = pack2(o[dt][4 * g + 2] * inv, o[dt][4 * g + 3] * inv);
      *(uint2*)(dst + dt * 32 + 8 * g + 4 * hh) = u;
    }
}

__device__ void mg_tile(const Params& P, const Cx& X, int t, int mtiles, char* smem) {
  const int lane = X.tid & 63, w = X.tid >> 6;
  const int mt = t % mtiles, nt = t / mtiles;
  const int m0 = mt * 128, c0 = nt * 64;
  const bf16_t* W = (const bf16_t*)(X.ws + OFF_WMIX);
  f32x16 macc[2][1];
  GMG::zero(macc);
#pragma unroll 1
  for (int i = 0; i < 3; ++i) {
    f32x16 ag[2][1], ao[2][1];
    GMG::zero(ag);
    GMG::zero(ao);
    GMG::run(X, (const bf16_t*)(X.ws + OFF_HBUF) + (size_t)m0 * 1024, 1024, W + WE_IN + (size_t)(2976 + i * 1024 + c0) * 1024, 1024, 1024, smem, ag);
    const bf16_t* Ai; const bf16_t* Bi; int ldi;
    if (i == 0) { Ai = (const bf16_t*)(X.ws + OFF_RWO) + (size_t)m0 * 512; Bi = W + WE_RO + (size_t)c0 * 512; ldi = 512; }
    else if (i == 1) { Ai = (const bf16_t*)(X.ws + OFF_ATT) + (size_t)m0 * 512; Bi = W + WE_MO + (size_t)c0 * 512; ldi = 512; }
    else { Ai = (const bf16_t*)(X.ws + OFF_Y) + (size_t)m0 * 1024; Bi = W + WE_FO + (size_t)c0 * 1024; ldi = 1024; }
    GMG::run(X, Ai, ldi, Bi, ldi, ldi, smem, ao);
#pragma unroll
    for (int a = 0; a < 2; ++a)
#pragma unroll
      for (int r = 0; r < 16; ++r) macc[a][0][r] += ao[a][0][r] / (1.f + __expf(-ag[a][0][r]));
  }
  bf16_t* mb = (bf16_t*)(X.ws + OFF_M);
  const int row0 = m0 + (w >> 1) * 64, col = c0 + (w & 1) * 32 + (lane & 31);
#pragma unroll
  for (int a = 0; a < 2; ++a)
#pragma unroll
    for (int r = 0; r < 16; ++r) mb[(size_t)(row0 + a * 32 + ROW_OF(r)) * 1024 + col] = f2bf(macc[a][0][r]);
}

__device__ void wo_tile(const Params& P, const Cx& X, int layer, int t, int mtiles, char* smem) {
  const int lane = X.tid & 63, w = X.tid >> 6;
  const int mt = t % mtiles, nt = t / mtiles;
  const int m0 = mt * 128, n0 = nt * 128;
  f32x16 acc[2][2];
  G22::zero(acc);
  G22::run(X, (const bf16_t*)(X.ws + OFF_M) + (size_t)m0 * 1024, 1024, (const bf16_t*)(X.ws + OFF_WMIX) + WE_OUT + (size_t)n0 * 1024, 1024, 1024, smem, acc);
  const int row0 = m0 + (w >> 1) * 64, col0 = n0 + (w & 1) * 64;
  const float* modv = (const float*)(X.ws + OFF_MOD) + (size_t)(layer * 5 + mod_row(m0)) * 6144 + 2048;
  const float* src; float* dst;
  if (m0 < NX) { src = (layer == 0 ? P.in[0] : X.out); dst = X.out; }
  else { src = (layer == 0 ? P.in[2] : (const float*)(X.ws + OFF_CS)) - (size_t)NX * 1024; dst = (float*)(X.ws + OFF_CS) - (size_t)NX * 1024; }
#pragma unroll
  for (int j = 0; j < 2; ++j) {
    const int col = col0 + j * 32 + (lane & 31);
    const float mg = modv[col];
#pragma unroll
    for (int i = 0; i < 2; ++i)
#pragma unroll
      for (int r = 0; r < 16; ++r) {
        size_t idx = (size_t)(row0 + i * 32 + ROW_OF(r)) * 1024 + col;
        dst[idx] = src[idx] + mg * acc[i][j][r];
      }
  }
}
__device__ void f1_tile(const Params& P, const Cx& X, int t, int mtiles, char* smem) {
  const int lane = X.tid & 63, w = X.tid >> 6;
  const int mt = t % mtiles, nt = t / mtiles;
  const int m0 = mt * 128, n0 = nt * 128;
  f32x16 acc[2][2];
  G22::zero(acc);
  G22::run(X, (const bf16_t*)(X.ws + OFF_HBUF) + (size_t)m0 * 1024, 1024, (const bf16_t*)(X.ws + OFF_WFFN) + WF_IN + (size_t)n0 * 1024, 1024, 1024, smem, acc);
  bf16_t* act = (bf16_t*)(X.ws + OFF_ACT);
  const int row0 = m0 + (w >> 1) * 64;
  const int hid = ((n0 + (w & 1) * 64) >> 6) * 32 + (lane & 31);
#pragma unroll
  for (int i = 0; i < 2; ++i)
#pragma unroll
    for (int r = 0; r < 16; ++r) {
      float g = acc[i][0][r], u = acc[i][1][r];
      act[(size_t)(row0 + i * 32 + ROW_OF(r)) * 2816 + hid] = f2bf(g / (1.f + __expf(-g)) * u);
    }
}
__device__ void f2_tile(const Params& P, const Cx& X, int layer, int t, int mtiles, char* smem) {
  const int lane = X.tid & 63, w = X.tid >> 6;
  const int mt = t % mtiles, nt = t / mtiles;
  const int m0 = mt * 128, n0 = nt * 128;
  f32x16 acc[2][2];
  G22::zero(acc);
  G22::run(X, (const bf16_t*)(X.ws + OFF_ACT) + (size_t)m0 * 2816, 2816, (const bf16_t*)(X.ws + OFF_WFFN) + WF_OUT + (size_t)n0 * 2816, 2816, 2816, smem, acc);
  const int row0 = m0 + (w >> 1) * 64, col0 = n0 + (w & 1) * 64;
  const float* modv = (const float*)(X.ws + OFF_MOD) + (size_t)(layer * 5 + mod_row(m0)) * 6144 + 5120;
  float* dst = (m0 < NX) ? X.out : (float*)(X.ws + OFF_CS) - (size_t)NX * 1024;
#pragma unroll
  for (int j = 0; j < 2; ++j) {
    const int col = col0 + j * 32 + (lane & 31);
    const float mg = modv[col];
#pragma unroll
    for (int i = 0; i < 2; ++i)
#pragma unroll
      for (int r = 0; r < 16; ++r) {
        size_t idx = (size_t)(row0 + i * 32 + ROW_OF(r)) * 1024 + col;
        dst[idx] = dst[idx] + mg * acc[i][j][r];
      }
  }
}

__device__ __forceinline__ void run_p(const Params& P, const Cx& X, int layer, int p, char* smem) {
  const int G = gridDim.x, B = blockIdx.x;
  if (p < 0) {
    if (!PON(14)) return;
    for (int j = B; j < 192 + 55; j += G) { if (j < 192) job_mod(P, X, smem, j); else job_tables(P, X, j - 192); }
    return;
  }
  const int mtiles = layer == 0 ? 136 : 128;
  switch (p) {
    case 0: if (!PON(0)) break;
      for (int j = B; j < NCW1 + 4352; j += G) { if (j < NCW1) cw_mixer_job(P, X, layer, j, smem); else norm_job(P, X, layer, 0, j - NCW1); }
      break;
    case 1: if (!PON(1)) break; for (int j = B; j < 136 * 15; j += G) g1a_tile(P, X, j, smem); break;
    case 2: if (!PON(2)) break; for (int j = B; j < NTOK; j += G) r1a_row(P, X, layer, j); break;
    case 3: if (!PON(3)) break; for (int j = B; j < 136 * 20; j += G) r1b_tile(P, X, layer, j, smem); break;
    case 4: if (!PON(4)) break; for (int j = B; j < 256; j += G) scan_job(P, X, layer, j, smem); break;
    case 5: if (!PON(5)) break; for (int j = B; j < 4352; j += G) s2_job(P, X, layer, j); break;
    case 6: if (!PON(6)) break; for (int j = B; j < 136 * 9; j += G) g1b_tile(P, X, j, smem); break;
    case 7: if (!PON(7)) break;
      for (int j = B; j < 2176 + 1024; j += G) {
        if (j < 1088) q1_kv_tile(P, X, layer, j, smem);
        else if (j < 2176) { if (layer == 0 || (j - 1088) % 136 < 128) q1_q_tile(P, X, layer, j - 1088, smem); }
        else fft1_tile(P, X, j - 2176, smem);
      }
      break;
    case 8: if (!PON(8)) break; {
      const int nctx = layer == 0 ? 64 : 0;
      for (int j = B; j < 1024 + 1024 + 2 * nctx; j += G) {
        if (j < 1024) attn_item(P, X, j, false, smem);
        else if (j < 2048) fft2_tile(P, X, j - 1024, smem);
        else if (j < 2048 + nctx) attn_item(P, X, j - 2048, true, smem);
        else ctxdft_tile(P, X, j - 2048 - nctx, smem);
      }
    } break;
    case 9: if (!PON(9)) break; for (int j = B; j < mtiles * 16; j += G) mg_tile(P, X, j, mtiles, smem); break;
    case 10: if (!PON(10)) break;
      for (int j = B; j < mtiles * 8 + NCW2; j += G) { if (j < mtiles * 8) wo_tile(P, X, layer, j, mtiles, smem); else cw_ffn_job(P, X, layer, j - mtiles * 8, smem); }
      break;
    case 11: if (!PON(11)) break; for (int j = B; j < mtiles * 32; j += G) norm_job(P, X, layer, 1, j); break;
    case 12: if (!PON(12)) break; for (int j = B; j < mtiles * 44; j += G) f1_tile(P, X, j, mtiles, smem); break;
    case 13: if (!PON(13)) break; for (int j = B; j < mtiles * 8; j += G) f2_tile(P, X, layer, j, mtiles, smem); break;
  }
}

#if SINGLE
__global__ void __launch_bounds__(256) fwd_kernel(Params P, int ph_lo, int ph_hi, int use_sync) {
  extern __shared__ __attribute__((aligned(16))) char smem[];
#pragma unroll 1
  for (int ph = ph_lo; ph < ph_hi; ++ph) {
    char* ws = P.ws; float* out = P.out; int tid = threadIdx.x;
    asm volatile("" : "+s"(ws));
    asm volatile("" : "+s"(out));
    asm volatile("" : "+v"(tid));
    const Cx X{ws, out, tid};
    if (ph == 0) run_p(P, X, 0, -1, smem);
    else run_p(P, X, (ph - 1) / 14, (ph - 1) % 14, smem);
    if (use_sync && ph + 1 < ph_hi) cg::this_grid().sync();
  }
}

#else
template <int PP>
__global__ void __launch_bounds__(256) phase_kernel(Params P, int layer) {
  extern __shared__ __attribute__((aligned(16))) char smem[];
  const Cx X{P.ws, P.out, (int)threadIdx.x};
  run_p(P, X, layer, PP, smem);
}
#endif

extern "C" void kernel_launch(void* const* d_in, const int* in_sizes, int n_in, void* d_out, int out_size, void* d_ws,
                              size_t ws_size, hipStream_t stream) {
  static int grid = 0;
  if (grid == 0) {
    if (n_in != 33 || ws_size < OFF_END) { fprintf(stderr, "kernel_launch: unexpected n_in %d / ws_size %zu (need %zu)\n", n_in, ws_size, (size_t)OFF_END); grid = -1; return; }
    int dev = 0, cus = 0, per_cu = 0;
    hipGetDevice(&dev);
    hipDeviceGetAttribute(&cus, hipDeviceAttributeMultiprocessorCount, dev);
#if SINGLE
    hipFuncSetAttribute((const void*)fwd_kernel, hipFuncAttributeMaxDynamicSharedMemorySize, LDS_BYTES);
    hipOccupancyMaxActiveBlocksPerMultiprocessor(&per_cu, (const void*)fwd_kernel, 256, LDS_BYTES);
#else
#define SA(pp) hipFuncSetAttribute((const void*)phase_kernel<pp>, hipFuncAttributeMaxDynamicSharedMemorySize, LDS_BYTES)
    SA(-1); SA(0); SA(1); SA(2); SA(3); SA(4); SA(5); SA(6); SA(7); SA(8); SA(9); SA(10); SA(11); SA(12); SA(13);
    per_cu = 2;
#endif
    if (per_cu < 1) { fprintf(stderr, "kernel_launch: occupancy query returned %d\n", per_cu); grid = -1; return; }
    if (per_cu > 2) per_cu = 2;
    grid = cus * per_cu;
  }
  if (grid < 0) return;
  Params P{};
  for (int i = 0; i < 33; ++i) P.in[i] = (const float*)d_in[i];
  P.out = (float*)d_out;
  P.ws = (char*)d_ws;
#if SINGLE
  int lo = 0, hi = NPH, us = 1;
  void* args[] = {&P, &lo, &hi, &us};
  hipError_t e = hipLaunchCooperativeKernel((const void*)fwd_kernel, dim3(grid), dim3(256), args, LDS_BYTES, stream);
  if (e != hipSuccess) fprintf(stderr, "cooperative launch failed: %s (grid %d)\n", hipGetErrorString(e), grid);
#else
#define LP(pp, ly) hipLaunchKernelGGL(phase_kernel<pp>, dim3(grid), dim3(256), LDS_BYTES, stream, P, ly)
  LP(-1, 0);
  for (int ly = 0; ly < 2; ++ly) {
    LP(0, ly); LP(1, ly); LP(2, ly); LP(3, ly); LP(4, ly); LP(5, ly); LP(6, ly); LP(7, ly); LP(8, ly); LP(9, ly); LP(10, ly); LP(11, ly); LP(12, ly); LP(13, ly);
  }
#endif
}
```

```cpp
#include <hip/hip_runtime.h>
#include <hip/hip_cooperative_groups.h>
#include <stdint.h>
#include <stdio.h>
namespace cg = cooperative_groups;

#ifndef SINGLE
#define SINGLE 1
#endif

#ifndef ONLYP
#define ONLYP -1
#endif
#define PON(x) (ONLYP < 0 || ONLYP == (x))

typedef unsigned short bf16_t;
typedef __attribute__((ext_vector_type(8))) short bf16x8;
typedef __attribute__((ext_vector_type(16))) float f32x16;
typedef __attribute__((ext_vector_type(4))) unsigned int u32x4;

#define NX 16384
#define NCX 1024
#define NTOK 17408
#define NPH 29
#define LDS_BYTES 77824

static constexpr size_t UU = 17825792ull;
static constexpr size_t OFF_HBUF = 0;
static constexpr size_t OFF_RKV = 2 * UU;
static constexpr size_t OFF_KK = 5 * UU;
static constexpr size_t OFF_ZR = 6 * UU;
static constexpr size_t OFF_LORA = 12 * UU + UU / 4;
static constexpr size_t OFF_LD = 6 * UU;
static constexpr size_t OFF_A = 8 * UU;
static constexpr size_t OFF_G = 10 * UU;
static constexpr size_t OFF_YF = 11 * UU;
static constexpr size_t OFF_YB = 12 * UU;
static constexpr size_t OFF_RWO = 5 * UU;
static constexpr size_t OFF_ZF = 2 * UU;
static constexpr size_t OFF_ZM = 3 * UU;
static constexpr size_t OFF_Q = 6 * UU;
static constexpr size_t OFF_K = 7 * UU + UU / 2;
static constexpr size_t OFF_VT = 9 * UU;
static constexpr size_t OFF_FFT1 = 10 * UU;
static constexpr size_t OFF_ATT = 12 * UU;
static constexpr size_t OFF_Y = 3 * UU;
static constexpr size_t OFF_M = 6 * UU;
static constexpr size_t OFF_ACT = 2 * UU;
static constexpr size_t OFF_WFFN = 9 * UU;
static constexpr size_t OFF_WMIX = 13 * UU;
static constexpr size_t WE_IN = 0;
static constexpr size_t WE_W2 = WE_IN + 6048ull * 1024;
static constexpr size_t WE_A2 = WE_W2 + 65536;
static constexpr size_t WE_G2 = WE_A2 + 65536;
static constexpr size_t WE_RO = WE_G2 + 65536;
static constexpr size_t WE_MO = WE_RO + 524288;
static constexpr size_t WE_FO = WE_MO + 524288;
static constexpr size_t WE_UQ = WE_FO + 1048576;
static constexpr size_t WE_UKV = WE_UQ + 294912;
static constexpr size_t WE_OUT = WE_UKV + 131072;
static constexpr size_t WE_END = WE_OUT + 1048576;
static constexpr size_t WF_IN = 0;
static constexpr size_t WF_OUT = 5632ull * 1024;
static constexpr size_t OFF_SMALL = OFF_WMIX + WE_END * 2;
static constexpr size_t OFF_CS = OFF_SMALL;
static constexpr size_t OFF_MOD = OFF_CS + 4194304;
static constexpr size_t OFF_TW = OFF_MOD + 245760;
static constexpr size_t OFF_F1 = OFF_TW + 32768;
static constexpr size_t OFF_F2 = OFF_F1 + 16384;
static constexpr size_t OFF_F256 = OFF_F2 + 32768;
static constexpr size_t OFF_ROPE = OFF_F256 + 262144;
static constexpr size_t OFF_BAR = OFF_ROPE + 524288;
static constexpr size_t OFF_END = OFF_BAR + 16384;

struct Cx {
  char* ws;
  float* out;
  int tid;
};

struct Params {
  const float* in[33];
  float* out;
  char* ws;
};

__device__ __forceinline__ float bf2f(bf16_t v) { return __uint_as_float(((uint32_t)v) << 16); }
typedef __bf16 bf16v2_t __attribute__((ext_vector_type(2)));
typedef float f32v2_t __attribute__((ext_vector_type(2)));
__device__ __forceinline__ uint32_t pack2(float a, float b) {
  f32v2_t v; v[0] = a; v[1] = b;
  return __builtin_bit_cast(uint32_t, __builtin_convertvector(v, bf16v2_t));
}
__device__ __forceinline__ bf16_t f2bf(float f) { return (bf16_t)(pack2(f, 0.f) & 0xffffu); }
__device__ __forceinline__ float lo16(uint32_t u) { return __uint_as_float(u << 16); }
__device__ __forceinline__ float hi16(uint32_t u) { return __uint_as_float(u & 0xffff0000u); }
__device__ __forceinline__ float sigmoidf_(float v) { return 1.f / (1.f + __expf(-v)); }
__device__ __forceinline__ int mod_row(int row) { return row < NX ? (row >> 12) : 4; }

#define XB_TMO      128
#define XB_XCNT(j)  (256  + 64 * (j))
#define XB_XSUB(j)  (1280 + 64 * (j))
#define XB_XGEN(j)  (2304 + 64 * (j))
#define XB_TOP      3328
#define XB_TOPGEN   3392
#define XCD_BAR_WORDS 3456
#define XB_SPIN_CAP (1u << 18)
#define LAS __attribute__((address_space(3)))

__device__ __forceinline__ unsigned xb_ld(unsigned* p)              { return __hip_atomic_load(p, __ATOMIC_RELAXED, __HIP_MEMORY_SCOPE_AGENT); }
__device__ __forceinline__ unsigned xb_add(unsigned* p, unsigned v) { return __hip_atomic_fetch_add(p, v, __ATOMIC_RELAXED, __HIP_MEMORY_SCOPE_AGENT); }
__device__ __forceinline__ unsigned xb_xcc_id() { return (unsigned)__builtin_amdgcn_s_getreg((3 << 11) | 20) & 0xFu; }
#define XB_SPIN(cond, bar) do { unsigned _sp = 0; while (cond) { __builtin_amdgcn_s_sleep(1); \
    if ((++_sp & 255u) == 0u) { if (xb_ld(&(bar)[XB_TMO])) break; if (_sp > XB_SPIN_CAP) { atomicAdd(&(bar)[XB_TMO], 1u); break; } } } } while (0)

struct XcdBarrier {
    unsigned* bar; unsigned x;
    volatile LAS unsigned* st;
};

__device__ __forceinline__ XcdBarrier xcd_barrier_post(unsigned* bar, volatile LAS unsigned* st) {
    XcdBarrier b; b.bar = bar; b.x = xb_xcc_id(); b.st = st;
    if (threadIdx.x == 0) (void)xb_add(&bar[XB_XCNT(b.x)], 1u);
    return b;
}
__device__ __forceinline__ void xcd_barrier_complete(unsigned* bar, unsigned x, unsigned& nloc, unsigned& nx) {
    const unsigned G = gridDim.x * gridDim.y * gridDim.z;
    unsigned sum, cnt, mine, sp = 0u;
    for (;;) {
        sum = 0u; cnt = 0u; mine = 0u;
#pragma unroll
        for (unsigned j = 0; j < 16; ++j) { const unsigned c = xb_ld(&bar[XB_XCNT(j)]); sum += c; cnt += (c > 0u) ? 1u : 0u; mine = (j == x) ? c : mine; }
        if (sum == G) break;
        __builtin_amdgcn_s_sleep(1);
        if ((++sp & 255u) == 0u) { if (xb_ld(&bar[XB_TMO])) break; if (sp > XB_SPIN_CAP) { atomicAdd(&bar[XB_TMO], 1u); break; } }
    }
    nloc = mine > 0u ? mine : 1u; nx = cnt > 0u ? cnt : 1u;
}

__device__ __forceinline__ void xcd_barrier(const XcdBarrier& b) {
    asm volatile("s_waitcnt vmcnt(0)" ::: "memory");
    __syncthreads();
    if (threadIdx.x == 0) {
        unsigned* bar = b.bar;
        __builtin_amdgcn_s_waitcnt(0);
        unsigned nloc = b.st[0], nx = b.st[1];
        if (nloc == 0u) { xcd_barrier_complete(bar, b.x, nloc, nx); b.st[0] = nloc; b.st[1] = nx; }
        const unsigned old = xb_add(&bar[XB_XSUB(b.x)], 1u);
        const unsigned gen = old / nloc;
        if (old + 1u == (gen + 1u) * nloc) {
            __builtin_amdgcn_fence(__ATOMIC_RELEASE, "agent");
            asm volatile("s_waitcnt vmcnt(0)" ::: "memory");
            const unsigned og = xb_add(&bar[XB_TOP], 1u);
            const unsigned tg = og / nx;
            if (og + 1u == (tg + 1u) * nx) xb_add(&bar[XB_TOPGEN], 1u);
            else XB_SPIN(xb_ld(&bar[XB_TOPGEN]) == tg, bar);
            __builtin_amdgcn_fence(__ATOMIC_ACQUIRE, "agent");
            xb_add(&bar[XB_XGEN(b.x)], 1u);
            asm volatile("s_waitcnt vmcnt(0)" ::: "memory");
        } else {
            XB_SPIN(xb_ld(&bar[XB_XGEN(b.x)]) == gen, bar);
            __builtin_amdgcn_fence(__ATOMIC_ACQUIRE, "agent");
            asm volatile("s_waitcnt vmcnt(0)" ::: "memory");
        }
    }
    __syncthreads();
}


template <int BM, int BN, int WGM, int WGN, bool TRB>
struct Gemm {
  static constexpr int WM = BM / WGM, WN = BN / WGN, MT = WM / 32, NTL = WN / 32;
  static constexpr int CA = BM * 8 / 256, CB = BN * 8 / 256;
  static constexpr int SA_ELEMS = BM * 72, SB_ELEMS = BN * 72;

  __device__ static __forceinline__ void zero(f32x16 (&acc)[MT][NTL]) {
#pragma unroll
    for (int i = 0; i < MT; ++i)
#pragma unroll
      for (int j = 0; j < NTL; ++j)
#pragma unroll
        for (int r = 0; r < 16; ++r) acc[i][j][r] = 0.f;
  }

  __device__ static __forceinline__ void run(const Cx& X, const bf16_t* __restrict__ A, int lda, const bf16_t* __restrict__ B, int ldb,
                                             int K, char* smem, f32x16 (&acc)[MT][NTL]) {
    const int tid = X.tid, lane = tid & 63, w = tid >> 6;
    const int wm = w / WGN, wn = w % WGN;
    bf16_t* sA = (bf16_t*)smem;
    bf16_t* sB = sA + 2 * SA_ELEMS;
    uint4 ra0, ra1, ra2, ra3, rb0, rb1, rb2 = make_uint4(0, 0, 0, 0), rb3 = make_uint4(0, 0, 0, 0);
    static_assert(CA == 4 && CB >= 2 && CB <= 4, "tile loader shape");
    const int nk = K >> 6;
#define LDA_(i, k0) (*(const uint4*)(A + (size_t)((tid + 256 * (i)) >> 3) * lda + (k0) + ((tid + 256 * (i)) & 7) * 8))
#define LDB_(i, k0)                                                                                                        \
  (!TRB ? *(const uint4*)(B + (size_t)((tid + 256 * (i)) >> 3) * ldb + (k0) + ((tid + 256 * (i)) & 7) * 8)                 \
        : *(const uint4*)(B + (size_t)((k0) + (tid + 256 * (i)) / (BN / 8)) * ldb + ((tid + 256 * (i)) % (BN / 8)) * 8))
#define GLOAD(k0)                                                                      \
  {                                                                                    \
    ra0 = LDA_(0, k0); ra1 = LDA_(1, k0); ra2 = LDA_(2, k0); ra3 = LDA_(3, k0);        \
    rb0 = LDB_(0, k0); rb1 = LDB_(1, k0);                                              \
    if (CB > 2) rb2 = LDB_(2, k0);                                                     \
    if (CB > 3) rb3 = LDB_(3, k0);                                                     \
  }
#define STA_(i, buf, v) *(uint4*)(sA + (buf)*SA_ELEMS + ((tid + 256 * (i)) >> 3) * 72 + ((tid + 256 * (i)) & 7) * 8) = v
#define STB_(i, buf, v)                                                                                       \
  {                                                                                                           \
    const int c_ = tid + 256 * (i);                                                                           \
    if (!TRB) *(uint4*)(sB + (buf)*SB_ELEMS + (c_ >> 3) * 72 + (c_ & 7) * 8) = v;                             \
    else {                                                                                                    \
      bf16_t* p = sB + (buf)*SB_ELEMS + (c_ % (BN / 8)) * 8 * 72 + c_ / (BN / 8);                             \
      p[0] = (bf16_t)(v.x & 0xffff); p[72] = (bf16_t)(v.x >> 16);                                             \
      p[144] = (bf16_t)(v.y & 0xffff); p[216] = (bf16_t)(v.y >> 16);                                          \
      p[288] = (bf16_t)(v.z & 0xffff); p[360] = (bf16_t)(v.z >> 16);                                          \
      p[432] = (bf16_t)(v.w & 0xffff); p[504] = (bf16_t)(v.w >> 16);                                          \
    }                                                                                                         \
  }
#define SSTORE(buf)                                                                    \
  {                                                                                    \
    STA_(0, buf, ra0); STA_(1, buf, ra1); STA_(2, buf, ra2); STA_(3, buf, ra3);        \
    STB_(0, buf, rb0); STB_(1, buf, rb1);                                              \
    if (CB > 2) STB_(2, buf, rb2);                                                     \
    if (CB > 3) STB_(3, buf, rb3);                                                     \
  }
    GLOAD(0);
    SSTORE(0);
    __syncthreads();
    for (int kt = 0; kt < nk; ++kt) {
      const int buf = kt & 1;
      if (kt + 1 < nk) GLOAD((kt + 1) * 64);
      const bf16_t* pa = sA + buf * SA_ELEMS + (wm * WM + (lane & 31)) * 72 + (lane >> 5) * 8;
      const bf16_t* pb = sB + buf * SB_ELEMS + (wn * WN + (lane & 31)) * 72 + (lane >> 5) * 8;
#pragma unroll
      for (int ks = 0; ks < 4; ++ks) {
        bf16x8 af[MT], bfr[NTL];
#pragma unroll
        for (int i = 0; i < MT; ++i) af[i] = *(const bf16x8*)(pa + i * 32 * 72 + ks * 16);
#pragma unroll
        for (int j = 0; j < NTL; ++j) bfr[j] = *(const bf16x8*)(pb + j * 32 * 72 + ks * 16);
#pragma unroll
        for (int i = 0; i < MT; ++i)
#pragma unroll
          for (int j = 0; j < NTL; ++j) acc[i][j] = __builtin_amdgcn_mfma_f32_32x32x16_bf16(af[i], bfr[j], acc[i][j], 0, 0, 0);
      }
      if (kt + 1 < nk) SSTORE(buf ^ 1);
      __syncthreads();
    }
#undef GLOAD
#undef SSTORE
#undef LDA_
#undef LDB_
#undef STA_
#undef STB_
  }
};

typedef Gemm<128, 128, 2, 2, false> G22;
typedef Gemm<128, 128, 2, 2, true> G22T;
typedef Gemm<128, 64, 2, 2, false> GMG;
typedef Gemm<128, 96, 4, 1, false> GQ;
typedef Gemm<128, 128, 4, 1, false> GKV;

#define ROW_OF(reg) (((reg) & 3) + 8 * ((reg) >> 2) + 4 * (lane >> 5))

__device__ __forceinline__ void job_mod(const Params& P, const Cx& X, char* smem, int job) {
  float* sc = (float*)smem;
  const int tid = X.tid;
  for (int i = tid; i < 5 * 1024; i += 256) {
    int r = i >> 10, k = i & 1023;
    float v = r < 4 ? P.in[1][r * 1024 + k] : P.in[3][k];
    sc[i] = v / (1.f + expf(-v));
  }
  __syncthreads();
  const int l = job / 96, n = (job % 96) * 64 + (tid & 63), w = tid >> 6;
  const float* W = P.in[4] + (size_t)l * 1024 * 6144;
  float a0 = 0, a1 = 0, a2 = 0, a3 = 0, a4 = 0;
#pragma unroll 4
  for (int k = w * 256; k < w * 256 + 256; ++k) {
    float wv = W[(size_t)k * 6144 + n];
    a0 += sc[k] * wv; a1 += sc[1024 + k] * wv; a2 += sc[2048 + k] * wv; a3 += sc[3072 + k] * wv; a4 += sc[4096 + k] * wv;
  }
  float* red = sc + 5 * 1024;
  red[(w * 5 + 0) * 64 + (tid & 63)] = a0; red[(w * 5 + 1) * 64 + (tid & 63)] = a1; red[(w * 5 + 2) * 64 + (tid & 63)] = a2;
  red[(w * 5 + 3) * 64 + (tid & 63)] = a3; red[(w * 5 + 4) * 64 + (tid & 63)] = a4;
  __syncthreads();
  float* modv = (float*)(X.ws + OFF_MOD);
  for (int i = tid; i < 320; i += 256) {
    int r = i >> 6, c = i & 63;
    int nn = (job % 96) * 64 + c;
    float s = red[(0 * 5 + r) * 64 + c] + red[(1 * 5 + r) * 64 + c] + red[(2 * 5 + r) * 64 + c] + red[(3 * 5 + r) * 64 + c];
    modv[(size_t)(l * 5 + r) * 6144 + nn] = s + P.in[5][l * 6144 + nn];
  }
  __syncthreads();
}

__device__ __forceinline__ void job_tables(const Params& P, const Cx& X, int job) {
  float2* tw = (float2*)(X.ws + OFF_TW);
  bf16_t* F1 = (bf16_t*)(X.ws + OFF_F1);
  bf16_t* F2 = (bf16_t*)(X.ws + OFF_F2);
  bf16_t* F256 = (bf16_t*)(X.ws + OFF_F256);
  float2* rope = (float2*)(X.ws + OFF_ROPE);
  for (int e = job * 4096 + X.tid; e < job * 4096 + 4096; e += 256) {
    int i = e;
    if (i < 4096) { tw[i] = make_float2(cospif(i / 2048.f), sinpif(i / 2048.f)); continue; }
    i -= 4096;
    if (i < 8192) {
      int R = i >> 6, t1 = i & 63;
      int f1 = (R >> 6) * 32 + (R & 31);
      int ph = (f1 * t1) & 63;
      F1[i] = f2bf(((R >> 5) & 1) ? -sinpif(ph / 32.f) : cospif(ph / 32.f));
      continue;
    }
    i -= 8192;
    if (i < 16384) {
      int m = i >> 7, k = i & 127;
      int f2 = m & 63, q = m >> 6, t2 = k & 63, p = k >> 6;
      int ph = (f2 * t2) & 63;
      float c = cospif(ph / 32.f), s = sinpif(ph / 32.f);
      float v = (q == 0) ? (p == 0 ? c : s) : (p == 0 ? -s : c);
      F2[i] = f2bf(v);
      continue;
    }
    i -= 16384;
    if (i < 131072) {
      int m = i >> 8, t = i & 255;
      int f = m & 255, q = m >> 8;
      int ph = (f * t) & 255;
      F256[i] = f2bf(q == 0 ? cospif(ph / 128.f) : -sinpif(ph / 128.f));
      continue;
    }
    i -= 131072;
    if (i < 65536) {
      int t = i >> 4, j = i & 15;
      float invf = powf(10000.f, -(float)(j & 7) / 8.f);
      float pos = (j < 8) ? (float)(t >> 6) : (float)(t & 63);
      float ang = pos * invf;
      rope[i] = make_float2(cosf(ang), sinf(ang));
    }
  }
}

__device__ __forceinline__ void cw_tile(const Cx& X, const float* __restrict__ src, int N, int lds_, bf16_t* __restrict__ dst, int ldd, const float* scale,
                        int perm, int tk, int tn, char* smem) {
  float* tile = (float*)smem;
  const int tid = X.tid;
  const int c = tid & 63, r0 = tid >> 6;
  const int ng = tn * 64 + c;
#pragma unroll 4
  for (int i = 0; i < 16; ++i) {
    int r = r0 + 4 * i;
    float v = (ng < N) ? src[(size_t)(tk * 64 + r) * lds_ + ng] : 0.f;
    if (scale) v *= scale[tk * 64 + r];
    tile[r * 65 + c] = v;
  }
  __syncthreads();
#pragma unroll 4
  for (int i = 0; i < 16; ++i) {
    int nn = r0 + 4 * i;
    int n2 = tn * 64 + nn;
    if (n2 < N) {
      int drow = n2;
      if (perm) {
        int u = n2 < 2816 ? n2 : n2 - 2816;
        drow = (u >> 5) * 64 + (n2 < 2816 ? 0 : 32) + (u & 31);
      }
      dst[(size_t)drow * ldd + tk * 64 + c] = f2bf(tile[c * 65 + nn]);
    }
  }
  __syncthreads();
}

__device__ __forceinline__ void fold_job(const Params& P, const Cx& X, int layer, int fj, char* smem) {
  float* wt = (float*)smem;
  float* ct = wt + 4096;
  const int tid = X.tid;
  const int g = fj >> 4, n0 = (fj & 15) * 64;
  const float* src = P.in[28] + (size_t)layer * 512 * 1024;
  for (int i = tid; i < 4096; i += 256) wt[i] = src[(size_t)(g * 64 + (i >> 6)) * 1024 + n0 + (i & 63)];
  if (tid < 64) { ct[tid] = cospif(tid / 32.f); ct[64 + tid] = sinpif(tid / 32.f); }
  __syncthreads();
  bf16_t* dst = (bf16_t*)(X.ws + OFF_WMIX) + WE_FO;
  const int c = tid & 63, nq = tid >> 6;
#pragma unroll 1
  for (int ni = 0; ni < 16; ++ni) {
    int n = nq * 16 + ni;
    float sr = 0.f, si = 0.f;
#pragma unroll 4
    for (int cp = 0; cp < 64; ++cp) {
      float wv = wt[cp * 64 + n];
      int ph = (c * cp) & 63;
      sr += ct[ph] * wv;
      si += ct[64 + ph] * wv;
    }
    dst[(size_t)(n0 + n) * 1024 + g * 64 + c] = f2bf(sr * (1.f / 512.f));
    dst[(size_t)(n0 + n) * 1024 + 512 + g * 64 + c] = f2bf(si * (1.f / 512.f));
  }
  __syncthreads();
}

#define NCW1 2312
__device__ __forceinline__ void cw_mixer_job(const Params& P, const Cx& X, int layer, int j, char* smem) {
  bf16_t* W = (bf16_t*)(X.ws + OFF_WMIX);
  const float* src; const float* scale = nullptr; bf16_t* dst; int N, ldd, tk, tn;
  if (j >= 2184) { fold_job(P, X, layer, j - 2184, smem); return; }
  if (j < 1520) { src = P.in[7] + (size_t)layer * 1024 * 6048; N = 6048; dst = W + WE_IN; ldd = 1024; tk = j / 95; tn = j % 95; }
  else if (j < 1536) { j -= 1520; int d = j >> 3; src = P.in[11] + (size_t)(layer * 2 + d) * 64 * 512; N = 512; dst = W + WE_W2 + d * 32768; ldd = 64; tk = 0; tn = j & 7; }
  else if (j < 1552) { j -= 1536; int d = j >> 3; src = P.in[13] + (size_t)(layer * 2 + d) * 64 * 512; N = 512; dst = W + WE_A2 + d * 32768; ldd = 64; tk = 0; tn = j & 7; }
  else if (j < 1568) { j -= 1552; src = P.in[17] + (size_t)layer * 128 * 512; N = 512; dst = W + WE_G2; ldd = 128; tk = j >> 3; tn = j & 7; }
  else if (j < 1696) { j -= 1568; src = P.in[20] + (size_t)layer * 512 * 1024; N = 1024; dst = W + WE_RO; ldd = 512; tk = j >> 4; tn = j & 15; }
  else if (j < 1824) { j -= 1696; src = P.in[27] + (size_t)layer * 512 * 1024; N = 1024; dst = W + WE_MO; ldd = 512; tk = j >> 4; tn = j & 15; }
  else if (j < 1896) { j -= 1824; src = P.in[23] + (size_t)layer * 384 * 768; N = 768; dst = W + WE_UQ; ldd = 384; scale = P.in[21] + layer * 384; tk = j / 12; tn = j % 12; }
  else if (j < 1928) { j -= 1896; src = P.in[24] + (size_t)layer * 128 * 1024; N = 1024; dst = W + WE_UKV; ldd = 128; scale = P.in[22] + layer * 128; tk = j >> 4; tn = j & 15; }
  else { j -= 1928; src = P.in[29] + (size_t)layer * 1024 * 1024; N = 1024; dst = W + WE_OUT; ldd = 1024; tk = j >> 4; tn = j & 15; }
  cw_tile(X, src, N, N, dst, ldd, scale, 0, tk, tn, smem);
}
#define NCW2 2112
__device__ __forceinline__ void cw_ffn_job(const Params& P, const Cx& X, int layer, int j, char* smem) {
  bf16_t* W = (bf16_t*)(X.ws + OFF_WFFN);
  const float* src; bf16_t* dst; int N, ldd, tk, tn, perm;
  if (j < 1408) { src = P.in[31] + (size_t)layer * 1024 * 5632; N = 5632; dst = W + WF_IN; ldd = 1024; perm = 1; tk = j / 88; tn = j % 88; }
  else { j -= 1408; src = P.in[32] + (size_t)layer * 2816 * 1024; N = 1024; dst = W + WF_OUT; ldd = 2816; perm = 0; tk = j >> 4; tn = j & 15; }
  cw_tile(X, src, N, N, dst, ldd, nullptr, perm, tk, tn, smem);
}

__device__ __forceinline__ void norm_job(const Params& P, const Cx& X, int layer, int which, int job) {
  const int lane = X.tid & 63, w = X.tid >> 6;
  const int row = job * 4 + w;
  const float* src;
  if (which == 0) {
    if (row < NX) src = (layer == 0 ? P.in[0] : X.out) + (size_t)row * 1024;
    else src = (layer == 0 ? P.in[2] : (const float*)(X.ws + OFF_CS)) + (size_t)(row - NX) * 1024;
  } else {
    if (row < NX) src = X.out + (size_t)row * 1024;
    else src = (const float*)(X.ws + OFF_CS) + (size_t)(row - NX) * 1024;
  }
  const float* g = (which == 0 ? P.in[6] : P.in[30]) + layer * 1024;
  const float* modv = (const float*)(X.ws + OFF_MOD) + (size_t)(layer * 5 + mod_row(row)) * 6144;
  const float* shift = modv + (which == 0 ? 0 : 3072);
  const float* scale = modv + (which == 0 ? 1024 : 4096);
  float4 v[4];
  float ss = 0.f;
#pragma unroll
  for (int i = 0; i < 4; ++i) {
    v[i] = ((const float4*)src)[lane + 64 * i];
    ss += v[i].x * v[i].x + v[i].y * v[i].y + v[i].z * v[i].z + v[i].w * v[i].w;
  }
#pragma unroll
  for (int o = 32; o >= 1; o >>= 1) ss += __shfl_xor(ss, o);
  const float rstd = rsqrtf(ss * (1.f / 1024.f) + 1e-6f);
  bf16_t* dst = (bf16_t*)(X.ws + OFF_HBUF) + (size_t)row * 1024;
#pragma unroll
  for (int i = 0; i < 4; ++i) {
    int col = 4 * (lane + 64 * i);
    float4 gg = *(const float4*)(g + col), sh = *(const float4*)(shift + col), sc = *(const float4*)(scale + col);
    float y0 = v[i].x * rstd * gg.x * (1.f + sc.x) + sh.x;
    float y1 = v[i].y * rstd * gg.y * (1.f + sc.y) + sh.y;
    float y2 = v[i].z * rstd * gg.z * (1.f + sc.z) + sh.z;
    float y3 = v[i].w * rstd * gg.w * (1.f + sc.w) + sh.w;
    uint2 o;
    o.x = pack2(y0, y1); o.y = pack2(y2, y3);
    *(uint2*)(dst + col) = o;
  }
}

__device__ __forceinline__ void g1a_tile(const Params& P, const Cx& X, int t, char* smem) {
  const int lane = X.tid & 63, w = X.tid >> 6;
  const int mt = t % 136, nt = t / 136;
  const int m0 = mt * 128, n0 = nt * 128;
  f32x16 acc[2][2];
  G22::zero(acc);
  G22::run(X, (const bf16_t*)(X.ws + OFF_HBUF) + (size_t)m0 * 1024, 1024, (const bf16_t*)(X.ws + OFF_WMIX) + WE_IN + (size_t)n0 * 1024, 1024, 1024, smem, acc);
  bf16_t* zr = (bf16_t*)(X.ws + OFF_ZR);
  const int row0 = m0 + (w >> 1) * 64, col0 = n0 + (w & 1) * 64;
#pragma unroll
  for (int i = 0; i < 2; ++i)
#pragma unroll
    for (int j = 0; j < 2; ++j)
#pragma unroll
      for (int r = 0; r < 16; ++r) {
        int row = row0 + i * 32 + ROW_OF(r), col = col0 + j * 32 + (lane & 31);
        zr[(size_t)row * 1920 + col] = f2bf(acc[i][j][r]);
      }
}
__device__ __forceinline__ void g1b_tile(const Params& P, const Cx& X, int t, char* smem) {
  const int lane = X.tid & 63, w = X.tid >> 6;
  const int mt = t % 136, nt = t / 136;
  const int m0 = mt * 128, n0 = nt * 128;
  f32x16 acc[2][2];
  G22::zero(acc);
  G22::run(X, (const bf16_t*)(X.ws + OFF_HBUF) + (size_t)m0 * 1024, 1024, (const bf16_t*)(X.ws + OFF_WMIX) + WE_IN + (size_t)(1920 + n0) * 1024, 1024, 1024, smem, acc);
  bf16_t* zm = (bf16_t*)(X.ws + OFF_ZM);
  bf16_t* zf = (bf16_t*)(X.ws + OFF_ZF);
  const int row0 = m0 + (w >> 1) * 64, col0 = n0 + (w & 1) * 64;
#pragma unroll
  for (int i = 0; i < 2; ++i)
#pragma unroll
    for (int j = 0; j < 2; ++j)
#pragma unroll
      for (int r = 0; r < 16; ++r) {
        int row = row0 + i * 32 + ROW_OF(r), col = col0 + j * 32 + (lane & 31);
        bf16_t v = f2bf(acc[i][j][r]);
        if (col < 544) zm[(size_t)row * 544 + col] = v;
        else if (col < 1056) zf[(size_t)row * 512 + (col - 544)] = v;
      }
}

__device__ __forceinline__ void r1a_row(const Params& P, const Cx& X, int layer, int row) {
  const int tid = X.tid;
  const int ch = tid < 240 ? tid : 239;
  const int col0 = ch * 8;
  const bf16_t* zr = (const bf16_t*)(X.ws + OFF_ZR);
  bool hp, hn;
  if (row < NX) { int t = row & 4095; hp = t > 0; hn = t < 4095; }
  else { int j = (row - NX) & 255; hp = j > 0; hn = j < 255; }
  uint4 zc = *(const uint4*)(zr + (size_t)row * 1920 + col0);
  uint4 zp = make_uint4(0, 0, 0, 0), zn = make_uint4(0, 0, 0, 0);
  if (hp) zp = *(const uint4*)(zr + (size_t)(row - 1) * 1920 + col0);
  if (hn) zn = *(const uint4*)(zr + (size_t)(row + 1) * 1920 + col0);
  const float* mup = P.in[8] + layer * 1920 + col0;
  const float* mun = P.in[9] + layer * 1920 + col0;
  float zs[8];
  {
    const uint32_t c4[4] = {zc.x, zc.y, zc.z, zc.w}, p4[4] = {zp.x, zp.y, zp.z, zp.w}, n4[4] = {zn.x, zn.y, zn.z, zn.w};
#pragma unroll
    for (int i = 0; i < 4; ++i) {
      float c0 = lo16(c4[i]), c1 = hi16(c4[i]);
      zs[2 * i] = c0 + (lo16(p4[i]) - c0) * mup[2 * i] + (lo16(n4[i]) - c0) * mun[2 * i];
      zs[2 * i + 1] = c1 + (hi16(p4[i]) - c1) * mup[2 * i + 1] + (hi16(n4[i]) - c1) * mun[2 * i + 1];
    }
  }
  float ss = 0.f;
  float kv[8];
  const bool isk = (col0 >= 512 && col0 < 1024);
  {
    const float* kk_w = P.in[14] + layer * 512 + (isk ? col0 - 512 : 0);
#pragma unroll
    for (int i = 0; i < 8; ++i) { kv[i] = zs[i] * kk_w[i]; ss += kv[i] * kv[i]; }
  }
  ss += __shfl_xor(ss, 1); ss += __shfl_xor(ss, 2); ss += __shfl_xor(ss, 4);
  if (tid < 240) {
    uint4 o;
    if (col0 < 1536) {
      o.x = pack2(zs[0], zs[1]); o.y = pack2(zs[2], zs[3]); o.z = pack2(zs[4], zs[5]); o.w = pack2(zs[6], zs[7]);
      *(uint4*)((bf16_t*)(X.ws + OFF_RKV) + (size_t)row * 1536 + col0) = o;
      if (isk) {
        float inv = 1.f / fmaxf(sqrtf(ss), 1e-12f);
        o.x = pack2(kv[0] * inv, kv[1] * inv); o.y = pack2(kv[2] * inv, kv[3] * inv);
        o.z = pack2(kv[4] * inv, kv[5] * inv); o.w = pack2(kv[6] * inv, kv[7] * inv);
        *(uint4*)((bf16_t*)(X.ws + OFF_KK) + (size_t)row * 512 + (col0 - 512)) = o;
      }
    } else {
      float t[8];
      if (col0 < 1664) {
#pragma unroll
        for (int i = 0; i < 8; ++i) t[i] = tanhf(zs[i]);
      } else if (col0 < 1792) {
#pragma unroll
        for (int i = 0; i < 8; ++i) t[i] = zs[i];
      } else {
#pragma unroll
        for (int i = 0; i < 8; ++i) t[i] = 1.f / (1.f + expf(-zs[i]));
      }
      o.x = pack2(t[0], t[1]); o.y = pack2(t[2], t[3]); o.z = pack2(t[4], t[5]); o.w = pack2(t[6], t[7]);
      *(uint4*)((bf16_t*)(X.ws + OFF_LORA) + (size_t)row * 384 + (col0 - 1536)) = o;
    }
  }
}

__device__ __forceinline__ void r1b_tile(const Params& P, const Cx& X, int layer, int t, char* smem) {
  const int lane = X.tid & 63, w = X.tid >> 6;
  const int mt = t % 136, rest = t / 136;
  const int nt = rest & 3, type = rest >> 2;
  const int m0 = mt * 128, n0 = nt * 128;
  const bf16_t* lora = (const bf16_t*)(X.ws + OFF_LORA) + (size_t)m0 * 384;
  const bf16_t* W = (const bf16_t*)(X.ws + OFF_WMIX);
  f32x16 acc[2][2];
  G22::zero(acc);
  if (type < 2) G22::run(X, lora + type * 64, 384, W + WE_W2 + type * 32768 + (size_t)n0 * 64, 64, 64, smem, acc);
  else if (type < 4) G22::run(X, lora + 128 + (type - 2) * 64, 384, W + WE_A2 + (type - 2) * 32768 + (size_t)n0 * 64, 64, 64, smem, acc);
  else G22::run(X, lora + 256, 384, W + WE_G2 + (size_t)n0 * 128, 128, 128, smem, acc);
  const int row0 = m0 + (w >> 1) * 64, col0 = n0 + (w & 1) * 64;
  bf16_t* ld = (bf16_t*)(X.ws + OFF_LD);
  bf16_t* ab = (bf16_t*)(X.ws + OFF_A);
  bf16_t* gb = (bf16_t*)(X.ws + OFF_G);
#pragma unroll
  for (int j = 0; j < 2; ++j) {
    const int col = col0 + j * 32 + (lane & 31);
    float bias = 0.f;
    if (type < 2) bias = P.in[10][(layer * 2 + type) * 512 + col];
    else if (type < 4) bias = P.in[12][(layer * 2 + type - 2) * 512 + col];
#pragma unroll
    for (int i = 0; i < 2; ++i)
#pragma unroll
      for (int r = 0; r < 16; ++r) {
        int row = row0 + i * 32 + ROW_OF(r);
        float v = acc[i][j][r] + bias;
        if (type < 2) ld[(size_t)row * 1024 + type * 512 + col] = f2bf(-0.60653066f / (1.f + __expf(-v)));
        else if (type < 4) ab[(size_t)row * 1024 + (type - 2) * 512 + col] = f2bf(1.f / (1.f + __expf(-v)));
        else gb[(size_t)row * 512 + col] = f2bf(v);
      }
  }
}

template <int CTRL>
__device__ __forceinline__ float dpp_f(float x) {
  return __int_as_float(__builtin_amdgcn_update_dpp(0, __float_as_int(x), CTRL, 0xf, 0xf, false));
}
__device__ __forceinline__ float red16(float x) {
  x += dpp_f<0x128>(x);
  x += dpp_f<0x124>(x);
  x += dpp_f<0x4E>(x);
  x += dpp_f<0xB1>(x);
  return x;
}
__device__ __forceinline__ int scan_tokrow(int b, int dir, int i) {
  if (i < 256) return NX + b * 256 + (dir ? 255 - i : i);
  int t = i - 256;
  return b * 4096 + (dir ? 4095 - t : t);
}
__device__ __forceinline__ void scan_job(const Params& P, const Cx& X, int layer, int bj, char* smem) {
  const int tid = X.tid, lane = tid & 63, w = tid >> 6;
  const int s = bj >> 2, rq = bj & 3;
  const int dir = s >> 5, b = (s & 31) >> 3, h = s & 7;
  float* sv = (float*)smem;
  float* sy = sv + 2 * 16 * 6 * 64;
  const bf16_t* rkv = (const bf16_t*)(X.ws + OFF_RKV);
  const bf16_t* kkb = (const bf16_t*)(X.ws + OFF_KK);
  const bf16_t* ab = (const bf16_t*)(X.ws + OFF_A);
  const bf16_t* ldb = (const bf16_t*)(X.ws + OFF_LD);
  bf16_t* yout = (bf16_t*)(X.ws + (dir ? OFF_YB : OFF_YF));
  const int lst = tid >> 4, lch = (tid & 15) * 4;
  const float4 ka4 = *(const float4*)(P.in[15] + layer * 512 + h * 64 + lch);
  uint2 pr, pk, pv, pkk, pa, pl;
#define SLOAD(chunk)                                                          \
  {                                                                           \
    int row = scan_tokrow(b, dir, (chunk)*16 + lst);                          \
    const bf16_t* p0 = rkv + (size_t)row * 1536 + h * 64 + lch;               \
    pr = *(const uint2*)p0; pk = *(const uint2*)(p0 + 512); pv = *(const uint2*)(p0 + 1024); \
    pkk = *(const uint2*)(kkb + (size_t)row * 512 + h * 64 + lch);            \
    pa = *(const uint2*)(ab + (size_t)row * 1024 + dir * 512 + h * 64 + lch); \
    pl = *(const uint2*)(ldb + (size_t)row * 1024 + dir * 512 + h * 64 + lch);\
  }
#define SSTORE2(buf)                                                          \
  {                                                                           \
    float* d = sv + ((buf)*16 + lst) * 384 + lch;                             \
    float a0 = lo16(pa.x), a1 = hi16(pa.x), a2 = lo16(pa.y), a3 = hi16(pa.y); \
    float k0 = lo16(pk.x), k1 = hi16(pk.x), k2 = lo16(pk.y), k3 = hi16(pk.y); \
    float q0 = lo16(pkk.x), q1 = hi16(pkk.x), q2 = lo16(pkk.y), q3 = hi16(pkk.y); \
    *(float4*)(d) = make_float4(q0, q1, q2, q3);                              \
    *(float4*)(d + 64) = make_float4(__expf(lo16(pl.x)), __expf(hi16(pl.x)), __expf(lo16(pl.y)), __expf(hi16(pl.y))); \
    *(float4*)(d + 128) = make_float4(q0 * a0, q1 * a1, q2 * a2, q3 * a3);    \
    *(float4*)(d + 192) = make_float4(k0 * (1.f + (a0 - 1.f) * ka4.x), k1 * (1.f + (a1 - 1.f) * ka4.y), k2 * (1.f + (a2 - 1.f) * ka4.z), k3 * (1.f + (a3 - 1.f) * ka4.w)); \
    *(float4*)(d + 256) = make_float4(lo16(pr.x), hi16(pr.x), lo16(pr.y), hi16(pr.y)); \
    *(float4*)(d + 320) = make_float4(lo16(pv.x), hi16(pv.x), lo16(pv.y), hi16(pv.y)); \
  }
  SLOAD(0);
  SSTORE2(0);
  __syncthreads();
  const int rl = w * 4 + (lane >> 4), ci = (lane & 15) * 4;
  const int vrow = rq * 16 + rl;
  float S0 = 0.f, S1 = 0.f, S2 = 0.f, S3 = 0.f;
  for (int chunk = 0; chunk < 272; ++chunk) {
    const int buf = chunk & 1;
    if (chunk + 1 < 272) SLOAD(chunk + 1);
    const float* base = sv + buf * 16 * 384;
#pragma unroll 4
    for (int st = 0; st < 16; ++st) {
      const float* d = base + st * 384;
      float4 kk4 = *(const float4*)(d + ci);
      float4 w4 = *(const float4*)(d + 64 + ci);
      float4 b4 = *(const float4*)(d + 128 + ci);
      float4 kd4 = *(const float4*)(d + 192 + ci);
      float4 r4 = *(const float4*)(d + 256 + ci);
      float vv = d[320 + vrow];
      float sa = S0 * kk4.x + S1 * kk4.y + S2 * kk4.z + S3 * kk4.w;
      sa = -red16(sa);
      S0 = S0 * w4.x + vv * kd4.x; S1 = S1 * w4.y + vv * kd4.y; S2 = S2 * w4.z + vv * kd4.z; S3 = S3 * w4.w + vv * kd4.w;
      S0 += sa * b4.x; S1 += sa * b4.y; S2 += sa * b4.z; S3 += sa * b4.w;
      float y = S0 * r4.x + S1 * r4.y + S2 * r4.z + S3 * r4.w;
      y = red16(y);
      if ((lane & 15) == 0) sy[(buf * 16 + st) * 16 + rl] = y;
    }
    if (chunk + 1 < 272) SSTORE2(buf ^ 1);
    __syncthreads();
    {
      int st = tid >> 4, r = tid & 15;
      int row = scan_tokrow(b, dir, chunk * 16 + st);
      yout[(size_t)row * 512 + h * 64 + rq * 16 + r] = f2bf(sy[(buf * 16 + st) * 16 + r]);
    }
  }
#undef SLOAD
#undef SSTORE2
  __syncthreads();
}

__device__ __forceinline__ void s2_job(const Params& P, const Cx& X, int layer, int job) {
  const int tid = X.tid;
  const int row = job * 4 + (tid >> 6);
  const int c0 = (tid & 63) * 8;
  const bf16_t* rkv = (const bf16_t*)(X.ws + OFF_RKV) + (size_t)row * 1536;
  uint4 ur = *(const uint4*)(rkv + c0), uk = *(const uint4*)(rkv + 512 + c0), uv = *(const uint4*)(rkv + 1024 + c0);
  uint4 ua0 = *(const uint4*)((const bf16_t*)(X.ws + OFF_A) + (size_t)row * 1024 + c0);
  uint4 ua1 = *(const uint4*)((const bf16_t*)(X.ws + OFF_A) + (size_t)row * 1024 + 512 + c0);
  uint4 ug = *(const uint4*)((const bf16_t*)(X.ws + OFF_G) + (size_t)row * 512 + c0);
  uint4 uyf = *(const uint4*)((const bf16_t*)(X.ws + OFF_YF) + (size_t)row * 512 + c0);
  uint4 uyb = *(const uint4*)((const bf16_t*)(X.ws + OFF_YB) + (size_t)row * 512 + c0);
  const uint32_t r4[4] = {ur.x, ur.y, ur.z, ur.w}, k4[4] = {uk.x, uk.y, uk.z, uk.w}, v4[4] = {uv.x, uv.y, uv.z, uv.w};
  const uint32_t a04[4] = {ua0.x, ua0.y, ua0.z, ua0.w}, a14[4] = {ua1.x, ua1.y, ua1.z, ua1.w}, g4[4] = {ug.x, ug.y, ug.z, ug.w};
  const uint32_t yf4[4] = {uyf.x, uyf.y, uyf.z, uyf.w}, yb4[4] = {uyb.x, uyb.y, uyb.z, uyb.w};
  float y[8], vv[8], gg[8];
  float sum = 0.f, bon = 0.f;
  const float* rk = P.in[16] + layer * 512 + c0;
  const float* ka = P.in[15] + layer * 512 + c0;
#pragma unroll
  for (int i = 0; i < 4; ++i) {
#pragma unroll
    for (int hh = 0; hh < 2; ++hh) {
      int e = 2 * i + hh;
      float r = hh ? hi16(r4[i]) : lo16(r4[i]);
      float k = hh ? hi16(k4[i]) : lo16(k4[i]);
      float a0 = hh ? hi16(a04[i]) : lo16(a04[i]);
      float a1 = hh ? hi16(a14[i]) : lo16(a14[i]);
      y[e] = (hh ? hi16(yf4[i]) : lo16(yf4[i])) + (hh ? hi16(yb4[i]) : lo16(yb4[i]));
      vv[e] = hh ? hi16(v4[i]) : lo16(v4[i]);
      gg[e] = hh ? hi16(g4[i]) : lo16(g4[i]);
      sum += y[e];
      float ksum = k * (2.f + (a0 + a1 - 2.f) * ka[e]);
      bon += r * rk[e] * ksum;
    }
  }
  sum += __shfl_xor(sum, 1); sum += __shfl_xor(sum, 2); sum += __shfl_xor(sum, 4);
  bon += __shfl_xor(bon, 1); bon += __shfl_xor(bon, 2); bon += __shfl_xor(bon, 4);
  const float mu = sum * (1.f / 64.f);
  float var = 0.f;
#pragma unroll
  for (int e = 0; e < 8; ++e) { float d = y[e] - mu; var += d * d; }
  var += __shfl_xor(var, 1); var += __shfl_xor(var, 2); var += __shfl_xor(var, 4);
  const float rs = rsqrtf(var * (1.f / 64.f) + 64e-5f);
  const float* gw = P.in[18] + layer * 512 + c0;
  const float* gbi = P.in[19] + layer * 512 + c0;
  float o[8];
#pragma unroll
  for (int e = 0; e < 8; ++e) o[e] = ((y[e] - mu) * rs * gw[e] + gbi[e] + bon * vv[e]) * gg[e];
  uint4 ou;
  ou.x = pack2(o[0], o[1]); ou.y = pack2(o[2], o[3]); ou.z = pack2(o[4], o[5]); ou.w = pack2(o[6], o[7]);
  *(uint4*)((bf16_t*)(X.ws + OFF_RWO) + (size_t)row * 512 + c0) = ou;
}

__device__ __forceinline__ float red32(float x) {
  x += __shfl_xor(x, 1); x += __shfl_xor(x, 2); x += __shfl_xor(x, 4); x += __shfl_xor(x, 8); x += __shfl_xor(x, 16);
  return x;
}
#define QSCALE 0.14724444f
__device__ __forceinline__ void q1_q_tile(const Params& P, const Cx& X, int layer, int t, char* smem) {
  const int tid = X.tid, lane = tid & 63, w = tid >> 6;
  const int mt = t % 136, head = t / 136;
  const int m0 = mt * 128;
  const bf16_t* zm = (const bf16_t*)(X.ws + OFF_ZM);
  float* srs = (float*)(smem + 73728);
  {
    int r = tid >> 1, hf = tid & 1;
    const bf16_t* p = zm + (size_t)(m0 + r) * 544 + hf * 192;
    float ss = 0.f;
    for (int i = 0; i < 24; ++i) {
      uint4 u = *(const uint4*)(p + i * 8);
      ss += lo16(u.x) * lo16(u.x) + hi16(u.x) * hi16(u.x) + lo16(u.y) * lo16(u.y) + hi16(u.y) * hi16(u.y) +
            lo16(u.z) * lo16(u.z) + hi16(u.z) * hi16(u.z) + lo16(u.w) * lo16(u.w) + hi16(u.w) * hi16(u.w);
    }
    ss += __shfl_xor(ss, 1);
    if (hf == 0) srs[r] = rsqrtf(ss * (1.f / 384.f) + 1e-6f);
  }
  f32x16 acc[1][3];
  GQ::zero(acc);
  GQ::run(X, zm + (size_t)m0 * 544, 544, (const bf16_t*)(X.ws + OFF_WMIX) + WE_UQ + (size_t)head * 96 * 384, 384, 384, smem, acc);
  const int l5 = lane & 31;
  const float* gq = P.in[25] + layer * 96;
  const float g0 = gq[l5], g1 = gq[32 + l5], g2 = gq[64 + l5];
  const float2* rope = (const float2*)(X.ws + OFF_ROPE);
  bf16_t* qb = (bf16_t*)(X.ws + OFF_Q);
#pragma unroll
  for (int r = 0; r < 16; ++r) {
    const int rl = w * 32 + ROW_OF(r);
    const int row = m0 + rl;
    const float rs = srs[rl];
    float x0 = acc[0][0][r] * rs, x1 = acc[0][1][r] * rs, x2 = acc[0][2][r] * rs;
    float ss = red32(x0 * x0 + x1 * x1 + x2 * x2);
    float rq = rsqrtf(ss * (1.f / 96.f) + 1e-6f);
    x0 *= rq * g0; x1 *= rq * g1; x2 *= rq * g2;
    bf16_t* dst;
    if (row < NX) {
      int tt = row & 4095, bb = row >> 12;
      float2 cs = rope[tt * 16 + (l5 >> 4) * 8 + (l5 & 7)];
      float other = __shfl_xor(x2, 8);
      x2 = (l5 & 8) ? x2 * cs.x + other * cs.y : x2 * cs.x - other * cs.y;
      dst = qb + ((size_t)(bb * 8 + head) * 4096 + tt) * 96;
    } else {
      int j = (row - NX) & 255, bb = (row - NX) >> 8;
      dst = qb + (size_t)NX * 768 + ((size_t)(bb * 8 + head) * 256 + j) * 96;
    }
    dst[l5] = f2bf(x0 * QSCALE); dst[32 + l5] = f2bf(x1 * QSCALE); dst[64 + l5] = f2bf(x2 * QSCALE);
  }
}
__device__ __forceinline__ void q1_kv_tile(const Params& P, const Cx& X, int layer, int t, char* smem) {
  const int tid = X.tid, lane = tid & 63, w = tid >> 6;
  const int mt = t % 136, head = t / 136;
  const int m0 = mt * 128;
  const bf16_t* zm = (const bf16_t*)(X.ws + OFF_ZM);
  float* srs = (float*)(smem + 73728);
  {
    int r = tid >> 1, hf = tid & 1;
    const bf16_t* p = zm + (size_t)(m0 + r) * 544 + 384 + hf * 64;
    float ss = 0.f;
    for (int i = 0; i < 8; ++i) {
      uint4 u = *(const uint4*)(p + i * 8);
      ss += lo16(u.x) * lo16(u.x) + hi16(u.x) * hi16(u.x) + lo16(u.y) * lo16(u.y) + hi16(u.y) * hi16(u.y) +
            lo16(u.z) * lo16(u.z) + hi16(u.z) * hi16(u.z) + lo16(u.w) * lo16(u.w) + hi16(u.w) * hi16(u.w);
    }
    ss += __shfl_xor(ss, 1);
    if (hf == 0) srs[r] = rsqrtf(ss * (1.f / 128.f) + 1e-6f);
  }
  f32x16 acc[1][4];
  GKV::zero(acc);
  GKV::run(X, zm + (size_t)m0 * 544 + 384, 544, (const bf16_t*)(X.ws + OFF_WMIX) + WE_UKV + (size_t)head * 128 * 128, 128, 128, smem, acc);
  const int l5 = lane & 31;
  const float* gk = P.in[26] + layer * 96;
  const float g0 = gk[l5], g1 = gk[32 + l5], g2 = gk[64 + l5];
  const float2* rope = (const float2*)(X.ws + OFF_ROPE);
  bf16_t* kb = (bf16_t*)(X.ws + OFF_K);
  bf16_t* vt = (bf16_t*)(X.ws + OFF_VT);
  const bool isx = m0 < NX;
  const int bb = isx ? (m0 >> 12) : ((m0 - NX) >> 8);
  float vv0[16], vv1[16];
#pragma unroll
  for (int r = 0; r < 16; ++r) {
    const int rl = w * 32 + ROW_OF(r);
    const int row = m0 + rl;
    const float rs = srs[rl];
    float k0 = acc[0][0][r] * rs, k1 = acc[0][1][r] * rs;
    float kr = bf2f(zm[(size_t)row * 544 + 512 + l5]);
    float ss = red32(k0 * k0 + k1 * k1 + kr * kr);
    float rk = rsqrtf(ss * (1.f / 96.f) + 1e-6f);
    k0 *= rk * g0; k1 *= rk * g1; kr *= rk * g2;
    int key;
    if (isx) {
      int tt = row & 4095;
      float2 cs = rope[tt * 16 + (l5 >> 4) * 8 + (l5 & 7)];
      float other = __shfl_xor(kr, 8);
      kr = (l5 & 8) ? kr * cs.x + other * cs.y : kr * cs.x - other * cs.y;
      key = 256 + tt;
    } else {
      key = (row - NX) & 255;
    }
    bf16_t* dst = kb + ((size_t)(bb * 8 + head) * 4352 + key) * 96;
    dst[l5] = f2bf(k0); dst[32 + l5] = f2bf(k1); dst[64 + l5] = f2bf(kr);
    vv0[r] = acc[0][2][r] * rs;
    vv1[r] = acc[0][3][r] * rs;
  }
#pragma unroll
  for (int g = 0; g < 4; ++g) {
    const int rl = w * 32 + 8 * g + 4 * (lane >> 5);
    const int row = m0 + rl;
    const int key = isx ? 256 + (row & 4095) : ((row - NX) & 255);
    uint2 o0, o1;
    o0.x = pack2(vv0[4 * g], vv0[4 * g + 1]); o0.y = pack2(vv0[4 * g + 2], vv0[4 * g + 3]);
    o1.x = pack2(vv1[4 * g], vv1[4 * g + 1]); o1.y = pack2(vv1[4 * g + 2], vv1[4 * g + 3]);
    *(uint2*)(vt + ((size_t)(bb * 8 + head) * 64 + l5) * 4352 + key) = o0;
    *(uint2*)(vt + ((size_t)(bb * 8 + head) * 64 + 32 + l5) * 4352 + key) = o1;
  }
}

__device__ __forceinline__ void fft1_tile(const Params& P, const Cx& X, int t, char* smem) {
  const int lane = X.tid & 63, w = X.tid >> 6;
  const int b = t >> 8, ntile = t & 255;
  const int n0 = ntile * 128;
  f32x16 acc[2][2];
  G22T::zero(acc);
  G22T::run(X, (const bf16_t*)(X.ws + OFF_F1), 64, (const bf16_t*)(X.ws + OFF_ZF) + (size_t)b * 4096 * 512 + n0, 32768, 64, smem, acc);
  const float2* tw = (const float2*)(X.ws + OFF_TW);
  bf16_t* out = (bf16_t*)(X.ws + OFF_FFT1);
  const int wm = w >> 1, wn = w & 1;
  const int t2 = n0 >> 9;
#pragma unroll
  for (int j = 0; j < 2; ++j) {
    const int ch = (n0 & 511) + wn * 64 + j * 32 + (lane & 31);
#pragma unroll
    for (int r = 0; r < 16; ++r) {
      const int f1 = wm * 32 + ROW_OF(r);
      float re = acc[0][j][r], im = acc[1][j][r];
      float2 cs = tw[t2 * f1];
      float re2 = re * cs.x + im * cs.y, im2 = im * cs.x - re * cs.y;
      size_t base = ((size_t)(b * 64 + f1) * 128) * 512 + ch;
      out[base + (size_t)t2 * 512] = f2bf(re2);
      out[base + (size_t)(64 + t2) * 512] = f2bf(im2);
    }
  }
}
__device__ __forceinline__ void fft2_tile(const Params& P, const Cx& X, int t, char* smem) {
  const int lane = X.tid & 63, w = X.tid >> 6;
  const int bf = t >> 2, ntile = t & 3;
  const int b = bf >> 6, f1 = bf & 63;
  const int n0 = ntile * 128;
  f32x16 acc[2][2];
  G22T::zero(acc);
  G22T::run(X, (const bf16_t*)(X.ws + OFF_F2), 128, (const bf16_t*)(X.ws + OFF_FFT1) + (size_t)bf * 128 * 512 + n0, 512, 128, smem, acc);
  bf16_t* Y = (bf16_t*)(X.ws + OFF_Y);
  const int wm = w >> 1, wn = w & 1;
#pragma unroll
  for (int i = 0; i < 2; ++i)
#pragma unroll
    for (int j = 0; j < 2; ++j)
#pragma unroll
      for (int r = 0; r < 16; ++r) {
        int m = wm * 64 + i * 32 + ROW_OF(r);
        int f2 = m & 63, q = m >> 6;
        int ch = n0 + wn * 64 + j * 32 + (lane & 31);
        Y[(size_t)(b * 4096 + f1 + 64 * f2) * 1024 + q * 512 + ch] = f2bf(acc[i][j][r]);
      }
}
__device__ __forceinline__ void ctxdft_tile(const Params& P, const Cx& X, int t, char* smem) {
  const int lane = X.tid & 63, w = X.tid >> 6;
  const int b = t >> 4, mt = (t >> 2) & 3, ntile = t & 3;
  const int n0 = ntile * 128;
  f32x16 acc[2][2];
  G22T::zero(acc);
  G22T::run(X, (const bf16_t*)(X.ws + OFF_F256) + (size_t)mt * 128 * 256, 256, (const bf16_t*)(X.ws + OFF_ZF) + (size_t)(NX + b * 256) * 512 + n0, 512, 256, smem, acc);
  bf16_t* Y = (bf16_t*)(X.ws + OFF_Y);
  const int wm = w >> 1, wn = w & 1;
#pragma unroll
  for (int i = 0; i < 2; ++i)
#pragma unroll
    for (int j = 0; j < 2; ++j)
#pragma unroll
      for (int r = 0; r < 16; ++r) {
        int m = mt * 128 + wm * 64 + i * 32 + ROW_OF(r);
        int f = m & 255, q = m >> 8;
        int ch = n0 + wn * 64 + j * 32 + (lane & 31);
        Y[(size_t)(NX + b * 256 + f) * 1024 + q * 512 + ch] = f2bf(acc[i][j][r] * 4.f);
      }
}

__device__ __forceinline__ void attn_item(const Params& P, const Cx& X, int it, bool isctx, char* smem) {
  const int tid = X.tid, lane = tid & 63, w = tid >> 6;
  int b, h, qb, nkt, qrow0;
  const bf16_t* qbase;
  if (!isctx) {
    b = it >> 8; h = (it >> 5) & 7; qb = it & 31; nkt = 68;
    qbase = (const bf16_t*)(X.ws + OFF_Q) + ((size_t)(b * 8 + h) * 4096 + qb * 128) * 96;
    qrow0 = b * 4096 + qb * 128;
  } else {
    b = it >> 4; h = (it >> 1) & 7; qb = it & 1; nkt = 4;
    qbase = (const bf16_t*)(X.ws + OFF_Q) + (size_t)NX * 768 + ((size_t)(b * 8 + h) * 256 + qb * 128) * 96;
    qrow0 = NX + b * 256 + qb * 128;
  }
  const bf16_t* kbase = (const bf16_t*)(X.ws + OFF_K) + (size_t)(b * 8 + h) * 4352 * 96;
  const bf16_t* vbase = (const bf16_t*)(X.ws + OFF_VT) + (size_t)(b * 8 + h) * 64 * 4352;
  bf16_t* sK = (bf16_t*)smem;
  bf16_t* sV = sK + 2 * 64 * 104;
  const int l5 = lane & 31, hh = lane >> 5;
  const bf16_t* qp = qbase + (size_t)(w * 32 + l5) * 96 + hh * 8;
  const bf16x8 qf0 = *(const bf16x8*)(qp), qf1 = *(const bf16x8*)(qp + 16), qf2 = *(const bf16x8*)(qp + 32);
  const bf16x8 qf3 = *(const bf16x8*)(qp + 48), qf4 = *(const bf16x8*)(qp + 64), qf5 = *(const bf16x8*)(qp + 80);
  uint4 rk0, rk1, rk2, rv0, rv1;
#define LK_(i, kt) (*(const uint4*)(kbase + (size_t)((kt)*64 + (tid + 256 * (i)) / 12) * 96 + ((tid + 256 * (i)) % 12) * 8))
#define LV_(i, kt) (*(const uint4*)(vbase + (size_t)((tid + 256 * (i)) >> 3) * 4352 + (kt)*64 + ((tid + 256 * (i)) & 7) * 8))
#define ALOAD(kt) { rk0 = LK_(0, kt); rk1 = LK_(1, kt); rk2 = LK_(2, kt); rv0 = LV_(0, kt); rv1 = LV_(1, kt); }
#define SK_(i, buf, v) *(uint4*)(sK + (buf)*64 * 104 + ((tid + 256 * (i)) / 12) * 104 + ((tid + 256 * (i)) % 12) * 8) = v
#define SV_(i, buf, v) *(uint4*)(sV + (buf)*64 * 72 + ((tid + 256 * (i)) >> 3) * 72 + ((tid + 256 * (i)) & 7) * 8) = v
#define ASTORE(buf) { SK_(0, buf, rk0); SK_(1, buf, rk1); SK_(2, buf, rk2); SV_(0, buf, rv0); SV_(1, buf, rv1); }
  f32x16 o[2];
#pragma unroll
  for (int r = 0; r < 16; ++r) { o[0][r] = 0.f; o[1][r] = 0.f; }
  float mrun = -1e30f, lrun = 0.f;
  ALOAD(0);
  ASTORE(0);
  __syncthreads();
  for (int kt = 0; kt < nkt; ++kt) {
    const int buf = kt & 1;
    if (kt + 1 < nkt) ALOAD(kt + 1);
    const bf16_t* pk = sK + buf * 64 * 104 + l5 * 104 + hh * 8;
    const bf16_t* pv = sV + buf * 64 * 72 + l5 * 72 + 4 * hh;
#pragma unroll
    for (int mt = 0; mt < 2; ++mt) {
      f32x16 sc;
#pragma unroll
      for (int r = 0; r < 16; ++r) sc[r] = 0.f;
#define QK(ks, qq) sc = __builtin_amdgcn_mfma_f32_32x32x16_bf16(*(const bf16x8*)(pk + mt * 32 * 104 + (ks)*16), qq, sc, 0, 0, 0)
      QK(0, qf0); QK(1, qf1); QK(2, qf2); QK(3, qf3); QK(4, qf4); QK(5, qf5);
#undef QK
      float mx = sc[0];
#pragma unroll
      for (int r = 1; r < 16; ++r) mx = fmaxf(mx, sc[r]);
      mx = fmaxf(mx, __shfl_xor(mx, 32));
      const float mnew = fmaxf(mrun, mx);
      if (__builtin_amdgcn_ballot_w64(mnew > mrun) != 0ull) {
        const float alpha = __builtin_amdgcn_exp2f(mrun - mnew);
        lrun *= alpha;
#pragma unroll
        for (int r = 0; r < 16; ++r) { o[0][r] *= alpha; o[1][r] *= alpha; }
        mrun = mnew;
      }
      float psum = 0.f;
#pragma unroll
      for (int r = 0; r < 16; ++r) { sc[r] = __builtin_amdgcn_exp2f(sc[r] - mrun); psum += sc[r]; }
      lrun += psum;
#pragma unroll
      for (int s2 = 0; s2 < 2; ++s2) {
        u32x4 pu;
        pu[0] = pack2(sc[8 * s2 + 0], sc[8 * s2 + 1]);
        pu[1] = pack2(sc[8 * s2 + 2], sc[8 * s2 + 3]);
        pu[2] = pack2(sc[8 * s2 + 4], sc[8 * s2 + 5]);
        pu[3] = pack2(sc[8 * s2 + 6], sc[8 * s2 + 7]);
        const bf16x8 pfv = __builtin_bit_cast(bf16x8, pu);
#pragma unroll
        for (int dt = 0; dt < 2; ++dt) {
          const bf16_t* p = pv + dt * 32 * 72 + mt * 32 + s2 * 16;
          uint2 v0 = *(const uint2*)(p), v1 = *(const uint2*)(p + 8);
          u32x4 vu;
          vu[0] = v0.x; vu[1] = v0.y; vu[2] = v1.x; vu[3] = v1.y;
          o[dt] = __builtin_amdgcn_mfma_f32_32x32x16_bf16(__builtin_bit_cast(bf16x8, vu), pfv, o[dt], 0, 0, 0);
        }
      }
    }
    if (kt + 1 < nkt) ASTORE(buf ^ 1);
    __syncthreads();
  }
#undef ALOAD
#undef ASTORE
#undef LK_
#undef LV_
#undef SK_
#undef SV_
  lrun += __shfl_xor(lrun, 32);
  const float inv = 1.f / lrun;
  bf16_t* dst = (bf16_t*)(X.ws + OFF_ATT) + (size_t)(qrow0 + w * 32 + l5) * 512 + h * 64;
#pragma unroll
  for (int dt = 0; dt < 2; ++dt)
#pragma unroll
    for (int g = 0; g < 4; ++g) {
      uint2 u;
      u.x = pack2(o[dt][4 * g] * inv, o[dt][4 * g + 1] * inv);
      u.y = pack2(o[dt][4 * g + 2] * inv, o[dt][4 * g + 3] * inv);
      *(uint2*)(dst + dt * 32 + 8 * g + 4 * hh) = u;
    }
}

__device__ __forceinline__ void mg_tile(const Params& P, const Cx& X, int t, int mtiles, char* smem) {
  const int lane = X.tid & 63, w = X.tid >> 6;
  const int mt = t % mtiles, nt = t / mtiles;
  const int m0 = mt * 128, c0 = nt * 64;
  const bf16_t* W = (const bf16_t*)(X.ws + OFF_WMIX);
  f32x16 macc[2][1];
  GMG::zero(macc);
#pragma unroll 1
  for (int i = 0; i < 3; ++i) {
    f32x16 ag[2][1], ao[2][1];
    GMG::zero(ag);
    GMG::zero(ao);
    GMG::run(X, (const bf16_t*)(X.ws + OFF_HBUF) + (size_t)m0 * 1024, 1024, W + WE_IN + (size_t)(2976 + i * 1024 + c0) * 1024, 1024, 1024, smem, ag);
    const bf16_t* Ai; const bf16_t* Bi; int ldi;
    if (i == 0) { Ai = (const bf16_t*)(X.ws + OFF_RWO) + (size_t)m0 * 512; Bi = W + WE_RO + (size_t)c0 * 512; ldi = 512; }
    else if (i == 1) { Ai = (const bf16_t*)(X.ws + OFF_ATT) + (size_t)m0 * 512; Bi = W + WE_MO + (size_t)c0 * 512; ldi = 512; }
    else { Ai = (const bf16_t*)(X.ws + OFF_Y) + (size_t)m0 * 1024; Bi = W + WE_FO + (size_t)c0 * 1024; ldi = 1024; }
    GMG::run(X, Ai, ldi, Bi, ldi, ldi, smem, ao);
#pragma unroll
    for (int a = 0; a < 2; ++a)
#pragma unroll
      for (int r = 0; r < 16; ++r) macc[a][0][r] += ao[a][0][r] / (1.f + __expf(-ag[a][0][r]));
  }
  bf16_t* mb = (bf16_t*)(X.ws + OFF_M);
  const int row0 = m0 + (w >> 1) * 64, col = c0 + (w & 1) * 32 + (lane & 31);
#pragma unroll
  for (int a = 0; a < 2; ++a)
#pragma unroll
    for (int r = 0; r < 16; ++r) mb[(size_t)(row0 + a * 32 + ROW_OF(r)) * 1024 + col] = f2bf(macc[a][0][r]);
}

__device__ __forceinline__ void wo_tile(const Params& P, const Cx& X, int layer, int t, int mtiles, char* smem) {
  const int lane = X.tid & 63, w = X.tid >> 6;
  const int mt = t % mtiles, nt = t / mtiles;
  const int m0 = mt * 128, n0 = nt * 128;
  f32x16 acc[2][2];
  G22::zero(acc);
  G22::run(X, (const bf16_t*)(X.ws + OFF_M) + (size_t)m0 * 1024, 1024, (const bf16_t*)(X.ws + OFF_WMIX) + WE_OUT + (size_t)n0 * 1024, 1024, 1024, smem, acc);
  const int row0 = m0 + (w >> 1) * 64, col0 = n0 + (w & 1) * 64;
  const float* modv = (const float*)(X.ws + OFF_MOD) + (size_t)(layer * 5 + mod_row(m0)) * 6144 + 2048;
  const float* src; float* dst;
  if (m0 < NX) { src = (layer == 0 ? P.in[0] : X.out); dst = X.out; }
  else { src = (layer == 0 ? P.in[2] : (const float*)(X.ws + OFF_CS)) - (size_t)NX * 1024; dst = (float*)(X.ws + OFF_CS) - (size_t)NX * 1024; }
#pragma unroll
  for (int j = 0; j < 2; ++j) {
    const int col = col0 + j * 32 + (lane & 31);
    const float mg = modv[col];
#pragma unroll
    for (int i = 0; i < 2; ++i)
#pragma unroll
      for (int r = 0; r < 16; ++r) {
        size_t idx = (size_t)(row0 + i * 32 + ROW_OF(r)) * 1024 + col;
        dst[idx] = src[idx] + mg * acc[i][j][r];
      }
  }
}
__device__ __forceinline__ void f1_tile(const Params& P, const Cx& X, int t, int mtiles, char* smem) {
  const int lane = X.tid & 63, w = X.tid >> 6;
  const int mt = t % mtiles, nt = t / mtiles;
  const int m0 = mt * 128, n0 = nt * 128;
  f32x16 acc[2][2];
  G22::zero(acc);
  G22::run(X, (const bf16_t*)(X.ws + OFF_HBUF) + (size_t)m0 * 1024, 1024, (const bf16_t*)(X.ws + OFF_WFFN) + WF_IN + (size_t)n0 * 1024, 1024, 1024, smem, acc);
  bf16_t* act = (bf16_t*)(X.ws + OFF_ACT);
  const int row0 = m0 + (w >> 1) * 64;
  const int hid = ((n0 + (w & 1) * 64) >> 6) * 32 + (lane & 31);
#pragma unroll
  for (int i = 0; i < 2; ++i)
#pragma unroll
    for (int r = 0; r < 16; ++r) {
      float g = acc[i][0][r], u = acc[i][1][r];
      act[(size_t)(row0 + i * 32 + ROW_OF(r)) * 2816 + hid] = f2bf(g / (1.f + __expf(-g)) * u);
    }
}
__device__ __forceinline__ void f2_tile(const Params& P, const Cx& X, int layer, int t, int mtiles, char* smem) {
  const int lane = X.tid & 63, w = X.tid >> 6;
  const int mt = t % mtiles, nt = t / mtiles;
  const int m0 = mt * 128, n0 = nt * 128;
  f32x16 acc[2][2];
  G22::zero(acc);
  G22::run(X, (const bf16_t*)(X.ws + OFF_ACT) + (size_t)m0 * 2816, 2816, (const bf16_t*)(X.ws + OFF_WFFN) + WF_OUT + (size_t)n0 * 2816, 2816, 2816, smem, acc);
  const int row0 = m0 + (w >> 1) * 64, col0 = n0 + (w & 1) * 64;
  const float* modv = (const float*)(X.ws + OFF_MOD) + (size_t)(layer * 5 + mod_row(m0)) * 6144 + 5120;
  float* dst = (m0 < NX) ? X.out : (float*)(X.ws + OFF_CS) - (size_t)NX * 1024;
#pragma unroll
  for (int j = 0; j < 2; ++j) {
    const int col = col0 + j * 32 + (lane & 31);
    const float mg = modv[col];
#pragma unroll
    for (int i = 0; i < 2; ++i)
#pragma unroll
      for (int r = 0; r < 16; ++r) {
        size_t idx = (size_t)(row0 + i * 32 + ROW_OF(r)) * 1024 + col;
        dst[idx] = dst[idx] + mg * acc[i][j][r];
      }
  }
}

__device__ __forceinline__ Cx fresh(const Cx& X) {
  int t = X.tid;
  asm volatile("" : "+v"(t));
  return Cx{X.ws, X.out, t};
}
__device__ __forceinline__ void run_p(const Params& P, const Cx& X, int layer, int p, char* smem) {
  const int G = gridDim.x, B = blockIdx.x;
  if (p < 0) {
    if (!PON(14)) return;
    for (int j = B; j < 192 + 55; j += G) { if (j < 192) job_mod(P, fresh(X), smem, j); else job_tables(P, fresh(X), j - 192); }
    return;
  }
  const int mtiles = layer == 0 ? 136 : 128;
  switch (p) {
    case 0: if (!PON(0)) break;
      for (int j = B; j < NCW1 + 4352; j += G) { if (j < NCW1) cw_mixer_job(P, fresh(X), layer, j, smem); else norm_job(P, fresh(X), layer, 0, j - NCW1); }
      break;
    case 1: if (!PON(1)) break; for (int j = B; j < 136 * 15; j += G) g1a_tile(P, fresh(X), j, smem); break;
    case 2: if (!PON(2)) break; for (int j = B; j < NTOK; j += G) r1a_row(P, fresh(X), layer, j); break;
    case 3: if (!PON(3)) break; for (int j = B; j < 136 * 20; j += G) r1b_tile(P, fresh(X), layer, j, smem); break;
    case 4: if (!PON(4)) break; for (int j = B; j < 256; j += G) scan_job(P, fresh(X), layer, j, smem); break;
    case 5: if (!PON(5)) break; for (int j = B; j < 4352; j += G) s2_job(P, fresh(X), layer, j); break;
    case 6: if (!PON(6)) break; for (int j = B; j < 136 * 9; j += G) g1b_tile(P, fresh(X), j, smem); break;
    case 7: if (!PON(7)) break;
      for (int j = B; j < 2176 + 1024; j += G) {
        if (j < 1088) q1_kv_tile(P, fresh(X), layer, j, smem);
        else if (j < 2176) { if (layer == 0 || (j - 1088) % 136 < 128) q1_q_tile(P, fresh(X), layer, j - 1088, smem); }
        else fft1_tile(P, fresh(X), j - 2176, smem);
      }
      break;
    case 8: if (!PON(8)) break; {
      const int nctx = layer == 0 ? 64 : 0;
      for (int j = B; j < 1024 + 1024 + 2 * nctx; j += G) {
        const bool isc = (j >= 2048 && j < 2048 + nctx);
        if (j < 1024 || isc) attn_item(P, fresh(X), isc ? j - 2048 : j, isc, smem);
        else if (j < 2048) fft2_tile(P, fresh(X), j - 1024, smem);
        else ctxdft_tile(P, fresh(X), j - 2048 - nctx, smem);
      }
    } break;
    case 9: if (!PON(9)) break; for (int j = B; j < mtiles * 16; j += G) mg_tile(P, fresh(X), j, mtiles, smem); break;
    case 10: if (!PON(10)) break;
      for (int j = B; j < mtiles * 8 + NCW2; j += G) { if (j < mtiles * 8) wo_tile(P, fresh(X), layer, j, mtiles, smem); else cw_ffn_job(P, fresh(X), layer, j - mtiles * 8, smem); }
      break;
    case 11: if (!PON(11)) break; for (int j = B; j < mtiles * 32; j += G) norm_job(P, fresh(X), layer, 1, j); break;
    case 12: if (!PON(12)) break; for (int j = B; j < mtiles * 44; j += G) f1_tile(P, fresh(X), j, mtiles, smem); break;
    case 13: if (!PON(13)) break; for (int j = B; j < mtiles * 8; j += G) f2_tile(P, fresh(X), layer, j, mtiles, smem); break;
  }
}

#if SINGLE
__global__ void __launch_bounds__(256, 2) fwd_kernel(Params P, int ph_lo, int ph_hi, int use_sync) {
  extern __shared__ __attribute__((aligned(16))) char smem[];
  volatile LAS unsigned* xst = (volatile LAS unsigned*)(smem + LDS_BYTES - 16);
  if (threadIdx.x == 0) { xst[0] = 0u; xst[1] = 0u; }
  __syncthreads();
  XcdBarrier xb = xcd_barrier_post((unsigned*)(P.ws + OFF_BAR), xst);
#pragma unroll 1
  for (int ph = ph_lo; ph < ph_hi; ++ph) {
    char* ws = P.ws; float* out = P.out; int tid = threadIdx.x;
    asm volatile("" : "+s"(ws));
    asm volatile("" : "+s"(out));
    asm volatile("" : "+v"(tid));
    const Cx X{ws, out, tid};
    if (ph == 0) run_p(P, X, 0, -1, smem);
    else run_p(P, X, (ph - 1) / 14, (ph - 1) % 14, smem);
    if (use_sync && ph + 1 < ph_hi) { if (ph == ph_lo) cg::this_grid().sync(); else xcd_barrier(xb); }
  }
}

#else
template <int PP>
__global__ void __launch_bounds__(256) phase_kernel(Params P, int layer) {
  extern __shared__ __attribute__((aligned(16))) char smem[];
  const Cx X{P.ws, P.out, (int)threadIdx.x};
  run_p(P, X, layer, PP, smem);
}
#endif

extern "C" void kernel_launch(void* const* d_in, const int* in_sizes, int n_in, void* d_out, int out_size, void* d_ws,
                              size_t ws_size, hipStream_t stream) {
  static int grid = 0;
  if (grid == 0) {
    if (n_in != 33 || ws_size < OFF_END) { fprintf(stderr, "kernel_launch: unexpected n_in %d / ws_size %zu (need %zu)\n", n_in, ws_size, (size_t)OFF_END); grid = -1; return; }
    int dev = 0, cus = 0, per_cu = 0;
    hipGetDevice(&dev);
    hipDeviceGetAttribute(&cus, hipDeviceAttributeMultiprocessorCount, dev);
#if SINGLE
    hipFuncSetAttribute((const void*)fwd_kernel, hipFuncAttributeMaxDynamicSharedMemorySize, LDS_BYTES);
    hipOccupancyMaxActiveBlocksPerMultiprocessor(&per_cu, (const void*)fwd_kernel, 256, LDS_BYTES);
#else
#define SA(pp) hipFuncSetAttribute((const void*)phase_kernel<pp>, hipFuncAttributeMaxDynamicSharedMemorySize, LDS_BYTES)
    SA(-1); SA(0); SA(1); SA(2); SA(3); SA(4); SA(5); SA(6); SA(7); SA(8); SA(9); SA(10); SA(11); SA(12); SA(13);
    per_cu = 2;
#endif
    if (per_cu < 1) { fprintf(stderr, "kernel_launch: occupancy query returned %d\n", per_cu); grid = -1; return; }
    if (per_cu > 2) per_cu = 2;
    grid = cus * per_cu;
  }
  if (grid < 0) return;
  if (hipMemsetAsync((char*)d_ws + OFF_BAR, 0, 16384, stream) != hipSuccess) { fprintf(stderr, "kernel_launch: memset failed\n"); return; }
  Params P{};
  for (int i = 0; i < 33; ++i) P.in[i] = (const float*)d_in[i];
  P.out = (float*)d_out;
  P.ws = (char*)d_ws;
#if SINGLE
  int lo = 0, hi = NPH, us = 1;
  void* args[] = {&P, &lo, &hi, &us};
  hipError_t e = hipLaunchCooperativeKernel((const void*)fwd_kernel, dim3(grid), dim3(256), args, LDS_BYTES, stream);
  if (e != hipSuccess) fprintf(stderr, "cooperative launch failed: %s (grid %d)\n", hipGetErrorString(e), grid);
#else
#define LP(pp, ly) hipLaunchKernelGGL(phase_kernel<pp>, dim3(grid), dim3(256), LDS_BYTES, stream, P, ly)
  LP(-1, 0);
  for (int ly = 0; ly < 2; ++ly) {
    LP(0, ly); LP(1, ly); LP(2, ly); LP(3, ly); LP(4, ly); LP(5, ly); LP(6, ly); LP(7, ly); LP(8, ly); LP(9, ly); LP(10, ly); LP(11, ly); LP(12, ly); LP(13, ly);
  }
#endif
}
```

```cpp
#include <hip/hip_runtime.h>
#include <hip/hip_cooperative_groups.h>
#include <stdint.h>
#include <stdio.h>
namespace cg = cooperative_groups;

#ifndef SINGLE
#define SINGLE 1
#endif

#ifndef ONLYP
#define ONLYP -1
#endif
#define PON(x) (ONLYP < 0 || ONLYP == (x))

typedef unsigned short bf16_t;
typedef __attribute__((ext_vector_type(8))) short bf16x8;
typedef __attribute__((ext_vector_type(16))) float f32x16;
typedef __attribute__((ext_vector_type(4))) unsigned int u32x4;

#define NX 16384
#define NCX 1024
#define NTOK 17408
#define NPH 29
#ifndef PROBE_P
#define PROBE_P -1
#endif
#define PROBE_N 2
#define LDS_BYTES 77824

static constexpr size_t UU = 17825792ull;
static constexpr size_t OFF_HBUF = 0;
static constexpr size_t OFF_RKV = 2 * UU;
static constexpr size_t OFF_KK = 5 * UU;
static constexpr size_t OFF_ZR = 6 * UU;
static constexpr size_t OFF_LORA = 12 * UU + UU / 4;
static constexpr size_t OFF_LD = 6 * UU;
static constexpr size_t OFF_A = 8 * UU;
static constexpr size_t OFF_G = 10 * UU;
static constexpr size_t OFF_YF = 11 * UU;
static constexpr size_t OFF_YB = 12 * UU;
static constexpr size_t OFF_RWO = 5 * UU;
static constexpr size_t OFF_ZF = 2 * UU;
static constexpr size_t OFF_ZM = 3 * UU;
static constexpr size_t OFF_Q = 6 * UU;
static constexpr size_t OFF_K = 7 * UU + UU / 2;
static constexpr size_t OFF_VT = 9 * UU;
static constexpr size_t OFF_FFT1 = 10 * UU;
static constexpr size_t OFF_ATT = 12 * UU;
static constexpr size_t OFF_Y = 3 * UU;
static constexpr size_t OFF_M = 6 * UU;
static constexpr size_t OFF_ACT = 2 * UU;
static constexpr size_t OFF_WFFN = 9 * UU;
static constexpr size_t OFF_WMIX = 13 * UU;
static constexpr size_t WE_IN = 0;
static constexpr size_t WE_W2 = WE_IN + 6048ull * 1024;
static constexpr size_t WE_A2 = WE_W2 + 65536;
static constexpr size_t WE_G2 = WE_A2 + 65536;
static constexpr size_t WE_RO = WE_G2 + 65536;
static constexpr size_t WE_MO = WE_RO + 524288;
static constexpr size_t WE_FO = WE_MO + 524288;
static constexpr size_t WE_UQ = WE_FO + 1048576;
static constexpr size_t WE_UKV = WE_UQ + 294912;
static constexpr size_t WE_OUT = WE_UKV + 131072;
static constexpr size_t WE_END = WE_OUT + 1048576;
static constexpr size_t WF_IN = 0;
static constexpr size_t WF_OUT = 5632ull * 1024;
static constexpr size_t OFF_SMALL = OFF_WMIX + WE_END * 2;
static constexpr size_t OFF_CS = OFF_SMALL;
static constexpr size_t OFF_MOD = OFF_CS + 4194304;
static constexpr size_t OFF_TW = OFF_MOD + 245760;
static constexpr size_t OFF_F1 = OFF_TW + 32768;
static constexpr size_t OFF_F2 = OFF_F1 + 16384;
static constexpr size_t OFF_F256 = OFF_F2 + 32768;
static constexpr size_t OFF_ROPE = OFF_F256 + 262144;
static constexpr size_t OFF_BAR = OFF_ROPE + 524288;
static constexpr size_t OFF_TICK = OFF_BAR + 16384;
static constexpr size_t OFF_END = OFF_TICK + 16384;

struct Cx {
  char* ws;
  float* out;
  int tid;
};

struct Params {
  const float* in[33];
  float* out;
  char* ws;
};

__device__ __forceinline__ float bf2f(bf16_t v) { return __uint_as_float(((uint32_t)v) << 16); }
typedef __bf16 bf16v2_t __attribute__((ext_vector_type(2)));
typedef float f32v2_t __attribute__((ext_vector_type(2)));
__device__ __forceinline__ uint32_t pack2(float a, float b) {
  f32v2_t v; v[0] = a; v[1] = b;
  return __builtin_bit_cast(uint32_t, __builtin_convertvector(v, bf16v2_t));
}
__device__ __forceinline__ bf16_t f2bf(float f) { return (bf16_t)(pack2(f, 0.f) & 0xffffu); }
__device__ __forceinline__ float lo16(uint32_t u) { return __uint_as_float(u << 16); }
__device__ __forceinline__ float hi16(uint32_t u) { return __uint_as_float(u & 0xffff0000u); }
__device__ __forceinline__ float sigmoidf_(float v) { return 1.f / (1.f + __expf(-v)); }
__device__ __forceinline__ int mod_row(int row) { return row < NX ? (row >> 12) : 4; }

#define XB_TMO      128
#define XB_XCNT(j)  (256  + 64 * (j))
#define XB_XSUB(j)  (1280 + 64 * (j))
#define XB_XGEN(j)  (2304 + 64 * (j))
#define XB_TOP      3328
#define XB_TOPGEN   3392
#define XCD_BAR_WORDS 3456
#define XB_SPIN_CAP (1u << 18)
#define LAS __attribute__((address_space(3)))

__device__ __forceinline__ unsigned xb_ld(unsigned* p)              { return __hip_atomic_load(p, __ATOMIC_RELAXED, __HIP_MEMORY_SCOPE_AGENT); }
__device__ __forceinline__ unsigned xb_add(unsigned* p, unsigned v) { return __hip_atomic_fetch_add(p, v, __ATOMIC_RELAXED, __HIP_MEMORY_SCOPE_AGENT); }
__device__ __forceinline__ unsigned xb_xcc_id() { return (unsigned)__builtin_amdgcn_s_getreg((3 << 11) | 20) & 0xFu; }
#define XB_SPIN(cond, bar) do { unsigned _sp = 0; while (cond) { __builtin_amdgcn_s_sleep(1); \
    if ((++_sp & 255u) == 0u) { if (xb_ld(&(bar)[XB_TMO])) break; if (_sp > XB_SPIN_CAP) { atomicAdd(&(bar)[XB_TMO], 1u); break; } } } } while (0)

struct XcdBarrier {
    unsigned* bar; unsigned x;
    volatile LAS unsigned* st;
};

__device__ __forceinline__ XcdBarrier xcd_barrier_post(unsigned* bar, volatile LAS unsigned* st) {
    XcdBarrier b; b.bar = bar; b.x = xb_xcc_id(); b.st = st;
    if (threadIdx.x == 0) (void)xb_add(&bar[XB_XCNT(b.x)], 1u);
    return b;
}
__device__ __forceinline__ void xcd_barrier_complete(unsigned* bar, unsigned x, unsigned& nloc, unsigned& nx) {
    const unsigned G = gridDim.x * gridDim.y * gridDim.z;
    unsigned sum, cnt, mine, sp = 0u;
    for (;;) {
        sum = 0u; cnt = 0u; mine = 0u;
#pragma unroll
        for (unsigned j = 0; j < 16; ++j) { const unsigned c = xb_ld(&bar[XB_XCNT(j)]); sum += c; cnt += (c > 0u) ? 1u : 0u; mine = (j == x) ? c : mine; }
        if (sum == G) break;
        __builtin_amdgcn_s_sleep(1);
        if ((++sp & 255u) == 0u) { if (xb_ld(&bar[XB_TMO])) break; if (sp > XB_SPIN_CAP) { atomicAdd(&bar[XB_TMO], 1u); break; } }
    }
    nloc = mine > 0u ? mine : 1u; nx = cnt > 0u ? cnt : 1u;
}

__device__ __forceinline__ void xcd_barrier(const XcdBarrier& b) {
    asm volatile("s_waitcnt vmcnt(0)" ::: "memory");
    __syncthreads();
    if (threadIdx.x == 0) {
        unsigned* bar = b.bar;
        __builtin_amdgcn_s_waitcnt(0);
        unsigned nloc = b.st[0], nx = b.st[1];
        if (nloc == 0u) { xcd_barrier_complete(bar, b.x, nloc, nx); b.st[0] = nloc; b.st[1] = nx; }
        const unsigned old = xb_add(&bar[XB_XSUB(b.x)], 1u);
        const unsigned gen = old / nloc;
        if (old + 1u == (gen + 1u) * nloc) {
            __builtin_amdgcn_fence(__ATOMIC_RELEASE, "agent");
            asm volatile("s_waitcnt vmcnt(0)" ::: "memory");
            const unsigned og = xb_add(&bar[XB_TOP], 1u);
            const unsigned tg = og / nx;
            if (og + 1u == (tg + 1u) * nx) xb_add(&bar[XB_TOPGEN], 1u);
            else XB_SPIN(xb_ld(&bar[XB_TOPGEN]) == tg, bar);
            __builtin_amdgcn_fence(__ATOMIC_ACQUIRE, "agent");
            xb_add(&bar[XB_XGEN(b.x)], 1u);
            asm volatile("s_waitcnt vmcnt(0)" ::: "memory");
        } else {
            XB_SPIN(xb_ld(&bar[XB_XGEN(b.x)]) == gen, bar);
            __builtin_amdgcn_fence(__ATOMIC_ACQUIRE, "agent");
            asm volatile("s_waitcnt vmcnt(0)" ::: "memory");
        }
    }
    __syncthreads();
}


template <int BM, int BN, int WGM, int WGN, bool TRB>
struct Gemm {
  static constexpr int WM = BM / WGM, WN = BN / WGN, MT = WM / 32, NTL = WN / 32;
  static constexpr int CA = BM * 8 / 256, CB = BN * 8 / 256;
  static constexpr int SA_ELEMS = BM * 72, SB_ELEMS = BN * 72;

  __device__ static __forceinline__ void zero(f32x16 (&acc)[MT][NTL]) {
#pragma unroll
    for (int i = 0; i < MT; ++i)
#pragma unroll
      for (int j = 0; j < NTL; ++j)
#pragma unroll
        for (int r = 0; r < 16; ++r) acc[i][j][r] = 0.f;
  }

  __device__ static __forceinline__ void run(const Cx& X, const bf16_t* __restrict__ A, int lda, const bf16_t* __restrict__ B, int ldb,
                                             int K, char* smem, f32x16 (&acc)[MT][NTL]) {
    const int tid = X.tid, lane = tid & 63, w = tid >> 6;
    const int wm = w / WGN, wn = w % WGN;
    bf16_t* sA = (bf16_t*)smem;
    bf16_t* sB = sA + 2 * SA_ELEMS;
    uint4 ra0, ra1, ra2, ra3, rb0, rb1, rb2 = make_uint4(0, 0, 0, 0), rb3 = make_uint4(0, 0, 0, 0);
    uint4 qa0, qa1, qa2, qa3, qb0, qb1, qb2 = make_uint4(0, 0, 0, 0), qb3 = make_uint4(0, 0, 0, 0);
    static_assert(CA == 4 && CB >= 2 && CB <= 4, "tile loader shape");
    const int nk = K >> 6;
#define LDA_(i, k0) (*(const uint4*)(A + (size_t)((tid + 256 * (i)) >> 3) * lda + (k0) + ((tid + 256 * (i)) & 7) * 8))
#define LDB_(i, k0)                                                                                                        \
  (!TRB ? *(const uint4*)(B + (size_t)((tid + 256 * (i)) >> 3) * ldb + (k0) + ((tid + 256 * (i)) & 7) * 8)                 \
        : *(const uint4*)(B + (size_t)((k0) + (tid + 256 * (i)) / (BN / 8)) * ldb + ((tid + 256 * (i)) % (BN / 8)) * 8))
#define GLOAD(R, k0)                                                                           \
  {                                                                                            \
    R##a0 = LDA_(0, k0); R##a1 = LDA_(1, k0); R##a2 = LDA_(2, k0); R##a3 = LDA_(3, k0);        \
    R##b0 = LDB_(0, k0); R##b1 = LDB_(1, k0);                                                  \
    if (CB > 2) R##b2 = LDB_(2, k0);                                                           \
    if (CB > 3) R##b3 = LDB_(3, k0);                                                           \
  }
#define STA_(i, buf, v) *(uint4*)(sA + (buf)*SA_ELEMS + ((tid + 256 * (i)) >> 3) * 72 + ((tid + 256 * (i)) & 7) * 8) = v
#define STB_(i, buf, v)                                                                                       \
  {                                                                                                           \
    const int c_ = tid + 256 * (i);                                                                           \
    if (!TRB) *(uint4*)(sB + (buf)*SB_ELEMS + (c_ >> 3) * 72 + (c_ & 7) * 8) = v;                             \
    else {                                                                                                    \
      bf16_t* p = sB + (buf)*SB_ELEMS + (c_ % (BN / 8)) * 8 * 72 + c_ / (BN / 8);                             \
      p[0] = (bf16_t)(v.x & 0xffff); p[72] = (bf16_t)(v.x >> 16);                                             \
      p[144] = (bf16_t)(v.y & 0xffff); p[216] = (bf16_t)(v.y >> 16);                                          \
      p[288] = (bf16_t)(v.z & 0xffff); p[360] = (bf16_t)(v.z >> 16);                                          \
      p[432] = (bf16_t)(v.w & 0xffff); p[504] = (bf16_t)(v.w >> 16);                                          \
    }                                                                                                         \
  }
#define SSTORE(R, buf)                                                                         \
  {                                                                                            \
    STA_(0, buf, R##a0); STA_(1, buf, R##a1); STA_(2, buf, R##a2); STA_(3, buf, R##a3);        \
    STB_(0, buf, R##b0); STB_(1, buf, R##b1);                                                  \
    if (CB > 2) STB_(2, buf, R##b2);                                                           \
    if (CB > 3) STB_(3, buf, R##b3);                                                           \
  }
#define COMPUTE(buf)                                                                                               \
  {                                                                                                                \
    const bf16_t* pa = sA + (buf)*SA_ELEMS + (wm * WM + (lane & 31)) * 72 + (lane >> 5) * 8;                       \
    const bf16_t* pb = sB + (buf)*SB_ELEMS + (wn * WN + (lane & 31)) * 72 + (lane >> 5) * 8;                       \
    _Pragma("unroll") for (int ks = 0; ks < 4; ++ks) {                                                             \
      bf16x8 af[MT], bfr[NTL];                                                                                     \
      _Pragma("unroll") for (int i = 0; i < MT; ++i) af[i] = *(const bf16x8*)(pa + i * 32 * 72 + ks * 16);         \
      _Pragma("unroll") for (int j = 0; j < NTL; ++j) bfr[j] = *(const bf16x8*)(pb + j * 32 * 72 + ks * 16);       \
      _Pragma("unroll") for (int i = 0; i < MT; ++i)                                                               \
        _Pragma("unroll") for (int j = 0; j < NTL; ++j)                                                            \
          acc[i][j] = __builtin_amdgcn_mfma_f32_32x32x16_bf16(af[i], bfr[j], acc[i][j], 0, 0, 0);                  \
    }                                                                                                              \
  }
    GLOAD(r, 0);
    if (nk > 1) GLOAD(q, 64);
    SSTORE(r, 0);
    __syncthreads();
    for (int kt = 0; kt < nk; kt += 2) {
      if (kt + 2 < nk) GLOAD(r, (kt + 2) * 64);
      COMPUTE(0);
      if (kt + 1 < nk) SSTORE(q, 1);
      __syncthreads();
      if (kt + 1 >= nk) break;
      if (kt + 3 < nk) GLOAD(q, (kt + 3) * 64);
      COMPUTE(1);
      if (kt + 2 < nk) SSTORE(r, 0);
      __syncthreads();
    }
#undef COMPUTE
#undef GLOAD
#undef SSTORE
#undef LDA_
#undef LDB_
#undef STA_
#undef STB_
  }
};

typedef Gemm<128, 128, 2, 2, false> G22;
typedef Gemm<128, 128, 2, 2, true> G22T;
typedef Gemm<128, 64, 2, 2, false> GMG;
typedef Gemm<128, 96, 4, 1, false> GQ;
typedef Gemm<128, 128, 4, 1, false> GKV;

#define ROW_OF(reg) (((reg) & 3) + 8 * ((reg) >> 2) + 4 * (lane >> 5))

__device__ __forceinline__ void job_mod(const Params& P, const Cx& X, char* smem, int job) {
  float* sc = (float*)smem;
  const int tid = X.tid;
  for (int i = tid; i < 5 * 1024; i += 256) {
    int r = i >> 10, k = i & 1023;
    float v = r < 4 ? P.in[1][r * 1024 + k] : P.in[3][k];
    sc[i] = v / (1.f + expf(-v));
  }
  __syncthreads();
  const int l = job / 96, n = (job % 96) * 64 + (tid & 63), w = tid >> 6;
  const float* W = P.in[4] + (size_t)l * 1024 * 6144;
  float a0 = 0, a1 = 0, a2 = 0, a3 = 0, a4 = 0;
#pragma unroll 4
  for (int k = w * 256; k < w * 256 + 256; ++k) {
    float wv = W[(size_t)k * 6144 + n];
    a0 += sc[k] * wv; a1 += sc[1024 + k] * wv; a2 += sc[2048 + k] * wv; a3 += sc[3072 + k] * wv; a4 += sc[4096 + k] * wv;
  }
  float* red = sc + 5 * 1024;
  red[(w * 5 + 0) * 64 + (tid & 63)] = a0; red[(w * 5 + 1) * 64 + (tid & 63)] = a1; red[(w * 5 + 2) * 64 + (tid & 63)] = a2;
  red[(w * 5 + 3) * 64 + (tid & 63)] = a3; red[(w * 5 + 4) * 64 + (tid & 63)] = a4;
  __syncthreads();
  float* modv = (float*)(X.ws + OFF_MOD);
  for (int i = tid; i < 320; i += 256) {
    int r = i >> 6, c = i & 63;
    int nn = (job % 96) * 64 + c;
    float s = red[(0 * 5 + r) * 64 + c] + red[(1 * 5 + r) * 64 + c] + red[(2 * 5 + r) * 64 + c] + red[(3 * 5 + r) * 64 + c];
    modv[(size_t)(l * 5 + r) * 6144 + nn] = s + P.in[5][l * 6144 + nn];
  }
  __syncthreads();
}

__device__ __forceinline__ void job_tables(const Params& P, const Cx& X, int job) {
  float2* tw = (float2*)(X.ws + OFF_TW);
  bf16_t* F1 = (bf16_t*)(X.ws + OFF_F1);
  bf16_t* F2 = (bf16_t*)(X.ws + OFF_F2);
  bf16_t* F256 = (bf16_t*)(X.ws + OFF_F256);
  float2* rope = (float2*)(X.ws + OFF_ROPE);
  for (int e = job * 4096 + X.tid; e < job * 4096 + 4096; e += 256) {
    int i = e;
    if (i < 4096) { tw[i] = make_float2(cospif(i / 2048.f), sinpif(i / 2048.f)); continue; }
    i -= 4096;
    if (i < 8192) {
      int R = i >> 6, t1 = i & 63;
      int f1 = (R >> 6) * 32 + (R & 31);
      int ph = (f1 * t1) & 63;
      F1[i] = f2bf(((R >> 5) & 1) ? -sinpif(ph / 32.f) : cospif(ph / 32.f));
      continue;
    }
    i -= 8192;
    if (i < 16384) {
      int m = i >> 7, k = i & 127;
      int f2 = m & 63, q = m >> 6, t2 = k & 63, p = k >> 6;
      int ph = (f2 * t2) & 63;
      float c = cospif(ph / 32.f), s = sinpif(ph / 32.f);
      float v = (q == 0) ? (p == 0 ? c : s) : (p == 0 ? -s : c);
      F2[i] = f2bf(v);
      continue;
    }
    i -= 16384;
    if (i < 131072) {
      int m = i >> 8, t = i & 255;
      int f = m & 255, q = m >> 8;
      int ph = (f * t) & 255;
      F256[i] = f2bf(q == 0 ? cospif(ph / 128.f) : -sinpif(ph / 128.f));
      continue;
    }
    i -= 131072;
    if (i < 65536) {
      int t = i >> 4, j = i & 15;
      float invf = powf(10000.f, -(float)(j & 7) / 8.f);
      float pos = (j < 8) ? (float)(t >> 6) : (float)(t & 63);
      float ang = pos * invf;
      rope[i] = make_float2(cosf(ang), sinf(ang));
    }
  }
}

__device__ __forceinline__ void cw_tile(const Cx& X, const float* __restrict__ src, int N, int lds_, bf16_t* __restrict__ dst, int ldd, const float* scale,
                        int perm, int tk, int tn, char* smem) {
  float* tile = (float*)smem;
  const int tid = X.tid;
  const int c = tid & 63, r0 = tid >> 6;
  const int ng = tn * 64 + c;
#pragma unroll 4
  for (int i = 0; i < 16; ++i) {
    int r = r0 + 4 * i;
    float v = (ng < N) ? src[(size_t)(tk * 64 + r) * lds_ + ng] : 0.f;
    if (scale) v *= scale[tk * 64 + r];
    tile[r * 65 + c] = v;
  }
  __syncthreads();
#pragma unroll 4
  for (int i = 0; i < 16; ++i) {
    int nn = r0 + 4 * i;
    int n2 = tn * 64 + nn;
    if (n2 < N) {
      int drow = n2;
      if (perm) {
        int u = n2 < 2816 ? n2 : n2 - 2816;
        drow = (u >> 5) * 64 + (n2 < 2816 ? 0 : 32) + (u & 31);
      }
      dst[(size_t)drow * ldd + tk * 64 + c] = f2bf(tile[c * 65 + nn]);
    }
  }
  __syncthreads();
}

__device__ __forceinline__ void fold_job(const Params& P, const Cx& X, int layer, int fj, char* smem) {
  float* wt = (float*)smem;
  float* ct = wt + 4096;
  const int tid = X.tid;
  const int g = fj >> 4, n0 = (fj & 15) * 64;
  const float* src = P.in[28] + (size_t)layer * 512 * 1024;
  for (int i = tid; i < 4096; i += 256) wt[i] = src[(size_t)(g * 64 + (i >> 6)) * 1024 + n0 + (i & 63)];
  if (tid < 64) { ct[tid] = cospif(tid / 32.f); ct[64 + tid] = sinpif(tid / 32.f); }
  __syncthreads();
  bf16_t* dst = (bf16_t*)(X.ws + OFF_WMIX) + WE_FO;
  const int c = tid & 63, nq = tid >> 6;
#pragma unroll 1
  for (int ni = 0; ni < 16; ++ni) {
    int n = nq * 16 + ni;
    float sr = 0.f, si = 0.f;
#pragma unroll 4
    for (int cp = 0; cp < 64; ++cp) {
      float wv = wt[cp * 64 + n];
      int ph = (c * cp) & 63;
      sr += ct[ph] * wv;
      si += ct[64 + ph] * wv;
    }
    dst[(size_t)(n0 + n) * 1024 + g * 64 + c] = f2bf(sr * (1.f / 512.f));
    dst[(size_t)(n0 + n) * 1024 + 512 + g * 64 + c] = f2bf(si * (1.f / 512.f));
  }
  __syncthreads();
}

#define NCW1 2312
__device__ __forceinline__ void cw_mixer_job(const Params& P, const Cx& X, int layer, int j, char* smem) {
  bf16_t* W = (bf16_t*)(X.ws + OFF_WMIX);
  const float* src; const float* scale = nullptr; bf16_t* dst; int N, ldd, tk, tn;
  if (j >= 2184) { fold_job(P, X, layer, j - 2184, smem); return; }
  if (j < 1520) { src = P.in[7] + (size_t)layer * 1024 * 6048; N = 6048; dst = W + WE_IN; ldd = 1024; tk = j / 95; tn = j % 95; }
  else if (j < 1536) { j -= 1520; int d = j >> 3; src = P.in[11] + (size_t)(layer * 2 + d) * 64 * 512; N = 512; dst = W + WE_W2 + d * 32768; ldd = 64; tk = 0; tn = j & 7; }
  else if (j < 1552) { j -= 1536; int d = j >> 3; src = P.in[13] + (size_t)(layer * 2 + d) * 64 * 512; N = 512; dst = W + WE_A2 + d * 32768; ldd = 64; tk = 0; tn = j & 7; }
  else if (j < 1568) { j -= 1552; src = P.in[17] + (size_t)layer * 128 * 512; N = 512; dst = W + WE_G2; ldd = 128; tk = j >> 3; tn = j & 7; }
  else if (j < 1696) { j -= 1568; src = P.in[20] + (size_t)layer * 512 * 1024; N = 1024; dst = W + WE_RO; ldd = 512; tk = j >> 4; tn = j & 15; }
  else if (j < 1824) { j -= 1696; src = P.in[27] + (size_t)layer * 512 * 1024; N = 1024; dst = W + WE_MO; ldd = 512; tk = j >> 4; tn = j & 15; }
  else if (j < 1896) { j -= 1824; src = P.in[23] + (size_t)layer * 384 * 768; N = 768; dst = W + WE_UQ; ldd = 384; scale = P.in[21] + layer * 384; tk = j / 12; tn = j % 12; }
  else if (j < 1928) { j -= 1896; src = P.in[24] + (size_t)layer * 128 * 1024; N = 1024; dst = W + WE_UKV; ldd = 128; scale = P.in[22] + layer * 128; tk = j >> 4; tn = j & 15; }
  else { j -= 1928; src = P.in[29] + (size_t)layer * 1024 * 1024; N = 1024; dst = W + WE_OUT; ldd = 1024; tk = j >> 4; tn = j & 15; }
  cw_tile(X, src, N, N, dst, ldd, scale, 0, tk, tn, smem);
}
#define NCW2 2112
__device__ __forceinline__ void cw_ffn_job(const Params& P, const Cx& X, int layer, int j, char* smem) {
  bf16_t* W = (bf16_t*)(X.ws + OFF_WFFN);
  const float* src; bf16_t* dst; int N, ldd, tk, tn, perm;
  if (j < 1408) { src = P.in[31] + (size_t)layer * 1024 * 5632; N = 5632; dst = W + WF_IN; ldd = 1024; perm = 1; tk = j / 88; tn = j % 88; }
  else { j -= 1408; src = P.in[32] + (size_t)layer * 2816 * 1024; N = 1024; dst = W + WF_OUT; ldd = 2816; perm = 0; tk = j >> 4; tn = j & 15; }
  cw_tile(X, src, N, N, dst, ldd, nullptr, perm, tk, tn, smem);
}

__device__ __forceinline__ void norm_job(const Params& P, const Cx& X, int layer, int which, int job) {
  const int lane = X.tid & 63, w = X.tid >> 6;
  const int row = job * 4 + w;
  const float* src;
  if (which == 0) {
    if (row < NX) src = (layer == 0 ? P.in[0] : X.out) + (size_t)row * 1024;
    else src = (layer == 0 ? P.in[2] : (const float*)(X.ws + OFF_CS)) + (size_t)(row - NX) * 1024;
  } else {
    if (row < NX) src = X.out + (size_t)row * 1024;
    else src = (const float*)(X.ws + OFF_CS) + (size_t)(row - NX) * 1024;
  }
  const float* g = (which == 0 ? P.in[6] : P.in[30]) + layer * 1024;
  const float* modv = (const float*)(X.ws + OFF_MOD) + (size_t)(layer * 5 + mod_row(row)) * 6144;
  const float* shift = modv + (which == 0 ? 0 : 3072);
  const float* scale = modv + (which == 0 ? 1024 : 4096);
  float4 v[4];
  float ss = 0.f;
#pragma unroll
  for (int i = 0; i < 4; ++i) {
    v[i] = ((const float4*)src)[lane + 64 * i];
    ss += v[i].x * v[i].x + v[i].y * v[i].y + v[i].z * v[i].z + v[i].w * v[i].w;
  }
#pragma unroll
  for (int o = 32; o >= 1; o >>= 1) ss += __shfl_xor(ss, o);
  const float rstd = rsqrtf(ss * (1.f / 1024.f) + 1e-6f);
  bf16_t* dst = (bf16_t*)(X.ws + OFF_HBUF) + (size_t)row * 1024;
#pragma unroll
  for (int i = 0; i < 4; ++i) {
    int col = 4 * (lane + 64 * i);
    float4 gg = *(const float4*)(g + col), sh = *(const float4*)(shift + col), sc = *(const float4*)(scale + col);
    float y0 = v[i].x * rstd * gg.x * (1.f + sc.x) + sh.x;
    float y1 = v[i].y * rstd * gg.y * (1.f + sc.y) + sh.y;
    float y2 = v[i].z * rstd * gg.z * (1.f + sc.z) + sh.z;
    float y3 = v[i].w * rstd * gg.w * (1.f + sc.w) + sh.w;
    uint2 o;
    o.x = pack2(y0, y1); o.y = pack2(y2, y3);
    *(uint2*)(dst + col) = o;
  }
}

__device__ __forceinline__ void g1a_tile(const Params& P, const Cx& X, int t, char* smem) {
  const int lane = X.tid & 63, w = X.tid >> 6;
  const int mt = t % 136, nt = t / 136;
  const int m0 = mt * 128, n0 = nt * 128;
  f32x16 acc[2][2];
  G22::zero(acc);
  G22::run(X, (const bf16_t*)(X.ws + OFF_HBUF) + (size_t)m0 * 1024, 1024, (const bf16_t*)(X.ws + OFF_WMIX) + WE_IN + (size_t)n0 * 1024, 1024, 1024, smem, acc);
  bf16_t* zr = (bf16_t*)(X.ws + OFF_ZR);
  const int row0 = m0 + (w >> 1) * 64, col0 = n0 + (w & 1) * 64;
#pragma unroll
  for (int i = 0; i < 2; ++i)
#pragma unroll
    for (int j = 0; j < 2; ++j)
#pragma unroll
      for (int r = 0; r < 16; ++r) {
        int row = row0 + i * 32 + ROW_OF(r), col = col0 + j * 32 + (lane & 31);
        zr[(size_t)row * 1920 + col] = f2bf(acc[i][j][r]);
      }
}
__device__ __forceinline__ void g1b_tile(const Params& P, const Cx& X, int t, char* smem) {
  const int lane = X.tid & 63, w = X.tid >> 6;
  const int mt = t % 136, nt = t / 136;
  const int m0 = mt * 128, n0 = nt * 128;
  f32x16 acc[2][2];
  G22::zero(acc);
  G22::run(X, (const bf16_t*)(X.ws + OFF_HBUF) + (size_t)m0 * 1024, 1024, (const bf16_t*)(X.ws + OFF_WMIX) + WE_IN + (size_t)(1920 + n0) * 1024, 1024, 1024, smem, acc);
  bf16_t* zm = (bf16_t*)(X.ws + OFF_ZM);
  bf16_t* zf = (bf16_t*)(X.ws + OFF_ZF);
  const int row0 = m0 + (w >> 1) * 64, col0 = n0 + (w & 1) * 64;
#pragma unroll
  for (int i = 0; i < 2; ++i)
#pragma unroll
    for (int j = 0; j < 2; ++j)
#pragma unroll
      for (int r = 0; r < 16; ++r) {
        int row = row0 + i * 32 + ROW_OF(r), col = col0 + j * 32 + (lane & 31);
        bf16_t v = f2bf(acc[i][j][r]);
        if (col < 544) zm[(size_t)row * 544 + col] = v;
        else if (col < 1056) zf[(size_t)row * 512 + (col - 544)] = v;
      }
}

__device__ __forceinline__ void r1a_row(const Params& P, const Cx& X, int layer, int row) {
  const int tid = X.tid;
  const int ch = tid < 240 ? tid : 239;
  const int col0 = ch * 8;
  const bf16_t* zr = (const bf16_t*)(X.ws + OFF_ZR);
  bool hp, hn;
  if (row < NX) { int t = row & 4095; hp = t > 0; hn = t < 4095; }
  else { int j = (row - NX) & 255; hp = j > 0; hn = j < 255; }
  uint4 zc = *(const uint4*)(zr + (size_t)row * 1920 + col0);
  uint4 zp = make_uint4(0, 0, 0, 0), zn = make_uint4(0, 0, 0, 0);
  if (hp) zp = *(const uint4*)(zr + (size_t)(row - 1) * 1920 + col0);
  if (hn) zn = *(const uint4*)(zr + (size_t)(row + 1) * 1920 + col0);
  const float* mup = P.in[8] + layer * 1920 + col0;
  const float* mun = P.in[9] + layer * 1920 + col0;
  float zs[8];
  {
    const uint32_t c4[4] = {zc.x, zc.y, zc.z, zc.w}, p4[4] = {zp.x, zp.y, zp.z, zp.w}, n4[4] = {zn.x, zn.y, zn.z, zn.w};
#pragma unroll
    for (int i = 0; i < 4; ++i) {
      float c0 = lo16(c4[i]), c1 = hi16(c4[i]);
      zs[2 * i] = c0 + (lo16(p4[i]) - c0) * mup[2 * i] + (lo16(n4[i]) - c0) * mun[2 * i];
      zs[2 * i + 1] = c1 + (hi16(p4[i]) - c1) * mup[2 * i + 1] + (hi16(n4[i]) - c1) * mun[2 * i + 1];
    }
  }
  float ss = 0.f;
  float kv[8];
  const bool isk = (col0 >= 512 && col0 < 1024);
  {
    const float* kk_w = P.in[14] + layer * 512 + (isk ? col0 - 512 : 0);
#pragma unroll
    for (int i = 0; i < 8; ++i) { kv[i] = zs[i] * kk_w[i]; ss += kv[i] * kv[i]; }
  }
  ss += __shfl_xor(ss, 1); ss += __shfl_xor(ss, 2); ss += __shfl_xor(ss, 4);
  if (tid < 240) {
    uint4 o;
    if (col0 < 1536) {
      o.x = pack2(zs[0], zs[1]); o.y = pack2(zs[2], zs[3]); o.z = pack2(zs[4], zs[5]); o.w = pack2(zs[6], zs[7]);
      *(uint4*)((bf16_t*)(X.ws + OFF_RKV) + (size_t)row * 1536 + col0) = o;
      if (isk) {
        float inv = 1.f / fmaxf(sqrtf(ss), 1e-12f);
        o.x = pack2(kv[0] * inv, kv[1] * inv); o.y = pack2(kv[2] * inv, kv[3] * inv);
        o.z = pack2(kv[4] * inv, kv[5] * inv); o.w = pack2(kv[6] * inv, kv[7] * inv);
        *(uint4*)((bf16_t*)(X.ws + OFF_KK) + (size_t)row * 512 + (col0 - 512)) = o;
      }
    } else {
      float t[8];
      if (col0 < 1664) {
#pragma unroll
        for (int i = 0; i < 8; ++i) t[i] = tanhf(zs[i]);
      } else if (col0 < 1792) {
#pragma unroll
        for (int i = 0; i < 8; ++i) t[i] = zs[i];
      } else {
#pragma unroll
        for (int i = 0; i < 8; ++i) t[i] = 1.f / (1.f + expf(-zs[i]));
      }
      o.x = pack2(t[0], t[1]); o.y = pack2(t[2], t[3]); o.z = pack2(t[4], t[5]); o.w = pack2(t[6], t[7]);
      *(uint4*)((bf16_t*)(X.ws + OFF_LORA) + (size_t)row * 384 + (col0 - 1536)) = o;
    }
  }
}

__device__ __forceinline__ void r1b_tile(const Params& P, const Cx& X, int layer, int t, char* smem) {
  const int lane = X.tid & 63, w = X.tid >> 6;
  const int mt = t % 136, rest = t / 136;
  const int nt = rest & 3, type = rest >> 2;
  const int m0 = mt * 128, n0 = nt * 128;
  const bf16_t* lora = (const bf16_t*)(X.ws + OFF_LORA) + (size_t)m0 * 384;
  const bf16_t* W = (const bf16_t*)(X.ws + OFF_WMIX);
  f32x16 acc[2][2];
  G22::zero(acc);
  if (type < 2) G22::run(X, lora + type * 64, 384, W + WE_W2 + type * 32768 + (size_t)n0 * 64, 64, 64, smem, acc);
  else if (type < 4) G22::run(X, lora + 128 + (type - 2) * 64, 384, W + WE_A2 + (type - 2) * 32768 + (size_t)n0 * 64, 64, 64, smem, acc);
  else G22::run(X, lora + 256, 384, W + WE_G2 + (size_t)n0 * 128, 128, 128, smem, acc);
  const int row0 = m0 + (w >> 1) * 64, col0 = n0 + (w & 1) * 64;
  bf16_t* ld = (bf16_t*)(X.ws + OFF_LD);
  bf16_t* ab = (bf16_t*)(X.ws + OFF_A);
  bf16_t* gb = (bf16_t*)(X.ws + OFF_G);
#pragma unroll
  for (int j = 0; j < 2; ++j) {
    const int col = col0 + j * 32 + (lane & 31);
    float bias = 0.f;
    if (type < 2) bias = P.in[10][(layer * 2 + type) * 512 + col];
    else if (type < 4) bias = P.in[12][(layer * 2 + type - 2) * 512 + col];
#pragma unroll
    for (int i = 0; i < 2; ++i)
#pragma unroll
      for (int r = 0; r < 16; ++r) {
        int row = row0 + i * 32 + ROW_OF(r);
        float v = acc[i][j][r] + bias;
        if (type < 2) ld[(size_t)row * 1024 + type * 512 + col] = f2bf(-0.60653066f / (1.f + __expf(-v)));
        else if (type < 4) ab[(size_t)row * 1024 + (type - 2) * 512 + col] = f2bf(1.f / (1.f + __expf(-v)));
        else gb[(size_t)row * 512 + col] = f2bf(v);
      }
  }
}

template <int CTRL>
__device__ __forceinline__ float dpp_f(float x) {
  return __int_as_float(__builtin_amdgcn_update_dpp(0, __float_as_int(x), CTRL, 0xf, 0xf, false));
}
__device__ __forceinline__ float red16(float x) {
  x += dpp_f<0x128>(x);
  x += dpp_f<0x124>(x);
  x += dpp_f<0x4E>(x);
  x += dpp_f<0xB1>(x);
  return x;
}
__device__ __forceinline__ int scan_tokrow(int b, int dir, int i) {
  if (i < 256) return NX + b * 256 + (dir ? 255 - i : i);
  int t = i - 256;
  return b * 4096 + (dir ? 4095 - t : t);
}
typedef float f2_t __attribute__((ext_vector_type(2)));
__device__ __forceinline__ void scan_job(const Params& P, const Cx& X, int layer, int bj, char* smem) {
  const int tid = X.tid, lane = tid & 63, w = tid >> 6;
  const int s = bj >> 2, rq = bj & 3;
  const int dir = s >> 5, b = (s & 31) >> 3, h = s & 7;
  float* sv = (float*)smem;
  float* sy = sv + 2 * 16 * 6 * 64;
  const bf16_t* rkv = (const bf16_t*)(X.ws + OFF_RKV);
  const bf16_t* kkb = (const bf16_t*)(X.ws + OFF_KK);
  const bf16_t* ab = (const bf16_t*)(X.ws + OFF_A);
  const bf16_t* ldb = (const bf16_t*)(X.ws + OFF_LD);
  bf16_t* yout = (bf16_t*)(X.ws + (dir ? OFF_YB : OFF_YF));
  const int lst = tid >> 4, lch = (tid & 15) * 4;
  const float4 ka4 = *(const float4*)(P.in[15] + layer * 512 + h * 64 + lch);
  uint2 pr, pk, pv, pkk, pa, pl;
#define SLOAD(chunk)                                                          \
  {                                                                           \
    int row = scan_tokrow(b, dir, (chunk)*16 + lst);                          \
    const bf16_t* p0 = rkv + (size_t)row * 1536 + h * 64 + lch;               \
    pr = *(const uint2*)p0; pk = *(const uint2*)(p0 + 512); pv = *(const uint2*)(p0 + 1024); \
    pkk = *(const uint2*)(kkb + (size_t)row * 512 + h * 64 + lch);            \
    pa = *(const uint2*)(ab + (size_t)row * 1024 + dir * 512 + h * 64 + lch); \
    pl = *(const uint2*)(ldb + (size_t)row * 1024 + dir * 512 + h * 64 + lch);\
  }
#define SSTORE2(buf)                                                          \
  {                                                                           \
    float* d = sv + ((buf)*16 + lst) * 384 + lch;                             \
    float a0 = lo16(pa.x), a1 = hi16(pa.x), a2 = lo16(pa.y), a3 = hi16(pa.y); \
    float k0 = lo16(pk.x), k1 = hi16(pk.x), k2 = lo16(pk.y), k3 = hi16(pk.y); \
    float q0 = lo16(pkk.x), q1 = hi16(pkk.x), q2 = lo16(pkk.y), q3 = hi16(pkk.y); \
    *(float4*)(d) = make_float4(q0, q1, q2, q3);                              \
    *(float4*)(d + 64) = make_float4(__expf(lo16(pl.x)), __expf(hi16(pl.x)), __expf(lo16(pl.y)), __expf(hi16(pl.y))); \
    *(float4*)(d + 128) = make_float4(q0 * a0, q1 * a1, q2 * a2, q3 * a3);    \
    *(float4*)(d + 192) = make_float4(k0 * (1.f + (a0 - 1.f) * ka4.x), k1 * (1.f + (a1 - 1.f) * ka4.y), k2 * (1.f + (a2 - 1.f) * ka4.z), k3 * (1.f + (a3 - 1.f) * ka4.w)); \
    *(float4*)(d + 256) = make_float4(lo16(pr.x), hi16(pr.x), lo16(pr.y), hi16(pr.y)); \
    *(float4*)(d + 320) = make_float4(lo16(pv.x), hi16(pv.x), lo16(pv.y), hi16(pv.y)); \
  }
  SLOAD(0);
  SSTORE2(0);
  __syncthreads();
  const int rp = lane >> 4, ci = (lane & 15) * 4;
  const int vrow = rq * 16 + w * 4 + rp;
  f2_t A01 = {0.f, 0.f}, A23 = {0.f, 0.f};
  for (int chunk = 0; chunk < 272; ++chunk) {
    const int buf = chunk & 1;
    if (chunk + 1 < 272) SLOAD(chunk + 1);
    {
      const float* base = sv + buf * 16 * 384;
      float ysel = 0.f;
      float4 p0kk, p0w, p0b, p0kd, p0r, p1kk, p1w, p1b, p1kd, p1r;
      float p0v, p1v;
#define LDS_SET(S, st)                                     \
  {                                                        \
    const float* d = base + (st)*384;                      \
    S##kk = *(const float4*)(d + ci);                      \
    S##w = *(const float4*)(d + 64 + ci);                  \
    S##b = *(const float4*)(d + 128 + ci);                 \
    S##kd = *(const float4*)(d + 192 + ci);                \
    S##r = *(const float4*)(d + 256 + ci);                 \
    S##v = d[320 + vrow];                                  \
  }
#define STEP(S, st)                                                                                   \
  {                                                                                                   \
    const f2_t kk01 = {S##kk.x, S##kk.y}, kk23 = {S##kk.z, S##kk.w}, w01 = {S##w.x, S##w.y}, w23 = {S##w.z, S##w.w}; \
    const f2_t b01 = {S##b.x, S##b.y}, b23 = {S##b.z, S##b.w}, kd01 = {S##kd.x, S##kd.y}, kd23 = {S##kd.z, S##kd.w}; \
    const f2_t r01 = {S##r.x, S##r.y}, r23 = {S##r.z, S##r.w};                                        \
    f2_t ta = __builtin_elementwise_fma(A01, kk01, A23 * kk23);                                       \
    const float sa = -red16(ta[0] + ta[1]);                                                           \
    const f2_t va = {S##v, S##v}, sa2 = {sa, sa};                                                     \
    A01 = __builtin_elementwise_fma(A01, w01, va * kd01); A23 = __builtin_elementwise_fma(A23, w23, va * kd23); \
    A01 = __builtin_elementwise_fma(sa2, b01, A01); A23 = __builtin_elementwise_fma(sa2, b23, A23);   \
    f2_t ya = __builtin_elementwise_fma(A01, r01, A23 * r23);                                         \
    const float y0 = red16(ya[0] + ya[1]);                                                            \
    ysel = ((lane & 15) == (st)) ? y0 : ysel;                                                         \
  }
      LDS_SET(p0, 0);
#pragma unroll
      for (int st = 0; st < 16; st += 2) {
        LDS_SET(p1, st + 1);
        __builtin_amdgcn_sched_barrier(0);
        STEP(p0, st);
        if (st + 2 < 16) LDS_SET(p0, st + 2);
        __builtin_amdgcn_sched_barrier(0);
        STEP(p1, st + 1);
      }
#undef LDS_SET
#undef STEP
      sy[(buf * 16 + (lane & 15)) * 16 + w * 4 + rp] = ysel;
    }
    if (chunk + 1 < 272) SSTORE2(buf ^ 1);
    __syncthreads();
    {
      int st = tid >> 4, r = tid & 15;
      int row = scan_tokrow(b, dir, chunk * 16 + st);
      yout[(size_t)row * 512 + h * 64 + rq * 16 + r] = f2bf(sy[(buf * 16 + st) * 16 + r]);
    }
  }
#undef SLOAD
#undef SSTORE2
  __syncthreads();
}

__device__ __forceinline__ void s2_job(const Params& P, const Cx& X, int layer, int job) {
  const int tid = X.tid;
  const int row = job * 4 + (tid >> 6);
  const int c0 = (tid & 63) * 8;
  const bf16_t* rkv = (const bf16_t*)(X.ws + OFF_RKV) + (size_t)row * 1536;
  uint4 ur = *(const uint4*)(rkv + c0), uk = *(const uint4*)(rkv + 512 + c0), uv = *(const uint4*)(rkv + 1024 + c0);
  uint4 ua0 = *(const uint4*)((const bf16_t*)(X.ws + OFF_A) + (size_t)row * 1024 + c0);
  uint4 ua1 = *(const uint4*)((const bf16_t*)(X.ws + OFF_A) + (size_t)row * 1024 + 512 + c0);
  uint4 ug = *(const uint4*)((const bf16_t*)(X.ws + OFF_G) + (size_t)row * 512 + c0);
  uint4 uyf = *(const uint4*)((const bf16_t*)(X.ws + OFF_YF) + (size_t)row * 512 + c0);
  uint4 uyb = *(const uint4*)((const bf16_t*)(X.ws + OFF_YB) + (size_t)row * 512 + c0);
  const uint32_t r4[4] = {ur.x, ur.y, ur.z, ur.w}, k4[4] = {uk.x, uk.y, uk.z, uk.w}, v4[4] = {uv.x, uv.y, uv.z, uv.w};
  const uint32_t a04[4] = {ua0.x, ua0.y, ua0.z, ua0.w}, a14[4] = {ua1.x, ua1.y, ua1.z, ua1.w}, g4[4] = {ug.x, ug.y, ug.z, ug.w};
  const uint32_t yf4[4] = {uyf.x, uyf.y, uyf.z, uyf.w}, yb4[4] = {uyb.x, uyb.y, uyb.z, uyb.w};
  float y[8], vv[8], gg[8];
  float sum = 0.f, bon = 0.f;
  const float* rk = P.in[16] + layer * 512 + c0;
  const float* ka = P.in[15] + layer * 512 + c0;
#pragma unroll
  for (int i = 0; i < 4; ++i) {
#pragma unroll
    for (int hh = 0; hh < 2; ++hh) {
      int e = 2 * i + hh;
      float r = hh ? hi16(r4[i]) : lo16(r4[i]);
      float k = hh ? hi16(k4[i]) : lo16(k4[i]);
      float a0 = hh ? hi16(a04[i]) : lo16(a04[i]);
      float a1 = hh ? hi16(a14[i]) : lo16(a14[i]);
      y[e] = (hh ? hi16(yf4[i]) : lo16(yf4[i])) + (hh ? hi16(yb4[i]) : lo16(yb4[i]));
      vv[e] = hh ? hi16(v4[i]) : lo16(v4[i]);
      gg[e] = hh ? hi16(g4[i]) : lo16(g4[i]);
      sum += y[e];
      float ksum = k * (2.f + (a0 + a1 - 2.f) * ka[e]);
      bon += r * rk[e] * ksum;
    }
  }
  sum += __shfl_xor(sum, 1); sum += __shfl_xor(sum, 2); sum += __shfl_xor(sum, 4);
  bon += __shfl_xor(bon, 1); bon += __shfl_xor(bon, 2); bon += __shfl_xor(bon, 4);
  const float mu = sum * (1.f / 64.f);
  float var = 0.f;
#pragma unroll
  for (int e = 0; e < 8; ++e) { float d = y[e] - mu; var += d * d; }
  var += __shfl_xor(var, 1); var += __shfl_xor(var, 2); var += __shfl_xor(var, 4);
  const float rs = rsqrtf(var * (1.f / 64.f) + 64e-5f);
  const float* gw = P.in[18] + layer * 512 + c0;
  const float* gbi = P.in[19] + layer * 512 + c0;
  float o[8];
#pragma unroll
  for (int e = 0; e < 8; ++e) o[e] = ((y[e] - mu) * rs * gw[e] + gbi[e] + bon * vv[e]) * gg[e];
  uint4 ou;
  ou.x = pack2(o[0], o[1]); ou.y = pack2(o[2], o[3]); ou.z = pack2(o[4], o[5]); ou.w = pack2(o[6], o[7]);
  *(uint4*)((bf16_t*)(X.ws + OFF_RWO) + (size_t)row * 512 + c0) = ou;
}

__device__ __forceinline__ float red32(float x) {
  x += __shfl_xor(x, 1); x += __shfl_xor(x, 2); x += __shfl_xor(x, 4); x += __shfl_xor(x, 8); x += __shfl_xor(x, 16);
  return x;
}
#define QSCALE 0.14724444f
__device__ __forceinline__ void q1_q_tile(const Params& P, const Cx& X, int layer, int t, char* smem) {
  const int tid = X.tid, lane = tid & 63, w = tid >> 6;
  const int mt = t % 136, head = t / 136;
  const int m0 = mt * 128;
  const bf16_t* zm = (const bf16_t*)(X.ws + OFF_ZM);
  float* srs = (float*)(smem + 73728);
  {
    int r = tid >> 1, hf = tid & 1;
    const bf16_t* p = zm + (size_t)(m0 + r) * 544 + hf * 192;
    float ss = 0.f;
    for (int i = 0; i < 24; ++i) {
      uint4 u = *(const uint4*)(p + i * 8);
      ss += lo16(u.x) * lo16(u.x) + hi16(u.x) * hi16(u.x) + lo16(u.y) * lo16(u.y) + hi16(u.y) * hi16(u.y) +
            lo16(u.z) * lo16(u.z) + hi16(u.z) * hi16(u.z) + lo16(u.w) * lo16(u.w) + hi16(u.w) * hi16(u.w);
    }
    ss += __shfl_xor(ss, 1);
    if (hf == 0) srs[r] = rsqrtf(ss * (1.f / 384.f) + 1e-6f);
  }
  f32x16 acc[1][3];
  GQ::zero(acc);
  GQ::run(X, zm + (size_t)m0 * 544, 544, (const bf16_t*)(X.ws + OFF_WMIX) + WE_UQ + (size_t)head * 96 * 384, 384, 384, smem, acc);
  const int l5 = lane & 31;
  const float* gq = P.in[25] + layer * 96;
  const float g0 = gq[l5], g1 = gq[32 + l5], g2 = gq[64 + l5];
  const float2* rope = (const float2*)(X.ws + OFF_ROPE);
  bf16_t* qb = (bf16_t*)(X.ws + OFF_Q);
#pragma unroll
  for (int r = 0; r < 16; ++r) {
    const int rl = w * 32 + ROW_OF(r);
    const int row = m0 + rl;
    const float rs = srs[rl];
    float x0 = acc[0][0][r] * rs, x1 = acc[0][1][r] * rs, x2 = acc[0][2][r] * rs;
    float ss = red32(x0 * x0 + x1 * x1 + x2 * x2);
    float rq = rsqrtf(ss * (1.f / 96.f) + 1e-6f);
    x0 *= rq * g0; x1 *= rq * g1; x2 *= rq * g2;
    bf16_t* dst;
    if (row < NX) {
      int tt = row & 4095, bb = row >> 12;
      float2 cs = rope[tt * 16 + (l5 >> 4) * 8 + (l5 & 7)];
      float other = __shfl_xor(x2, 8);
      x2 = (l5 & 8) ? x2 * cs.x + other * cs.y : x2 * cs.x - other * cs.y;
      dst = qb + ((size_t)(bb * 8 + head) * 4096 + tt) * 96;
    } else {
      int j = (row - NX) & 255, bb = (row - NX) >> 8;
      dst = qb + (size_t)NX * 768 + ((size_t)(bb * 8 + head) * 256 + j) * 96;
    }
    dst[l5] = f2bf(x0 * QSCALE); dst[32 + l5] = f2bf(x1 * QSCALE); dst[64 + l5] = f2bf(x2 * QSCALE);
  }
}
__device__ __forceinline__ void q1_kv_tile(const Params& P, const Cx& X, int layer, int t, char* smem) {
  const int tid = X.tid, lane = tid & 63, w = tid >> 6;
  const int mt = t % 136, head = t / 136;
  const int m0 = mt * 128;
  const bf16_t* zm = (const bf16_t*)(X.ws + OFF_ZM);
  float* srs = (float*)(smem + 73728);
  {
    int r = tid >> 1, hf = tid & 1;
    const bf16_t* p = zm + (size_t)(m0 + r) * 544 + 384 + hf * 64;
    float ss = 0.f;
    for (int i = 0; i < 8; ++i) {
      uint4 u = *(const uint4*)(p + i * 8);
      ss += lo16(u.x) * lo16(u.x) + hi16(u.x) * hi16(u.x) + lo16(u.y) * lo16(u.y) + hi16(u.y) * hi16(u.y) +
            lo16(u.z) * lo16(u.z) + hi16(u.z) * hi16(u.z) + lo16(u.w) * lo16(u.w) + hi16(u.w) * hi16(u.w);
    }
    ss += __shfl_xor(ss, 1);
    if (hf == 0) srs[r] = rsqrtf(ss * (1.f / 128.f) + 1e-6f);
  }
  f32x16 acc[1][4];
  GKV::zero(acc);
  GKV::run(X, zm + (size_t)m0 * 544 + 384, 544, (const bf16_t*)(X.ws + OFF_WMIX) + WE_UKV + (size_t)head * 128 * 128, 128, 128, smem, acc);
  const int l5 = lane & 31;
  const float* gk = P.in[26] + layer * 96;
  const float g0 = gk[l5], g1 = gk[32 + l5], g2 = gk[64 + l5];
  const float2* rope = (const float2*)(X.ws + OFF_ROPE);
  bf16_t* kb = (bf16_t*)(X.ws + OFF_K);
  bf16_t* vt = (bf16_t*)(X.ws + OFF_VT);
  const bool isx = m0 < NX;
  const int bb = isx ? (m0 >> 12) : ((m0 - NX) >> 8);
  float vv0[16], vv1[16];
#pragma unroll
  for (int r = 0; r < 16; ++r) {
    const int rl = w * 32 + ROW_OF(r);
    const int row = m0 + rl;
    const float rs = srs[rl];
    float k0 = acc[0][0][r] * rs, k1 = acc[0][1][r] * rs;
    float kr = bf2f(zm[(size_t)row * 544 + 512 + l5]);
    float ss = red32(k0 * k0 + k1 * k1 + kr * kr);
    float rk = rsqrtf(ss * (1.f / 96.f) + 1e-6f);
    k0 *= rk * g0; k1 *= rk * g1; kr *= rk * g2;
    int key;
    if (isx) {
      int tt = row & 4095;
      float2 cs = rope[tt * 16 + (l5 >> 4) * 8 + (l5 & 7)];
      float other = __shfl_xor(kr, 8);
      kr = (l5 & 8) ? kr * cs.x + other * cs.y : kr * cs.x - other * cs.y;
      key = 256 + tt;
    } else {
      key = (row - NX) & 255;
    }
    bf16_t* dst = kb + ((size_t)(bb * 8 + head) * 4352 + key) * 96;
    dst[l5] = f2bf(k0); dst[32 + l5] = f2bf(k1); dst[64 + l5] = f2bf(kr);
    vv0[r] = acc[0][2][r] * rs;
    vv1[r] = acc[0][3][r] * rs;
  }
#pragma unroll
  for (int g = 0; g < 4; ++g) {
    const int rl = w * 32 + 8 * g + 4 * (lane >> 5);
    const int row = m0 + rl;
    const int key = isx ? 256 + (row & 4095) : ((row - NX) & 255);
    uint2 o0, o1;
    o0.x = pack2(vv0[4 * g], vv0[4 * g + 1]); o0.y = pack2(vv0[4 * g + 2], vv0[4 * g + 3]);
    o1.x = pack2(vv1[4 * g], vv1[4 * g + 1]); o1.y = pack2(vv1[4 * g + 2], vv1[4 * g + 3]);
    *(uint2*)(vt + ((size_t)(bb * 8 + head) * 64 + l5) * 4352 + key) = o0;
    *(uint2*)(vt + ((size_t)(bb * 8 + head) * 64 + 32 + l5) * 4352 + key) = o1;
  }
}

__device__ __forceinline__ void fft1_tile(const Params& P, const Cx& X, int t, char* smem) {
  const int lane = X.tid & 63, w = X.tid >> 6;
  const int b = t >> 8, ntile = t & 255;
  const int n0 = ntile * 128;
  f32x16 acc[2][2];
  G22T::zero(acc);
  G22T::run(X, (const bf16_t*)(X.ws + OFF_F1), 64, (const bf16_t*)(X.ws + OFF_ZF) + (size_t)b * 4096 * 512 + n0, 32768, 64, smem, acc);
  const float2* tw = (const float2*)(X.ws + OFF_TW);
  bf16_t* out = (bf16_t*)(X.ws + OFF_FFT1);
  const int wm = w >> 1, wn = w & 1;
  const int t2 = n0 >> 9;
#pragma unroll
  for (int j = 0; j < 2; ++j) {
    const int ch = (n0 & 511) + wn * 64 + j * 32 + (lane & 31);
#pragma unroll
    for (int r = 0; r < 16; ++r) {
      const int f1 = wm * 32 + ROW_OF(r);
      float re = acc[0][j][r], im = acc[1][j][r];
      float2 cs = tw[t2 * f1];
      float re2 = re * cs.x + im * cs.y, im2 = im * cs.x - re * cs.y;
      size_t base = ((size_t)(b * 64 + f1) * 128) * 512 + ch;
      out[base + (size_t)t2 * 512] = f2bf(re2);
      out[base + (size_t)(64 + t2) * 512] = f2bf(im2);
    }
  }
}
__device__ __forceinline__ void fft2_tile(const Params& P, const Cx& X, int t, char* smem) {
  const int lane = X.tid & 63, w = X.tid >> 6;
  const int bf = t >> 2, ntile = t & 3;
  const int b = bf >> 6, f1 = bf & 63;
  const int n0 = ntile * 128;
  f32x16 acc[2][2];
  G22T::zero(acc);
  G22T::run(X, (const bf16_t*)(X.ws + OFF_F2), 128, (const bf16_t*)(X.ws + OFF_FFT1) + (size_t)bf * 128 * 512 + n0, 512, 128, smem, acc);
  bf16_t* Y = (bf16_t*)(X.ws + OFF_Y);
  const int wm = w >> 1, wn = w & 1;
#pragma unroll
  for (int i = 0; i < 2; ++i)
#pragma unroll
    for (int j = 0; j < 2; ++j)
#pragma unroll
      for (int r = 0; r < 16; ++r) {
        int m = wm * 64 + i * 32 + ROW_OF(r);
        int f2 = m & 63, q = m >> 6;
        int ch = n0 + wn * 64 + j * 32 + (lane & 31);
        Y[(size_t)(b * 4096 + f1 + 64 * f2) * 1024 + q * 512 + ch] = f2bf(acc[i][j][r]);
      }
}
__device__ __forceinline__ void ctxdft_tile(const Params& P, const Cx& X, int t, char* smem) {
  const int lane = X.tid & 63, w = X.tid >> 6;
  const int b = t >> 4, mt = (t >> 2) & 3, ntile = t & 3;
  const int n0 = ntile * 128;
  f32x16 acc[2][2];
  G22T::zero(acc);
  G22T::run(X, (const bf16_t*)(X.ws + OFF_F256) + (size_t)mt * 128 * 256, 256, (const bf16_t*)(X.ws + OFF_ZF) + (size_t)(NX + b * 256) * 512 + n0, 512, 256, smem, acc);
  bf16_t* Y = (bf16_t*)(X.ws + OFF_Y);
  const int wm = w >> 1, wn = w & 1;
#pragma unroll
  for (int i = 0; i < 2; ++i)
#pragma unroll
    for (int j = 0; j < 2; ++j)
#pragma unroll
      for (int r = 0; r < 16; ++r) {
        int m = mt * 128 + wm * 64 + i * 32 + ROW_OF(r);
        int f = m & 255, q = m >> 8;
        int ch = n0 + wn * 64 + j * 32 + (lane & 31);
        Y[(size_t)(NX + b * 256 + f) * 1024 + q * 512 + ch] = f2bf(acc[i][j][r] * 4.f);
      }
}

__device__ __forceinline__ void attn_item(const Params& P, const Cx& X, int it, bool isctx, char* smem) {
  const int tid = X.tid, lane = tid & 63, w = tid >> 6;
  int b, h, qb, nkt, qrow0;
  const bf16_t* qbase;
  if (!isctx) {
    b = it >> 8; h = (it >> 5) & 7; qb = it & 31; nkt = 68;
    qbase = (const bf16_t*)(X.ws + OFF_Q) + ((size_t)(b * 8 + h) * 4096 + qb * 128) * 96;
    qrow0 = b * 4096 + qb * 128;
  } else {
    b = it >> 4; h = (it >> 1) & 7; qb = it & 1; nkt = 4;
    qbase = (const bf16_t*)(X.ws + OFF_Q) + (size_t)NX * 768 + ((size_t)(b * 8 + h) * 256 + qb * 128) * 96;
    qrow0 = NX + b * 256 + qb * 128;
  }
  const bf16_t* kbase = (const bf16_t*)(X.ws + OFF_K) + (size_t)(b * 8 + h) * 4352 * 96;
  const bf16_t* vbase = (const bf16_t*)(X.ws + OFF_VT) + (size_t)(b * 8 + h) * 64 * 4352;
  bf16_t* sK = (bf16_t*)smem;
  bf16_t* sV = sK + 2 * 64 * 104;
  const int l5 = lane & 31, hh = lane >> 5;
  const bf16_t* qp = qbase + (size_t)(w * 32 + l5) * 96 + hh * 8;
  const bf16x8 qf0 = *(const bf16x8*)(qp), qf1 = *(const bf16x8*)(qp + 16), qf2 = *(const bf16x8*)(qp + 32);
  const bf16x8 qf3 = *(const bf16x8*)(qp + 48), qf4 = *(const bf16x8*)(qp + 64), qf5 = *(const bf16x8*)(qp + 80);
  uint4 rk0, rk1, rk2, rv0, rv1;
#define LK_(i, kt) (*(const uint4*)(kbase + (size_t)((kt)*64 + (tid + 256 * (i)) / 12) * 96 + ((tid + 256 * (i)) % 12) * 8))
#define LV_(i, kt) (*(const uint4*)(vbase + (size_t)((tid + 256 * (i)) >> 3) * 4352 + (kt)*64 + ((tid + 256 * (i)) & 7) * 8))
#define ALOAD(kt) { rk0 = LK_(0, kt); rk1 = LK_(1, kt); rk2 = LK_(2, kt); rv0 = LV_(0, kt); rv1 = LV_(1, kt); }
#define SK_(i, buf, v) *(uint4*)(sK + (buf)*64 * 104 + ((tid + 256 * (i)) / 12) * 104 + ((tid + 256 * (i)) % 12) * 8) = v
#define SV_(i, buf, v) *(uint4*)(sV + (buf)*64 * 72 + ((tid + 256 * (i)) >> 3) * 72 + ((tid + 256 * (i)) & 7) * 8) = v
#define ASTORE(buf) { SK_(0, buf, rk0); SK_(1, buf, rk1); SK_(2, buf, rk2); SV_(0, buf, rv0); SV_(1, buf, rv1); }
  f32x16 o[2];
#pragma unroll
  for (int r = 0; r < 16; ++r) { o[0][r] = 0.f; o[1][r] = 0.f; }
  float mrun = -1e30f, lrun = 0.f;
  ALOAD(0);
  ASTORE(0);
  __syncthreads();
  for (int kt = 0; kt < nkt; ++kt) {
    const int buf = kt & 1;
    if (kt + 1 < nkt) ALOAD(kt + 1);
    const bf16_t* pk = sK + buf * 64 * 104 + l5 * 104 + hh * 8;
    const bf16_t* pv = sV + buf * 64 * 72 + l5 * 72 + 4 * hh;
#pragma unroll
    for (int mt = 0; mt < 2; ++mt) {
      f32x16 sc;
#pragma unroll
      for (int r = 0; r < 16; ++r) sc[r] = 0.f;
#define QK(ks, qq) sc = __builtin_amdgcn_mfma_f32_32x32x16_bf16(*(const bf16x8*)(pk + mt * 32 * 104 + (ks)*16), qq, sc, 0, 0, 0)
      QK(0, qf0); QK(1, qf1); QK(2, qf2); QK(3, qf3); QK(4, qf4); QK(5, qf5);
#undef QK
      float mx = sc[0];
#pragma unroll
      for (int r = 1; r < 16; ++r) mx = fmaxf(mx, sc[r]);
      mx = fmaxf(mx, __shfl_xor(mx, 32));
      const float mnew = fmaxf(mrun, mx);
      if (__builtin_amdgcn_ballot_w64(mnew > mrun) != 0ull) {
        const float alpha = __builtin_amdgcn_exp2f(mrun - mnew);
        lrun *= alpha;
#pragma unroll
        for (int r = 0; r < 16; ++r) { o[0][r] *= alpha; o[1][r] *= alpha; }
        mrun = mnew;
      }
      float psum = 0.f;
#pragma unroll
      for (int r = 0; r < 16; ++r) { sc[r] = __builtin_amdgcn_exp2f(sc[r] - mrun); psum += sc[r]; }
      lrun += psum;
#pragma unroll
      for (int s2 = 0; s2 < 2; ++s2) {
        u32x4 pu;
        pu[0] = pack2(sc[8 * s2 + 0], sc[8 * s2 + 1]);
        pu[1] = pack2(sc[8 * s2 + 2], sc[8 * s2 + 3]);
        pu[2] = pack2(sc[8 * s2 + 4], sc[8 * s2 + 5]);
        pu[3] = pack2(sc[8 * s2 + 6], sc[8 * s2 + 7]);
        const bf16x8 pfv = __builtin_bit_cast(bf16x8, pu);
#pragma unroll
        for (int dt = 0; dt < 2; ++dt) {
          const bf16_t* p = pv + dt * 32 * 72 + mt * 32 + s2 * 16;
          uint2 v0 = *(const uint2*)(p), v1 = *(const uint2*)(p + 8);
          u32x4 vu;
          vu[0] = v0.x; vu[1] = v0.y; vu[2] = v1.x; vu[3] = v1.y;
          o[dt] = __builtin_amdgcn_mfma_f32_32x32x16_bf16(__builtin_bit_cast(bf16x8, vu), pfv, o[dt], 0, 0, 0);
        }
      }
    }
    if (kt + 1 < nkt) ASTORE(buf ^ 1);
    __syncthreads();
  }
#undef ALOAD
#undef ASTORE
#undef LK_
#undef LV_
#undef SK_
#undef SV_
  lrun += __shfl_xor(lrun, 32);
  const float inv = 1.f / lrun;
  bf16_t* dst = (bf16_t*)(X.ws + OFF_ATT) + (size_t)(qrow0 + w * 32 + l5) * 512 + h * 64;
#pragma unroll
  for (int dt = 0; dt < 2; ++dt)
#pragma unroll
    for (int g = 0; g < 4; ++g) {
      uint2 u;
      u.x = pack2(o[dt][4 * g] * inv, o[dt][4 * g + 1] * inv);
      u.y = pack2(o[dt][4 * g + 2] * inv, o[dt][4 * g + 3] * inv);
      *(uint2*)(dst + dt * 32 + 8 * g + 4 * hh) = u;
    }
}

__device__ __forceinline__ void mg_tile(const Params& P, const Cx& X, int t, int mtiles, char* smem) {
  const int lane = X.tid & 63, w = X.tid >> 6;
  const int mt = t % mtiles, nt = t / mtiles;
  const int m0 = mt * 128, c0 = nt * 64;
  const bf16_t* W = (const bf16_t*)(X.ws + OFF_WMIX);
  f32x16 macc[2][1];
  GMG::zero(macc);
#pragma unroll 1
  for (int i = 0; i < 3; ++i) {
    f32x16 ag[2][1], ao[2][1];
    GMG::zero(ag);
    GMG::zero(ao);
    GMG::run(X, (const bf16_t*)(X.ws + OFF_HBUF) + (size_t)m0 * 1024, 1024, W + WE_IN + (size_t)(2976 + i * 1024 + c0) * 1024, 1024, 1024, smem, ag);
    const bf16_t* Ai; const bf16_t* Bi; int ldi;
    if (i == 0) { Ai = (const bf16_t*)(X.ws + OFF_RWO) + (size_t)m0 * 512; Bi = W + WE_RO + (size_t)c0 * 512; ldi = 512; }
    else if (i == 1) { Ai = (const bf16_t*)(X.ws + OFF_ATT) + (size_t)m0 * 512; Bi = W + WE_MO + (size_t)c0 * 512; ldi = 512; }
    else { Ai = (const bf16_t*)(X.ws + OFF_Y) + (size_t)m0 * 1024; Bi = W + WE_FO + (size_t)c0 * 1024; ldi = 1024; }
    GMG::run(X, Ai, ldi, Bi, ldi, ldi, smem, ao);
#pragma unroll
    for (int a = 0; a < 2; ++a)
#pragma unroll
      for (int r = 0; r < 16; ++r) macc[a][0][r] += ao[a][0][r] / (1.f + __expf(-ag[a][0][r]));
  }
  bf16_t* mb = (bf16_t*)(X.ws + OFF_M);
  const int row0 = m0 + (w >> 1) * 64, col = c0 + (w & 1) * 32 + (lane & 31);
#pragma unroll
  for (int a = 0; a < 2; ++a)
#pragma unroll
    for (int r = 0; r < 16; ++r) mb[(size_t)(row0 + a * 32 + ROW_OF(r)) * 1024 + col] = f2bf(macc[a][0][r]);
}

__device__ __forceinline__ void wo_tile(const Params& P, const Cx& X, int layer, int t, int mtiles, char* smem) {
  const int lane = X.tid & 63, w = X.tid >> 6;
  const int mt = t % mtiles, nt = t / mtiles;
  const int m0 = mt * 128, n0 = nt * 128;
  f32x16 acc[2][2];
  G22::zero(acc);
  G22::run(X, (const bf16_t*)(X.ws + OFF_M) + (size_t)m0 * 1024, 1024, (const bf16_t*)(X.ws + OFF_WMIX) + WE_OUT + (size_t)n0 * 1024, 1024, 1024, smem, acc);
  const int row0 = m0 + (w >> 1) * 64, col0 = n0 + (w & 1) * 64;
  const float* modv = (const float*)(X.ws + OFF_MOD) + (size_t)(layer * 5 + mod_row(m0)) * 6144 + 2048;
  const float* src; float* dst;
  if (m0 < NX) { src = (layer == 0 ? P.in[0] : X.out); dst = X.out; }
  else { src = (layer == 0 ? P.in[2] : (const float*)(X.ws + OFF_CS)) - (size_t)NX * 1024; dst = (float*)(X.ws + OFF_CS) - (size_t)NX * 1024; }
#pragma unroll
  for (int j = 0; j < 2; ++j) {
    const int col = col0 + j * 32 + (lane & 31);
    const float mg = modv[col];
#pragma unroll
    for (int i = 0; i < 2; ++i)
#pragma unroll
      for (int r = 0; r < 16; ++r) {
        size_t idx = (size_t)(row0 + i * 32 + ROW_OF(r)) * 1024 + col;
        dst[idx] = src[idx] + mg * acc[i][j][r];
      }
  }
}
__device__ __forceinline__ void f1_tile(const Params& P, const Cx& X, int t, int mtiles, char* smem) {
  const int lane = X.tid & 63, w = X.tid >> 6;
  const int mt = t % mtiles, nt = t / mtiles;
  const int m0 = mt * 128, n0 = nt * 128;
  f32x16 acc[2][2];
  G22::zero(acc);
  G22::run(X, (const bf16_t*)(X.ws + OFF_HBUF) + (size_t)m0 * 1024, 1024, (const bf16_t*)(X.ws + OFF_WFFN) + WF_IN + (size_t)n0 * 1024, 1024, 1024, smem, acc);
  bf16_t* act = (bf16_t*)(X.ws + OFF_ACT);
  const int row0 = m0 + (w >> 1) * 64;
  const int hid = ((n0 + (w & 1) * 64) >> 6) * 32 + (lane & 31);
#pragma unroll
  for (int i = 0; i < 2; ++i)
#pragma unroll
    for (int r = 0; r < 16; ++r) {
      float g = acc[i][0][r], u = acc[i][1][r];
      act[(size_t)(row0 + i * 32 + ROW_OF(r)) * 2816 + hid] = f2bf(g / (1.f + __expf(-g)) * u);
    }
}
__device__ __forceinline__ void f2_tile(const Params& P, const Cx& X, int layer, int t, int mtiles, char* smem) {
  const int lane = X.tid & 63, w = X.tid >> 6;
  const int mt = t % mtiles, nt = t / mtiles;
  const int m0 = mt * 128, n0 = nt * 128;
  f32x16 acc[2][2];
  G22::zero(acc);
  G22::run(X, (const bf16_t*)(X.ws + OFF_ACT) + (size_t)m0 * 2816, 2816, (const bf16_t*)(X.ws + OFF_WFFN) + WF_OUT + (size_t)n0 * 2816, 2816, 2816, smem, acc);
  const int row0 = m0 + (w >> 1) * 64, col0 = n0 + (w & 1) * 64;
  const float* modv = (const float*)(X.ws + OFF_MOD) + (size_t)(layer * 5 + mod_row(m0)) * 6144 + 5120;
  float* dst = (m0 < NX) ? X.out : (float*)(X.ws + OFF_CS) - (size_t)NX * 1024;
#pragma unroll
  for (int j = 0; j < 2; ++j) {
    const int col = col0 + j * 32 + (lane & 31);
    const float mg = modv[col];
#pragma unroll
    for (int i = 0; i < 2; ++i)
#pragma unroll
      for (int r = 0; r < 16; ++r) {
        size_t idx = (size_t)(row0 + i * 32 + ROW_OF(r)) * 1024 + col;
        dst[idx] = dst[idx] + mg * acc[i][j][r];
      }
  }
}

__device__ __forceinline__ Cx fresh(const Cx& X) {
  int t = X.tid;
  asm volatile("" : "+v"(t));
  return Cx{X.ws, X.out, t};
}
__device__ __forceinline__ void run_p(const Params& P, const Cx& X, int layer, int p, char* smem) {
  const int G = gridDim.x, B = blockIdx.x;
  if (p < 0) {
    if (!PON(14)) return;
    for (int j = B; j < 192 + 55; j += G) { if (j < 192) job_mod(P, fresh(X), smem, j); else job_tables(P, fresh(X), j - 192); }
    return;
  }
  const int mtiles = layer == 0 ? 136 : 128;
  switch (p) {
    case 0: if (!PON(0)) break;
      for (int j = B; j < NCW1 + 4352; j += G) { if (j < NCW1) cw_mixer_job(P, fresh(X), layer, j, smem); else norm_job(P, fresh(X), layer, 0, j - NCW1); }
      break;
    case 1: if (!PON(1)) break; for (int j = B; j < 136 * 15; j += G) g1a_tile(P, fresh(X), j, smem); break;
    case 2: if (!PON(2)) break; for (int j = B; j < NTOK; j += G) r1a_row(P, fresh(X), layer, j); break;
    case 3: if (!PON(3)) break; for (int j = B; j < 136 * 20; j += G) r1b_tile(P, fresh(X), layer, j, smem); break;
    case 4: if (!PON(4)) break; {
      volatile int* sflag = (volatile int*)(smem + LDS_BYTES - 32);
      if (sflag[0]) {
        unsigned* ctr = (unsigned*)(X.ws + OFF_TICK) + 2048 + layer * 64;
        for (;;) {
          __syncthreads();
          if (X.tid == 0) sflag[1] = (int)atomicAdd(ctr, 1u);
          __syncthreads();
          const int j = sflag[1];
          if (j >= 256) break;
          scan_job(P, fresh(X), layer, j, smem);
        }
      }
    } break;
    case 5: if (!PON(5)) break; for (int j = B; j < 4352; j += G) s2_job(P, fresh(X), layer, j); break;
    case 6: if (!PON(6)) break; for (int j = B; j < 136 * 9; j += G) g1b_tile(P, fresh(X), j, smem); break;
    case 7: if (!PON(7)) break;
      for (int j = B; j < 2176 + 1024; j += G) {
        if (j < 1088) q1_kv_tile(P, fresh(X), layer, j, smem);
        else if (j < 2176) { if (layer == 0 || (j - 1088) % 136 < 128) q1_q_tile(P, fresh(X), layer, j - 1088, smem); }
        else fft1_tile(P, fresh(X), j - 2176, smem);
      }
      break;
    case 8: if (!PON(8)) break; {
      const int nctx = layer == 0 ? 64 : 0;
      for (int j = B; j < 1024 + 1024 + 2 * nctx; j += G) {
        const bool isc = (j >= 2048 && j < 2048 + nctx);
        if (j < 1024 || isc) attn_item(P, fresh(X), isc ? j - 2048 : j, isc, smem);
        else if (j < 2048) fft2_tile(P, fresh(X), j - 1024, smem);
        else ctxdft_tile(P, fresh(X), j - 2048 - nctx, smem);
      }
    } break;
    case 9: if (!PON(9)) break; for (int j = B; j < mtiles * 16; j += G) mg_tile(P, fresh(X), j, mtiles, smem); break;
    case 10: if (!PON(10)) break;
      for (int j = B; j < mtiles * 8 + NCW2; j += G) { if (j < mtiles * 8) wo_tile(P, fresh(X), layer, j, mtiles, smem); else cw_ffn_job(P, fresh(X), layer, j - mtiles * 8, smem); }
      break;
    case 11: if (!PON(11)) break; for (int j = B; j < mtiles * 32; j += G) norm_job(P, fresh(X), layer, 1, j); break;
    case 12: if (!PON(12)) break; for (int j = B; j < mtiles * 44; j += G) f1_tile(P, fresh(X), j, mtiles, smem); break;
    case 13: if (!PON(13)) break; for (int j = B; j < mtiles * 8; j += G) f2_tile(P, fresh(X), layer, j, mtiles, smem); break;
  }
}

#if SINGLE
__global__ void __launch_bounds__(256, 2) fwd_kernel(Params P, int ph_lo, int ph_hi, int use_sync) {
  extern __shared__ __attribute__((aligned(16))) char smem[];
  volatile LAS unsigned* xst = (volatile LAS unsigned*)(smem + LDS_BYTES - 16);
  if (threadIdx.x == 0) { xst[0] = 0u; xst[1] = 0u; }
  __syncthreads();
  XcdBarrier xb = xcd_barrier_post((unsigned*)(P.ws + OFF_BAR), xst);
  if (threadIdx.x == 0) {
    const unsigned hwid = (unsigned)__builtin_amdgcn_s_getreg((31 << 11) | 4);
    const unsigned slot = ((xb_xcc_id() * 8u + ((hwid >> 13) & 7u)) * 2u + ((hwid >> 12) & 1u)) * 16u + ((hwid >> 8) & 15u);
    const unsigned t = atomicAdd((unsigned*)(P.ws + OFF_TICK) + slot, 1u);
    *(volatile int*)(smem + LDS_BYTES - 32) = (t == 0u) ? 1 : 0;
  }
  __syncthreads();
#pragma unroll 1
  for (int ph = ph_lo; ph < ph_hi; ++ph) {
    char* ws = P.ws; float* out = P.out; int tid = threadIdx.x;
    asm volatile("" : "+s"(ws));
    asm volatile("" : "+s"(out));
    asm volatile("" : "+v"(tid));
    const Cx X{ws, out, tid};
    if (ph == 0) run_p(P, X, 0, -1, smem);
    else {
      run_p(P, X, (ph - 1) / 14, (ph - 1) % 14, smem);
      if (PROBE_P >= 0 && (ph - 1) % 14 == PROBE_P) {
#pragma unroll 1
        for (int rep = 0; rep < PROBE_N; ++rep) { xcd_barrier(xb); run_p(P, X, (ph - 1) / 14, PROBE_P, smem); }
      }
    }
    if (use_sync && ph + 1 < ph_hi) { if (ph == ph_lo) cg::this_grid().sync(); else xcd_barrier(xb); }
  }
}

#else
template <int PP>
__global__ void __launch_bounds__(256) phase_kernel(Params P, int layer) {
  extern __shared__ __attribute__((aligned(16))) char smem[];
  const Cx X{P.ws, P.out, (int)threadIdx.x};
  run_p(P, X, layer, PP, smem);
}
#endif

extern "C" void kernel_launch(void* const* d_in, const int* in_sizes, int n_in, void* d_out, int out_size, void* d_ws,
                              size_t ws_size, hipStream_t stream) {
  static int grid = 0;
  if (grid == 0) {
    if (n_in != 33 || ws_size < OFF_END) { fprintf(stderr, "kernel_launch: unexpected n_in %d / ws_size %zu (need %zu)\n", n_in, ws_size, (size_t)OFF_END); grid = -1; return; }
    int dev = 0, cus = 0, per_cu = 0;
    hipGetDevice(&dev);
    hipDeviceGetAttribute(&cus, hipDeviceAttributeMultiprocessorCount, dev);
#if SINGLE
    hipFuncSetAttribute((const void*)fwd_kernel, hipFuncAttributeMaxDynamicSharedMemorySize, LDS_BYTES);
    hipOccupancyMaxActiveBlocksPerMultiprocessor(&per_cu, (const void*)fwd_kernel, 256, LDS_BYTES);
#else
#define SA(pp) hipFuncSetAttribute((const void*)phase_kernel<pp>, hipFuncAttributeMaxDynamicSharedMemorySize, LDS_BYTES)
    SA(-1); SA(0); SA(1); SA(2); SA(3); SA(4); SA(5); SA(6); SA(7); SA(8); SA(9); SA(10); SA(11); SA(12); SA(13);
    per_cu = 2;
#endif
    if (per_cu < 1) { fprintf(stderr, "kernel_launch: occupancy query returned %d\n", per_cu); grid = -1; return; }
    if (per_cu > 2) per_cu = 2;
    grid = cus * per_cu;
  }
  if (grid < 0) return;
  if (hipMemsetAsync((char*)d_ws + OFF_BAR, 0, 32768, stream) != hipSuccess) { fprintf(stderr, "kernel_launch: memset failed\n"); return; }
  Params P{};
  for (int i = 0; i < 33; ++i) P.in[i] = (const float*)d_in[i];
  P.out = (float*)d_out;
  P.ws = (char*)d_ws;
#if SINGLE
  int lo = 0, hi = NPH, us = 1;
  void* args[] = {&P, &lo, &hi, &us};
  hipError_t e = hipLaunchCooperativeKernel((const void*)fwd_kernel, dim3(grid), dim3(256), args, LDS_BYTES, stream);
  if (e != hipSuccess) fprintf(stderr, "cooperative launch failed: %s (grid %d)\n", hipGetErrorString(e), grid);
#else
#define LP(pp, ly) hipLaunchKernelGGL(phase_kernel<pp>, dim3(grid), dim3(256), LDS_BYTES, stream, P, ly)
  LP(-1, 0);
  for (int ly = 0; ly < 2; ++ly) {
    LP(0, ly); LP(1, ly); LP(2, ly); LP(3, ly); LP(4, ly); LP(5, ly); LP(6, ly); LP(7, ly); LP(8, ly); LP(9, ly); LP(10, ly); LP(11, ly); LP(12, ly); LP(13, ly);
  }
#endif
}
```

```cpp
#include <hip/hip_runtime.h>
#include <hip/hip_cooperative_groups.h>
#include <stdint.h>
#include <stdio.h>
namespace cg = cooperative_groups;

#ifndef SINGLE
#define SINGLE 1
#endif

#ifndef ONLYP
#define ONLYP -1
#endif
#define PON(x) (ONLYP < 0 || ONLYP == (x))

typedef unsigned short bf16_t;
typedef __attribute__((ext_vector_type(8))) short bf16x8;
typedef __attribute__((ext_vector_type(16))) float f32x16;
typedef __attribute__((ext_vector_type(4))) unsigned int u32x4;

#define NX 16384
#define NCX 1024
#define NTOK 17408
#define NPH 29
#ifndef PROBE_P
#define PROBE_P -1
#endif
#define PROBE_N 2
#define LDS_BYTES 77824

static constexpr size_t UU = 17825792ull;
static constexpr size_t OFF_HBUF = 0;
static constexpr size_t OFF_RKV = 2 * UU;
static constexpr size_t OFF_KK = 5 * UU;
static constexpr size_t OFF_ZR = 6 * UU;
static constexpr size_t OFF_LORA = 12 * UU + UU / 4;
static constexpr size_t OFF_LD = 6 * UU;
static constexpr size_t OFF_A = 8 * UU;
static constexpr size_t OFF_G = 10 * UU;
static constexpr size_t OFF_YF = 11 * UU;
static constexpr size_t OFF_YB = 12 * UU;
static constexpr size_t OFF_RWO = 5 * UU;
static constexpr size_t OFF_ZF = 2 * UU;
static constexpr size_t OFF_ZM = 3 * UU;
static constexpr size_t OFF_Q = 6 * UU;
static constexpr size_t OFF_K = 7 * UU + UU / 2;
static constexpr size_t OFF_VT = 9 * UU;
static constexpr size_t OFF_FFT1 = 10 * UU;
static constexpr size_t OFF_ATT = 12 * UU;
static constexpr size_t OFF_Y = 3 * UU;
static constexpr size_t OFF_M = 6 * UU;
static constexpr size_t OFF_ACT = 2 * UU;
static constexpr size_t OFF_WFFN = 9 * UU;
static constexpr size_t OFF_WMIX = 13 * UU;
static constexpr size_t WE_IN = 0;
static constexpr size_t WE_W2 = WE_IN + 6048ull * 1024;
static constexpr size_t WE_A2 = WE_W2 + 65536;
static constexpr size_t WE_G2 = WE_A2 + 65536;
static constexpr size_t WE_RO = WE_G2 + 65536;
static constexpr size_t WE_MO = WE_RO + 524288;
static constexpr size_t WE_FO = WE_MO + 524288;
static constexpr size_t WE_UQ = WE_FO + 1048576;
static constexpr size_t WE_UKV = WE_UQ + 294912;
static constexpr size_t WE_OUT = WE_UKV + 131072;
static constexpr size_t WE_END = WE_OUT + 1048576;
static constexpr size_t WF_IN = 0;
static constexpr size_t WF_OUT = 5632ull * 1024;
static constexpr size_t OFF_SMALL = OFF_WMIX + WE_END * 2;
static constexpr size_t OFF_CS = OFF_SMALL;
static constexpr size_t OFF_MOD = OFF_CS + 4194304;
static constexpr size_t OFF_TW = OFF_MOD + 245760;
static constexpr size_t OFF_F1 = OFF_TW + 32768;
static constexpr size_t OFF_F2 = OFF_F1 + 16384;
static constexpr size_t OFF_F256 = OFF_F2 + 32768;
static constexpr size_t OFF_ROPE = OFF_F256 + 262144;
static constexpr size_t OFF_BAR = OFF_ROPE + 524288;
static constexpr size_t OFF_TICK = OFF_BAR + 16384;
static constexpr size_t OFF_END = OFF_TICK + 16384;

struct Cx {
  char* ws;
  float* out;
  int tid;
};

struct Params {
  const float* in[33];
  float* out;
  char* ws;
};

__device__ __forceinline__ float bf2f(bf16_t v) { return __uint_as_float(((uint32_t)v) << 16); }
typedef __bf16 bf16v2_t __attribute__((ext_vector_type(2)));
typedef float f32v2_t __attribute__((ext_vector_type(2)));
__device__ __forceinline__ uint32_t pack2(float a, float b) {
  f32v2_t v; v[0] = a; v[1] = b;
  return __builtin_bit_cast(uint32_t, __builtin_convertvector(v, bf16v2_t));
}
__device__ __forceinline__ bf16_t f2bf(float f) { return (bf16_t)(pack2(f, 0.f) & 0xffffu); }
__device__ __forceinline__ float lo16(uint32_t u) { return __uint_as_float(u << 16); }
__device__ __forceinline__ float hi16(uint32_t u) { return __uint_as_float(u & 0xffff0000u); }
__device__ __forceinline__ float sigmoidf_(float v) { return 1.f / (1.f + __expf(-v)); }
__device__ __forceinline__ int mod_row(int row) { return row < NX ? (row >> 12) : 4; }

__device__ __forceinline__ Cx fresh(const Cx& X) {
  int t = X.tid;
  asm volatile("" : "+v"(t));
  return Cx{X.ws, X.out, t};
}

#define XB_TMO      128
#define XB_XCNT(j)  (256  + 64 * (j))
#define XB_XSUB(j)  (1280 + 64 * (j))
#define XB_XGEN(j)  (2304 + 64 * (j))
#define XB_TOP      3328
#define XB_TOPGEN   3392
#define XCD_BAR_WORDS 3456
#define XB_SPIN_CAP (1u << 18)
#define LAS __attribute__((address_space(3)))

__device__ __forceinline__ unsigned xb_ld(unsigned* p)              { return __hip_atomic_load(p, __ATOMIC_RELAXED, __HIP_MEMORY_SCOPE_AGENT); }
__device__ __forceinline__ unsigned xb_add(unsigned* p, unsigned v) { return __hip_atomic_fetch_add(p, v, __ATOMIC_RELAXED, __HIP_MEMORY_SCOPE_AGENT); }
__device__ __forceinline__ unsigned xb_xcc_id() { return (unsigned)__builtin_amdgcn_s_getreg((3 << 11) | 20) & 0xFu; }
#define XB_SPIN(cond, bar) do { unsigned _sp = 0; while (cond) { __builtin_amdgcn_s_sleep(1); \
    if ((++_sp & 255u) == 0u) { if (xb_ld(&(bar)[XB_TMO])) break; if (_sp > XB_SPIN_CAP) { atomicAdd(&(bar)[XB_TMO], 1u); break; } } } } while (0)

struct XcdBarrier {
    unsigned* bar; unsigned x;
    volatile LAS unsigned* st;
};

__device__ __forceinline__ XcdBarrier xcd_barrier_post(unsigned* bar, volatile LAS unsigned* st) {
    XcdBarrier b; b.bar = bar; b.x = xb_xcc_id(); b.st = st;
    if (threadIdx.x == 0) (void)xb_add(&bar[XB_XCNT(b.x)], 1u);
    return b;
}
__device__ __forceinline__ void xcd_barrier_complete(unsigned* bar, unsigned x, unsigned& nloc, unsigned& nx) {
    const unsigned G = gridDim.x * gridDim.y * gridDim.z;
    unsigned sum, cnt, mine, sp = 0u;
    for (;;) {
        sum = 0u; cnt = 0u; mine = 0u;
#pragma unroll
        for (unsigned j = 0; j < 16; ++j) { const unsigned c = xb_ld(&bar[XB_XCNT(j)]); sum += c; cnt += (c > 0u) ? 1u : 0u; mine = (j == x) ? c : mine; }
        if (sum == G) break;
        __builtin_amdgcn_s_sleep(1);
        if ((++sp & 255u) == 0u) { if (xb_ld(&bar[XB_TMO])) break; if (sp > XB_SPIN_CAP) { atomicAdd(&bar[XB_TMO], 1u); break; } }
    }
    nloc = mine > 0u ? mine : 1u; nx = cnt > 0u ? cnt : 1u;
}

__device__ __forceinline__ void xcd_barrier(const XcdBarrier& b) {
    asm volatile("s_waitcnt vmcnt(0)" ::: "memory");
    __syncthreads();
    if (threadIdx.x == 0) {
        unsigned* bar = b.bar;
        __builtin_amdgcn_s_waitcnt(0);
        unsigned nloc = b.st[0], nx = b.st[1];
        if (nloc == 0u) { xcd_barrier_complete(bar, b.x, nloc, nx); b.st[0] = nloc; b.st[1] = nx; }
        const unsigned old = xb_add(&bar[XB_XSUB(b.x)], 1u);
        const unsigned gen = old / nloc;
        if (old + 1u == (gen + 1u) * nloc) {
            __builtin_amdgcn_fence(__ATOMIC_RELEASE, "agent");
            asm volatile("s_waitcnt vmcnt(0)" ::: "memory");
            const unsigned og = xb_add(&bar[XB_TOP], 1u);
            const unsigned tg = og / nx;
            if (og + 1u == (tg + 1u) * nx) xb_add(&bar[XB_TOPGEN], 1u);
            else XB_SPIN(xb_ld(&bar[XB_TOPGEN]) == tg, bar);
            __builtin_amdgcn_fence(__ATOMIC_ACQUIRE, "agent");
            xb_add(&bar[XB_XGEN(b.x)], 1u);
            asm volatile("s_waitcnt vmcnt(0)" ::: "memory");
        } else {
            XB_SPIN(xb_ld(&bar[XB_XGEN(b.x)]) == gen, bar);
            __builtin_amdgcn_fence(__ATOMIC_ACQUIRE, "agent");
            asm volatile("s_waitcnt vmcnt(0)" ::: "memory");
        }
    }
    __syncthreads();
}


template <int BM, int BN, int WGM, int WGN, bool TRB>
struct Gemm {
  static constexpr int WM = BM / WGM, WN = BN / WGN, MT = WM / 32, NTL = WN / 32;
  static constexpr int CA = BM * 8 / 256, CB = BN * 8 / 256;
  static constexpr int SA_ELEMS = BM * 72, SB_ELEMS = BN * 72;

  __device__ static __forceinline__ void zero(f32x16 (&acc)[MT][NTL]) {
#pragma unroll
    for (int i = 0; i < MT; ++i)
#pragma unroll
      for (int j = 0; j < NTL; ++j)
#pragma unroll
        for (int r = 0; r < 16; ++r) acc[i][j][r] = 0.f;
  }

  __device__ static __forceinline__ void run(const Cx& X, const bf16_t* __restrict__ A, int lda, const bf16_t* __restrict__ B, int ldb,
                                             int K, char* smem, f32x16 (&acc)[MT][NTL]) {
    const int tid = X.tid, lane = tid & 63, w = tid >> 6;
    const int wm = w / WGN, wn = w % WGN;
    bf16_t* sA = (bf16_t*)smem;
    bf16_t* sB = sA + 2 * SA_ELEMS;
    uint4 ra0, ra1, ra2, ra3, rb0, rb1, rb2 = make_uint4(0, 0, 0, 0), rb3 = make_uint4(0, 0, 0, 0);
    uint4 qa0, qa1, qa2, qa3, qb0, qb1, qb2 = make_uint4(0, 0, 0, 0), qb3 = make_uint4(0, 0, 0, 0);
    static_assert(CA == 4 && CB >= 2 && CB <= 4, "tile loader shape");
    const int nk = K >> 6;
#define LDA_(i, k0) (*(const uint4*)(A + (size_t)((tid + 256 * (i)) >> 3) * lda + (k0) + ((tid + 256 * (i)) & 7) * 8))
#define LDB_(i, k0)                                                                                                        \
  (!TRB ? *(const uint4*)(B + (size_t)((tid + 256 * (i)) >> 3) * ldb + (k0) + ((tid + 256 * (i)) & 7) * 8)                 \
        : *(const uint4*)(B + (size_t)((k0) + (tid + 256 * (i)) / (BN / 8)) * ldb + ((tid + 256 * (i)) % (BN / 8)) * 8))
#define GLOAD(R, k0)                                                                           \
  {                                                                                            \
    R##a0 = LDA_(0, k0); R##a1 = LDA_(1, k0); R##a2 = LDA_(2, k0); R##a3 = LDA_(3, k0);        \
    R##b0 = LDB_(0, k0); R##b1 = LDB_(1, k0);                                                  \
    if (CB > 2) R##b2 = LDB_(2, k0);                                                           \
    if (CB > 3) R##b3 = LDB_(3, k0);                                                           \
  }
#define STA_(i, buf, v) *(uint4*)(sA + (buf)*SA_ELEMS + ((tid + 256 * (i)) >> 3) * 72 + ((tid + 256 * (i)) & 7) * 8) = v
#define STB_(i, buf, v)                                                                                       \
  {                                                                                                           \
    const int c_ = tid + 256 * (i);                                                                           \
    if (!TRB) *(uint4*)(sB + (buf)*SB_ELEMS + (c_ >> 3) * 72 + (c_ & 7) * 8) = v;                             \
    else {                                                                                                    \
      bf16_t* p = sB + (buf)*SB_ELEMS + (c_ % (BN / 8)) * 8 * 72 + c_ / (BN / 8);                             \
      p[0] = (bf16_t)(v.x & 0xffff); p[72] = (bf16_t)(v.x >> 16);                                             \
      p[144] = (bf16_t)(v.y & 0xffff); p[216] = (bf16_t)(v.y >> 16);                                          \
      p[288] = (bf16_t)(v.z & 0xffff); p[360] = (bf16_t)(v.z >> 16);                                          \
      p[432] = (bf16_t)(v.w & 0xffff); p[504] = (bf16_t)(v.w >> 16);                                          \
    }                                                                                                         \
  }
#define SSTORE(R, buf)                                                                         \
  {                                                                                            \
    STA_(0, buf, R##a0); STA_(1, buf, R##a1); STA_(2, buf, R##a2); STA_(3, buf, R##a3);        \
    STB_(0, buf, R##b0); STB_(1, buf, R##b1);                                                  \
    if (CB > 2) STB_(2, buf, R##b2);                                                           \
    if (CB > 3) STB_(3, buf, R##b3);                                                           \
  }
#define COMPUTE(buf)                                                                                               \
  {                                                                                                                \
    const bf16_t* pa = sA + (buf)*SA_ELEMS + (wm * WM + (lane & 31)) * 72 + (lane >> 5) * 8;                       \
    const bf16_t* pb = sB + (buf)*SB_ELEMS + (wn * WN + (lane & 31)) * 72 + (lane >> 5) * 8;                       \
    _Pragma("unroll") for (int ks = 0; ks < 4; ++ks) {                                                             \
      bf16x8 af[MT], bfr[NTL];                                                                                     \
      _Pragma("unroll") for (int i = 0; i < MT; ++i) af[i] = *(const bf16x8*)(pa + i * 32 * 72 + ks * 16);         \
      _Pragma("unroll") for (int j = 0; j < NTL; ++j) bfr[j] = *(const bf16x8*)(pb + j * 32 * 72 + ks * 16);       \
      _Pragma("unroll") for (int i = 0; i < MT; ++i)                                                               \
        _Pragma("unroll") for (int j = 0; j < NTL; ++j)                                                            \
          acc[i][j] = __builtin_amdgcn_mfma_f32_32x32x16_bf16(af[i], bfr[j], acc[i][j], 0, 0, 0);                  \
    }                                                                                                              \
  }
    if (!TRB) {
      bf16_t* dA = sA;
      bf16_t* dB = sA + 2 * BM * 64;
#define DSTAGE(buf, k0)                                                                                              \
  {                                                                                                                  \
    _Pragma("unroll") for (int i = 0; i < CA; ++i) {                                                                 \
      const int p = tid + 256 * i, r = p >> 3, c = (p & 7) ^ ((r >> 1) & 7);                                         \
      __builtin_amdgcn_global_load_lds((const unsigned*)(A + (size_t)r * lda + (k0) + c * 8),                        \
                                       (LAS unsigned*)(dA + (buf)*BM * 64 + p * 8), 16, 0, 0);                       \
    }                                                                                                                \
    _Pragma("unroll") for (int i = 0; i < CB; ++i) {                                                                 \
      const int p = tid + 256 * i, r = p >> 3, c = (p & 7) ^ ((r >> 1) & 7);                                         \
      __builtin_amdgcn_global_load_lds((const unsigned*)(B + (size_t)r * ldb + (k0) + c * 8),                        \
                                       (LAS unsigned*)(dB + (buf)*BN * 64 + p * 8), 16, 0, 0);                       \
    }                                                                                                                \
  }
      const int swz = (lane >> 1) & 7, hh = lane >> 5;
      DSTAGE(0, 0);
      asm volatile("s_waitcnt vmcnt(0)" ::: "memory");
      __syncthreads();
#pragma unroll 1
      for (int kt = 0; kt < nk; ++kt) {
        const int buf = kt & 1;
        if (kt + 1 < nk) DSTAGE(buf ^ 1, (kt + 1) * 64);
        const bf16_t* pa = dA + buf * BM * 64 + (wm * WM + (lane & 31)) * 64;
        const bf16_t* pb = dB + buf * BN * 64 + (wn * WN + (lane & 31)) * 64;
#pragma unroll
        for (int ks = 0; ks < 4; ++ks) {
          const int co = (((ks * 2 + hh) ^ swz) * 8);
          bf16x8 af[MT], bfr[NTL];
#pragma unroll
          for (int i = 0; i < MT; ++i) af[i] = *(const bf16x8*)(pa + i * 32 * 64 + co);
#pragma unroll
          for (int j = 0; j < NTL; ++j) bfr[j] = *(const bf16x8*)(pb + j * 32 * 64 + co);
#pragma unroll
          for (int i = 0; i < MT; ++i)
#pragma unroll
            for (int j = 0; j < NTL; ++j) acc[i][j] = __builtin_amdgcn_mfma_f32_32x32x16_bf16(af[i], bfr[j], acc[i][j], 0, 0, 0);
        }
        asm volatile("s_waitcnt vmcnt(0)" ::: "memory");
        __syncthreads();
      }
#undef DSTAGE
    } else {
    GLOAD(r, 0);
    if (nk > 1) GLOAD(q, 64);
    SSTORE(r, 0);
    __syncthreads();
    for (int kt = 0; kt < nk; kt += 2) {
      if (kt + 2 < nk) GLOAD(r, (kt + 2) * 64);
      COMPUTE(0);
      if (kt + 1 < nk) SSTORE(q, 1);
      __syncthreads();
      if (kt + 1 >= nk) break;
      if (kt + 3 < nk) GLOAD(q, (kt + 3) * 64);
      COMPUTE(1);
      if (kt + 2 < nk) SSTORE(r, 0);
      __syncthreads();
    }
    }
#undef COMPUTE
#undef GLOAD
#undef SSTORE
#undef LDA_
#undef LDB_
#undef STA_
#undef STB_
  }
};

typedef Gemm<128, 128, 2, 2, false> G22;
typedef Gemm<128, 128, 2, 2, true> G22T;
typedef Gemm<128, 64, 2, 2, false> GMG;
typedef Gemm<128, 96, 4, 1, false> GQ;
typedef Gemm<128, 128, 4, 1, false> GKV;

struct GemmW {
  static constexpr int MT = 2, NTL = 4;
  __device__ static __forceinline__ void zero(f32x16 (&acc)[MT][NTL]) {
#pragma unroll
    for (int i = 0; i < MT; ++i)
#pragma unroll
      for (int j = 0; j < NTL; ++j)
#pragma unroll
        for (int r = 0; r < 16; ++r) acc[i][j][r] = 0.f;
  }
  __device__ static __forceinline__ void run(const Cx& X, const bf16_t* __restrict__ A, int lda, const bf16_t* __restrict__ B, int ldb,
                                             int K, char* smem, f32x16 (&acc)[MT][NTL]) {
    const int tid = X.tid, lane = tid & 63, w = tid >> 6;
    const int wm = w >> 1, wn = w & 1;
    bf16_t* dA = (bf16_t*)smem;
    bf16_t* dB = dA + 2 * 128 * 32;
    const int nk = K >> 5;
#define WSTAGE(buf, k0)                                                                                              \
  {                                                                                                                  \
    _Pragma("unroll") for (int i = 0; i < 2; ++i) {                                                                  \
      const int p = tid + 256 * i, r = p >> 2, c = (p & 3) ^ ((r >> 2) & 3);                                         \
      __builtin_amdgcn_global_load_lds((const unsigned*)(A + (size_t)r * lda + (k0) + c * 8),                        \
                                       (LAS unsigned*)(dA + (buf)*128 * 32 + p * 8), 16, 0, 0);                      \
    }                                                                                                                \
    _Pragma("unroll") for (int i = 0; i < 4; ++i) {                                                                  \
      const int p = tid + 256 * i, r = p >> 2, c = (p & 3) ^ ((r >> 2) & 3);                                         \
      __builtin_amdgcn_global_load_lds((const unsigned*)(B + (size_t)r * ldb + (k0) + c * 8),                        \
                                       (LAS unsigned*)(dB + (buf)*256 * 32 + p * 8), 16, 0, 0);                      \
    }                                                                                                                \
  }
    const int swz = ((lane & 31) >> 2) & 3, hh = lane >> 5;
    WSTAGE(0, 0);
    asm volatile("s_waitcnt vmcnt(0)" ::: "memory");
    __syncthreads();
#pragma unroll 1
    for (int kt = 0; kt < nk; ++kt) {
      const int buf = kt & 1;
      if (kt + 1 < nk) WSTAGE(buf ^ 1, (kt + 1) * 32);
      const bf16_t* pa = dA + buf * 128 * 32 + (wm * 64 + (lane & 31)) * 32;
      const bf16_t* pb = dB + buf * 256 * 32 + (wn * 128 + (lane & 31)) * 32;
#pragma unroll
      for (int ks = 0; ks < 2; ++ks) {
        const int co = (((ks * 2 + hh) ^ swz) * 8);
        bf16x8 af[MT], bfr[NTL];
#pragma unroll
        for (int i = 0; i < MT; ++i) af[i] = *(const bf16x8*)(pa + i * 32 * 32 + co);
#pragma unroll
        for (int j = 0; j < NTL; ++j) bfr[j] = *(const bf16x8*)(pb + j * 32 * 32 + co);
#pragma unroll
        for (int i = 0; i < MT; ++i)
#pragma unroll
          for (int j = 0; j < NTL; ++j) acc[i][j] = __builtin_amdgcn_mfma_f32_32x32x16_bf16(af[i], bfr[j], acc[i][j], 0, 0, 0);
      }
      asm volatile("s_waitcnt vmcnt(0)" ::: "memory");
      __syncthreads();
    }
#undef WSTAGE
  }
};

#define ROW_OF(reg) (((reg) & 3) + 8 * ((reg) >> 2) + 4 * (lane >> 5))

__device__ __forceinline__ void job_mod(const Params& P, const Cx& X, char* smem, int job) {
  float* sc = (float*)smem;
  const int tid = X.tid;
  for (int i = tid; i < 5 * 1024; i += 256) {
    int r = i >> 10, k = i & 1023;
    float v = r < 4 ? P.in[1][r * 1024 + k] : P.in[3][k];
    sc[i] = v / (1.f + expf(-v));
  }
  __syncthreads();
  const int l = job / 96, n = (job % 96) * 64 + (tid & 63), w = tid >> 6;
  const float* W = P.in[4] + (size_t)l * 1024 * 6144;
  float a0 = 0, a1 = 0, a2 = 0, a3 = 0, a4 = 0;
#pragma unroll 16
  for (int k = w * 256; k < w * 256 + 256; ++k) {
    float wv = W[(size_t)k * 6144 + n];
    a0 += sc[k] * wv; a1 += sc[1024 + k] * wv; a2 += sc[2048 + k] * wv; a3 += sc[3072 + k] * wv; a4 += sc[4096 + k] * wv;
  }
  float* red = sc + 5 * 1024;
  red[(w * 5 + 0) * 64 + (tid & 63)] = a0; red[(w * 5 + 1) * 64 + (tid & 63)] = a1; red[(w * 5 + 2) * 64 + (tid & 63)] = a2;
  red[(w * 5 + 3) * 64 + (tid & 63)] = a3; red[(w * 5 + 4) * 64 + (tid & 63)] = a4;
  __syncthreads();
  float* modv = (float*)(X.ws + OFF_MOD);
  for (int i = tid; i < 320; i += 256) {
    int r = i >> 6, c = i & 63;
    int nn = (job % 96) * 64 + c;
    float s = red[(0 * 5 + r) * 64 + c] + red[(1 * 5 + r) * 64 + c] + red[(2 * 5 + r) * 64 + c] + red[(3 * 5 + r) * 64 + c];
    modv[(size_t)(l * 5 + r) * 6144 + nn] = s + P.in[5][l * 6144 + nn];
  }
  __syncthreads();
}

__device__ __forceinline__ void job_tables(const Params& P, const Cx& X, int job) {
  float2* tw = (float2*)(X.ws + OFF_TW);
  bf16_t* F1 = (bf16_t*)(X.ws + OFF_F1);
  bf16_t* F2 = (bf16_t*)(X.ws + OFF_F2);
  bf16_t* F256 = (bf16_t*)(X.ws + OFF_F256);
  float2* rope = (float2*)(X.ws + OFF_ROPE);
  for (int e = job * 4096 + X.tid; e < job * 4096 + 4096; e += 256) {
    int i = e;
    if (i < 4096) { tw[i] = make_float2(cospif(i / 2048.f), sinpif(i / 2048.f)); continue; }
    i -= 4096;
    if (i < 8192) {
      int R = i >> 6, t1 = i & 63;
      int f1 = (R >> 6) * 32 + (R & 31);
      int ph = (f1 * t1) & 63;
      F1[i] = f2bf(((R >> 5) & 1) ? -sinpif(ph / 32.f) : cospif(ph / 32.f));
      continue;
    }
    i -= 8192;
    if (i < 16384) {
      int m = i >> 7, k = i & 127;
      int f2 = m & 63, q = m >> 6, t2 = k & 63, p = k >> 6;
      int ph = (f2 * t2) & 63;
      float c = cospif(ph / 32.f), s = sinpif(ph / 32.f);
      float v = (q == 0) ? (p == 0 ? c : s) : (p == 0 ? -s : c);
      F2[i] = f2bf(v);
      continue;
    }
    i -= 16384;
    if (i < 131072) {
      int m = i >> 8, t = i & 255;
      int f = m & 255, q = m >> 8;
      int ph = (f * t) & 255;
      F256[i] = f2bf(q == 0 ? cospif(ph / 128.f) : -sinpif(ph / 128.f));
      continue;
    }
    i -= 131072;
    if (i < 65536) {
      int t = i >> 4, j = i & 15;
      float invf = powf(10000.f, -(float)(j & 7) / 8.f);
      float pos = (j < 8) ? (float)(t >> 6) : (float)(t & 63);
      float ang = pos * invf;
      rope[i] = make_float2(cosf(ang), sinf(ang));
    }
  }
}

__device__ __forceinline__ void cw_tile(const Cx& X, const float* __restrict__ src, int N, int lds_, bf16_t* __restrict__ dst, int ldd, const float* scale,
                        int perm, int tk, int tn, char* smem) {
  float* tile = (float*)smem;
  const int tid = X.tid;
  const int c = tid & 63, r0 = tid >> 6;
  const int ng = tn * 64 + c;
#pragma unroll 4
  for (int i = 0; i < 16; ++i) {
    int r = r0 + 4 * i;
    float v = (ng < N) ? src[(size_t)(tk * 64 + r) * lds_ + ng] : 0.f;
    if (scale) v *= scale[tk * 64 + r];
    tile[r * 65 + c] = v;
  }
  __syncthreads();
#pragma unroll 4
  for (int i = 0; i < 16; ++i) {
    int nn = r0 + 4 * i;
    int n2 = tn * 64 + nn;
    if (n2 < N) {
      int drow = n2;
      if (perm) {
        int u = n2 < 2816 ? n2 : n2 - 2816;
        drow = (u >> 5) * 64 + (n2 < 2816 ? 0 : 32) + (u & 31);
      }
      dst[(size_t)drow * ldd + tk * 64 + c] = f2bf(tile[c * 65 + nn]);
    }
  }
  __syncthreads();
}

__device__ __forceinline__ void fold_job(const Params& P, const Cx& X, int layer, int fj, char* smem) {
  float* wt = (float*)smem;
  float* ct = wt + 4096;
  const int tid = X.tid;
  const int g = fj >> 4, n0 = (fj & 15) * 64;
  const float* src = P.in[28] + (size_t)layer * 512 * 1024;
  for (int i = tid; i < 4096; i += 256) wt[i] = src[(size_t)(g * 64 + (i >> 6)) * 1024 + n0 + (i & 63)];
  if (tid < 64) { ct[tid] = cospif(tid / 32.f); ct[64 + tid] = sinpif(tid / 32.f); }
  __syncthreads();
  bf16_t* dst = (bf16_t*)(X.ws + OFF_WMIX) + WE_FO;
  const int c = tid & 63, nq = tid >> 6;
#pragma unroll 1
  for (int ni = 0; ni < 16; ++ni) {
    int n = nq * 16 + ni;
    float sr = 0.f, si = 0.f;
#pragma unroll 4
    for (int cp = 0; cp < 64; ++cp) {
      float wv = wt[cp * 64 + n];
      int ph = (c * cp) & 63;
      sr += ct[ph] * wv;
      si += ct[64 + ph] * wv;
    }
    dst[(size_t)(n0 + n) * 1024 + g * 64 + c] = f2bf(sr * (1.f / 512.f));
    dst[(size_t)(n0 + n) * 1024 + 512 + g * 64 + c] = f2bf(si * (1.f / 512.f));
  }
  __syncthreads();
}

#define NCW1 2312
__device__ __forceinline__ void cw_mixer_job(const Params& P, const Cx& X, int layer, int j, char* smem) {
  bf16_t* W = (bf16_t*)(X.ws + OFF_WMIX);
  const float* src; const float* scale = nullptr; bf16_t* dst; int N, ldd, tk, tn;
  if (j >= 2184) { fold_job(P, X, layer, j - 2184, smem); return; }
  if (j < 1520) { src = P.in[7] + (size_t)layer * 1024 * 6048; N = 6048; dst = W + WE_IN; ldd = 1024; tk = j / 95; tn = j % 95; }
  else if (j < 1536) { j -= 1520; int d = j >> 3; src = P.in[11] + (size_t)(layer * 2 + d) * 64 * 512; N = 512; dst = W + WE_W2 + d * 32768; ldd = 64; tk = 0; tn = j & 7; }
  else if (j < 1552) { j -= 1536; int d = j >> 3; src = P.in[13] + (size_t)(layer * 2 + d) * 64 * 512; N = 512; dst = W + WE_A2 + d * 32768; ldd = 64; tk = 0; tn = j & 7; }
  else if (j < 1568) { j -= 1552; src = P.in[17] + (size_t)layer * 128 * 512; N = 512; dst = W + WE_G2; ldd = 128; tk = j >> 3; tn = j & 7; }
  else if (j < 1696) { j -= 1568; src = P.in[20] + (size_t)layer * 512 * 1024; N = 1024; dst = W + WE_RO; ldd = 512; tk = j >> 4; tn = j & 15; }
  else if (j < 1824) { j -= 1696; src = P.in[27] + (size_t)layer * 512 * 1024; N = 1024; dst = W + WE_MO; ldd = 512; tk = j >> 4; tn = j & 15; }
  else if (j < 1896) { j -= 1824; src = P.in[23] + (size_t)layer * 384 * 768; N = 768; dst = W + WE_UQ; ldd = 384; scale = P.in[21] + layer * 384; tk = j / 12; tn = j % 12; }
  else if (j < 1928) { j -= 1896; src = P.in[24] + (size_t)layer * 128 * 1024; N = 1024; dst = W + WE_UKV; ldd = 128; scale = P.in[22] + layer * 128; tk = j >> 4; tn = j & 15; }
  else { j -= 1928; src = P.in[29] + (size_t)layer * 1024 * 1024; N = 1024; dst = W + WE_OUT; ldd = 1024; tk = j >> 4; tn = j & 15; }
  cw_tile(X, src, N, N, dst, ldd, scale, 0, tk, tn, smem);
}
#define NCW2 2112
__device__ __forceinline__ void cw_ffn_job(const Params& P, const Cx& X, int layer, int j, char* smem) {
  bf16_t* W = (bf16_t*)(X.ws + OFF_WFFN);
  const float* src; bf16_t* dst; int N, ldd, tk, tn, perm;
  if (j < 1408) { src = P.in[31] + (size_t)layer * 1024 * 5632; N = 5632; dst = W + WF_IN; ldd = 1024; perm = 1; tk = j / 88; tn = j % 88; }
  else { j -= 1408; src = P.in[32] + (size_t)layer * 2816 * 1024; N = 1024; dst = W + WF_OUT; ldd = 2816; perm = 0; tk = j >> 4; tn = j & 15; }
  cw_tile(X, src, N, N, dst, ldd, nullptr, perm, tk, tn, smem);
}

__device__ __forceinline__ void norm_job(const Params& P, const Cx& X, int layer, int which, int job) {
  const int lane = X.tid & 63, w = X.tid >> 6;
  const int row = job * 4 + w;
  const float* src;
  if (which == 0) {
    if (row < NX) src = (layer == 0 ? P.in[0] : X.out) + (size_t)row * 1024;
    else src = (layer == 0 ? P.in[2] : (const float*)(X.ws + OFF_CS)) + (size_t)(row - NX) * 1024;
  } else {
    if (row < NX) src = X.out + (size_t)row * 1024;
    else src = (const float*)(X.ws + OFF_CS) + (size_t)(row - NX) * 1024;
  }
  const float* g = (which == 0 ? P.in[6] : P.in[30]) + layer * 1024;
  const float* modv = (const float*)(X.ws + OFF_MOD) + (size_t)(layer * 5 + mod_row(row)) * 6144;
  const float* shift = modv + (which == 0 ? 0 : 3072);
  const float* scale = modv + (which == 0 ? 1024 : 4096);
  float4 v[4];
  float ss = 0.f;
#pragma unroll
  for (int i = 0; i < 4; ++i) {
    v[i] = ((const float4*)src)[lane + 64 * i];
    ss += v[i].x * v[i].x + v[i].y * v[i].y + v[i].z * v[i].z + v[i].w * v[i].w;
  }
#pragma unroll
  for (int o = 32; o >= 1; o >>= 1) ss += __shfl_xor(ss, o);
  const float rstd = rsqrtf(ss * (1.f / 1024.f) + 1e-6f);
  bf16_t* dst = (bf16_t*)(X.ws + OFF_HBUF) + (size_t)row * 1024;
#pragma unroll
  for (int i = 0; i < 4; ++i) {
    int col = 4 * (lane + 64 * i);
    float4 gg = *(const float4*)(g + col), sh = *(const float4*)(shift + col), sc = *(const float4*)(scale + col);
    float y0 = v[i].x * rstd * gg.x * (1.f + sc.x) + sh.x;
    float y1 = v[i].y * rstd * gg.y * (1.f + sc.y) + sh.y;
    float y2 = v[i].z * rstd * gg.z * (1.f + sc.z) + sh.z;
    float y3 = v[i].w * rstd * gg.w * (1.f + sc.w) + sh.w;
    uint2 o;
    o.x = pack2(y0, y1); o.y = pack2(y2, y3);
    *(uint2*)(dst + col) = o;
  }
}

__device__ __forceinline__ void g1a_tile(const Params& P, const Cx& X, int t, char* smem) {
  const int lane = X.tid & 63, w = X.tid >> 6;
  const int mt = t % 136, nt = t / 136;
  const int m0 = mt * 128, n0 = nt * 128;
  f32x16 acc[2][2];
  G22::zero(acc);
  G22::run(X, (const bf16_t*)(X.ws + OFF_HBUF) + (size_t)m0 * 1024, 1024, (const bf16_t*)(X.ws + OFF_WMIX) + WE_IN + (size_t)n0 * 1024, 1024, 1024, smem, acc);
  bf16_t* zr = (bf16_t*)(X.ws + OFF_ZR);
  const int row0 = m0 + (w >> 1) * 64, col0 = n0 + (w & 1) * 64;
#pragma unroll
  for (int i = 0; i < 2; ++i)
#pragma unroll
    for (int j = 0; j < 2; ++j)
#pragma unroll
      for (int r = 0; r < 16; ++r) {
        int row = row0 + i * 32 + ROW_OF(r), col = col0 + j * 32 + (lane & 31);
        zr[(size_t)row * 1920 + col] = f2bf(acc[i][j][r]);
      }
}
__device__ __forceinline__ void g1b_tile(const Params& P, const Cx& X, int t, char* smem) {
  const int lane = X.tid & 63, w = X.tid >> 6;
  const int mt = t % 136, nt = t / 136;
  const int m0 = mt * 128, n0 = nt * 128;
  f32x16 acc[2][2];
  G22::zero(acc);
  G22::run(X, (const bf16_t*)(X.ws + OFF_HBUF) + (size_t)m0 * 1024, 1024, (const bf16_t*)(X.ws + OFF_WMIX) + WE_IN + (size_t)(1920 + n0) * 1024, 1024, 1024, smem, acc);
  bf16_t* zm = (bf16_t*)(X.ws + OFF_ZM);
  bf16_t* zf = (bf16_t*)(X.ws + OFF_ZF);
  const int row0 = m0 + (w >> 1) * 64, col0 = n0 + (w & 1) * 64;
#pragma unroll
  for (int i = 0; i < 2; ++i)
#pragma unroll
    for (int j = 0; j < 2; ++j)
#pragma unroll
      for (int r = 0; r < 16; ++r) {
        int row = row0 + i * 32 + ROW_OF(r), col = col0 + j * 32 + (lane & 31);
        bf16_t v = f2bf(acc[i][j][r]);
        if (col < 544) zm[(size_t)row * 544 + col] = v;
        else if (col < 1056) zf[(size_t)row * 512 + (col - 544)] = v;
      }
}

__device__ __forceinline__ void r1a_job(const Params& P, const Cx& X, int layer, int job) {
  const int tid = X.tid;
  const int ch = tid < 240 ? tid : 239;
  const int col0 = ch * 8;
  const bf16_t* zr = (const bf16_t*)(X.ws + OFF_ZR);
  const int rowb = job * 8;
  int pos, len;
  if (rowb < NX) { pos = rowb & 4095; len = 4096; } else { pos = (rowb - NX) & 255; len = 256; }
  const bool isk = (col0 >= 512 && col0 < 1024);
  float mup[8], mun[8], kkw[8];
  {
    const float4 a0 = *(const float4*)(P.in[8] + layer * 1920 + col0), a1 = *(const float4*)(P.in[8] + layer * 1920 + col0 + 4);
    const float4 b0 = *(const float4*)(P.in[9] + layer * 1920 + col0), b1 = *(const float4*)(P.in[9] + layer * 1920 + col0 + 4);
    const float* kp = P.in[14] + layer * 512 + (isk ? col0 - 512 : 0);
    const float4 c0 = *(const float4*)kp, c1 = *(const float4*)(kp + 4);
    mup[0] = a0.x; mup[1] = a0.y; mup[2] = a0.z; mup[3] = a0.w; mup[4] = a1.x; mup[5] = a1.y; mup[6] = a1.z; mup[7] = a1.w;
    mun[0] = b0.x; mun[1] = b0.y; mun[2] = b0.z; mun[3] = b0.w; mun[4] = b1.x; mun[5] = b1.y; mun[6] = b1.z; mun[7] = b1.w;
    kkw[0] = c0.x; kkw[1] = c0.y; kkw[2] = c0.z; kkw[3] = c0.w; kkw[4] = c1.x; kkw[5] = c1.y; kkw[6] = c1.z; kkw[7] = c1.w;
  }
  uint4 zw[10];
#pragma unroll
  for (int i = 0; i < 10; ++i) {
    const int pp = pos - 1 + i;
    zw[i] = make_uint4(0, 0, 0, 0);
    if (pp >= 0 && pp < len) zw[i] = *(const uint4*)(zr + (size_t)(rowb - 1 + i) * 1920 + col0);
  }
#pragma unroll
  for (int i8 = 0; i8 < 8; ++i8) {
    const int row = rowb + i8;
    const uint4 zp = zw[i8], zc = zw[i8 + 1], zn = zw[i8 + 2];
    float zs[8];
    {
      const uint32_t c4[4] = {zc.x, zc.y, zc.z, zc.w}, p4[4] = {zp.x, zp.y, zp.z, zp.w}, n4[4] = {zn.x, zn.y, zn.z, zn.w};
#pragma unroll
      for (int i = 0; i < 4; ++i) {
        float c0 = lo16(c4[i]), c1 = hi16(c4[i]);
        zs[2 * i] = c0 + (lo16(p4[i]) - c0) * mup[2 * i] + (lo16(n4[i]) - c0) * mun[2 * i];
        zs[2 * i + 1] = c1 + (hi16(p4[i]) - c1) * mup[2 * i + 1] + (hi16(n4[i]) - c1) * mun[2 * i + 1];
      }
    }
    float ss = 0.f;
    float kv[8];
#pragma unroll
    for (int i = 0; i < 8; ++i) { kv[i] = zs[i] * kkw[i]; ss += kv[i] * kv[i]; }
    ss += __shfl_xor(ss, 1); ss += __shfl_xor(ss, 2); ss += __shfl_xor(ss, 4);
    if (tid < 240) {
      uint4 o;
      if (col0 < 1536) {
        o.x = pack2(zs[0], zs[1]); o.y = pack2(zs[2], zs[3]); o.z = pack2(zs[4], zs[5]); o.w = pack2(zs[6], zs[7]);
        *(uint4*)((bf16_t*)(X.ws + OFF_RKV) + (size_t)row * 1536 + col0) = o;
        if (isk) {
          float inv = 1.f / fmaxf(sqrtf(ss), 1e-12f);
          o.x = pack2(kv[0] * inv, kv[1] * inv); o.y = pack2(kv[2] * inv, kv[3] * inv);
          o.z = pack2(kv[4] * inv, kv[5] * inv); o.w = pack2(kv[6] * inv, kv[7] * inv);
          *(uint4*)((bf16_t*)(X.ws + OFF_KK) + (size_t)row * 512 + (col0 - 512)) = o;
        }
      } else {
        float t[8];
        if (col0 < 1664) {
#pragma unroll
          for (int i = 0; i < 8; ++i) t[i] = 1.f - 2.f / (1.f + __expf(2.f * zs[i]));
        } else if (col0 < 1792) {
#pragma unroll
          for (int i = 0; i < 8; ++i) t[i] = zs[i];
        } else {
#pragma unroll
          for (int i = 0; i < 8; ++i) t[i] = 1.f / (1.f + __expf(-zs[i]));
        }
        o.x = pack2(t[0], t[1]); o.y = pack2(t[2], t[3]); o.z = pack2(t[4], t[5]); o.w = pack2(t[6], t[7]);
        *(uint4*)((bf16_t*)(X.ws + OFF_LORA) + (size_t)row * 384 + (col0 - 1536)) = o;
      }
    }
  }
}

__device__ __forceinline__ void r1b_tile(const Params& P, const Cx& X, int layer, int t, char* smem) {
  const int lane = X.tid & 63, w = X.tid >> 6;
  const int mt = t % 136, rest = t / 136;
  const int nt = rest & 3, type = rest >> 2;
  const int m0 = mt * 128, n0 = nt * 128;
  const bf16_t* lora = (const bf16_t*)(X.ws + OFF_LORA) + (size_t)m0 * 384;
  const bf16_t* W = (const bf16_t*)(X.ws + OFF_WMIX);
  f32x16 acc[2][2];
  G22::zero(acc);
  if (type < 2) G22::run(X, lora + type * 64, 384, W + WE_W2 + type * 32768 + (size_t)n0 * 64, 64, 64, smem, acc);
  else if (type < 4) G22::run(X, lora + 128 + (type - 2) * 64, 384, W + WE_A2 + (type - 2) * 32768 + (size_t)n0 * 64, 64, 64, smem, acc);
  else G22::run(X, lora + 256, 384, W + WE_G2 + (size_t)n0 * 128, 128, 128, smem, acc);
  const int row0 = m0 + (w >> 1) * 64, col0 = n0 + (w & 1) * 64;
  bf16_t* ld = (bf16_t*)(X.ws + OFF_LD);
  bf16_t* ab = (bf16_t*)(X.ws + OFF_A);
  bf16_t* gb = (bf16_t*)(X.ws + OFF_G);
#pragma unroll
  for (int j = 0; j < 2; ++j) {
    const int col = col0 + j * 32 + (lane & 31);
    float bias = 0.f;
    if (type < 2) bias = P.in[10][(layer * 2 + type) * 512 + col];
    else if (type < 4) bias = P.in[12][(layer * 2 + type - 2) * 512 + col];
#pragma unroll
    for (int i = 0; i < 2; ++i)
#pragma unroll
      for (int r = 0; r < 16; ++r) {
        int row = row0 + i * 32 + ROW_OF(r);
        float v = acc[i][j][r] + bias;
        if (type < 2) ld[(size_t)row * 1024 + type * 512 + col] = f2bf(-0.60653066f / (1.f + __expf(-v)));
        else if (type < 4) ab[(size_t)row * 1024 + (type - 2) * 512 + col] = f2bf(1.f / (1.f + __expf(-v)));
        else gb[(size_t)row * 512 + col] = f2bf(v);
      }
  }
}

template <int CTRL>
__device__ __forceinline__ float dpp_f(float x) {
  return __int_as_float(__builtin_amdgcn_update_dpp(0, __float_as_int(x), CTRL, 0xf, 0xf, false));
}
__device__ __forceinline__ float red16(float x) {
  x += dpp_f<0x128>(x);
  x += dpp_f<0x124>(x);
  x += dpp_f<0x4E>(x);
  x += dpp_f<0xB1>(x);
  return x;
}
__device__ __forceinline__ int scan_tokrow(int b, int dir, int i) {
  if (i < 256) return NX + b * 256 + (dir ? 255 - i : i);
  int t = i - 256;
  return b * 4096 + (dir ? 4095 - t : t);
}
typedef float f2_t __attribute__((ext_vector_type(2)));
__device__ __forceinline__ void scan_job(const Params& P, const Cx& X, int layer, int bj, char* smem) {
  const int tid = X.tid, lane = tid & 63, w = tid >> 6;
  const int s = bj >> 2, rq = bj & 3;
  const int dir = s >> 5, b = (s & 31) >> 3, h = s & 7;
  float* sv = (float*)smem;
  float* sy = sv + 2 * 16 * 6 * 64;
  const bf16_t* rkv = (const bf16_t*)(X.ws + OFF_RKV);
  const bf16_t* kkb = (const bf16_t*)(X.ws + OFF_KK);
  const bf16_t* ab = (const bf16_t*)(X.ws + OFF_A);
  const bf16_t* ldb = (const bf16_t*)(X.ws + OFF_LD);
  bf16_t* yout = (bf16_t*)(X.ws + (dir ? OFF_YB : OFF_YF));
  const int lst = tid >> 4, lch = (tid & 15) * 4;
  const float4 ka4 = *(const float4*)(P.in[15] + layer * 512 + h * 64 + lch);
  uint2 pr, pk, pv, pkk, pa, pl;
#define SLOAD(chunk)                                                          \
  {                                                                           \
    int row = scan_tokrow(b, dir, (chunk)*16 + lst);                          \
    const bf16_t* p0 = rkv + (size_t)row * 1536 + h * 64 + lch;               \
    pr = *(const uint2*)p0; pk = *(const uint2*)(p0 + 512); pv = *(const uint2*)(p0 + 1024); \
    pkk = *(const uint2*)(kkb + (size_t)row * 512 + h * 64 + lch);            \
    pa = *(const uint2*)(ab + (size_t)row * 1024 + dir * 512 + h * 64 + lch); \
    pl = *(const uint2*)(ldb + (size_t)row * 1024 + dir * 512 + h * 64 + lch);\
  }
#define SSTORE2(buf)                                                          \
  {                                                                           \
    float* d = sv + ((buf)*16 + lst) * 384 + lch;                             \
    float a0 = lo16(pa.x), a1 = hi16(pa.x), a2 = lo16(pa.y), a3 = hi16(pa.y); \
    float k0 = lo16(pk.x), k1 = hi16(pk.x), k2 = lo16(pk.y), k3 = hi16(pk.y); \
    float q0 = lo16(pkk.x), q1 = hi16(pkk.x), q2 = lo16(pkk.y), q3 = hi16(pkk.y); \
    *(float4*)(d) = make_float4(q0, q1, q2, q3);                              \
    *(float4*)(d + 64) = make_float4(__expf(lo16(pl.x)), __expf(hi16(pl.x)), __expf(lo16(pl.y)), __expf(hi16(pl.y))); \
    *(float4*)(d + 128) = make_float4(q0 * a0, q1 * a1, q2 * a2, q3 * a3);    \
    *(float4*)(d + 192) = make_float4(k0 * (1.f + (a0 - 1.f) * ka4.x), k1 * (1.f + (a1 - 1.f) * ka4.y), k2 * (1.f + (a2 - 1.f) * ka4.z), k3 * (1.f + (a3 - 1.f) * ka4.w)); \
    *(float4*)(d + 256) = make_float4(lo16(pr.x), hi16(pr.x), lo16(pr.y), hi16(pr.y)); \
    *(float4*)(d + 320) = make_float4(lo16(pv.x), hi16(pv.x), lo16(pv.y), hi16(pv.y)); \
  }
  SLOAD(0);
  SSTORE2(0);
  __syncthreads();
  const int rp = lane >> 4, ci = (lane & 15) * 4;
  const int vrow = rq * 16 + w * 4 + rp;
  float S0 = 0.f, S1 = 0.f, S2 = 0.f, S3 = 0.f, qy = 0.f;
  for (int chunk = 0; chunk < 272; ++chunk) {
    const int buf = chunk & 1;
    SLOAD(chunk + 1 < 272 ? chunk + 1 : 271);
    __builtin_amdgcn_sched_barrier(0);
    {
      const float* base = sv + buf * 16 * 384;
      float ysel = 0.f;
      qy = 0.f;
      float4 p0kk, p0w, p0b, p0kd, p0r, p1kk, p1w, p1b, p1kd, p1r;
      float p0v, p1v;
#define LDS_SET(S, st)                                     \
  {                                                        \
    const float* d = base + (st)*384;                      \
    S##kk = *(const float4*)(d + ci);                      \
    S##w = *(const float4*)(d + 64 + ci);                  \
    S##b = *(const float4*)(d + 128 + ci);                 \
    S##kd = *(const float4*)(d + 192 + ci);                \
    S##r = *(const float4*)(d + 256 + ci);                 \
    S##v = d[320 + vrow];                                  \
  }
#define DPPS "row_mask:0xf bank_mask:0xf bound_ctrl:1\n"
#define STEP(S, st)                                                                                   \
  {                                                                                                   \
    float t0, t1, u0, u1, u2, u3;                                                                     \
    asm volatile(                                                                                     \
        "v_mul_f32 %5, %0, %11\n"                                                                     \
        "v_mul_f32 %6, %1, %12\n"                                                                     \
        "v_fma_f32 %5, %2, %13, %5\n"                                                                 \
        "v_fma_f32 %6, %3, %14, %6\n"                                                                 \
        "v_mul_f32 %7, %27, %23\n"                                                                    \
        "v_add_f32 %5, %5, %6\n"                                                                      \
        "v_mul_f32 %8, %27, %24\n"                                                                    \
        "v_mul_f32 %9, %27, %25\n"                                                                    \
        "v_add_f32_dpp %5, %5, %5 row_ror:8 " DPPS                                                    \
        "v_add_f32_dpp %4, %4, %4 row_ror:8 " DPPS                                                    \
        "v_mul_f32 %10, %27, %26\n"                                                                   \
        "v_add_f32_dpp %5, %5, %5 row_ror:4 " DPPS                                                    \
        "v_add_f32_dpp %4, %4, %4 row_ror:4 " DPPS                                                    \
        "v_fma_f32 %7, %0, %15, %7\n"                                                                 \
        "v_add_f32_dpp %5, %5, %5 quad_perm:[2,3,0,1] " DPPS                                          \
        "v_add_f32_dpp %4, %4, %4 quad_perm:[2,3,0,1] " DPPS                                          \
        "v_fma_f32 %8, %1, %16, %8\n"                                                                 \
        "v_add_f32_dpp %5, %5, %5 quad_perm:[1,0,3,2] " DPPS                                          \
        "v_add_f32_dpp %4, %4, %4 quad_perm:[1,0,3,2] " DPPS                                          \
        "v_fma_f32 %9, %2, %17, %9\n"                                                                 \
        "v_fma_f32 %10, %3, %18, %10\n"                                                               \
        "v_fma_f32 %0, -%5, %19, %7\n"                                                                \
        "v_fma_f32 %1, -%5, %20, %8\n"                                                                \
        "v_fma_f32 %2, -%5, %21, %9\n"                                                                \
        "v_fma_f32 %3, -%5, %22, %10\n"                                                               \
        : "+v"(S0), "+v"(S1), "+v"(S2), "+v"(S3), "+v"(qy), "=&v"(t0), "=&v"(t1), "=&v"(u0), "=&v"(u1), \
          "=&v"(u2), "=&v"(u3)                                                                        \
        : "v"(S##kk.x), "v"(S##kk.y), "v"(S##kk.z), "v"(S##kk.w), "v"(S##w.x), "v"(S##w.y), "v"(S##w.z), \
          "v"(S##w.w), "v"(S##b.x), "v"(S##b.y), "v"(S##b.z), "v"(S##b.w), "v"(S##kd.x), "v"(S##kd.y), \
          "v"(S##kd.z), "v"(S##kd.w), "v"(S##v));                                                     \
                                                 \
    if ((st) > 0) ysel = ((lane & 15) == (st)-1) ? qy : ysel;                                         \
    qy = fmaf(S2, S##r.z, S0 * S##r.x) + fmaf(S3, S##r.w, S1 * S##r.y);                               \
  }
      LDS_SET(p0, 0);
#pragma unroll
      for (int st = 0; st < 16; st += 2) {
        LDS_SET(p1, st + 1);
        __builtin_amdgcn_sched_barrier(0);
        STEP(p0, st);
        if (st + 2 < 16) LDS_SET(p0, st + 2);
        __builtin_amdgcn_sched_barrier(0);
        STEP(p1, st + 1);
      }
#undef LDS_SET
#undef STEP
#undef DPPS
      qy = red16(qy);
      ysel = ((lane & 15) == 15) ? qy : ysel;
      sy[(buf * 16 + (lane & 15)) * 16 + w * 4 + rp] = ysel;
    }
    if (chunk + 1 < 272) SSTORE2(buf ^ 1);
    __syncthreads();
    {
      int st = tid >> 4, r = tid & 15;
      int row = scan_tokrow(b, dir, chunk * 16 + st);
      yout[(size_t)row * 512 + h * 64 + rq * 16 + r] = f2bf(sy[(buf * 16 + st) * 16 + r]);
    }
  }
#undef SLOAD
#undef SSTORE2
  __syncthreads();
}

__device__ __forceinline__ void s2_job(const Params& P, const Cx& X, int layer, int job) {
  const int tid = X.tid;
  const int row = job * 4 + (tid >> 6);
  const int c0 = (tid & 63) * 8;
  const bf16_t* rkv = (const bf16_t*)(X.ws + OFF_RKV) + (size_t)row * 1536;
  uint4 ur = *(const uint4*)(rkv + c0), uk = *(const uint4*)(rkv + 512 + c0), uv = *(const uint4*)(rkv + 1024 + c0);
  uint4 ua0 = *(const uint4*)((const bf16_t*)(X.ws + OFF_A) + (size_t)row * 1024 + c0);
  uint4 ua1 = *(const uint4*)((const bf16_t*)(X.ws + OFF_A) + (size_t)row * 1024 + 512 + c0);
  uint4 ug = *(const uint4*)((const bf16_t*)(X.ws + OFF_G) + (size_t)row * 512 + c0);
  uint4 uyf = *(const uint4*)((const bf16_t*)(X.ws + OFF_YF) + (size_t)row * 512 + c0);
  uint4 uyb = *(const uint4*)((const bf16_t*)(X.ws + OFF_YB) + (size_t)row * 512 + c0);
  const uint32_t r4[4] = {ur.x, ur.y, ur.z, ur.w}, k4[4] = {uk.x, uk.y, uk.z, uk.w}, v4[4] = {uv.x, uv.y, uv.z, uv.w};
  const uint32_t a04[4] = {ua0.x, ua0.y, ua0.z, ua0.w}, a14[4] = {ua1.x, ua1.y, ua1.z, ua1.w}, g4[4] = {ug.x, ug.y, ug.z, ug.w};
  const uint32_t yf4[4] = {uyf.x, uyf.y, uyf.z, uyf.w}, yb4[4] = {uyb.x, uyb.y, uyb.z, uyb.w};
  float y[8], vv[8], gg[8];
  float sum = 0.f, bon = 0.f;
  const float* rk = P.in[16] + layer * 512 + c0;
  const float* ka = P.in[15] + layer * 512 + c0;
#pragma unroll
  for (int i = 0; i < 4; ++i) {
#pragma unroll
    for (int hh = 0; hh < 2; ++hh) {
      int e = 2 * i + hh;
      float r = hh ? hi16(r4[i]) : lo16(r4[i]);
      float k = hh ? hi16(k4[i]) : lo16(k4[i]);
      float a0 = hh ? hi16(a04[i]) : lo16(a04[i]);
      float a1 = hh ? hi16(a14[i]) : lo16(a14[i]);
      y[e] = (hh ? hi16(yf4[i]) : lo16(yf4[i])) + (hh ? hi16(yb4[i]) : lo16(yb4[i]));
      vv[e] = hh ? hi16(v4[i]) : lo16(v4[i]);
      gg[e] = hh ? hi16(g4[i]) : lo16(g4[i]);
      sum += y[e];
      float ksum = k * (2.f + (a0 + a1 - 2.f) * ka[e]);
      bon += r * rk[e] * ksum;
    }
  }
  sum += __shfl_xor(sum, 1); sum += __shfl_xor(sum, 2); sum += __shfl_xor(sum, 4);
  bon += __shfl_xor(bon, 1); bon += __shfl_xor(bon, 2); bon += __shfl_xor(bon, 4);
  const float mu = sum * (1.f / 64.f);
  float var = 0.f;
#pragma unroll
  for (int e = 0; e < 8; ++e) { float d = y[e] - mu; var += d * d; }
  var += __shfl_xor(var, 1); var += __shfl_xor(var, 2); var += __shfl_xor(var, 4);
  const float rs = rsqrtf(var * (1.f / 64.f) + 64e-5f);
  const float* gw = P.in[18] + layer * 512 + c0;
  const float* gbi = P.in[19] + layer * 512 + c0;
  float o[8];
#pragma unroll
  for (int e = 0; e < 8; ++e) o[e] = ((y[e] - mu) * rs * gw[e] + gbi[e] + bon * vv[e]) * gg[e];
  uint4 ou;
  ou.x = pack2(o[0], o[1]); ou.y = pack2(o[2], o[3]); ou.z = pack2(o[4], o[5]); ou.w = pack2(o[6], o[7]);
  *(uint4*)((bf16_t*)(X.ws + OFF_RWO) + (size_t)row * 512 + c0) = ou;
}

__device__ __forceinline__ float red32(float x) {
  x += __shfl_xor(x, 1); x += __shfl_xor(x, 2); x += __shfl_xor(x, 4); x += __shfl_xor(x, 8); x += __shfl_xor(x, 16);
  return x;
}
#define QSCALE 0.14724444f
__device__ __forceinline__ void q1_q_tile(const Params& P, const Cx& X, int layer, int t, char* smem) {
  const int tid = X.tid, lane = tid & 63, w = tid >> 6;
  const int mt = t % 136, head = t / 136;
  const int m0 = mt * 128;
  const bf16_t* zm = (const bf16_t*)(X.ws + OFF_ZM);
  float* srs = (float*)(smem + 73728);
  {
    int r = tid >> 1, hf = tid & 1;
    const bf16_t* p = zm + (size_t)(m0 + r) * 544 + hf * 192;
    float ss = 0.f;
    for (int i = 0; i < 24; ++i) {
      uint4 u = *(const uint4*)(p + i * 8);
      ss += lo16(u.x) * lo16(u.x) + hi16(u.x) * hi16(u.x) + lo16(u.y) * lo16(u.y) + hi16(u.y) * hi16(u.y) +
            lo16(u.z) * lo16(u.z) + hi16(u.z) * hi16(u.z) + lo16(u.w) * lo16(u.w) + hi16(u.w) * hi16(u.w);
    }
    ss += __shfl_xor(ss, 1);
    if (hf == 0) srs[r] = rsqrtf(ss * (1.f / 384.f) + 1e-6f);
  }
  f32x16 acc[1][3];
  GQ::zero(acc);
  GQ::run(X, zm + (size_t)m0 * 544, 544, (const bf16_t*)(X.ws + OFF_WMIX) + WE_UQ + (size_t)head * 96 * 384, 384, 384, smem, acc);
  const int l5 = lane & 31;
  const float* gq = P.in[25] + layer * 96;
  const float g0 = gq[l5], g1 = gq[32 + l5], g2 = gq[64 + l5];
  const float2* rope = (const float2*)(X.ws + OFF_ROPE);
  bf16_t* qb = (bf16_t*)(X.ws + OFF_Q);
#pragma unroll
  for (int r = 0; r < 16; ++r) {
    const int rl = w * 32 + ROW_OF(r);
    const int row = m0 + rl;
    const float rs = srs[rl];
    float x0 = acc[0][0][r] * rs, x1 = acc[0][1][r] * rs, x2 = acc[0][2][r] * rs;
    float ss = red32(x0 * x0 + x1 * x1 + x2 * x2);
    float rq = rsqrtf(ss * (1.f / 96.f) + 1e-6f);
    x0 *= rq * g0; x1 *= rq * g1; x2 *= rq * g2;
    bf16_t* dst;
    if (row < NX) {
      int tt = row & 4095, bb = row >> 12;
      float2 cs = rope[tt * 16 + (l5 >> 4) * 8 + (l5 & 7)];
      float other = __shfl_xor(x2, 8);
      x2 = (l5 & 8) ? x2 * cs.x + other * cs.y : x2 * cs.x - other * cs.y;
      dst = qb + ((size_t)(bb * 8 + head) * 4096 + tt) * 96;
    } else {
      int j = (row - NX) & 255, bb = (row - NX) >> 8;
      dst = qb + (size_t)NX * 768 + ((size_t)(bb * 8 + head) * 256 + j) * 96;
    }
    dst[l5] = f2bf(x0 * QSCALE); dst[32 + l5] = f2bf(x1 * QSCALE); dst[64 + l5] = f2bf(x2 * QSCALE);
  }
}
__device__ __forceinline__ void q1_kv_tile(const Params& P, const Cx& X, int layer, int t, char* smem) {
  const int tid = X.tid, lane = tid & 63, w = tid >> 6;
  const int mt = t % 136, head = t / 136;
  const int m0 = mt * 128;
  const bf16_t* zm = (const bf16_t*)(X.ws + OFF_ZM);
  float* srs = (float*)(smem + 73728);
  {
    int r = tid >> 1, hf = tid & 1;
    const bf16_t* p = zm + (size_t)(m0 + r) * 544 + 384 + hf * 64;
    float ss = 0.f;
    for (int i = 0; i < 8; ++i) {
      uint4 u = *(const uint4*)(p + i * 8);
      ss += lo16(u.x) * lo16(u.x) + hi16(u.x) * hi16(u.x) + lo16(u.y) * lo16(u.y) + hi16(u.y) * hi16(u.y) +
            lo16(u.z) * lo16(u.z) + hi16(u.z) * hi16(u.z) + lo16(u.w) * lo16(u.w) + hi16(u.w) * hi16(u.w);
    }
    ss += __shfl_xor(ss, 1);
    if (hf == 0) srs[r] = rsqrtf(ss * (1.f / 128.f) + 1e-6f);
  }
  f32x16 acc[1][4];
  GKV::zero(acc);
  GKV::run(X, zm + (size_t)m0 * 544 + 384, 544, (const bf16_t*)(X.ws + OFF_WMIX) + WE_UKV + (size_t)head * 128 * 128, 128, 128, smem, acc);
  const int l5 = lane & 31;
  const float* gk = P.in[26] + layer * 96;
  const float g0 = gk[l5], g1 = gk[32 + l5], g2 = gk[64 + l5];
  const float2* rope = (const float2*)(X.ws + OFF_ROPE);
  bf16_t* kb = (bf16_t*)(X.ws + OFF_K);
  bf16_t* vt = (bf16_t*)(X.ws + OFF_VT);
  const bool isx = m0 < NX;
  const int bb = isx ? (m0 >> 12) : ((m0 - NX) >> 8);
  float vv0[16], vv1[16];
#pragma unroll
  for (int r = 0; r < 16; ++r) {
    const int rl = w * 32 + ROW_OF(r);
    const int row = m0 + rl;
    const float rs = srs[rl];
    float k0 = acc[0][0][r] * rs, k1 = acc[0][1][r] * rs;
    float kr = bf2f(zm[(size_t)row * 544 + 512 + l5]);
    float ss = red32(k0 * k0 + k1 * k1 + kr * kr);
    float rk = rsqrtf(ss * (1.f / 96.f) + 1e-6f);
    k0 *= rk * g0; k1 *= rk * g1; kr *= rk * g2;
    int key;
    if (isx) {
      int tt = row & 4095;
      float2 cs = rope[tt * 16 + (l5 >> 4) * 8 + (l5 & 7)];
      float other = __shfl_xor(kr, 8);
      kr = (l5 & 8) ? kr * cs.x + other * cs.y : kr * cs.x - other * cs.y;
      key = 256 + tt;
    } else {
      key = (row - NX) & 255;
    }
    bf16_t* dst = kb + ((size_t)(bb * 8 + head) * 4352 + key) * 96;
    dst[l5] = f2bf(k0); dst[32 + l5] = f2bf(k1); dst[64 + l5] = f2bf(kr);
    vv0[r] = acc[0][2][r] * rs;
    vv1[r] = acc[0][3][r] * rs;
  }
#pragma unroll
  for (int g = 0; g < 4; ++g) {
    const int rl = w * 32 + 8 * g + 4 * (lane >> 5);
    const int row = m0 + rl;
    const int key = isx ? 256 + (row & 4095) : ((row - NX) & 255);
    uint2 o0, o1;
    o0.x = pack2(vv0[4 * g], vv0[4 * g + 1]); o0.y = pack2(vv0[4 * g + 2], vv0[4 * g + 3]);
    o1.x = pack2(vv1[4 * g], vv1[4 * g + 1]); o1.y = pack2(vv1[4 * g + 2], vv1[4 * g + 3]);
    *(uint2*)(vt + ((size_t)(bb * 8 + head) * 64 + l5) * 4352 + key) = o0;
    *(uint2*)(vt + ((size_t)(bb * 8 + head) * 64 + 32 + l5) * 4352 + key) = o1;
  }
}

__device__ __forceinline__ void fft1_tile(const Params& P, const Cx& X, int t, char* smem) {
  const int lane = X.tid & 63, w = X.tid >> 6;
  const int b = t >> 8, ntile = t & 255;
  const int n0 = ntile * 128;
  f32x16 acc[2][2];
  G22T::zero(acc);
  G22T::run(X, (const bf16_t*)(X.ws + OFF_F1), 64, (const bf16_t*)(X.ws + OFF_ZF) + (size_t)b * 4096 * 512 + n0, 32768, 64, smem, acc);
  const float2* tw = (const float2*)(X.ws + OFF_TW);
  bf16_t* out = (bf16_t*)(X.ws + OFF_FFT1);
  const int wm = w >> 1, wn = w & 1;
  const int t2 = n0 >> 9;
#pragma unroll
  for (int j = 0; j < 2; ++j) {
    const int ch = (n0 & 511) + wn * 64 + j * 32 + (lane & 31);
#pragma unroll
    for (int r = 0; r < 16; ++r) {
      const int f1 = wm * 32 + ROW_OF(r);
      float re = acc[0][j][r], im = acc[1][j][r];
      float2 cs = tw[t2 * f1];
      float re2 = re * cs.x + im * cs.y, im2 = im * cs.x - re * cs.y;
      size_t base = ((size_t)(b * 64 + f1) * 128) * 512 + ch;
      out[base + (size_t)t2 * 512] = f2bf(re2);
      out[base + (size_t)(64 + t2) * 512] = f2bf(im2);
    }
  }
}
__device__ __forceinline__ void fft2_tile(const Params& P, const Cx& X, int t, char* smem) {
  const int lane = X.tid & 63, w = X.tid >> 6;
  const int bf = t >> 2, ntile = t & 3;
  const int b = bf >> 6, f1 = bf & 63;
  const int n0 = ntile * 128;
  f32x16 acc[2][2];
  G22T::zero(acc);
  G22T::run(X, (const bf16_t*)(X.ws + OFF_F2), 128, (const bf16_t*)(X.ws + OFF_FFT1) + (size_t)bf * 128 * 512 + n0, 512, 128, smem, acc);
  bf16_t* Y = (bf16_t*)(X.ws + OFF_Y);
  const int wm = w >> 1, wn = w & 1;
#pragma unroll
  for (int i = 0; i < 2; ++i)
#pragma unroll
    for (int j = 0; j < 2; ++j)
#pragma unroll
      for (int r = 0; r < 16; ++r) {
        int m = wm * 64 + i * 32 + ROW_OF(r);
        int f2 = m & 63, q = m >> 6;
        int ch = n0 + wn * 64 + j * 32 + (lane & 31);
        Y[(size_t)(b * 4096 + f1 + 64 * f2) * 1024 + q * 512 + ch] = f2bf(acc[i][j][r]);
      }
}
__device__ __forceinline__ void ctxdft_tile(const Params& P, const Cx& X, int t, char* smem) {
  const int lane = X.tid & 63, w = X.tid >> 6;
  const int b = t >> 4, mt = (t >> 2) & 3, ntile = t & 3;
  const int n0 = ntile * 128;
  f32x16 acc[2][2];
  G22T::zero(acc);
  G22T::run(X, (const bf16_t*)(X.ws + OFF_F256) + (size_t)mt * 128 * 256, 256, (const bf16_t*)(X.ws + OFF_ZF) + (size_t)(NX + b * 256) * 512 + n0, 512, 256, smem, acc);
  bf16_t* Y = (bf16_t*)(X.ws + OFF_Y);
  const int wm = w >> 1, wn = w & 1;
#pragma unroll
  for (int i = 0; i < 2; ++i)
#pragma unroll
    for (int j = 0; j < 2; ++j)
#pragma unroll
      for (int r = 0; r < 16; ++r) {
        int m = mt * 128 + wm * 64 + i * 32 + ROW_OF(r);
        int f = m & 255, q = m >> 8;
        int ch = n0 + wn * 64 + j * 32 + (lane & 31);
        Y[(size_t)(NX + b * 256 + f) * 1024 + q * 512 + ch] = f2bf(acc[i][j][r] * 4.f);
      }
}

__device__ __forceinline__ void attn_item(const Params& P, const Cx& X, int it, bool isctx, char* smem) {
  const int tid = X.tid, lane = tid & 63, w = tid >> 6;
  int b, h, qb, nkt, qrow0;
  const bf16_t* qbase;
  if (!isctx) {
    b = it >> 8; h = (it >> 5) & 7; qb = it & 31; nkt = 68;
    qbase = (const bf16_t*)(X.ws + OFF_Q) + ((size_t)(b * 8 + h) * 4096 + qb * 128) * 96;
    qrow0 = b * 4096 + qb * 128;
  } else {
    b = it >> 4; h = (it >> 1) & 7; qb = it & 1; nkt = 4;
    qbase = (const bf16_t*)(X.ws + OFF_Q) + (size_t)NX * 768 + ((size_t)(b * 8 + h) * 256 + qb * 128) * 96;
    qrow0 = NX + b * 256 + qb * 128;
  }
  const bf16_t* kbase = (const bf16_t*)(X.ws + OFF_K) + (size_t)(b * 8 + h) * 4352 * 96;
  const bf16_t* vbase = (const bf16_t*)(X.ws + OFF_VT) + (size_t)(b * 8 + h) * 64 * 4352;
  bf16_t* sK = (bf16_t*)smem;
  bf16_t* sV = sK + 2 * 64 * 104;
  const int l5 = lane & 31, hh = lane >> 5;
  const bf16_t* qp = qbase + (size_t)(w * 32 + l5) * 96 + hh * 8;
  const bf16x8 qf0 = *(const bf16x8*)(qp), qf1 = *(const bf16x8*)(qp + 16), qf2 = *(const bf16x8*)(qp + 32);
  const bf16x8 qf3 = *(const bf16x8*)(qp + 48), qf4 = *(const bf16x8*)(qp + 64), qf5 = *(const bf16x8*)(qp + 80);
  uint4 rk0, rk1, rk2, rv0, rv1;
#define LK_(i, kt) (*(const uint4*)(kbase + (size_t)((kt)*64 + (tid + 256 * (i)) / 12) * 96 + ((tid + 256 * (i)) % 12) * 8))
#define LV_(i, kt) (*(const uint4*)(vbase + (size_t)((tid + 256 * (i)) >> 3) * 4352 + (kt)*64 + ((tid + 256 * (i)) & 7) * 8))
#define ALOAD(kt) { rk0 = LK_(0, kt); rk1 = LK_(1, kt); rk2 = LK_(2, kt); rv0 = LV_(0, kt); rv1 = LV_(1, kt); }
#define SK_(i, buf, v) *(uint4*)(sK + (buf)*64 * 104 + ((tid + 256 * (i)) / 12) * 104 + ((tid + 256 * (i)) % 12) * 8) = v
#define SV_(i, buf, v) *(uint4*)(sV + (buf)*64 * 72 + ((tid + 256 * (i)) >> 3) * 72 + ((tid + 256 * (i)) & 7) * 8) = v
#define ASTORE(buf) { SK_(0, buf, rk0); SK_(1, buf, rk1); SK_(2, buf, rk2); SV_(0, buf, rv0); SV_(1, buf, rv1); }
  f32x16 o[2];
#pragma unroll
  for (int r = 0; r < 16; ++r) { o[0][r] = 0.f; o[1][r] = 0.f; }
  float mrun = -1e30f, lrun = 0.f;
  ALOAD(0);
  ASTORE(0);
  __syncthreads();
  for (int kt = 0; kt < nkt; ++kt) {
    const int buf = kt & 1;
    if (kt + 1 < nkt) ALOAD(kt + 1);
    const bf16_t* pk = sK + buf * 64 * 104 + l5 * 104 + hh * 8;
    const bf16_t* pv = sV + buf * 64 * 72 + l5 * 72 + 4 * hh;
#pragma unroll
    for (int mt = 0; mt < 2; ++mt) {
      f32x16 sc;
#pragma unroll
      for (int r = 0; r < 16; ++r) sc[r] = 0.f;
#define QK(ks, qq) sc = __builtin_amdgcn_mfma_f32_32x32x16_bf16(*(const bf16x8*)(pk + mt * 32 * 104 + (ks)*16), qq, sc, 0, 0, 0)
      QK(0, qf0); QK(1, qf1); QK(2, qf2); QK(3, qf3); QK(4, qf4); QK(5, qf5);
#undef QK
      float mx = sc[0];
#pragma unroll
      for (int r = 1; r < 16; ++r) mx = fmaxf(mx, sc[r]);
      mx = fmaxf(mx, __shfl_xor(mx, 32));
      const float mnew = fmaxf(mrun, mx);
      if (__builtin_amdgcn_ballot_w64(mnew > mrun) != 0ull) {
        const float alpha = __builtin_amdgcn_exp2f(mrun - mnew);
        lrun *= alpha;
#pragma unroll
        for (int r = 0; r < 16; ++r) { o[0][r] *= alpha; o[1][r] *= alpha; }
        mrun = mnew;
      }
      float psum = 0.f;
#pragma unroll
      for (int r = 0; r < 16; ++r) { sc[r] = __builtin_amdgcn_exp2f(sc[r] - mrun); psum += sc[r]; }
      lrun += psum;
#pragma unroll
      for (int s2 = 0; s2 < 2; ++s2) {
        u32x4 pu;
        pu[0] = pack2(sc[8 * s2 + 0], sc[8 * s2 + 1]);
        pu[1] = pack2(sc[8 * s2 + 2], sc[8 * s2 + 3]);
        pu[2] = pack2(sc[8 * s2 + 4], sc[8 * s2 + 5]);
        pu[3] = pack2(sc[8 * s2 + 6], sc[8 * s2 + 7]);
        const bf16x8 pfv = __builtin_bit_cast(bf16x8, pu);
#pragma unroll
        for (int dt = 0; dt < 2; ++dt) {
          const bf16_t* p = pv + dt * 32 * 72 + mt * 32 + s2 * 16;
          uint2 v0 = *(const uint2*)(p), v1 = *(const uint2*)(p + 8);
          u32x4 vu;
          vu[0] = v0.x; vu[1] = v0.y; vu[2] = v1.x; vu[3] = v1.y;
          o[dt] = __builtin_amdgcn_mfma_f32_32x32x16_bf16(__builtin_bit_cast(bf16x8, vu), pfv, o[dt], 0, 0, 0);
        }
      }
    }
    if (kt + 1 < nkt) ASTORE(buf ^ 1);
    __syncthreads();
  }
#undef ALOAD
#undef ASTORE
#undef LK_
#undef LV_
#undef SK_
#undef SV_
  lrun += __shfl_xor(lrun, 32);
  const float inv = 1.f / lrun;
  bf16_t* dst = (bf16_t*)(X.ws + OFF_ATT) + (size_t)(qrow0 + w * 32 + l5) * 512 + h * 64;
#pragma unroll
  for (int dt = 0; dt < 2; ++dt)
#pragma unroll
    for (int g = 0; g < 4; ++g) {
      uint2 u;
      u.x = pack2(o[dt][4 * g] * inv, o[dt][4 * g + 1] * inv);
      u.y = pack2(o[dt][4 * g + 2] * inv, o[dt][4 * g + 3] * inv);
      *(uint2*)(dst + dt * 32 + 8 * g + 4 * hh) = u;
    }
}

__device__ __forceinline__ void mg_tile(const Params& P, const Cx& X, int t, int mtiles, char* smem) {
  const int lane = X.tid & 63, w = X.tid >> 6;
  const int mt = t % mtiles, nt = t / mtiles;
  const int m0 = mt * 128, c0 = nt * 128;
  const bf16_t* W = (const bf16_t*)(X.ws + OFF_WMIX);
  uint32_t mpk[2][2][8];
#pragma unroll
  for (int a = 0; a < 2; ++a)
#pragma unroll
    for (int c = 0; c < 2; ++c)
#pragma unroll
      for (int r = 0; r < 8; ++r) mpk[a][c][r] = 0u;
#pragma unroll 1
  for (int i = 0; i < 3; ++i) {
    f32x16 acc[2][2];
    G22::zero(acc);
    const bf16_t* Ai; const bf16_t* Bi; int ldi;
    if (i == 0) { Ai = (const bf16_t*)(X.ws + OFF_RWO) + (size_t)m0 * 512; Bi = W + WE_RO + (size_t)c0 * 512; ldi = 512; }
    else if (i == 1) { Ai = (const bf16_t*)(X.ws + OFF_ATT) + (size_t)m0 * 512; Bi = W + WE_MO + (size_t)c0 * 512; ldi = 512; }
    else { Ai = (const bf16_t*)(X.ws + OFF_Y) + (size_t)m0 * 1024; Bi = W + WE_FO + (size_t)c0 * 1024; ldi = 1024; }
    { const Cx Y1 = fresh(X); G22::run(Y1, Ai, ldi, Bi, ldi, ldi, smem, acc); }
    uint32_t opk[2][2][8];
#pragma unroll
    for (int a = 0; a < 2; ++a)
#pragma unroll
      for (int c = 0; c < 2; ++c)
#pragma unroll
        for (int r = 0; r < 8; ++r) opk[a][c][r] = pack2(acc[a][c][2 * r], acc[a][c][2 * r + 1]);
    __builtin_amdgcn_sched_barrier(0);
    G22::zero(acc);
    { const Cx Y2 = fresh(X); G22::run(Y2, (const bf16_t*)(X.ws + OFF_HBUF) + (size_t)m0 * 1024, 1024, W + WE_IN + (size_t)(2976 + i * 1024 + c0) * 1024, 1024, 1024, smem, acc); }
#pragma unroll
    for (int a = 0; a < 2; ++a)
#pragma unroll
      for (int c = 0; c < 2; ++c)
#pragma unroll
        for (int r = 0; r < 8; ++r) {
          const float m0v = lo16(mpk[a][c][r]) + lo16(opk[a][c][r]) / (1.f + __expf(-acc[a][c][2 * r]));
          const float m1v = hi16(mpk[a][c][r]) + hi16(opk[a][c][r]) / (1.f + __expf(-acc[a][c][2 * r + 1]));
          mpk[a][c][r] = pack2(m0v, m1v);
        }
  }
  bf16_t* mb = (bf16_t*)(X.ws + OFF_M);
  const int row0 = m0 + (w >> 1) * 64, col0 = c0 + (w & 1) * 64;
#pragma unroll
  for (int a = 0; a < 2; ++a)
#pragma unroll
    for (int c = 0; c < 2; ++c)
#pragma unroll
      for (int r = 0; r < 16; ++r)
        mb[(size_t)(row0 + a * 32 + ROW_OF(r)) * 1024 + col0 + c * 32 + (lane & 31)] = (bf16_t)((r & 1) ? (mpk[a][c][r >> 1] >> 16) : (mpk[a][c][r >> 1] & 0xffffu));
}

__device__ __forceinline__ void wo_tile(const Params& P, const Cx& X, int layer, int t, int mtiles, char* smem) {
  const int lane = X.tid & 63, w = X.tid >> 6;
  const int mt = t % mtiles, nt = t / mtiles;
  const int m0 = mt * 128, n0 = nt * 128;
  f32x16 acc[2][2];
  G22::zero(acc);
  G22::run(X, (const bf16_t*)(X.ws + OFF_M) + (size_t)m0 * 1024, 1024, (const bf16_t*)(X.ws + OFF_WMIX) + WE_OUT + (size_t)n0 * 1024, 1024, 1024, smem, acc);
  const int row0 = m0 + (w >> 1) * 64, col0 = n0 + (w & 1) * 64;
  const float* modv = (const float*)(X.ws + OFF_MOD) + (size_t)(layer * 5 + mod_row(m0)) * 6144 + 2048;
  const float* src; float* dst;
  if (m0 < NX) { src = (layer == 0 ? P.in[0] : X.out); dst = X.out; }
  else { src = (layer == 0 ? P.in[2] : (const float*)(X.ws + OFF_CS)) - (size_t)NX * 1024; dst = (float*)(X.ws + OFF_CS) - (size_t)NX * 1024; }
#pragma unroll
  for (int j = 0; j < 2; ++j) {
    const int col = col0 + j * 32 + (lane & 31);
    const float mg = modv[col];
#pragma unroll
    for (int i = 0; i < 2; ++i)
#pragma unroll
      for (int r = 0; r < 16; ++r) {
        size_t idx = (size_t)(row0 + i * 32 + ROW_OF(r)) * 1024 + col;
        dst[idx] = src[idx] + mg * acc[i][j][r];
      }
  }
}
__device__ __forceinline__ void f1_tile(const Params& P, const Cx& X, int t, int mtiles, char* smem) {
  const int lane = X.tid & 63, w = X.tid >> 6;
  const int mt = t % mtiles, nt = t / mtiles;
  const int m0 = mt * 128, n0 = nt * 256;
  f32x16 acc[2][4];
  GemmW::zero(acc);
  GemmW::run(X, (const bf16_t*)(X.ws + OFF_HBUF) + (size_t)m0 * 1024, 1024, (const bf16_t*)(X.ws + OFF_WFFN) + WF_IN + (size_t)n0 * 1024, 1024, 1024, smem, acc);
  bf16_t* act = (bf16_t*)(X.ws + OFF_ACT);
  const int row0 = m0 + (w >> 1) * 64;
#pragma unroll
  for (int jp = 0; jp < 2; ++jp) {
    const int hid = ((n0 + (w & 1) * 128 + jp * 64) >> 6) * 32 + (lane & 31);
#pragma unroll
    for (int i = 0; i < 2; ++i)
#pragma unroll
      for (int r = 0; r < 16; ++r) {
        float g = acc[i][2 * jp][r], u = acc[i][2 * jp + 1][r];
        act[(size_t)(row0 + i * 32 + ROW_OF(r)) * 2816 + hid] = f2bf(g / (1.f + __expf(-g)) * u);
      }
  }
}
__device__ __forceinline__ void f2_tile(const Params& P, const Cx& X, int layer, int t, int mtiles, char* smem) {
  const int lane = X.tid & 63, w = X.tid >> 6;
  const int mt = t % mtiles, nt = t / mtiles;
  const int m0 = mt * 128, n0 = nt * 128;
  f32x16 acc[2][2];
  G22::zero(acc);
  G22::run(X, (const bf16_t*)(X.ws + OFF_ACT) + (size_t)m0 * 2816, 2816, (const bf16_t*)(X.ws + OFF_WFFN) + WF_OUT + (size_t)n0 * 2816, 2816, 2816, smem, acc);
  const int row0 = m0 + (w >> 1) * 64, col0 = n0 + (w & 1) * 64;
  const float* modv = (const float*)(X.ws + OFF_MOD) + (size_t)(layer * 5 + mod_row(m0)) * 6144 + 5120;
  float* dst = (m0 < NX) ? X.out : (float*)(X.ws + OFF_CS) - (size_t)NX * 1024;
#pragma unroll
  for (int j = 0; j < 2; ++j) {
    const int col = col0 + j * 32 + (lane & 31);
    const float mg = modv[col];
#pragma unroll
    for (int i = 0; i < 2; ++i)
#pragma unroll
      for (int r = 0; r < 16; ++r) {
        size_t idx = (size_t)(row0 + i * 32 + ROW_OF(r)) * 1024 + col;
        dst[idx] = dst[idx] + mg * acc[i][j][r];
      }
  }
}

__device__ __forceinline__ void run_p(const Params& P, const Cx& X, int layer, int p, char* smem) {
  const int G = gridDim.x, B = blockIdx.x;
  if (p < 0) {
    if (!PON(14)) return;
    for (int j = B; j < 192 + 55 + NCW1; j += G) {
      if (j < 192) job_mod(P, fresh(X), smem, j);
      else if (j < 247) job_tables(P, fresh(X), j - 192);
      else cw_mixer_job(P, fresh(X), 0, j - 247, smem);
    }
    return;
  }
  const int mtiles = layer == 0 ? 136 : 128;
  switch (p) {
    case 0: if (!PON(0)) break;
      if (layer == 0) { for (int j = B; j < 4352; j += G) norm_job(P, fresh(X), layer, 0, j); }
      else { for (int j = B; j < NCW1 + 4352; j += G) { if (j < NCW1) cw_mixer_job(P, fresh(X), layer, j, smem); else norm_job(P, fresh(X), layer, 0, j - NCW1); } }
      break;
    case 1: if (!PON(1)) break; for (int j = B; j < 136 * 15; j += G) g1a_tile(P, fresh(X), j, smem); break;
    case 2: if (!PON(2)) break; for (int j = B; j < NTOK / 8; j += G) r1a_job(P, fresh(X), layer, j); break;
    case 3: if (!PON(3)) break; for (int j = B; j < 136 * 20; j += G) r1b_tile(P, fresh(X), layer, j, smem); break;
    case 4: if (!PON(4)) break; {
      volatile int* sflag = (volatile int*)(smem + LDS_BYTES - 32);
      if (sflag[0]) {
        unsigned* ctr = (unsigned*)(X.ws + OFF_TICK) + 2048 + layer * 64 + sflag[2] * 8;
        for (;;) {
          __syncthreads();
          if (X.tid == 0) sflag[1] = (int)atomicAdd(ctr, 1u);
          __syncthreads();
          const int j = sflag[1];
          if (j >= 256) break;
          scan_job(P, fresh(X), layer, j, smem);
        }
      }
    } break;
    case 5: if (!PON(5)) break; for (int j = B; j < 4352; j += G) s2_job(P, fresh(X), layer, j); break;
    case 6: if (!PON(6)) break; for (int j = B; j < 136 * 9; j += G) g1b_tile(P, fresh(X), j, smem); break;
    case 7: if (!PON(7)) break;
      for (int j = B; j < 2176 + 1024; j += G) {
        if (j < 1088) q1_kv_tile(P, fresh(X), layer, j, smem);
        else if (j < 2176) { if (layer == 0 || (j - 1088) % 136 < 128) q1_q_tile(P, fresh(X), layer, j - 1088, smem); }
        else fft1_tile(P, fresh(X), j - 2176, smem);
      }
      break;
    case 8: if (!PON(8)) break; {
      const int nctx = layer == 0 ? 64 : 0;
      for (int j = B; j < 1024 + 1024 + 2 * nctx; j += G) {
        const bool isc = (j >= 2048 && j < 2048 + nctx);
        if (j < 1024 || isc) attn_item(P, fresh(X), isc ? j - 2048 : j, isc, smem);
        else if (j < 2048) fft2_tile(P, fresh(X), j - 1024, smem);
        else ctxdft_tile(P, fresh(X), j - 2048 - nctx, smem);
      }
    } break;
    case 9: if (!PON(9)) break; for (int j = B; j < mtiles * 8; j += G) mg_tile(P, fresh(X), j, mtiles, smem); break;
    case 10: if (!PON(10)) break;
      for (int j = B; j < mtiles * 8 + NCW2; j += G) { if (j < mtiles * 8) wo_tile(P, fresh(X), layer, j, mtiles, smem); else cw_ffn_job(P, fresh(X), layer, j - mtiles * 8, smem); }
      break;
    case 11: if (!PON(11)) break; for (int j = B; j < mtiles * 32; j += G) norm_job(P, fresh(X), layer, 1, j); break;
    case 12: if (!PON(12)) break; for (int j = B; j < mtiles * 22; j += G) f1_tile(P, fresh(X), j, mtiles, smem); break;
    case 13: if (!PON(13)) break; for (int j = B; j < mtiles * 8; j += G) f2_tile(P, fresh(X), layer, j, mtiles, smem); break;
  }
}

#if SINGLE
__global__ void __launch_bounds__(256, 2) fwd_kernel(Params P, int ph_lo, int ph_hi, int use_sync) {
  extern __shared__ __attribute__((aligned(16))) char smem[];
  volatile LAS unsigned* xst = (volatile LAS unsigned*)(smem + LDS_BYTES - 16);
  if (threadIdx.x == 0) { xst[0] = 0u; xst[1] = 0u; }
  __syncthreads();
  XcdBarrier xb = xcd_barrier_post((unsigned*)(P.ws + OFF_BAR), xst);
  if (threadIdx.x == 0) {
    const unsigned hwid = (unsigned)__builtin_amdgcn_s_getreg((31 << 11) | 4);
    const unsigned slot = ((xb_xcc_id() * 8u + ((hwid >> 13) & 7u)) * 2u + ((hwid >> 12) & 1u)) * 16u + ((hwid >> 8) & 15u);
    const unsigned t = atomicAdd((unsigned*)(P.ws + OFF_TICK) + slot, 1u);
    *(volatile int*)(smem + LDS_BYTES - 32) = (t == 0u) ? 1 : 0;
    *(volatile int*)(smem + LDS_BYTES - 24) = 0;
  }
  __syncthreads();
#pragma unroll 1
  for (int ph = ph_lo; ph < ph_hi; ++ph) {
    char* ws = P.ws; float* out = P.out; int tid = threadIdx.x;
    asm volatile("" : "+v"(tid));
    const Cx X{ws, out, tid};
    if (ph == 0) run_p(P, X, 0, -1, smem);
    else {
      run_p(P, X, (ph - 1) / 14, (ph - 1) % 14, smem);
      if (PROBE_P >= 0 && (ph - 1) % 14 == PROBE_P) {
#pragma unroll 1
        for (int rep = 0; rep < PROBE_N; ++rep) { xcd_barrier(xb); if (threadIdx.x == 0) *(volatile int*)(smem + LDS_BYTES - 24) = rep + 1; __syncthreads(); run_p(P, X, (ph - 1) / 14, PROBE_P, smem); }
        if (threadIdx.x == 0) *(volatile int*)(smem + LDS_BYTES - 24) = 0;
        __syncthreads();
      }
    }
    if (use_sync && ph + 1 < ph_hi) { if (use_sync == 2) cg::this_grid().sync(); else xcd_barrier(xb); }
  }
}

#else
template <int PP>
__global__ void __launch_bounds__(256) phase_kernel(Params P, int layer) {
  extern __shared__ __attribute__((aligned(16))) char smem[];
  const Cx X{P.ws, P.out, (int)threadIdx.x};
  run_p(P, X, layer, PP, smem);
}
#endif

extern "C" void kernel_launch(void* const* d_in, const int* in_sizes, int n_in, void* d_out, int out_size, void* d_ws,
                              size_t ws_size, hipStream_t stream) {
  static int grid = 0;
  if (grid == 0) {
    if (n_in != 33 || ws_size < OFF_END) { fprintf(stderr, "kernel_launch: unexpected n_in %d / ws_size %zu (need %zu)\n", n_in, ws_size, (size_t)OFF_END); grid = -1; return; }
    int dev = 0, cus = 0, per_cu = 0;
    hipGetDevice(&dev);
    hipDeviceGetAttribute(&cus, hipDeviceAttributeMultiprocessorCount, dev);
#if SINGLE
    hipFuncSetAttribute((const void*)fwd_kernel, hipFuncAttributeMaxDynamicSharedMemorySize, LDS_BYTES);
    hipOccupancyMaxActiveBlocksPerMultiprocessor(&per_cu, (const void*)fwd_kernel, 256, LDS_BYTES);
#else
#define SA(pp) hipFuncSetAttribute((const void*)phase_kernel<pp>, hipFuncAttributeMaxDynamicSharedMemorySize, LDS_BYTES)
    SA(-1); SA(0); SA(1); SA(2); SA(3); SA(4); SA(5); SA(6); SA(7); SA(8); SA(9); SA(10); SA(11); SA(12); SA(13);
    per_cu = 2;
#endif
    if (per_cu < 1) { fprintf(stderr, "kernel_launch: occupancy query returned %d\n", per_cu); grid = -1; return; }
    if (per_cu > 2) per_cu = 2;
    grid = cus * per_cu;
  }
  if (grid < 0) return;
  if (hipMemsetAsync((char*)d_ws + OFF_BAR, 0, 32768, stream) != hipSuccess) { fprintf(stderr, "kernel_launch: memset failed\n"); return; }
  Params P{};
  for (int i = 0; i < 33; ++i) P.in[i] = (const float*)d_in[i];
  P.out = (float*)d_out;
  P.ws = (char*)d_ws;
#if SINGLE
  int lo = 0, hi = NPH, us = 1;
  void* args[] = {&P, &lo, &hi, &us};
  hipError_t e = hipLaunchCooperativeKernel((const void*)fwd_kernel, dim3(grid), dim3(256), args, LDS_BYTES, stream);
  if (e != hipSuccess) fprintf(stderr, "cooperative launch failed: %s (grid %d)\n", hipGetErrorString(e), grid);
#else
#define LP(pp, ly) hipLaunchKernelGGL(phase_kernel<pp>, dim3(grid), dim3(256), LDS_BYTES, stream, P, ly)
  LP(-1, 0);
  for (int ly = 0; ly < 2; ++ly) {
    LP(0, ly); LP(1, ly); LP(2, ly); LP(3, ly); LP(4, ly); LP(5, ly); LP(6, ly); LP(7, ly); LP(8, ly); LP(9, ly); LP(10, ly); LP(11, ly); LP(12, ly); LP(13, ly);
  }
#endif
}
```

```cpp
#include <hip/hip_runtime.h>
#include <hip/hip_cooperative_groups.h>
#include <stdint.h>
#include <stdio.h>
namespace cg = cooperative_groups;

#ifndef SINGLE
#define SINGLE 1
#endif

#ifndef ONLYP
#define ONLYP -1
#endif
#define PON(x) (ONLYP < 0 || ONLYP == (x))

typedef unsigned short bf16_t;
typedef __attribute__((ext_vector_type(8))) short bf16x8;
typedef __attribute__((ext_vector_type(16))) float f32x16;
typedef __attribute__((ext_vector_type(4))) unsigned int u32x4;

#define NX 16384
#define NCX 1024
#define NTOK 17408
#define NPH 29
#ifndef PROBE_P
#define PROBE_P -1
#endif
#define PROBE_N 2
#define LDS_BYTES 77824

static constexpr size_t UU = 17825792ull;
static constexpr size_t OFF_HBUF = 0;
static constexpr size_t OFF_RKV = 2 * UU;
static constexpr size_t OFF_KK = 5 * UU;
static constexpr size_t OFF_ZR = 6 * UU;
static constexpr size_t OFF_LORA = 12 * UU + UU / 4;
static constexpr size_t OFF_LD = 6 * UU;
static constexpr size_t OFF_A = 8 * UU;
static constexpr size_t OFF_G = 10 * UU;
static constexpr size_t OFF_YF = 11 * UU;
static constexpr size_t OFF_YB = 12 * UU;
static constexpr size_t OFF_RWO = 5 * UU;
static constexpr size_t OFF_ZF = 2 * UU;
static constexpr size_t OFF_ZM = 3 * UU;
static constexpr size_t OFF_Q = 6 * UU;
static constexpr size_t OFF_K = 7 * UU + UU / 2;
static constexpr size_t OFF_VT = 9 * UU;
static constexpr size_t OFF_FFT1 = 10 * UU;
static constexpr size_t OFF_ATT = 12 * UU;
static constexpr size_t OFF_Y = 3 * UU;
static constexpr size_t OFF_M = 6 * UU;
static constexpr size_t OFF_ACT = 2 * UU;
static constexpr size_t OFF_WFFN = 9 * UU;
static constexpr size_t OFF_WMIX = 13 * UU;
static constexpr size_t WE_IN = 0;
static constexpr size_t WE_W2 = WE_IN + 6048ull * 1024;
static constexpr size_t WE_A2 = WE_W2 + 65536;
static constexpr size_t WE_G2 = WE_A2 + 65536;
static constexpr size_t WE_RO = WE_G2 + 65536;
static constexpr size_t WE_MO = WE_RO + 524288;
static constexpr size_t WE_FO = WE_MO + 524288;
static constexpr size_t WE_UQ = WE_FO + 1048576;
static constexpr size_t WE_UKV = WE_UQ + 294912;
static constexpr size_t WE_OUT = WE_UKV + 131072;
static constexpr size_t WE_END = WE_OUT + 1048576;
static constexpr size_t WF_IN = 0;
static constexpr size_t WF_OUT = 5632ull * 1024;
static constexpr size_t OFF_SMALL = OFF_WMIX + WE_END * 2;
static constexpr size_t OFF_CS = OFF_SMALL;
static constexpr size_t OFF_MOD = OFF_CS + 4194304;
static constexpr size_t OFF_TW = OFF_MOD + 245760;
static constexpr size_t OFF_F1 = OFF_TW + 32768;
static constexpr size_t OFF_F2 = OFF_F1 + 16384;
static constexpr size_t OFF_F256 = OFF_F2 + 32768;
static constexpr size_t OFF_ROPE = OFF_F256 + 262144;
static constexpr size_t OFF_BAR = OFF_ROPE + 524288;
static constexpr size_t OFF_TICK = OFF_BAR + 16384;
static constexpr size_t OFF_END = OFF_TICK + 16384;

struct Cx {
  char* ws;
  float* out;
  int tid;
};

struct Params {
  const float* in[33];
  float* out;
  char* ws;
};

__device__ __forceinline__ float bf2f(bf16_t v) { return __uint_as_float(((uint32_t)v) << 16); }
typedef __bf16 bf16v2_t __attribute__((ext_vector_type(2)));
typedef float f32v2_t __attribute__((ext_vector_type(2)));
__device__ __forceinline__ uint32_t pack2(float a, float b) {
  f32v2_t v; v[0] = a; v[1] = b;
  return __builtin_bit_cast(uint32_t, __builtin_convertvector(v, bf16v2_t));
}
__device__ __forceinline__ bf16_t f2bf(float f) { return (bf16_t)(pack2(f, 0.f) & 0xffffu); }
__device__ __forceinline__ float lo16(uint32_t u) { return __uint_as_float(u << 16); }
__device__ __forceinline__ float hi16(uint32_t u) { return __uint_as_float(u & 0xffff0000u); }
__device__ __forceinline__ float sigmoidf_(float v) { return 1.f / (1.f + __expf(-v)); }
__device__ __forceinline__ int mod_row(int row) { return row < NX ? (row >> 12) : 4; }

__device__ __forceinline__ Cx fresh(const Cx& X) {
  int t = X.tid;
  asm volatile("" : "+v"(t));
  return Cx{X.ws, X.out, t};
}

#define XB_TMO      128
#define XB_XCNT(j)  (256  + 64 * (j))
#define XB_XSUB(j)  (1280 + 64 * (j))
#define XB_XGEN(j)  (2304 + 64 * (j))
#define XB_TOP      3328
#define XB_TOPGEN   3392
#define XCD_BAR_WORDS 3456
#define XB_SPIN_CAP (1u << 18)
#define LAS __attribute__((address_space(3)))

__device__ __forceinline__ unsigned xb_ld(unsigned* p)              { return __hip_atomic_load(p, __ATOMIC_RELAXED, __HIP_MEMORY_SCOPE_AGENT); }
__device__ __forceinline__ unsigned xb_add(unsigned* p, unsigned v) { return __hip_atomic_fetch_add(p, v, __ATOMIC_RELAXED, __HIP_MEMORY_SCOPE_AGENT); }
__device__ __forceinline__ unsigned xb_xcc_id() { return (unsigned)__builtin_amdgcn_s_getreg((3 << 11) | 20) & 0xFu; }
#define XB_SPIN(cond, bar) do { unsigned _sp = 0; while (cond) { __builtin_amdgcn_s_sleep(1); \
    if ((++_sp & 255u) == 0u) { if (xb_ld(&(bar)[XB_TMO])) break; if (_sp > XB_SPIN_CAP) { atomicAdd(&(bar)[XB_TMO], 1u); break; } } } } while (0)

struct XcdBarrier {
    unsigned* bar; unsigned x;
    volatile LAS unsigned* st;
};

__device__ __forceinline__ XcdBarrier xcd_barrier_post(unsigned* bar, volatile LAS unsigned* st) {
    XcdBarrier b; b.bar = bar; b.x = xb_xcc_id(); b.st = st;
    if (threadIdx.x == 0) (void)xb_add(&bar[XB_XCNT(b.x)], 1u);
    return b;
}
__device__ __forceinline__ void xcd_barrier_complete(unsigned* bar, unsigned x, unsigned& nloc, unsigned& nx) {
    const unsigned G = gridDim.x * gridDim.y * gridDim.z;
    unsigned sum, cnt, mine, sp = 0u;
    for (;;) {
        sum = 0u; cnt = 0u; mine = 0u;
#pragma unroll
        for (unsigned j = 0; j < 16; ++j) { const unsigned c = xb_ld(&bar[XB_XCNT(j)]); sum += c; cnt += (c > 0u) ? 1u : 0u; mine = (j == x) ? c : mine; }
        if (sum == G) break;
        __builtin_amdgcn_s_sleep(1);
        if ((++sp & 255u) == 0u) { if (xb_ld(&bar[XB_TMO])) break; if (sp > XB_SPIN_CAP) { atomicAdd(&bar[XB_TMO], 1u); break; } }
    }
    nloc = mine > 0u ? mine : 1u; nx = cnt > 0u ? cnt : 1u;
}

__device__ __forceinline__ void xcd_barrier(const XcdBarrier& b) {
    asm volatile("s_waitcnt vmcnt(0)" ::: "memory");
    __syncthreads();
    if (threadIdx.x == 0) {
        unsigned* bar = b.bar;
        __builtin_amdgcn_s_waitcnt(0);
        unsigned nloc = b.st[0], nx = b.st[1];
        if (nloc == 0u) { xcd_barrier_complete(bar, b.x, nloc, nx); b.st[0] = nloc; b.st[1] = nx; }
        const unsigned old = xb_add(&bar[XB_XSUB(b.x)], 1u);
        const unsigned gen = old / nloc;
        if (old + 1u == (gen + 1u) * nloc) {
            __builtin_amdgcn_fence(__ATOMIC_RELEASE, "agent");
            asm volatile("s_waitcnt vmcnt(0)" ::: "memory");
            const unsigned og = xb_add(&bar[XB_TOP], 1u);
            const unsigned tg = og / nx;
            if (og + 1u == (tg + 1u) * nx) xb_add(&bar[XB_TOPGEN], 1u);
            else XB_SPIN(xb_ld(&bar[XB_TOPGEN]) == tg, bar);
            __builtin_amdgcn_fence(__ATOMIC_ACQUIRE, "agent");
            xb_add(&bar[XB_XGEN(b.x)], 1u);
            asm volatile("s_waitcnt vmcnt(0)" ::: "memory");
        } else {
            XB_SPIN(xb_ld(&bar[XB_XGEN(b.x)]) == gen, bar);
            __builtin_amdgcn_fence(__ATOMIC_ACQUIRE, "agent");
            asm volatile("s_waitcnt vmcnt(0)" ::: "memory");
        }
    }
    __syncthreads();
}


template <int BM, int BN, int WGM, int WGN, bool TRB>
struct Gemm {
  static constexpr int WM = BM / WGM, WN = BN / WGN, MT = WM / 32, NTL = WN / 32;
  static constexpr int CA = BM * 8 / 256, CB = BN * 8 / 256;
  static constexpr int SA_ELEMS = BM * 72, SB_ELEMS = BN * 72;

  __device__ static __forceinline__ void zero(f32x16 (&acc)[MT][NTL]) {
#pragma unroll
    for (int i = 0; i < MT; ++i)
#pragma unroll
      for (int j = 0; j < NTL; ++j)
#pragma unroll
        for (int r = 0; r < 16; ++r) acc[i][j][r] = 0.f;
  }

  __device__ static __forceinline__ void run(const Cx& X, const bf16_t* __restrict__ A, int lda, const bf16_t* __restrict__ B, int ldb,
                                             int K, char* smem, f32x16 (&acc)[MT][NTL]) {
    const int tid = X.tid, lane = tid & 63, w = tid >> 6;
    const int wm = w / WGN, wn = w % WGN;
    bf16_t* sA = (bf16_t*)smem;
    bf16_t* sB = sA + 2 * SA_ELEMS;
    uint4 ra0, ra1, ra2, ra3, rb0, rb1, rb2 = make_uint4(0, 0, 0, 0), rb3 = make_uint4(0, 0, 0, 0);
    uint4 qa0, qa1, qa2, qa3, qb0, qb1, qb2 = make_uint4(0, 0, 0, 0), qb3 = make_uint4(0, 0, 0, 0);
    static_assert(CA == 4 && CB >= 2 && CB <= 4, "tile loader shape");
    const int nk = K >> 6;
#define LDA_(i, k0) (*(const uint4*)(A + (size_t)((tid + 256 * (i)) >> 3) * lda + (k0) + ((tid + 256 * (i)) & 7) * 8))
#define LDB_(i, k0)                                                                                                        \
  (!TRB ? *(const uint4*)(B + (size_t)((tid + 256 * (i)) >> 3) * ldb + (k0) + ((tid + 256 * (i)) & 7) * 8)                 \
        : *(const uint4*)(B + (size_t)((k0) + (tid + 256 * (i)) / (BN / 8)) * ldb + ((tid + 256 * (i)) % (BN / 8)) * 8))
#define GLOAD(R, k0)                                                                           \
  {                                                                                            \
    R##a0 = LDA_(0, k0); R##a1 = LDA_(1, k0); R##a2 = LDA_(2, k0); R##a3 = LDA_(3, k0);        \
    R##b0 = LDB_(0, k0); R##b1 = LDB_(1, k0);                                                  \
    if (CB > 2) R##b2 = LDB_(2, k0);                                                           \
    if (CB > 3) R##b3 = LDB_(3, k0);                                                           \
  }
#define STA_(i, buf, v) *(uint4*)(sA + (buf)*SA_ELEMS + ((tid + 256 * (i)) >> 3) * 72 + ((tid + 256 * (i)) & 7) * 8) = v
#define STB_(i, buf, v)                                                                                       \
  {                                                                                                           \
    const int c_ = tid + 256 * (i);                                                                           \
    if (!TRB) *(uint4*)(sB + (buf)*SB_ELEMS + (c_ >> 3) * 72 + (c_ & 7) * 8) = v;                             \
    else {                                                                                                    \
      bf16_t* p = sB + (buf)*SB_ELEMS + (c_ % (BN / 8)) * 8 * 72 + c_ / (BN / 8);                             \
      p[0] = (bf16_t)(v.x & 0xffff); p[72] = (bf16_t)(v.x >> 16);                                             \
      p[144] = (bf16_t)(v.y & 0xffff); p[216] = (bf16_t)(v.y >> 16);                                          \
      p[288] = (bf16_t)(v.z & 0xffff); p[360] = (bf16_t)(v.z >> 16);                                          \
      p[432] = (bf16_t)(v.w & 0xffff); p[504] = (bf16_t)(v.w >> 16);                                          \
    }                                                                                                         \
  }
#define SSTORE(R, buf)                                                                         \
  {                                                                                            \
    STA_(0, buf, R##a0); STA_(1, buf, R##a1); STA_(2, buf, R##a2); STA_(3, buf, R##a3);        \
    STB_(0, buf, R##b0); STB_(1, buf, R##b1);                                                  \
    if (CB > 2) STB_(2, buf, R##b2);                                                           \
    if (CB > 3) STB_(3, buf, R##b3);                                                           \
  }
#define COMPUTE(buf)                                                                                               \
  {                                                                                                                \
    const bf16_t* pa = sA + (buf)*SA_ELEMS + (wm * WM + (lane & 31)) * 72 + (lane >> 5) * 8;                       \
    const bf16_t* pb = sB + (buf)*SB_ELEMS + (wn * WN + (lane & 31)) * 72 + (lane >> 5) * 8;                       \
    _Pragma("unroll") for (int ks = 0; ks < 4; ++ks) {                                                             \
      bf16x8 af[MT], bfr[NTL];                                                                                     \
      _Pragma("unroll") for (int i = 0; i < MT; ++i) af[i] = *(const bf16x8*)(pa + i * 32 * 72 + ks * 16);         \
      _Pragma("unroll") for (int j = 0; j < NTL; ++j) bfr[j] = *(const bf16x8*)(pb + j * 32 * 72 + ks * 16);       \
      _Pragma("unroll") for (int i = 0; i < MT; ++i)                                                               \
        _Pragma("unroll") for (int j = 0; j < NTL; ++j)                                                            \
          acc[i][j] = __builtin_amdgcn_mfma_f32_32x32x16_bf16(af[i], bfr[j], acc[i][j], 0, 0, 0);                  \
    }                                                                                                              \
  }
    if (!TRB) {
      bf16_t* dA = sA;
      bf16_t* dB = sA + 2 * BM * 64;
#define DSTAGE(buf, k0)                                                                                              \
  {                                                                                                                  \
    _Pragma("unroll") for (int i = 0; i < CA; ++i) {                                                                 \
      const int p = tid + 256 * i, r = p >> 3, c = (p & 7) ^ ((r >> 1) & 7);                                         \
      __builtin_amdgcn_global_load_lds((const unsigned*)(A + (size_t)r * lda + (k0) + c * 8),                        \
                                       (LAS unsigned*)(dA + (buf)*BM * 64 + p * 8), 16, 0, 0);                       \
    }                                                                                                                \
    _Pragma("unroll") for (int i = 0; i < CB; ++i) {                                                                 \
      const int p = tid + 256 * i, r = p >> 3, c = (p & 7) ^ ((r >> 1) & 7);                                         \
      __builtin_amdgcn_global_load_lds((const unsigned*)(B + (size_t)r * ldb + (k0) + c * 8),                        \
                                       (LAS unsigned*)(dB + (buf)*BN * 64 + p * 8), 16, 0, 0);                       \
    }                                                                                                                \
  }
      const int swz = (lane >> 1) & 7, hh = lane >> 5;
      DSTAGE(0, 0);
      asm volatile("s_waitcnt vmcnt(0)" ::: "memory");
      __syncthreads();
#pragma unroll 1
      for (int kt = 0; kt < nk; ++kt) {
        const int buf = kt & 1;
        if (kt + 1 < nk) DSTAGE(buf ^ 1, (kt + 1) * 64);
        const bf16_t* pa = dA + buf * BM * 64 + (wm * WM + (lane & 31)) * 64;
        const bf16_t* pb = dB + buf * BN * 64 + (wn * WN + (lane & 31)) * 64;
#pragma unroll
        for (int ks = 0; ks < 4; ++ks) {
          const int co = (((ks * 2 + hh) ^ swz) * 8);
          bf16x8 af[MT], bfr[NTL];
#pragma unroll
          for (int i = 0; i < MT; ++i) af[i] = *(const bf16x8*)(pa + i * 32 * 64 + co);
#pragma unroll
          for (int j = 0; j < NTL; ++j) bfr[j] = *(const bf16x8*)(pb + j * 32 * 64 + co);
#pragma unroll
          for (int i = 0; i < MT; ++i)
#pragma unroll
            for (int j = 0; j < NTL; ++j) acc[i][j] = __builtin_amdgcn_mfma_f32_32x32x16_bf16(af[i], bfr[j], acc[i][j], 0, 0, 0);
        }
        asm volatile("s_waitcnt vmcnt(0)" ::: "memory");
        __syncthreads();
      }
#undef DSTAGE
    } else {
    GLOAD(r, 0);
    if (nk > 1) GLOAD(q, 64);
    SSTORE(r, 0);
    __syncthreads();
    for (int kt = 0; kt < nk; kt += 2) {
      if (kt + 2 < nk) GLOAD(r, (kt + 2) * 64);
      COMPUTE(0);
      if (kt + 1 < nk) SSTORE(q, 1);
      __syncthreads();
      if (kt + 1 >= nk) break;
      if (kt + 3 < nk) GLOAD(q, (kt + 3) * 64);
      COMPUTE(1);
      if (kt + 2 < nk) SSTORE(r, 0);
      __syncthreads();
    }
    }
#undef COMPUTE
#undef GLOAD
#undef SSTORE
#undef LDA_
#undef LDB_
#undef STA_
#undef STB_
  }
};

typedef Gemm<128, 128, 2, 2, false> G22;
typedef Gemm<128, 128, 2, 2, true> G22T;
typedef Gemm<128, 64, 2, 2, false> GMG;
typedef Gemm<128, 96, 4, 1, false> GQ;
typedef Gemm<128, 128, 4, 1, false> GKV;

struct GemmW {
  static constexpr int MT = 2, NTL = 4;
  __device__ static __forceinline__ void zero(f32x16 (&acc)[MT][NTL]) {
#pragma unroll
    for (int i = 0; i < MT; ++i)
#pragma unroll
      for (int j = 0; j < NTL; ++j)
#pragma unroll
        for (int r = 0; r < 16; ++r) acc[i][j][r] = 0.f;
  }
  __device__ static __forceinline__ void run(const Cx& X, const bf16_t* __restrict__ A, int lda, const bf16_t* __restrict__ B, int ldb,
                                             int K, char* smem, f32x16 (&acc)[MT][NTL]) {
    const int tid = X.tid, lane = tid & 63, w = tid >> 6;
    const int wm = w >> 1, wn = w & 1;
    bf16_t* dA = (bf16_t*)smem;
    bf16_t* dB = dA + 2 * 128 * 32;
    const int nk = K >> 5;
#define WSTAGE(buf, k0)                                                                                              \
  {                                                                                                                  \
    _Pragma("unroll") for (int i = 0; i < 2; ++i) {                                                                  \
      const int p = tid + 256 * i, r = p >> 2, c = (p & 3) ^ ((r >> 2) & 3);                                         \
      __builtin_amdgcn_global_load_lds((const unsigned*)(A + (size_t)r * lda + (k0) + c * 8),                        \
                                       (LAS unsigned*)(dA + (buf)*128 * 32 + p * 8), 16, 0, 0);                      \
    }                                                                                                                \
    _Pragma("unroll") for (int i = 0; i < 4; ++i) {                                                                  \
      const int p = tid + 256 * i, r = p >> 2, c = (p & 3) ^ ((r >> 2) & 3);                                         \
      __builtin_amdgcn_global_load_lds((const unsigned*)(B + (size_t)r * ldb + (k0) + c * 8),                        \
                                       (LAS unsigned*)(dB + (buf)*256 * 32 + p * 8), 16, 0, 0);                      \
    }                                                                                                                \
  }
    const int swz = ((lane & 31) >> 2) & 3, hh = lane >> 5;
    WSTAGE(0, 0);
    asm volatile("s_waitcnt vmcnt(0)" ::: "memory");
    __syncthreads();
#pragma unroll 1
    for (int kt = 0; kt < nk; ++kt) {
      const int buf = kt & 1;
      if (kt + 1 < nk) WSTAGE(buf ^ 1, (kt + 1) * 32);
      const bf16_t* pa = dA + buf * 128 * 32 + (wm * 64 + (lane & 31)) * 32;
      const bf16_t* pb = dB + buf * 256 * 32 + (wn * 128 + (lane & 31)) * 32;
#pragma unroll
      for (int ks = 0; ks < 2; ++ks) {
        const int co = (((ks * 2 + hh) ^ swz) * 8);
        bf16x8 af[MT], bfr[NTL];
#pragma unroll
        for (int i = 0; i < MT; ++i) af[i] = *(const bf16x8*)(pa + i * 32 * 32 + co);
#pragma unroll
        for (int j = 0; j < NTL; ++j) bfr[j] = *(const bf16x8*)(pb + j * 32 * 32 + co);
#pragma unroll
        for (int i = 0; i < MT; ++i)
#pragma unroll
          for (int j = 0; j < NTL; ++j) acc[i][j] = __builtin_amdgcn_mfma_f32_32x32x16_bf16(af[i], bfr[j], acc[i][j], 0, 0, 0);
      }
      asm volatile("s_waitcnt vmcnt(0)" ::: "memory");
      __syncthreads();
    }
#undef WSTAGE
  }
};

#define ROW_OF(reg) (((reg) & 3) + 8 * ((reg) >> 2) + 4 * (lane >> 5))

__device__ __forceinline__ void job_mod(const Params& P, const Cx& X, char* smem, int job) {
  float* sc = (float*)smem;
  const int tid = X.tid;
  for (int i = tid; i < 5 * 1024; i += 256) {
    int r = i >> 10, k = i & 1023;
    float v = r < 4 ? P.in[1][r * 1024 + k] : P.in[3][k];
    sc[i] = v / (1.f + expf(-v));
  }
  __syncthreads();
  const int l = job / 96, n = (job % 96) * 64 + (tid & 63), w = tid >> 6;
  const float* W = P.in[4] + (size_t)l * 1024 * 6144;
  float a0 = 0, a1 = 0, a2 = 0, a3 = 0, a4 = 0;
#pragma unroll 16
  for (int k = w * 256; k < w * 256 + 256; ++k) {
    float wv = W[(size_t)k * 6144 + n];
    a0 += sc[k] * wv; a1 += sc[1024 + k] * wv; a2 += sc[2048 + k] * wv; a3 += sc[3072 + k] * wv; a4 += sc[4096 + k] * wv;
  }
  float* red = sc + 5 * 1024;
  red[(w * 5 + 0) * 64 + (tid & 63)] = a0; red[(w * 5 + 1) * 64 + (tid & 63)] = a1; red[(w * 5 + 2) * 64 + (tid & 63)] = a2;
  red[(w * 5 + 3) * 64 + (tid & 63)] = a3; red[(w * 5 + 4) * 64 + (tid & 63)] = a4;
  __syncthreads();
  float* modv = (float*)(X.ws + OFF_MOD);
  for (int i = tid; i < 320; i += 256) {
    int r = i >> 6, c = i & 63;
    int nn = (job % 96) * 64 + c;
    float s = red[(0 * 5 + r) * 64 + c] + red[(1 * 5 + r) * 64 + c] + red[(2 * 5 + r) * 64 + c] + red[(3 * 5 + r) * 64 + c];
    modv[(size_t)(l * 5 + r) * 6144 + nn] = s + P.in[5][l * 6144 + nn];
  }
  __syncthreads();
}

__device__ __forceinline__ void job_tables(const Params& P, const Cx& X, int job) {
  float2* tw = (float2*)(X.ws + OFF_TW);
  bf16_t* F1 = (bf16_t*)(X.ws + OFF_F1);
  bf16_t* F2 = (bf16_t*)(X.ws + OFF_F2);
  bf16_t* F256 = (bf16_t*)(X.ws + OFF_F256);
  float2* rope = (float2*)(X.ws + OFF_ROPE);
  for (int e = job * 4096 + X.tid; e < job * 4096 + 4096; e += 256) {
    int i = e;
    if (i < 4096) { tw[i] = make_float2(cospif(i / 2048.f), sinpif(i / 2048.f)); continue; }
    i -= 4096;
    if (i < 8192) {
      int R = i >> 6, t1 = i & 63;
      int f1 = (R >> 6) * 32 + (R & 31);
      int ph = (f1 * t1) & 63;
      F1[i] = f2bf(((R >> 5) & 1) ? -sinpif(ph / 32.f) : cospif(ph / 32.f));
      continue;
    }
    i -= 8192;
    if (i < 16384) {
      int m = i >> 7, k = i & 127;
      int f2 = m & 63, q = m >> 6, t2 = k & 63, p = k >> 6;
      int ph = (f2 * t2) & 63;
      float c = cospif(ph / 32.f), s = sinpif(ph / 32.f);
      float v = (q == 0) ? (p == 0 ? c : s) : (p == 0 ? -s : c);
      F2[i] = f2bf(v);
      continue;
    }
    i -= 16384;
    if (i < 131072) {
      int m = i >> 8, t = i & 255;
      int f = m & 255, q = m >> 8;
      int ph = (f * t) & 255;
      F256[i] = f2bf(q == 0 ? cospif(ph / 128.f) : -sinpif(ph / 128.f));
      continue;
    }
    i -= 131072;
    if (i < 65536) {
      int t = i >> 4, j = i & 15;
      float invf = powf(10000.f, -(float)(j & 7) / 8.f);
      float pos = (j < 8) ? (float)(t >> 6) : (float)(t & 63);
      float ang = pos * invf;
      rope[i] = make_float2(cosf(ang), sinf(ang));
    }
  }
}

__device__ __forceinline__ void cw_tile(const Cx& X, const float* __restrict__ src, int N, int lds_, bf16_t* __restrict__ dst, int ldd, const float* scale,
                        int perm, int tk, int tn, char* smem) {
  float* tile = (float*)smem;
  const int tid = X.tid;
  const int c = tid & 63, r0 = tid >> 6;
  const int ng = tn * 64 + c;
#pragma unroll 4
  for (int i = 0; i < 16; ++i) {
    int r = r0 + 4 * i;
    float v = (ng < N) ? src[(size_t)(tk * 64 + r) * lds_ + ng] : 0.f;
    if (scale) v *= scale[tk * 64 + r];
    tile[r * 65 + c] = v;
  }
  __syncthreads();
#pragma unroll 4
  for (int i = 0; i < 16; ++i) {
    int nn = r0 + 4 * i;
    int n2 = tn * 64 + nn;
    if (n2 < N) {
      int drow = n2;
      if (perm) {
        int u = n2 < 2816 ? n2 : n2 - 2816;
        drow = (u >> 5) * 64 + (n2 < 2816 ? 0 : 32) + (u & 31);
      }
      dst[(size_t)drow * ldd + tk * 64 + c] = f2bf(tile[c * 65 + nn]);
    }
  }
  __syncthreads();
}

__device__ __forceinline__ void fold_job(const Params& P, const Cx& X, int layer, int fj, char* smem) {
  float* wt = (float*)smem;
  float* ct = wt + 4096;
  const int tid = X.tid;
  const int g = fj >> 4, n0 = (fj & 15) * 64;
  const float* src = P.in[28] + (size_t)layer * 512 * 1024;
  for (int i = tid; i < 4096; i += 256) wt[i] = src[(size_t)(g * 64 + (i >> 6)) * 1024 + n0 + (i & 63)];
  if (tid < 64) { ct[tid] = cospif(tid / 32.f); ct[64 + tid] = sinpif(tid / 32.f); }
  __syncthreads();
  bf16_t* dst = (bf16_t*)(X.ws + OFF_WMIX) + WE_FO;
  const int c = tid & 63, nq = tid >> 6;
#pragma unroll 1
  for (int ni = 0; ni < 16; ++ni) {
    int n = nq * 16 + ni;
    float sr = 0.f, si = 0.f;
#pragma unroll 4
    for (int cp = 0; cp < 64; ++cp) {
      float wv = wt[cp * 64 + n];
      int ph = (c * cp) & 63;
      sr += ct[ph] * wv;
      si += ct[64 + ph] * wv;
    }
    dst[(size_t)(n0 + n) * 1024 + g * 64 + c] = f2bf(sr * (1.f / 512.f));
    dst[(size_t)(n0 + n) * 1024 + 512 + g * 64 + c] = f2bf(si * (1.f / 512.f));
  }
  __syncthreads();
}

#define NCW1 2312
__device__ __forceinline__ void cw_mixer_job(const Params& P, const Cx& X, int layer, int j, char* smem) {
  bf16_t* W = (bf16_t*)(X.ws + OFF_WMIX);
  const float* src; const float* scale = nullptr; bf16_t* dst; int N, ldd, tk, tn;
  if (j >= 2184) { fold_job(P, X, layer, j - 2184, smem); return; }
  if (j < 1520) { src = P.in[7] + (size_t)layer * 1024 * 6048; N = 6048; dst = W + WE_IN; ldd = 1024; tk = j / 95; tn = j % 95; }
  else if (j < 1536) { j -= 1520; int d = j >> 3; src = P.in[11] + (size_t)(layer * 2 + d) * 64 * 512; N = 512; dst = W + WE_W2 + d * 32768; ldd = 64; tk = 0; tn = j & 7; }
  else if (j < 1552) { j -= 1536; int d = j >> 3; src = P.in[13] + (size_t)(layer * 2 + d) * 64 * 512; N = 512; dst = W + WE_A2 + d * 32768; ldd = 64; tk = 0; tn = j & 7; }
  else if (j < 1568) { j -= 1552; src = P.in[17] + (size_t)layer * 128 * 512; N = 512; dst = W + WE_G2; ldd = 128; tk = j >> 3; tn = j & 7; }
  else if (j < 1696) { j -= 1568; src = P.in[20] + (size_t)layer * 512 * 1024; N = 1024; dst = W + WE_RO; ldd = 512; tk = j >> 4; tn = j & 15; }
  else if (j < 1824) { j -= 1696; src = P.in[27] + (size_t)layer * 512 * 1024; N = 1024; dst = W + WE_MO; ldd = 512; tk = j >> 4; tn = j & 15; }
  else if (j < 1896) { j -= 1824; src = P.in[23] + (size_t)layer * 384 * 768; N = 768; dst = W + WE_UQ; ldd = 384; scale = P.in[21] + layer * 384; tk = j / 12; tn = j % 12; }
  else if (j < 1928) { j -= 1896; src = P.in[24] + (size_t)layer * 128 * 1024; N = 1024; dst = W + WE_UKV; ldd = 128; scale = P.in[22] + layer * 128; tk = j >> 4; tn = j & 15; }
  else { j -= 1928; src = P.in[29] + (size_t)layer * 1024 * 1024; N = 1024; dst = W + WE_OUT; ldd = 1024; tk = j >> 4; tn = j & 15; }
  cw_tile(X, src, N, N, dst, ldd, scale, 0, tk, tn, smem);
}
#define NCW2 2112
__device__ __forceinline__ void cw_ffn_job(const Params& P, const Cx& X, int layer, int j, char* smem) {
  bf16_t* W = (bf16_t*)(X.ws + OFF_WFFN);
  const float* src; bf16_t* dst; int N, ldd, tk, tn, perm;
  if (j < 1408) { src = P.in[31] + (size_t)layer * 1024 * 5632; N = 5632; dst = W + WF_IN; ldd = 1024; perm = 1; tk = j / 88; tn = j % 88; }
  else { j -= 1408; src = P.in[32] + (size_t)layer * 2816 * 1024; N = 1024; dst = W + WF_OUT; ldd = 2816; perm = 0; tk = j >> 4; tn = j & 15; }
  cw_tile(X, src, N, N, dst, ldd, nullptr, perm, tk, tn, smem);
}

__device__ __forceinline__ void norm_job(const Params& P, const Cx& X, int layer, int which, int job) {
  const int lane = X.tid & 63, w = X.tid >> 6;
  const int row = job * 4 + w;
  const float* src;
  if (which == 0) {
    if (row < NX) src = (layer == 0 ? P.in[0] : X.out) + (size_t)row * 1024;
    else src = (layer == 0 ? P.in[2] : (const float*)(X.ws + OFF_CS)) + (size_t)(row - NX) * 1024;
  } else {
    if (row < NX) src = X.out + (size_t)row * 1024;
    else src = (const float*)(X.ws + OFF_CS) + (size_t)(row - NX) * 1024;
  }
  const float* g = (which == 0 ? P.in[6] : P.in[30]) + layer * 1024;
  const float* modv = (const float*)(X.ws + OFF_MOD) + (size_t)(layer * 5 + mod_row(row)) * 6144;
  const float* shift = modv + (which == 0 ? 0 : 3072);
  const float* scale = modv + (which == 0 ? 1024 : 4096);
  float4 v[4];
  float ss = 0.f;
#pragma unroll
  for (int i = 0; i < 4; ++i) {
    v[i] = ((const float4*)src)[lane + 64 * i];
    ss += v[i].x * v[i].x + v[i].y * v[i].y + v[i].z * v[i].z + v[i].w * v[i].w;
  }
#pragma unroll
  for (int o = 32; o >= 1; o >>= 1) ss += __shfl_xor(ss, o);
  const float rstd = rsqrtf(ss * (1.f / 1024.f) + 1e-6f);
  bf16_t* dst = (bf16_t*)(X.ws + OFF_HBUF) + (size_t)row * 1024;
#pragma unroll
  for (int i = 0; i < 4; ++i) {
    int col = 4 * (lane + 64 * i);
    float4 gg = *(const float4*)(g + col), sh = *(const float4*)(shift + col), sc = *(const float4*)(scale + col);
    float y0 = v[i].x * rstd * gg.x * (1.f + sc.x) + sh.x;
    float y1 = v[i].y * rstd * gg.y * (1.f + sc.y) + sh.y;
    float y2 = v[i].z * rstd * gg.z * (1.f + sc.z) + sh.z;
    float y3 = v[i].w * rstd * gg.w * (1.f + sc.w) + sh.w;
    uint2 o;
    o.x = pack2(y0, y1); o.y = pack2(y2, y3);
    *(uint2*)(dst + col) = o;
  }
}

__device__ __forceinline__ void g1a_tile(const Params& P, const Cx& X, int t, char* smem) {
  const int lane = X.tid & 63, w = X.tid >> 6;
  const int mt = t % 136, nt = t / 136;
  const int m0 = mt * 128, n0 = nt * 128;
  f32x16 acc[2][2];
  G22::zero(acc);
  G22::run(X, (const bf16_t*)(X.ws + OFF_HBUF) + (size_t)m0 * 1024, 1024, (const bf16_t*)(X.ws + OFF_WMIX) + WE_IN + (size_t)n0 * 1024, 1024, 1024, smem, acc);
  bf16_t* zr = (bf16_t*)(X.ws + OFF_ZR);
  const int row0 = m0 + (w >> 1) * 64, col0 = n0 + (w & 1) * 64;
#pragma unroll
  for (int i = 0; i < 2; ++i)
#pragma unroll
    for (int j = 0; j < 2; ++j)
#pragma unroll
      for (int r = 0; r < 16; ++r) {
        int row = row0 + i * 32 + ROW_OF(r), col = col0 + j * 32 + (lane & 31);
        zr[(size_t)row * 1920 + col] = f2bf(acc[i][j][r]);
      }
}
__device__ __forceinline__ void g1b_tile(const Params& P, const Cx& X, int t, char* smem) {
  const int lane = X.tid & 63, w = X.tid >> 6;
  const int mt = t % 136, nt = t / 136;
  const int m0 = mt * 128, n0 = nt * 128;
  f32x16 acc[2][2];
  G22::zero(acc);
  G22::run(X, (const bf16_t*)(X.ws + OFF_HBUF) + (size_t)m0 * 1024, 1024, (const bf16_t*)(X.ws + OFF_WMIX) + WE_IN + (size_t)(1920 + n0) * 1024, 1024, 1024, smem, acc);
  bf16_t* zm = (bf16_t*)(X.ws + OFF_ZM);
  bf16_t* zf = (bf16_t*)(X.ws + OFF_ZF);
  const int row0 = m0 + (w >> 1) * 64, col0 = n0 + (w & 1) * 64;
#pragma unroll
  for (int i = 0; i < 2; ++i)
#pragma unroll
    for (int j = 0; j < 2; ++j)
#pragma unroll
      for (int r = 0; r < 16; ++r) {
        int row = row0 + i * 32 + ROW_OF(r), col = col0 + j * 32 + (lane & 31);
        bf16_t v = f2bf(acc[i][j][r]);
        if (col < 544) zm[(size_t)row * 544 + col] = v;
        else if (col < 1056) zf[(size_t)row * 512 + (col - 544)] = v;
      }
}

__device__ __forceinline__ void r1a_row(const Params& P, const Cx& X, int layer, int row) {
  const int tid = X.tid;
  const int ch = tid < 240 ? tid : 239;
  const int col0 = ch * 8;
  const bf16_t* zr = (const bf16_t*)(X.ws + OFF_ZR);
  bool hp, hn;
  if (row < NX) { int t = row & 4095; hp = t > 0; hn = t < 4095; }
  else { int j = (row - NX) & 255; hp = j > 0; hn = j < 255; }
  uint4 zc = *(const uint4*)(zr + (size_t)row * 1920 + col0);
  uint4 zp = make_uint4(0, 0, 0, 0), zn = make_uint4(0, 0, 0, 0);
  if (hp) zp = *(const uint4*)(zr + (size_t)(row - 1) * 1920 + col0);
  if (hn) zn = *(const uint4*)(zr + (size_t)(row + 1) * 1920 + col0);
  const float* mup = P.in[8] + layer * 1920 + col0;
  const float* mun = P.in[9] + layer * 1920 + col0;
  float zs[8];
  {
    const uint32_t c4[4] = {zc.x, zc.y, zc.z, zc.w}, p4[4] = {zp.x, zp.y, zp.z, zp.w}, n4[4] = {zn.x, zn.y, zn.z, zn.w};
#pragma unroll
    for (int i = 0; i < 4; ++i) {
      float c0 = lo16(c4[i]), c1 = hi16(c4[i]);
      zs[2 * i] = c0 + (lo16(p4[i]) - c0) * mup[2 * i] + (lo16(n4[i]) - c0) * mun[2 * i];
      zs[2 * i + 1] = c1 + (hi16(p4[i]) - c1) * mup[2 * i + 1] + (hi16(n4[i]) - c1) * mun[2 * i + 1];
    }
  }
  float ss = 0.f;
  float kv[8];
  const bool isk = (col0 >= 512 && col0 < 1024);
  {
    const float* kk_w = P.in[14] + layer * 512 + (isk ? col0 - 512 : 0);
#pragma unroll
    for (int i = 0; i < 8; ++i) { kv[i] = zs[i] * kk_w[i]; ss += kv[i] * kv[i]; }
  }
  ss += __shfl_xor(ss, 1); ss += __shfl_xor(ss, 2); ss += __shfl_xor(ss, 4);
  if (tid < 240) {
    uint4 o;
    if (col0 < 1536) {
      o.x = pack2(zs[0], zs[1]); o.y = pack2(zs[2], zs[3]); o.z = pack2(zs[4], zs[5]); o.w = pack2(zs[6], zs[7]);
      *(uint4*)((bf16_t*)(X.ws + OFF_RKV) + (size_t)row * 1536 + col0) = o;
      if (isk) {
        float inv = 1.f / fmaxf(sqrtf(ss), 1e-12f);
        o.x = pack2(kv[0] * inv, kv[1] * inv); o.y = pack2(kv[2] * inv, kv[3] * inv);
        o.z = pack2(kv[4] * inv, kv[5] * inv); o.w = pack2(kv[6] * inv, kv[7] * inv);
        *(uint4*)((bf16_t*)(X.ws + OFF_KK) + (size_t)row * 512 + (col0 - 512)) = o;
      }
    } else {
      float t[8];
      if (col0 < 1664) {
#pragma unroll
        for (int i = 0; i < 8; ++i) t[i] = tanhf(zs[i]);
      } else if (col0 < 1792) {
#pragma unroll
        for (int i = 0; i < 8; ++i) t[i] = zs[i];
      } else {
#pragma unroll
        for (int i = 0; i < 8; ++i) t[i] = 1.f / (1.f + expf(-zs[i]));
      }
      o.x = pack2(t[0], t[1]); o.y = pack2(t[2], t[3]); o.z = pack2(t[4], t[5]); o.w = pack2(t[6], t[7]);
      *(uint4*)((bf16_t*)(X.ws + OFF_LORA) + (size_t)row * 384 + (col0 - 1536)) = o;
    }
  }
}

__device__ __forceinline__ void r1b_tile(const Params& P, const Cx& X, int layer, int t, char* smem) {
  const int lane = X.tid & 63, w = X.tid >> 6;
  const int mt = t % 136, rest = t / 136;
  const int nt = rest & 3, type = rest >> 2;
  const int m0 = mt * 128, n0 = nt * 128;
  const bf16_t* lora = (const bf16_t*)(X.ws + OFF_LORA) + (size_t)m0 * 384;
  const bf16_t* W = (const bf16_t*)(X.ws + OFF_WMIX);
  f32x16 acc[2][2];
  G22::zero(acc);
  if (type < 2) G22::run(X, lora + type * 64, 384, W + WE_W2 + type * 32768 + (size_t)n0 * 64, 64, 64, smem, acc);
  else if (type < 4) G22::run(X, lora + 128 + (type - 2) * 64, 384, W + WE_A2 + (type - 2) * 32768 + (size_t)n0 * 64, 64, 64, smem, acc);
  else G22::run(X, lora + 256, 384, W + WE_G2 + (size_t)n0 * 128, 128, 128, smem, acc);
  const int row0 = m0 + (w >> 1) * 64, col0 = n0 + (w & 1) * 64;
  bf16_t* ld = (bf16_t*)(X.ws + OFF_LD);
  bf16_t* ab = (bf16_t*)(X.ws + OFF_A);
  bf16_t* gb = (bf16_t*)(X.ws + OFF_G);
#pragma unroll
  for (int j = 0; j < 2; ++j) {
    const int col = col0 + j * 32 + (lane & 31);
    float bias = 0.f;
    if (type < 2) bias = P.in[10][(layer * 2 + type) * 512 + col];
    else if (type < 4) bias = P.in[12][(layer * 2 + type - 2) * 512 + col];
#pragma unroll
    for (int i = 0; i < 2; ++i)
#pragma unroll
      for (int r = 0; r < 16; ++r) {
        int row = row0 + i * 32 + ROW_OF(r);
        float v = acc[i][j][r] + bias;
        if (type < 2) ld[(size_t)row * 1024 + type * 512 + col] = f2bf(-0.60653066f / (1.f + __expf(-v)));
        else if (type < 4) ab[(size_t)row * 1024 + (type - 2) * 512 + col] = f2bf(1.f / (1.f + __expf(-v)));
        else gb[(size_t)row * 512 + col] = f2bf(v);
      }
  }
}

template <int CTRL>
__device__ __forceinline__ float dpp_f(float x) {
  return __int_as_float(__builtin_amdgcn_update_dpp(0, __float_as_int(x), CTRL, 0xf, 0xf, false));
}
__device__ __forceinline__ float red16(float x) {
  x += dpp_f<0x128>(x);
  x += dpp_f<0x124>(x);
  x += dpp_f<0x4E>(x);
  x += dpp_f<0xB1>(x);
  return x;
}
__device__ __forceinline__ int scan_tokrow(int b, int dir, int i) {
  if (i < 256) return NX + b * 256 + (dir ? 255 - i : i);
  int t = i - 256;
  return b * 4096 + (dir ? 4095 - t : t);
}
typedef float f2_t __attribute__((ext_vector_type(2)));
__device__ __forceinline__ void scan_job(const Params& P, const Cx& X, int layer, int bj, char* smem) {
  const int tid = X.tid, lane = tid & 63, w = tid >> 6;
  const int s = bj >> 2, rq = bj & 3;
  const int dir = s >> 5, b = (s & 31) >> 3, h = s & 7;
  float* sv = (float*)smem;
  float* sy = sv + 2 * 16 * 6 * 64;
  const bf16_t* rkv = (const bf16_t*)(X.ws + OFF_RKV);
  const bf16_t* kkb = (const bf16_t*)(X.ws + OFF_KK);
  const bf16_t* ab = (const bf16_t*)(X.ws + OFF_A);
  const bf16_t* ldb = (const bf16_t*)(X.ws + OFF_LD);
  bf16_t* yout = (bf16_t*)(X.ws + (dir ? OFF_YB : OFF_YF));
  const int lst = tid >> 4, lch = (tid & 15) * 4;
  const float4 ka4 = *(const float4*)(P.in[15] + layer * 512 + h * 64 + lch);
  uint2 pr, pk, pv, pkk, pa, pl;
#define SLOAD(chunk)                                                          \
  {                                                                           \
    int row = scan_tokrow(b, dir, (chunk)*16 + lst);                          \
    const bf16_t* p0 = rkv + (size_t)row * 1536 + h * 64 + lch;               \
    pr = *(const uint2*)p0; pk = *(const uint2*)(p0 + 512); pv = *(const uint2*)(p0 + 1024); \
    pkk = *(const uint2*)(kkb + (size_t)row * 512 + h * 64 + lch);            \
    pa = *(const uint2*)(ab + (size_t)row * 1024 + dir * 512 + h * 64 + lch); \
    pl = *(const uint2*)(ldb + (size_t)row * 1024 + dir * 512 + h * 64 + lch);\
  }
#define SSTORE2(buf)                                                          \
  {                                                                           \
    float* d = sv + ((buf)*16 + lst) * 384 + lch;                             \
    float a0 = lo16(pa.x), a1 = hi16(pa.x), a2 = lo16(pa.y), a3 = hi16(pa.y); \
    float k0 = lo16(pk.x), k1 = hi16(pk.x), k2 = lo16(pk.y), k3 = hi16(pk.y); \
    float q0 = lo16(pkk.x), q1 = hi16(pkk.x), q2 = lo16(pkk.y), q3 = hi16(pkk.y); \
    *(float4*)(d) = make_float4(q0, q1, q2, q3);                              \
    *(float4*)(d + 64) = make_float4(__expf(lo16(pl.x)), __expf(hi16(pl.x)), __expf(lo16(pl.y)), __expf(hi16(pl.y))); \
    *(float4*)(d + 128) = make_float4(q0 * a0, q1 * a1, q2 * a2, q3 * a3);    \
    *(float4*)(d + 192) = make_float4(k0 * (1.f + (a0 - 1.f) * ka4.x), k1 * (1.f + (a1 - 1.f) * ka4.y), k2 * (1.f + (a2 - 1.f) * ka4.z), k3 * (1.f + (a3 - 1.f) * ka4.w)); \
    *(float4*)(d + 256) = make_float4(lo16(pr.x), hi16(pr.x), lo16(pr.y), hi16(pr.y)); \
    *(float4*)(d + 320) = make_float4(lo16(pv.x), hi16(pv.x), lo16(pv.y), hi16(pv.y)); \
  }
  SLOAD(0);
  SSTORE2(0);
  __syncthreads();
  const int rp = lane >> 4, ci = (lane & 15) * 4;
  const int vrow = rq * 16 + w * 4 + rp;
  float S0 = 0.f, S1 = 0.f, S2 = 0.f, S3 = 0.f, qy = 0.f;
  for (int chunk = 0; chunk < 272; ++chunk) {
    const int buf = chunk & 1;
    SLOAD(chunk + 1 < 272 ? chunk + 1 : 271);
    __builtin_amdgcn_sched_barrier(0);
    {
      const float* base = sv + buf * 16 * 384;
      float ysel = 0.f;
      qy = 0.f;
      float4 p0kk, p0w, p0b, p0kd, p0r, p1kk, p1w, p1b, p1kd, p1r;
      float p0v, p1v;
#define LDS_SET(S, st)                                     \
  {                                                        \
    const float* d = base + (st)*384;                      \
    S##kk = *(const float4*)(d + ci);                      \
    S##w = *(const float4*)(d + 64 + ci);                  \
    S##b = *(const float4*)(d + 128 + ci);                 \
    S##kd = *(const float4*)(d + 192 + ci);                \
    S##r = *(const float4*)(d + 256 + ci);                 \
    S##v = d[320 + vrow];                                  \
  }
#define DPPS "row_mask:0xf bank_mask:0xf bound_ctrl:1\n"
#define STEP(S, st)                                                                                   \
  {                                                                                                   \
    float t0, t1, u0, u1, u2, u3;                                                                     \
    asm volatile(                                                                                     \
        "v_mul_f32 %5, %0, %11\n"                                                                     \
        "v_mul_f32 %6, %1, %12\n"                                                                     \
        "v_fma_f32 %5, %2, %13, %5\n"                                                                 \
        "v_fma_f32 %6, %3, %14, %6\n"                                                                 \
        "v_mul_f32 %7, %27, %23\n"                                                                    \
        "v_add_f32 %5, %5, %6\n"                                                                      \
        "v_mul_f32 %8, %27, %24\n"                                                                    \
        "v_mul_f32 %9, %27, %25\n"                                                                    \
        "v_add_f32_dpp %5, %5, %5 row_ror:8 " DPPS                                                    \
        "v_add_f32_dpp %4, %4, %4 row_ror:8 " DPPS                                                    \
        "v_mul_f32 %10, %27, %26\n"                                                                   \
        "v_add_f32_dpp %5, %5, %5 row_ror:4 " DPPS                                                    \
        "v_add_f32_dpp %4, %4, %4 row_ror:4 " DPPS                                                    \
        "v_fma_f32 %7, %0, %15, %7\n"                                                                 \
        "v_add_f32_dpp %5, %5, %5 quad_perm:[2,3,0,1] " DPPS                                          \
        "v_add_f32_dpp %4, %4, %4 quad_perm:[2,3,0,1] " DPPS                                          \
        "v_fma_f32 %8, %1, %16, %8\n"                                                                 \
        "v_add_f32_dpp %5, %5, %5 quad_perm:[1,0,3,2] " DPPS                                          \
        "v_add_f32_dpp %4, %4, %4 quad_perm:[1,0,3,2] " DPPS                                          \
        "v_fma_f32 %9, %2, %17, %9\n"                                                                 \
        "v_fma_f32 %10, %3, %18, %10\n"                                                               \
        "v_fma_f32 %0, -%5, %19, %7\n"                                                                \
        "v_fma_f32 %1, -%5, %20, %8\n"                                                                \
        "v_fma_f32 %2, -%5, %21, %9\n"                                                                \
        "v_fma_f32 %3, -%5, %22, %10\n"                                                               \
        : "+v"(S0), "+v"(S1), "+v"(S2), "+v"(S3), "+v"(qy), "=&v"(t0), "=&v"(t1), "=&v"(u0), "=&v"(u1), \
          "=&v"(u2), "=&v"(u3)                                                                        \
        : "v"(S##kk.x), "v"(S##kk.y), "v"(S##kk.z), "v"(S##kk.w), "v"(S##w.x), "v"(S##w.y), "v"(S##w.z), \
          "v"(S##w.w), "v"(S##b.x), "v"(S##b.y), "v"(S##b.z), "v"(S##b.w), "v"(S##kd.x), "v"(S##kd.y), \
          "v"(S##kd.z), "v"(S##kd.w), "v"(S##v));                                                     \
                                                 \
    if ((st) > 0) ysel = ((lane & 15) == (st)-1) ? qy : ysel;                                         \
    qy = fmaf(S2, S##r.z, S0 * S##r.x) + fmaf(S3, S##r.w, S1 * S##r.y);                               \
  }
      LDS_SET(p0, 0);
#pragma unroll
      for (int st = 0; st < 16; st += 2) {
        LDS_SET(p1, st + 1);
        __builtin_amdgcn_sched_barrier(0);
        STEP(p0, st);
        if (st + 2 < 16) LDS_SET(p0, st + 2);
        __builtin_amdgcn_sched_barrier(0);
        STEP(p1, st + 1);
      }
#undef LDS_SET
#undef STEP
#undef DPPS
      qy = red16(qy);
      ysel = ((lane & 15) == 15) ? qy : ysel;
      sy[(buf * 16 + (lane & 15)) * 16 + w * 4 + rp] = ysel;
    }
    if (chunk + 1 < 272) SSTORE2(buf ^ 1);
    __syncthreads();
    {
      int st = tid >> 4, r = tid & 15;
      int row = scan_tokrow(b, dir, chunk * 16 + st);
      yout[(size_t)row * 512 + h * 64 + rq * 16 + r] = f2bf(sy[(buf * 16 + st) * 16 + r]);
    }
  }
#undef SLOAD
#undef SSTORE2
  __syncthreads();
}

__device__ __forceinline__ void s2_job(const Params& P, const Cx& X, int layer, int job) {
  const int tid = X.tid;
  const int row = job * 4 + (tid >> 6);
  const int c0 = (tid & 63) * 8;
  const bf16_t* rkv = (const bf16_t*)(X.ws + OFF_RKV) + (size_t)row * 1536;
  uint4 ur = *(const uint4*)(rkv + c0), uk = *(const uint4*)(rkv + 512 + c0), uv = *(const uint4*)(rkv + 1024 + c0);
  uint4 ua0 = *(const uint4*)((const bf16_t*)(X.ws + OFF_A) + (size_t)row * 1024 + c0);
  uint4 ua1 = *(const uint4*)((const bf16_t*)(X.ws + OFF_A) + (size_t)row * 1024 + 512 + c0);
  uint4 ug = *(const uint4*)((const bf16_t*)(X.ws + OFF_G) + (size_t)row * 512 + c0);
  uint4 uyf = *(const uint4*)((const bf16_t*)(X.ws + OFF_YF) + (size_t)row * 512 + c0);
  uint4 uyb = *(const uint4*)((const bf16_t*)(X.ws + OFF_YB) + (size_t)row * 512 + c0);
  const uint32_t r4[4] = {ur.x, ur.y, ur.z, ur.w}, k4[4] = {uk.x, uk.y, uk.z, uk.w}, v4[4] = {uv.x, uv.y, uv.z, uv.w};
  const uint32_t a04[4] = {ua0.x, ua0.y, ua0.z, ua0.w}, a14[4] = {ua1.x, ua1.y, ua1.z, ua1.w}, g4[4] = {ug.x, ug.y, ug.z, ug.w};
  const uint32_t yf4[4] = {uyf.x, uyf.y, uyf.z, uyf.w}, yb4[4] = {uyb.x, uyb.y, uyb.z, uyb.w};
  float y[8], vv[8], gg[8];
  float sum = 0.f, bon = 0.f;
  const float* rk = P.in[16] + layer * 512 + c0;
  const float* ka = P.in[15] + layer * 512 + c0;
#pragma unroll
  for (int i = 0; i < 4; ++i) {
#pragma unroll
    for (int hh = 0; hh < 2; ++hh) {
      int e = 2 * i + hh;
      float r = hh ? hi16(r4[i]) : lo16(r4[i]);
      float k = hh ? hi16(k4[i]) : lo16(k4[i]);
      float a0 = hh ? hi16(a04[i]) : lo16(a04[i]);
      float a1 = hh ? hi16(a14[i]) : lo16(a14[i]);
      y[e] = (hh ? hi16(yf4[i]) : lo16(yf4[i])) + (hh ? hi16(yb4[i]) : lo16(yb4[i]));
      vv[e] = hh ? hi16(v4[i]) : lo16(v4[i]);
      gg[e] = hh ? hi16(g4[i]) : lo16(g4[i]);
      sum += y[e];
      float ksum = k * (2.f + (a0 + a1 - 2.f) * ka[e]);
      bon += r * rk[e] * ksum;
    }
  }
  sum += __shfl_xor(sum, 1); sum += __shfl_xor(sum, 2); sum += __shfl_xor(sum, 4);
  bon += __shfl_xor(bon, 1); bon += __shfl_xor(bon, 2); bon += __shfl_xor(bon, 4);
  const float mu = sum * (1.f / 64.f);
  float var = 0.f;
#pragma unroll
  for (int e = 0; e < 8; ++e) { float d = y[e] - mu; var += d * d; }
  var += __shfl_xor(var, 1); var += __shfl_xor(var, 2); var += __shfl_xor(var, 4);
  const float rs = rsqrtf(var * (1.f / 64.f) + 64e-5f);
  const float* gw = P.in[18] + layer * 512 + c0;
  const float* gbi = P.in[19] + layer * 512 + c0;
  float o[8];
#pragma unroll
  for (int e = 0; e < 8; ++e) o[e] = ((y[e] - mu) * rs * gw[e] + gbi[e] + bon * vv[e]) * gg[e];
  uint4 ou;
  ou.x = pack2(o[0], o[1]); ou.y = pack2(o[2], o[3]); ou.z = pack2(o[4], o[5]); ou.w = pack2(o[6], o[7]);
  *(uint4*)((bf16_t*)(X.ws + OFF_RWO) + (size_t)row * 512 + c0) = ou;
}

__device__ __forceinline__ float red32(float x) {
  x += __shfl_xor(x, 1); x += __shfl_xor(x, 2); x += __shfl_xor(x, 4); x += __shfl_xor(x, 8); x += __shfl_xor(x, 16);
  return x;
}
#define QSCALE 0.14724444f
__device__ __forceinline__ void q1_q_tile(const Params& P, const Cx& X, int layer, int t, char* smem) {
  const int tid = X.tid, lane = tid & 63, w = tid >> 6;
  const int mt = t % 136, head = t / 136;
  const int m0 = mt * 128;
  const bf16_t* zm = (const bf16_t*)(X.ws + OFF_ZM);
  float* srs = (float*)(smem + 73728);
  {
    int r = tid >> 1, hf = tid & 1;
    const bf16_t* p = zm + (size_t)(m0 + r) * 544 + hf * 192;
    float ss = 0.f;
#pragma unroll 12
    for (int i = 0; i < 24; ++i) {
      uint4 u = *(const uint4*)(p + i * 8);
      ss += lo16(u.x) * lo16(u.x) + hi16(u.x) * hi16(u.x) + lo16(u.y) * lo16(u.y) + hi16(u.y) * hi16(u.y) +
            lo16(u.z) * lo16(u.z) + hi16(u.z) * hi16(u.z) + lo16(u.w) * lo16(u.w) + hi16(u.w) * hi16(u.w);
    }
    ss += __shfl_xor(ss, 1);
    if (hf == 0) srs[r] = rsqrtf(ss * (1.f / 384.f) + 1e-6f);
  }
  f32x16 acc[1][3];
  GQ::zero(acc);
  GQ::run(X, zm + (size_t)m0 * 544, 544, (const bf16_t*)(X.ws + OFF_WMIX) + WE_UQ + (size_t)head * 96 * 384, 384, 384, smem, acc);
  const int l5 = lane & 31;
  const float* gq = P.in[25] + layer * 96;
  const float g0 = gq[l5], g1 = gq[32 + l5], g2 = gq[64 + l5];
  const float2* rope = (const float2*)(X.ws + OFF_ROPE);
  bf16_t* qb = (bf16_t*)(X.ws + OFF_Q);
  float2 rcs[16];
#pragma unroll
  for (int r = 0; r < 16; ++r) {
    const int row = m0 + w * 32 + ROW_OF(r);
    rcs[r] = (row < NX) ? rope[(row & 4095) * 16 + (l5 >> 4) * 8 + (l5 & 7)] : make_float2(1.f, 0.f);
  }
#pragma unroll
  for (int r = 0; r < 16; ++r) {
    const int rl = w * 32 + ROW_OF(r);
    const int row = m0 + rl;
    const float rs = srs[rl];
    float x0 = acc[0][0][r] * rs, x1 = acc[0][1][r] * rs, x2 = acc[0][2][r] * rs;
    float ss = red32(x0 * x0 + x1 * x1 + x2 * x2);
    float rq = rsqrtf(ss * (1.f / 96.f) + 1e-6f);
    x0 *= rq * g0; x1 *= rq * g1; x2 *= rq * g2;
    bf16_t* dst;
    if (row < NX) {
      int tt = row & 4095, bb = row >> 12;
      float2 cs = rcs[r];
      float other = __shfl_xor(x2, 8);
      x2 = (l5 & 8) ? x2 * cs.x + other * cs.y : x2 * cs.x - other * cs.y;
      dst = qb + ((size_t)(bb * 8 + head) * 4096 + tt) * 96;
    } else {
      int j = (row - NX) & 255, bb = (row - NX) >> 8;
      dst = qb + (size_t)NX * 768 + ((size_t)(bb * 8 + head) * 256 + j) * 96;
    }
    dst[l5] = f2bf(x0 * QSCALE); dst[32 + l5] = f2bf(x1 * QSCALE); dst[64 + l5] = f2bf(x2 * QSCALE);
  }
}
__device__ __forceinline__ void q1_kv_tile(const Params& P, const Cx& X, int layer, int t, char* smem) {
  const int tid = X.tid, lane = tid & 63, w = tid >> 6;
  const int mt = t % 136, head = t / 136;
  const int m0 = mt * 128;
  const bf16_t* zm = (const bf16_t*)(X.ws + OFF_ZM);
  float* srs = (float*)(smem + 73728);
  {
    int r = tid >> 1, hf = tid & 1;
    const bf16_t* p = zm + (size_t)(m0 + r) * 544 + 384 + hf * 64;
    float ss = 0.f;
#pragma unroll
    for (int i = 0; i < 8; ++i) {
      uint4 u = *(const uint4*)(p + i * 8);
      ss += lo16(u.x) * lo16(u.x) + hi16(u.x) * hi16(u.x) + lo16(u.y) * lo16(u.y) + hi16(u.y) * hi16(u.y) +
            lo16(u.z) * lo16(u.z) + hi16(u.z) * hi16(u.z) + lo16(u.w) * lo16(u.w) + hi16(u.w) * hi16(u.w);
    }
    ss += __shfl_xor(ss, 1);
    if (hf == 0) srs[r] = rsqrtf(ss * (1.f / 128.f) + 1e-6f);
  }
  f32x16 acc[1][4];
  GKV::zero(acc);
  GKV::run(X, zm + (size_t)m0 * 544 + 384, 544, (const bf16_t*)(X.ws + OFF_WMIX) + WE_UKV + (size_t)head * 128 * 128, 128, 128, smem, acc);
  const int l5 = lane & 31;
  const float* gk = P.in[26] + layer * 96;
  const float g0 = gk[l5], g1 = gk[32 + l5], g2 = gk[64 + l5];
  const float2* rope = (const float2*)(X.ws + OFF_ROPE);
  bf16_t* kb = (bf16_t*)(X.ws + OFF_K);
  bf16_t* vt = (bf16_t*)(X.ws + OFF_VT);
  const bool isx = m0 < NX;
  const int bb = isx ? (m0 >> 12) : ((m0 - NX) >> 8);
  float vv0[16], vv1[16];
  float krv[16];
  float2 rcs[16];
#pragma unroll
  for (int r = 0; r < 16; ++r) {
    const int row = m0 + w * 32 + ROW_OF(r);
    krv[r] = bf2f(zm[(size_t)row * 544 + 512 + l5]);
    rcs[r] = isx ? rope[(row & 4095) * 16 + (l5 >> 4) * 8 + (l5 & 7)] : make_float2(1.f, 0.f);
  }
#pragma unroll
  for (int r = 0; r < 16; ++r) {
    const int rl = w * 32 + ROW_OF(r);
    const int row = m0 + rl;
    const float rs = srs[rl];
    float k0 = acc[0][0][r] * rs, k1 = acc[0][1][r] * rs;
    float kr = krv[r];
    float ss = red32(k0 * k0 + k1 * k1 + kr * kr);
    float rk = rsqrtf(ss * (1.f / 96.f) + 1e-6f);
    k0 *= rk * g0; k1 *= rk * g1; kr *= rk * g2;
    int key;
    if (isx) {
      int tt = row & 4095;
      float2 cs = rcs[r];
      float other = __shfl_xor(kr, 8);
      kr = (l5 & 8) ? kr * cs.x + other * cs.y : kr * cs.x - other * cs.y;
      key = 256 + tt;
    } else {
      key = (row - NX) & 255;
    }
    bf16_t* dst = kb + ((size_t)(bb * 8 + head) * 4352 + key) * 96;
    dst[l5] = f2bf(k0); dst[32 + l5] = f2bf(k1); dst[64 + l5] = f2bf(kr);
    vv0[r] = acc[0][2][r] * rs;
    vv1[r] = acc[0][3][r] * rs;
  }
#pragma unroll
  for (int g = 0; g < 4; ++g) {
    const int rl = w * 32 + 8 * g + 4 * (lane >> 5);
    const int row = m0 + rl;
    const int key = isx ? 256 + (row & 4095) : ((row - NX) & 255);
    uint2 o0, o1;
    o0.x = pack2(vv0[4 * g], vv0[4 * g + 1]); o0.y = pack2(vv0[4 * g + 2], vv0[4 * g + 3]);
    o1.x = pack2(vv1[4 * g], vv1[4 * g + 1]); o1.y = pack2(vv1[4 * g + 2], vv1[4 * g + 3]);
    *(uint2*)(vt + ((size_t)(bb * 8 + head) * 64 + l5) * 4352 + key) = o0;
    *(uint2*)(vt + ((size_t)(bb * 8 + head) * 64 + 32 + l5) * 4352 + key) = o1;
  }
}

__device__ __forceinline__ void fft1_tile(const Params& P, const Cx& X, int t, char* smem) {
  const int lane = X.tid & 63, w = X.tid >> 6;
  const int b = t >> 8, ntile = t & 255;
  const int n0 = ntile * 128;
  f32x16 acc[2][2];
  G22T::zero(acc);
  G22T::run(X, (const bf16_t*)(X.ws + OFF_F1), 64, (const bf16_t*)(X.ws + OFF_ZF) + (size_t)b * 4096 * 512 + n0, 32768, 64, smem, acc);
  const float2* tw = (const float2*)(X.ws + OFF_TW);
  bf16_t* out = (bf16_t*)(X.ws + OFF_FFT1);
  const int wm = w >> 1, wn = w & 1;
  const int t2 = n0 >> 9;
#pragma unroll
  for (int j = 0; j < 2; ++j) {
    const int ch = (n0 & 511) + wn * 64 + j * 32 + (lane & 31);
    float2 tcs[16];
#pragma unroll
    for (int r = 0; r < 16; ++r) tcs[r] = tw[t2 * (wm * 32 + ROW_OF(r))];
#pragma unroll
    for (int r = 0; r < 16; ++r) {
      const int f1 = wm * 32 + ROW_OF(r);
      float re = acc[0][j][r], im = acc[1][j][r];
      float2 cs = tcs[r];
      float re2 = re * cs.x + im * cs.y, im2 = im * cs.x - re * cs.y;
      size_t base = ((size_t)(b * 64 + f1) * 128) * 512 + ch;
      out[base + (size_t)t2 * 512] = f2bf(re2);
      out[base + (size_t)(64 + t2) * 512] = f2bf(im2);
    }
  }
}
__device__ __forceinline__ void fft2_tile(const Params& P, const Cx& X, int t, char* smem) {
  const int lane = X.tid & 63, w = X.tid >> 6;
  const int bf = t >> 2, ntile = t & 3;
  const int b = bf >> 6, f1 = bf & 63;
  const int n0 = ntile * 128;
  f32x16 acc[2][2];
  G22T::zero(acc);
  G22T::run(X, (const bf16_t*)(X.ws + OFF_F2), 128, (const bf16_t*)(X.ws + OFF_FFT1) + (size_t)bf * 128 * 512 + n0, 512, 128, smem, acc);
  bf16_t* Y = (bf16_t*)(X.ws + OFF_Y);
  const int wm = w >> 1, wn = w & 1;
#pragma unroll
  for (int i = 0; i < 2; ++i)
#pragma unroll
    for (int j = 0; j < 2; ++j)
#pragma unroll
      for (int r = 0; r < 16; ++r) {
        int m = wm * 64 + i * 32 + ROW_OF(r);
        int f2 = m & 63, q = m >> 6;
        int ch = n0 + wn * 64 + j * 32 + (lane & 31);
        Y[(size_t)(b * 4096 + f1 + 64 * f2) * 1024 + q * 512 + ch] = f2bf(acc[i][j][r]);
      }
}
__device__ __forceinline__ void ctxdft_tile(const Params& P, const Cx& X, int t, char* smem) {
  const int lane = X.tid & 63, w = X.tid >> 6;
  const int b = t >> 4, mt = (t >> 2) & 3, ntile = t & 3;
  const int n0 = ntile * 128;
  f32x16 acc[2][2];
  G22T::zero(acc);
  G22T::run(X, (const bf16_t*)(X.ws + OFF_F256) + (size_t)mt * 128 * 256, 256, (const bf16_t*)(X.ws + OFF_ZF) + (size_t)(NX + b * 256) * 512 + n0, 512, 256, smem, acc);
  bf16_t* Y = (bf16_t*)(X.ws + OFF_Y);
  const int wm = w >> 1, wn = w & 1;
#pragma unroll
  for (int i = 0; i < 2; ++i)
#pragma unroll
    for (int j = 0; j < 2; ++j)
#pragma unroll
      for (int r = 0; r < 16; ++r) {
        int m = mt * 128 + wm * 64 + i * 32 + ROW_OF(r);
        int f = m & 255, q = m >> 8;
        int ch = n0 + wn * 64 + j * 32 + (lane & 31);
        Y[(size_t)(NX + b * 256 + f) * 1024 + q * 512 + ch] = f2bf(acc[i][j][r] * 4.f);
      }
}

__device__ __forceinline__ void attn_item(const Params& P, const Cx& X, int it, bool isctx, char* smem) {
  const int tid = X.tid, lane = tid & 63, w = tid >> 6;
  int b, h, qb, nkt, qrow0;
  const bf16_t* qbase;
  if (!isctx) {
    b = it >> 8; h = (it >> 5) & 7; qb = it & 31; nkt = 68;
    qbase = (const bf16_t*)(X.ws + OFF_Q) + ((size_t)(b * 8 + h) * 4096 + qb * 128) * 96;
    qrow0 = b * 4096 + qb * 128;
  } else {
    b = it >> 4; h = (it >> 1) & 7; qb = it & 1; nkt = 4;
    qbase = (const bf16_t*)(X.ws + OFF_Q) + (size_t)NX * 768 + ((size_t)(b * 8 + h) * 256 + qb * 128) * 96;
    qrow0 = NX + b * 256 + qb * 128;
  }
  const bf16_t* kbase = (const bf16_t*)(X.ws + OFF_K) + (size_t)(b * 8 + h) * 4352 * 96;
  const bf16_t* vbase = (const bf16_t*)(X.ws + OFF_VT) + (size_t)(b * 8 + h) * 64 * 4352;
  bf16_t* sK = (bf16_t*)smem;
  bf16_t* sV = sK + 2 * 64 * 104;
  const int l5 = lane & 31, hh = lane >> 5;
  const bf16_t* qp = qbase + (size_t)(w * 32 + l5) * 96 + hh * 8;
  const bf16x8 qf0 = *(const bf16x8*)(qp), qf1 = *(const bf16x8*)(qp + 16), qf2 = *(const bf16x8*)(qp + 32);
  const bf16x8 qf3 = *(const bf16x8*)(qp + 48), qf4 = *(const bf16x8*)(qp + 64), qf5 = *(const bf16x8*)(qp + 80);
  uint4 rk0, rk1, rk2, rv0, rv1;
#define LK_(i, kt) (*(const uint4*)(kbase + (size_t)((kt)*64 + (tid + 256 * (i)) / 12) * 96 + ((tid + 256 * (i)) % 12) * 8))
#define LV_(i, kt) (*(const uint4*)(vbase + (size_t)((tid + 256 * (i)) >> 3) * 4352 + (kt)*64 + ((tid + 256 * (i)) & 7) * 8))
#define ALOAD(kt) { rk0 = LK_(0, kt); rk1 = LK_(1, kt); rk2 = LK_(2, kt); rv0 = LV_(0, kt); rv1 = LV_(1, kt); }
#define SK_(i, buf, v) *(uint4*)(sK + (buf)*64 * 104 + ((tid + 256 * (i)) / 12) * 104 + ((tid + 256 * (i)) % 12) * 8) = v
#define SV_(i, buf, v) *(uint4*)(sV + (buf)*64 * 72 + ((tid + 256 * (i)) >> 3) * 72 + ((tid + 256 * (i)) & 7) * 8) = v
#define ASTORE(buf) { SK_(0, buf, rk0); SK_(1, buf, rk1); SK_(2, buf, rk2); SV_(0, buf, rv0); SV_(1, buf, rv1); }
  f32x16 o[2];
#pragma unroll
  for (int r = 0; r < 16; ++r) { o[0][r] = 0.f; o[1][r] = 0.f; }
  float mrun = -1e30f, lrun = 0.f;
  ALOAD(0);
  ASTORE(0);
  __syncthreads();
  for (int kt = 0; kt < nkt; ++kt) {
    const int buf = kt & 1;
    if (kt + 1 < nkt) ALOAD(kt + 1);
    const bf16_t* pk = sK + buf * 64 * 104 + l5 * 104 + hh * 8;
    const bf16_t* pv = sV + buf * 64 * 72 + l5 * 72 + 4 * hh;
#pragma unroll
    for (int mt = 0; mt < 2; ++mt) {
      f32x16 sc;
#pragma unroll
      for (int r = 0; r < 16; ++r) sc[r] = 0.f;
#define QK(ks, qq) sc = __builtin_amdgcn_mfma_f32_32x32x16_bf16(*(const bf16x8*)(pk + mt * 32 * 104 + (ks)*16), qq, sc, 0, 0, 0)
      QK(0, qf0); QK(1, qf1); QK(2, qf2); QK(3, qf3); QK(4, qf4); QK(5, qf5);
#undef QK
      float mx = sc[0];
#pragma unroll
      for (int r = 1; r < 16; ++r) mx = fmaxf(mx, sc[r]);
      mx = fmaxf(mx, __shfl_xor(mx, 32));
      const float mnew = fmaxf(mrun, mx);
      if (__builtin_amdgcn_ballot_w64(mnew > mrun) != 0ull) {
        const float alpha = __builtin_amdgcn_exp2f(mrun - mnew);
        lrun *= alpha;
#pragma unroll
        for (int r = 0; r < 16; ++r) { o[0][r] *= alpha; o[1][r] *= alpha; }
        mrun = mnew;
      }
      float psum = 0.f;
#pragma unroll
      for (int r = 0; r < 16; ++r) { sc[r] = __builtin_amdgcn_exp2f(sc[r] - mrun); psum += sc[r]; }
      lrun += psum;
#pragma unroll
      for (int s2 = 0; s2 < 2; ++s2) {
        u32x4 pu;
        pu[0] = pack2(sc[8 * s2 + 0], sc[8 * s2 + 1]);
        pu[1] = pack2(sc[8 * s2 + 2], sc[8 * s2 + 3]);
        pu[2] = pack2(sc[8 * s2 + 4], sc[8 * s2 + 5]);
        pu[3] = pack2(sc[8 * s2 + 6], sc[8 * s2 + 7]);
        const bf16x8 pfv = __builtin_bit_cast(bf16x8, pu);
#pragma unroll
        for (int dt = 0; dt < 2; ++dt) {
          const bf16_t* p = pv + dt * 32 * 72 + mt * 32 + s2 * 16;
          uint2 v0 = *(const uint2*)(p), v1 = *(const uint2*)(p + 8);
          u32x4 vu;
          vu[0] = v0.x; vu[1] = v0.y; vu[2] = v1.x; vu[3] = v1.y;
          o[dt] = __builtin_amdgcn_mfma_f32_32x32x16_bf16(__builtin_bit_cast(bf16x8, vu), pfv, o[dt], 0, 0, 0);
        }
      }
    }
    if (kt + 1 < nkt) ASTORE(buf ^ 1);
    __syncthreads();
  }
#undef ALOAD
#undef ASTORE
#undef LK_
#undef LV_
#undef SK_
#undef SV_
  lrun += __shfl_xor(lrun, 32);
  const float inv = 1.f / lrun;
  bf16_t* dst = (bf16_t*)(X.ws + OFF_ATT) + (size_t)(qrow0 + w * 32 + l5) * 512 + h * 64;
#pragma unroll
  for (int dt = 0; dt < 2; ++dt)
#pragma unroll
    for (int g = 0; g < 4; ++g) {
      uint2 u;
      u.x = pack2(o[dt][4 * g] * inv, o[dt][4 * g + 1] * inv);
      u.y = pack2(o[dt][4 * g + 2] * inv, o[dt][4 * g + 3] * inv);
      *(uint2*)(dst + dt * 32 + 8 * g + 4 * hh) = u;
    }
}

__device__ __forceinline__ void mg_tile(const Params& P, const Cx& X, int t, int mtiles, char* smem) {
  const int lane = X.tid & 63, w = X.tid >> 6;
  const int mt = t % mtiles, nt = t / mtiles;
  const int m0 = mt * 128, c0 = nt * 128;
  const bf16_t* W = (const bf16_t*)(X.ws + OFF_WMIX);
  uint32_t mpk[2][2][8];
#pragma unroll
  for (int a = 0; a < 2; ++a)
#pragma unroll
    for (int c = 0; c < 2; ++c)
#pragma unroll
      for (int r = 0; r < 8; ++r) mpk[a][c][r] = 0u;
#pragma unroll 1
  for (int i = 0; i < 3; ++i) {
    f32x16 acc[2][2];
    G22::zero(acc);
    const bf16_t* Ai; const bf16_t* Bi; int ldi;
    if (i == 0) { Ai = (const bf16_t*)(X.ws + OFF_RWO) + (size_t)m0 * 512; Bi = W + WE_RO + (size_t)c0 * 512; ldi = 512; }
    else if (i == 1) { Ai = (const bf16_t*)(X.ws + OFF_ATT) + (size_t)m0 * 512; Bi = W + WE_MO + (size_t)c0 * 512; ldi = 512; }
    else { Ai = (const bf16_t*)(X.ws + OFF_Y) + (size_t)m0 * 1024; Bi = W + WE_FO + (size_t)c0 * 1024; ldi = 1024; }
    { const Cx Y1 = fresh(X); G22::run(Y1, Ai, ldi, Bi, ldi, ldi, smem, acc); }
    uint32_t opk[2][2][8];
#pragma unroll
    for (int a = 0; a < 2; ++a)
#pragma unroll
      for (int c = 0; c < 2; ++c)
#pragma unroll
        for (int r = 0; r < 8; ++r) opk[a][c][r] = pack2(acc[a][c][2 * r], acc[a][c][2 * r + 1]);
    __builtin_amdgcn_sched_barrier(0);
    G22::zero(acc);
    { const Cx Y2 = fresh(X); G22::run(Y2, (const bf16_t*)(X.ws + OFF_HBUF) + (size_t)m0 * 1024, 1024, W + WE_IN + (size_t)(2976 + i * 1024 + c0) * 1024, 1024, 1024, smem, acc); }
#pragma unroll
    for (int a = 0; a < 2; ++a)
#pragma unroll
      for (int c = 0; c < 2; ++c)
#pragma unroll
        for (int r = 0; r < 8; ++r) {
          const float m0v = lo16(mpk[a][c][r]) + lo16(opk[a][c][r]) / (1.f + __expf(-acc[a][c][2 * r]));
          const float m1v = hi16(mpk[a][c][r]) + hi16(opk[a][c][r]) / (1.f + __expf(-acc[a][c][2 * r + 1]));
          mpk[a][c][r] = pack2(m0v, m1v);
        }
  }
  bf16_t* mb = (bf16_t*)(X.ws + OFF_M);
  const int row0 = m0 + (w >> 1) * 64, col0 = c0 + (w & 1) * 64;
#pragma unroll
  for (int a = 0; a < 2; ++a)
#pragma unroll
    for (int c = 0; c < 2; ++c)
#pragma unroll
      for (int r = 0; r < 16; ++r)
        mb[(size_t)(row0 + a * 32 + ROW_OF(r)) * 1024 + col0 + c * 32 + (lane & 31)] = (bf16_t)((r & 1) ? (mpk[a][c][r >> 1] >> 16) : (mpk[a][c][r >> 1] & 0xffffu));
}

__device__ __forceinline__ void wo_tile(const Params& P, const Cx& X, int layer, int t, int mtiles, char* smem) {
  const int lane = X.tid & 63, w = X.tid >> 6;
  const int mt = t % mtiles, nt = t / mtiles;
  const int m0 = mt * 128, n0 = nt * 128;
  f32x16 acc[2][2];
  G22::zero(acc);
  G22::run(X, (const bf16_t*)(X.ws + OFF_M) + (size_t)m0 * 1024, 1024, (const bf16_t*)(X.ws + OFF_WMIX) + WE_OUT + (size_t)n0 * 1024, 1024, 1024, smem, acc);
  const int row0 = m0 + (w >> 1) * 64, col0 = n0 + (w & 1) * 64;
  const float* modv = (const float*)(X.ws + OFF_MOD) + (size_t)(layer * 5 + mod_row(m0)) * 6144 + 2048;
  const float* src; float* dst;
  if (m0 < NX) { src = (layer == 0 ? P.in[0] : X.out); dst = X.out; }
  else { src = (layer == 0 ? P.in[2] : (const float*)(X.ws + OFF_CS)) - (size_t)NX * 1024; dst = (float*)(X.ws + OFF_CS) - (size_t)NX * 1024; }
#pragma unroll
  for (int j = 0; j < 2; ++j) {
    const int col = col0 + j * 32 + (lane & 31);
    const float mg = modv[col];
#pragma unroll
    for (int i = 0; i < 2; ++i) {
      float t[16];
#pragma unroll
      for (int r = 0; r < 16; ++r) t[r] = src[(size_t)(row0 + i * 32 + ROW_OF(r)) * 1024 + col];
#pragma unroll
      for (int r = 0; r < 16; ++r) dst[(size_t)(row0 + i * 32 + ROW_OF(r)) * 1024 + col] = t[r] + mg * acc[i][j][r];
    }
  }
}
__device__ __forceinline__ void f1_tile(const Params& P, const Cx& X, int t, int mtiles, char* smem) {
  const int lane = X.tid & 63, w = X.tid >> 6;
  const int mt = t % mtiles, nt = t / mtiles;
  const int m0 = mt * 128, n0 = nt * 256;
  f32x16 acc[2][4];
  GemmW::zero(acc);
  GemmW::run(X, (const bf16_t*)(X.ws + OFF_HBUF) + (size_t)m0 * 1024, 1024, (const bf16_t*)(X.ws + OFF_WFFN) + WF_IN + (size_t)n0 * 1024, 1024, 1024, smem, acc);
  bf16_t* act = (bf16_t*)(X.ws + OFF_ACT);
  const int row0 = m0 + (w >> 1) * 64;
#pragma unroll
  for (int jp = 0; jp < 2; ++jp) {
    const int hid = ((n0 + (w & 1) * 128 + jp * 64) >> 6) * 32 + (lane & 31);
#pragma unroll
    for (int i = 0; i < 2; ++i)
#pragma unroll
      for (int r = 0; r < 16; ++r) {
        float g = acc[i][2 * jp][r], u = acc[i][2 * jp + 1][r];
        act[(size_t)(row0 + i * 32 + ROW_OF(r)) * 2816 + hid] = f2bf(g / (1.f + __expf(-g)) * u);
      }
  }
}
__device__ __forceinline__ void f2_tile(const Params& P, const Cx& X, int layer, int t, int mtiles, char* smem) {
  const int lane = X.tid & 63, w = X.tid >> 6;
  const int mt = t % mtiles, nt = t / mtiles;
  const int m0 = mt * 128, n0 = nt * 128;
  f32x16 acc[2][2];
  G22::zero(acc);
  G22::run(X, (const bf16_t*)(X.ws + OFF_ACT) + (size_t)m0 * 2816, 2816, (const bf16_t*)(X.ws + OFF_WFFN) + WF_OUT + (size_t)n0 * 2816, 2816, 2816, smem, acc);
  const int row0 = m0 + (w >> 1) * 64, col0 = n0 + (w & 1) * 64;
  const float* modv = (const float*)(X.ws + OFF_MOD) + (size_t)(layer * 5 + mod_row(m0)) * 6144 + 5120;
  float* dst = (m0 < NX) ? X.out : (float*)(X.ws + OFF_CS) - (size_t)NX * 1024;
#pragma unroll
  for (int j = 0; j < 2; ++j) {
    const int col = col0 + j * 32 + (lane & 31);
    const float mg = modv[col];
#pragma unroll
    for (int i = 0; i < 2; ++i) {
      float t[16];
#pragma unroll
      for (int r = 0; r < 16; ++r) t[r] = dst[(size_t)(row0 + i * 32 + ROW_OF(r)) * 1024 + col];
#pragma unroll
      for (int r = 0; r < 16; ++r) dst[(size_t)(row0 + i * 32 + ROW_OF(r)) * 1024 + col] = t[r] + mg * acc[i][j][r];
    }
  }
}

__device__ __forceinline__ void run_p(const Params& P, const Cx& X, int layer, int p, char* smem) {
  const int G = gridDim.x, B = blockIdx.x;
  if (p < 0) {
    if (!PON(14)) return;
    for (int j = B; j < 192 + 55 + NCW1; j += G) {
      if (j < 192) job_mod(P, fresh(X), smem, j);
      else if (j < 247) job_tables(P, fresh(X), j - 192);
      else cw_mixer_job(P, fresh(X), 0, j - 247, smem);
    }
    return;
  }
  const int mtiles = layer == 0 ? 136 : 128;
  switch (p) {
    case 0: if (!PON(0)) break;
      if (layer == 0) { for (int j = B; j < 4352; j += G) norm_job(P, fresh(X), layer, 0, j); }
      else { for (int j = B; j < NCW1 + 4352; j += G) { if (j < NCW1) cw_mixer_job(P, fresh(X), layer, j, smem); else norm_job(P, fresh(X), layer, 0, j - NCW1); } }
      break;
    case 1: if (!PON(1)) break; for (int j = B; j < 136 * 15; j += G) g1a_tile(P, fresh(X), j, smem); break;
    case 2: if (!PON(2)) break; for (int j = B; j < NTOK; j += G) r1a_row(P, fresh(X), layer, j); break;
    case 3: if (!PON(3)) break; for (int j = B; j < 136 * 20; j += G) r1b_tile(P, fresh(X), layer, j, smem); break;
    case 4: if (!PON(4)) break; {
      volatile int* sflag = (volatile int*)(smem + LDS_BYTES - 32);
      if (sflag[0]) {
        unsigned* ctr = (unsigned*)(X.ws + OFF_TICK) + 2048 + layer * 64 + sflag[2] * 8;
        for (;;) {
          __syncthreads();
          if (X.tid == 0) sflag[1] = (int)atomicAdd(ctr, 1u);
          __syncthreads();
          const int j = sflag[1];
          if (j >= 256) break;
          scan_job(P, fresh(X), layer, j, smem);
        }
      }
    } break;
    case 5: if (!PON(5)) break; for (int j = B; j < 4352; j += G) s2_job(P, fresh(X), layer, j); break;
    case 6: if (!PON(6)) break; for (int j = B; j < 136 * 9; j += G) g1b_tile(P, fresh(X), j, smem); break;
    case 7: if (!PON(7)) break;
      for (int j = B; j < 2176 + 1024; j += G) {
        if (j < 1088) q1_kv_tile(P, fresh(X), layer, j, smem);
        else if (j < 2176) { if (layer == 0 || (j - 1088) % 136 < 128) q1_q_tile(P, fresh(X), layer, j - 1088, smem); }
        else fft1_tile(P, fresh(X), j - 2176, smem);
      }
      break;
    case 8: if (!PON(8)) break; {
      const int nctx = layer == 0 ? 64 : 0;
      for (int j = B; j < 1024 + 1024 + 2 * nctx; j += G) {
        const bool isc = (j >= 2048 && j < 2048 + nctx);
        if (j < 1024 || isc) attn_item(P, fresh(X), isc ? j - 2048 : j, isc, smem);
        else if (j < 2048) fft2_tile(P, fresh(X), j - 1024, smem);
        else ctxdft_tile(P, fresh(X), j - 2048 - nctx, smem);
      }
    } break;
    case 9: if (!PON(9)) break; for (int j = B; j < mtiles * 8; j += G) mg_tile(P, fresh(X), j, mtiles, smem); break;
    case 10: if (!PON(10)) break;
      for (int j = B; j < mtiles * 8 + NCW2; j += G) { if (j < mtiles * 8) wo_tile(P, fresh(X), layer, j, mtiles, smem); else cw_ffn_job(P, fresh(X), layer, j - mtiles * 8, smem); }
      break;
    case 11: if (!PON(11)) break; for (int j = B; j < mtiles * 32; j += G) norm_job(P, fresh(X), layer, 1, j); break;
    case 12: if (!PON(12)) break; for (int j = B; j < mtiles * 22; j += G) f1_tile(P, fresh(X), j, mtiles, smem); break;
    case 13: if (!PON(13)) break; for (int j = B; j < mtiles * 8; j += G) f2_tile(P, fresh(X), layer, j, mtiles, smem); break;
  }
}

#if SINGLE
__global__ void __launch_bounds__(256, 2) fwd_kernel(Params P, int ph_lo, int ph_hi, int use_sync) {
  extern __shared__ __attribute__((aligned(16))) char smem[];
  volatile LAS unsigned* xst = (volatile LAS unsigned*)(smem + LDS_BYTES - 16);
  if (threadIdx.x == 0) { xst[0] = 0u; xst[1] = 0u; }
  __syncthreads();
  XcdBarrier xb = xcd_barrier_post((unsigned*)(P.ws + OFF_BAR), xst);
  if (threadIdx.x == 0) {
    const unsigned hwid = (unsigned)__builtin_amdgcn_s_getreg((31 << 11) | 4);
    const unsigned slot = ((xb_xcc_id() * 8u + ((hwid >> 13) & 7u)) * 2u + ((hwid >> 12) & 1u)) * 16u + ((hwid >> 8) & 15u);
    const unsigned t = atomicAdd((unsigned*)(P.ws + OFF_TICK) + slot, 1u);
    *(volatile int*)(smem + LDS_BYTES - 32) = (t == 0u) ? 1 : 0;
    *(volatile int*)(smem + LDS_BYTES - 24) = 0;
  }
  __syncthreads();
#pragma unroll 1
  for (int ph = ph_lo; ph < ph_hi; ++ph) {
    char* ws = P.ws; float* out = P.out; int tid = threadIdx.x;
    asm volatile("" : "+v"(tid));
    const Cx X{ws, out, tid};
    if (ph == 0) run_p(P, X, 0, -1, smem);
    else {
      run_p(P, X, (ph - 1) / 14, (ph - 1) % 14, smem);
      if (PROBE_P >= 0 && (ph - 1) % 14 == PROBE_P) {
#pragma unroll 1
        for (int rep = 0; rep < PROBE_N; ++rep) { xcd_barrier(xb); if (threadIdx.x == 0) *(volatile int*)(smem + LDS_BYTES - 24) = rep + 1; __syncthreads(); run_p(P, X, (ph - 1) / 14, PROBE_P, smem); }
        if (threadIdx.x == 0) *(volatile int*)(smem + LDS_BYTES - 24) = 0;
        __syncthreads();
      }
    }
    if (use_sync && ph + 1 < ph_hi) { if (use_sync == 2) cg::this_grid().sync(); else xcd_barrier(xb); }
  }
}

#else
template <int PP>
__global__ void __launch_bounds__(256) phase_kernel(Params P, int layer) {
  extern __shared__ __attribute__((aligned(16))) char smem[];
  const Cx X{P.ws, P.out, (int)threadIdx.x};
  run_p(P, X, layer, PP, smem);
}
#endif

extern "C" void kernel_launch(void* const* d_in, const int* in_sizes, int n_in, void* d_out, int out_size, void* d_ws,
                              size_t ws_size, hipStream_t stream) {
  static int grid = 0;
  if (grid == 0) {
    if (n_in != 33 || ws_size < OFF_END) { fprintf(stderr, "kernel_launch: unexpected n_in %d / ws_size %zu (need %zu)\n", n_in, ws_size, (size_t)OFF_END); grid = -1; return; }
    int dev = 0, cus = 0, per_cu = 0;
    hipGetDevice(&dev);
    hipDeviceGetAttribute(&cus, hipDeviceAttributeMultiprocessorCount, dev);
#if SINGLE
    hipFuncSetAttribute((const void*)fwd_kernel, hipFuncAttributeMaxDynamicSharedMemorySize, LDS_BYTES);
    hipOccupancyMaxActiveBlocksPerMultiprocessor(&per_cu, (const void*)fwd_kernel, 256, LDS_BYTES);
#else
#define SA(pp) hipFuncSetAttribute((const void*)phase_kernel<pp>, hipFuncAttributeMaxDynamicSharedMemorySize, LDS_BYTES)
    SA(-1); SA(0); SA(1); SA(2); SA(3); SA(4); SA(5); SA(6); SA(7); SA(8); SA(9); SA(10); SA(11); SA(12); SA(13);
    per_cu = 2;
#endif
    if (per_cu < 1) { fprintf(stderr, "kernel_launch: occupancy query returned %d\n", per_cu); grid = -1; return; }
    if (per_cu > 2) per_cu = 2;
    grid = cus * per_cu;
  }
  if (grid < 0) return;
  if (hipMemsetAsync((char*)d_ws + OFF_BAR, 0, 32768, stream) != hipSuccess) { fprintf(stderr, "kernel_launch: memset failed\n"); return; }
  Params P{};
  for (int i = 0; i < 33; ++i) P.in[i] = (const float*)d_in[i];
  P.out = (float*)d_out;
  P.ws = (char*)d_ws;
#if SINGLE
  int lo = 0, hi = NPH, us = 1;
  void* args[] = {&P, &lo, &hi, &us};
  hipError_t e = hipLaunchCooperativeKernel((const void*)fwd_kernel, dim3(grid), dim3(256), args, LDS_BYTES, stream);
  if (e != hipSuccess) fprintf(stderr, "cooperative launch failed: %s (grid %d)\n", hipGetErrorString(e), grid);
#else
#define LP(pp, ly) hipLaunchKernelGGL(phase_kernel<pp>, dim3(grid), dim3(256), LDS_BYTES, stream, P, ly)
  LP(-1, 0);
  for (int ly = 0; ly < 2; ++ly) {
    LP(0, ly); LP(1, ly); LP(2, ly); LP(3, ly); LP(4, ly); LP(5, ly); LP(6, ly); LP(7, ly); LP(8, ly); LP(9, ly); LP(10, ly); LP(11, ly); LP(12, ly); LP(13, ly);
  }
#endif
}
```

```cpp
#include <hip/hip_runtime.h>
#include <hip/hip_cooperative_groups.h>
#include <stdint.h>
#include <stdio.h>
namespace cg = cooperative_groups;

#ifndef SINGLE
#define SINGLE 1
#endif

#ifndef ONLYP
#define ONLYP -1
#endif
#define PON(x) (ONLYP < 0 || ONLYP == (x))

typedef unsigned short bf16_t;
typedef __attribute__((ext_vector_type(8))) short bf16x8;
typedef __attribute__((ext_vector_type(16))) float f32x16;
typedef __attribute__((ext_vector_type(4))) unsigned int u32x4;

#define NX 16384
#define NCX 1024
#define NTOK 17408
#define NPH 29
#ifndef PROBE_P
#define PROBE_P -1
#endif
#define PROBE_N 2
#define LDS_BYTES 77824

static constexpr size_t UU = 17825792ull;
static constexpr size_t OFF_HBUF = 0;
static constexpr size_t OFF_RKV = 2 * UU;
static constexpr size_t OFF_KK = 5 * UU;
static constexpr size_t OFF_ZR = 6 * UU;
static constexpr size_t OFF_LORA = 12 * UU + UU / 4;
static constexpr size_t OFF_LD = 6 * UU;
static constexpr size_t OFF_A = 8 * UU;
static constexpr size_t OFF_G = 10 * UU;
static constexpr size_t OFF_YF = 11 * UU;
static constexpr size_t OFF_YB = 12 * UU;
static constexpr size_t OFF_RWO = 5 * UU;
static constexpr size_t OFF_ZF = 2 * UU;
static constexpr size_t OFF_ZM = 3 * UU;
static constexpr size_t OFF_Q = 6 * UU;
static constexpr size_t OFF_K = 7 * UU + UU / 2;
static constexpr size_t OFF_VT = 9 * UU;
static constexpr size_t OFF_FFT1 = 10 * UU;
static constexpr size_t OFF_ATT = 12 * UU;
static constexpr size_t OFF_Y = 3 * UU;
static constexpr size_t OFF_M = 6 * UU;
static constexpr size_t OFF_ACT = 2 * UU;
static constexpr size_t OFF_WFFN = 9 * UU;
static constexpr size_t OFF_WMIX = 13 * UU;
static constexpr size_t WE_IN = 0;
static constexpr size_t WE_W2 = WE_IN + 6048ull * 1024;
static constexpr size_t WE_A2 = WE_W2 + 65536;
static constexpr size_t WE_G2 = WE_A2 + 65536;
static constexpr size_t WE_RO = WE_G2 + 65536;
static constexpr size_t WE_MO = WE_RO + 524288;
static constexpr size_t WE_FO = WE_MO + 524288;
static constexpr size_t WE_UQ = WE_FO + 1048576;
static constexpr size_t WE_UKV = WE_UQ + 294912;
static constexpr size_t WE_OUT = WE_UKV + 131072;
static constexpr size_t WE_END = WE_OUT + 1048576;
static constexpr size_t WF_IN = 0;
static constexpr size_t WF_OUT = 5632ull * 1024;
static constexpr size_t OFF_SMALL = OFF_WMIX + WE_END * 2;
static constexpr size_t OFF_CS = OFF_SMALL;
static constexpr size_t OFF_MOD = OFF_CS + 4194304;
static constexpr size_t OFF_TW = OFF_MOD + 245760;
static constexpr size_t OFF_F1 = OFF_TW + 32768;
static constexpr size_t OFF_F2 = OFF_F1 + 16384;
static constexpr size_t OFF_F256 = OFF_F2 + 32768;
static constexpr size_t OFF_ROPE = OFF_F256 + 262144;
static constexpr size_t OFF_BAR = OFF_ROPE + 524288;
static constexpr size_t OFF_TICK = OFF_BAR + 16384;
static constexpr size_t OFF_END = OFF_TICK + 16384;

struct Cx {
  char* ws;
  float* out;
  int tid;
};

struct Params {
  const float* in[33];
  float* out;
  char* ws;
};

__device__ __forceinline__ float bf2f(bf16_t v) { return __uint_as_float(((uint32_t)v) << 16); }
typedef __bf16 bf16v2_t __attribute__((ext_vector_type(2)));
typedef float f32v2_t __attribute__((ext_vector_type(2)));
__device__ __forceinline__ uint32_t pack2(float a, float b) {
  f32v2_t v; v[0] = a; v[1] = b;
  return __builtin_bit_cast(uint32_t, __builtin_convertvector(v, bf16v2_t));
}
__device__ __forceinline__ bf16_t f2bf(float f) { return (bf16_t)(pack2(f, 0.f) & 0xffffu); }
__device__ __forceinline__ float lo16(uint32_t u) { return __uint_as_float(u << 16); }
__device__ __forceinline__ float hi16(uint32_t u) { return __uint_as_float(u & 0xffff0000u); }
__device__ __forceinline__ float sigmoidf_(float v) { return 1.f / (1.f + __expf(-v)); }
__device__ __forceinline__ int mod_row(int row) { return row < NX ? (row >> 12) : 4; }

__device__ __forceinline__ Cx fresh(const Cx& X) {
  int t = X.tid;
  asm volatile("" : "+v"(t));
  return Cx{X.ws, X.out, t};
}

#define XB_TMO      128
#define XB_XCNT(j)  (256  + 64 * (j))
#define XB_XSUB(j)  (1280 + 64 * (j))
#define XB_XGEN(j)  (2304 + 64 * (j))
#define XB_TOP      3328
#define XB_TOPGEN   3392
#define XCD_BAR_WORDS 3456
#define XB_SPIN_CAP (1u << 18)
#define LAS __attribute__((address_space(3)))

__device__ __forceinline__ unsigned xb_ld(unsigned* p)              { return __hip_atomic_load(p, __ATOMIC_RELAXED, __HIP_MEMORY_SCOPE_AGENT); }
__device__ __forceinline__ unsigned xb_add(unsigned* p, unsigned v) { return __hip_atomic_fetch_add(p, v, __ATOMIC_RELAXED, __HIP_MEMORY_SCOPE_AGENT); }
__device__ __forceinline__ unsigned xb_xcc_id() { return (unsigned)__builtin_amdgcn_s_getreg((3 << 11) | 20) & 0xFu; }
#define XB_SPIN(cond, bar) do { unsigned _sp = 0; while (cond) { __builtin_amdgcn_s_sleep(1); \
    if ((++_sp & 255u) == 0u) { if (xb_ld(&(bar)[XB_TMO])) break; if (_sp > XB_SPIN_CAP) { atomicAdd(&(bar)[XB_TMO], 1u); break; } } } } while (0)

struct XcdBarrier {
    unsigned* bar; unsigned x;
    volatile LAS unsigned* st;
};

__device__ __forceinline__ XcdBarrier xcd_barrier_post(unsigned* bar, volatile LAS unsigned* st) {
    XcdBarrier b; b.bar = bar; b.x = xb_xcc_id(); b.st = st;
    if (threadIdx.x == 0) (void)xb_add(&bar[XB_XCNT(b.x)], 1u);
    return b;
}
__device__ __forceinline__ void xcd_barrier_complete(unsigned* bar, unsigned x, unsigned& nloc, unsigned& nx) {
    const unsigned G = gridDim.x * gridDim.y * gridDim.z;
    unsigned sum, cnt, mine, sp = 0u;
    for (;;) {
        sum = 0u; cnt = 0u; mine = 0u;
#pragma unroll
        for (unsigned j = 0; j < 16; ++j) { const unsigned c = xb_ld(&bar[XB_XCNT(j)]); sum += c; cnt += (c > 0u) ? 1u : 0u; mine = (j == x) ? c : mine; }
        if (sum == G) break;
        __builtin_amdgcn_s_sleep(1);
        if ((++sp & 255u) == 0u) { if (xb_ld(&bar[XB_TMO])) break; if (sp > XB_SPIN_CAP) { atomicAdd(&bar[XB_TMO], 1u); break; } }
    }
    nloc = mine > 0u ? mine : 1u; nx = cnt > 0u ? cnt : 1u;
}

__device__ __forceinline__ void xcd_barrier(const XcdBarrier& b) {
    asm volatile("s_waitcnt vmcnt(0)" ::: "memory");
    __syncthreads();
    if (threadIdx.x == 0) {
        unsigned* bar = b.bar;
        __builtin_amdgcn_s_waitcnt(0);
        unsigned nloc = b.st[0], nx = b.st[1];
        if (nloc == 0u) { xcd_barrier_complete(bar, b.x, nloc, nx); b.st[0] = nloc; b.st[1] = nx; }
        const unsigned old = xb_add(&bar[XB_XSUB(b.x)], 1u);
        const unsigned gen = old / nloc;
        if (old + 1u == (gen + 1u) * nloc) {
            __builtin_amdgcn_fence(__ATOMIC_RELEASE, "agent");
            asm volatile("s_waitcnt vmcnt(0)" ::: "memory");
            const unsigned og = xb_add(&bar[XB_TOP], 1u);
            const unsigned tg = og / nx;
            if (og + 1u == (tg + 1u) * nx) xb_add(&bar[XB_TOPGEN], 1u);
            else XB_SPIN(xb_ld(&bar[XB_TOPGEN]) == tg, bar);
            __builtin_amdgcn_fence(__ATOMIC_ACQUIRE, "agent");
            xb_add(&bar[XB_XGEN(b.x)], 1u);
            asm volatile("s_waitcnt vmcnt(0)" ::: "memory");
        } else {
            XB_SPIN(xb_ld(&bar[XB_XGEN(b.x)]) == gen, bar);
            __builtin_amdgcn_fence(__ATOMIC_ACQUIRE, "agent");
            asm volatile("s_waitcnt vmcnt(0)" ::: "memory");
        }
    }
    __syncthreads();
}


template <int BM, int BN, int WGM, int WGN, bool TRB>
struct Gemm {
  static constexpr int WM = BM / WGM, WN = BN / WGN, MT = WM / 32, NTL = WN / 32;
  static constexpr int CA = BM * 8 / 256, CB = BN * 8 / 256;
  static constexpr int SA_ELEMS = BM * 72, SB_ELEMS = BN * 72;

  __device__ static __forceinline__ void zero(f32x16 (&acc)[MT][NTL]) {
#pragma unroll
    for (int i = 0; i < MT; ++i)
#pragma unroll
      for (int j = 0; j < NTL; ++j)
#pragma unroll
        for (int r = 0; r < 16; ++r) acc[i][j][r] = 0.f;
  }

  __device__ static __forceinline__ void run(const Cx& X, const bf16_t* __restrict__ A, int lda, const bf16_t* __restrict__ B, int ldb,
                                             int K, char* smem, f32x16 (&acc)[MT][NTL]) {
    const int tid = X.tid, lane = tid & 63, w = tid >> 6;
    const int wm = w / WGN, wn = w % WGN;
    bf16_t* sA = (bf16_t*)smem;
    bf16_t* sB = sA + 2 * SA_ELEMS;
    uint4 ra0, ra1, ra2, ra3, rb0, rb1, rb2 = make_uint4(0, 0, 0, 0), rb3 = make_uint4(0, 0, 0, 0);
    uint4 qa0, qa1, qa2, qa3, qb0, qb1, qb2 = make_uint4(0, 0, 0, 0), qb3 = make_uint4(0, 0, 0, 0);
    static_assert(CA == 4 && CB >= 2 && CB <= 4, "tile loader shape");
    const int nk = K >> 6;
#define LDA_(i, k0) (*(const uint4*)(A + (size_t)((tid + 256 * (i)) >> 3) * lda + (k0) + ((tid + 256 * (i)) & 7) * 8))
#define LDB_(i, k0)                                                                                                        \
  (!TRB ? *(const uint4*)(B + (size_t)((tid + 256 * (i)) >> 3) * ldb + (k0) + ((tid + 256 * (i)) & 7) * 8)                 \
        : *(const uint4*)(B + (size_t)((k0) + (tid + 256 * (i)) / (BN / 8)) * ldb + ((tid + 256 * (i)) % (BN / 8)) * 8))
#define GLOAD(R, k0)                                                                           \
  {                                                                                            \
    R##a0 = LDA_(0, k0); R##a1 = LDA_(1, k0); R##a2 = LDA_(2, k0); R##a3 = LDA_(3, k0);        \
    R##b0 = LDB_(0, k0); R##b1 = LDB_(1, k0);                                                  \
    if (CB > 2) R##b2 = LDB_(2, k0);                                                           \
    if (CB > 3) R##b3 = LDB_(3, k0);                                                           \
  }
#define STA_(i, buf, v) *(uint4*)(sA + (buf)*SA_ELEMS + ((tid + 256 * (i)) >> 3) * 72 + ((tid + 256 * (i)) & 7) * 8) = v
#define STB_(i, buf, v)                                                                                       \
  {                                                                                                           \
    const int c_ = tid + 256 * (i);                                                                           \
    if (!TRB) *(uint4*)(sB + (buf)*SB_ELEMS + (c_ >> 3) * 72 + (c_ & 7) * 8) = v;                             \
    else {                                                                                                    \
      bf16_t* p = sB + (buf)*SB_ELEMS + (c_ % (BN / 8)) * 8 * 72 + c_ / (BN / 8);                             \
      p[0] = (bf16_t)(v.x & 0xffff); p[72] = (bf16_t)(v.x >> 16);                                             \
      p[144] = (bf16_t)(v.y & 0xffff); p[216] = (bf16_t)(v.y >> 16);                                          \
      p[288] = (bf16_t)(v.z & 0xffff); p[360] = (bf16_t)(v.z >> 16);                                          \
      p[432] = (bf16_t)(v.w & 0xffff); p[504] = (bf16_t)(v.w >> 16);                                          \
    }                                                                                                         \
  }
#define SSTORE(R, buf)                                                                         \
  {                                                                                            \
    STA_(0, buf, R##a0); STA_(1, buf, R##a1); STA_(2, buf, R##a2); STA_(3, buf, R##a3);        \
    STB_(0, buf, R##b0); STB_(1, buf, R##b1);                                                  \
    if (CB > 2) STB_(2, buf, R##b2);                                                           \
    if (CB > 3) STB_(3, buf, R##b3);                                                           \
  }
#define COMPUTE(buf)                                                                                               \
  {                                                                                                                \
    const bf16_t* pa = sA + (buf)*SA_ELEMS + (wm * WM + (lane & 31)) * 72 + (lane >> 5) * 8;                       \
    const bf16_t* pb = sB + (buf)*SB_ELEMS + (wn * WN + (lane & 31)) * 72 + (lane >> 5) * 8;                       \
    _Pragma("unroll") for (int ks = 0; ks < 4; ++ks) {                                                             \
      bf16x8 af[MT], bfr[NTL];                                                                                     \
      _Pragma("unroll") for (int i = 0; i < MT; ++i) af[i] = *(const bf16x8*)(pa + i * 32 * 72 + ks * 16);         \
      _Pragma("unroll") for (int j = 0; j < NTL; ++j) bfr[j] = *(const bf16x8*)(pb + j * 32 * 72 + ks * 16);       \
      _Pragma("unroll") for (int i = 0; i < MT; ++i)                                                               \
        _Pragma("unroll") for (int j = 0; j < NTL; ++j)                                                            \
          acc[i][j] = __builtin_amdgcn_mfma_f32_32x32x16_bf16(af[i], bfr[j], acc[i][j], 0, 0, 0);                  \
    }                                                                                                              \
  }
    if (!TRB) {
      bf16_t* dA = sA;
      bf16_t* dB = sA + 2 * BM * 64;
#define DSTAGE(buf, k0)                                                                                              \
  {                                                                                                                  \
    _Pragma("unroll") for (int i = 0; i < CA; ++i) {                                                                 \
      const int p = tid + 256 * i, r = p >> 3, c = (p & 7) ^ ((r >> 1) & 7);                                         \
      __builtin_amdgcn_global_load_lds((const unsigned*)(A + (size_t)r * lda + (k0) + c * 8),                        \
                                       (LAS unsigned*)(dA + (buf)*BM * 64 + p * 8), 16, 0, 0);                       \
    }                                                                                                                \
    _Pragma("unroll") for (int i = 0; i < CB; ++i) {                                                                 \
      const int p = tid + 256 * i, r = p >> 3, c = (p & 7) ^ ((r >> 1) & 7);                                         \
      __builtin_amdgcn_global_load_lds((const unsigned*)(B + (size_t)r * ldb + (k0) + c * 8),                        \
                                       (LAS unsigned*)(dB + (buf)*BN * 64 + p * 8), 16, 0, 0);                       \
    }                                                                                                                \
  }
      const int swz = (lane >> 1) & 7, hh = lane >> 5;
      DSTAGE(0, 0);
      asm volatile("s_waitcnt vmcnt(0)" ::: "memory");
      __syncthreads();
#pragma unroll 1
      for (int kt = 0; kt < nk; ++kt) {
        const int buf = kt & 1;
        if (kt + 1 < nk) DSTAGE(buf ^ 1, (kt + 1) * 64);
        const bf16_t* pa = dA + buf * BM * 64 + (wm * WM + (lane & 31)) * 64;
        const bf16_t* pb = dB + buf * BN * 64 + (wn * WN + (lane & 31)) * 64;
#pragma unroll
        for (int ks = 0; ks < 4; ++ks) {
          const int co = (((ks * 2 + hh) ^ swz) * 8);
          bf16x8 af[MT], bfr[NTL];
#pragma unroll
          for (int i = 0; i < MT; ++i) af[i] = *(const bf16x8*)(pa + i * 32 * 64 + co);
#pragma unroll
          for (int j = 0; j < NTL; ++j) bfr[j] = *(const bf16x8*)(pb + j * 32 * 64 + co);
#pragma unroll
          for (int i = 0; i < MT; ++i)
#pragma unroll
            for (int j = 0; j < NTL; ++j) acc[i][j] = __builtin_amdgcn_mfma_f32_32x32x16_bf16(af[i], bfr[j], acc[i][j], 0, 0, 0);
        }
        asm volatile("s_waitcnt vmcnt(0)" ::: "memory");
        __syncthreads();
      }
#undef DSTAGE
    } else {
    GLOAD(r, 0);
    if (nk > 1) GLOAD(q, 64);
    SSTORE(r, 0);
    __syncthreads();
    for (int kt = 0; kt < nk; kt += 2) {
      if (kt + 2 < nk) GLOAD(r, (kt + 2) * 64);
      COMPUTE(0);
      if (kt + 1 < nk) SSTORE(q, 1);
      __syncthreads();
      if (kt + 1 >= nk) break;
      if (kt + 3 < nk) GLOAD(q, (kt + 3) * 64);
      COMPUTE(1);
      if (kt + 2 < nk) SSTORE(r, 0);
      __syncthreads();
    }
    }
#undef COMPUTE
#undef GLOAD
#undef SSTORE
#undef LDA_
#undef LDB_
#undef STA_
#undef STB_
  }
};

typedef Gemm<128, 128, 2, 2, false> G22;
typedef Gemm<128, 128, 2, 2, true> G22T;
typedef Gemm<128, 64, 2, 2, false> GMG;
typedef Gemm<128, 96, 4, 1, false> GQ;
typedef Gemm<128, 128, 4, 1, false> GKV;

struct GemmW {
  static constexpr int MT = 2, NTL = 4;
  __device__ static __forceinline__ void zero(f32x16 (&acc)[MT][NTL]) {
#pragma unroll
    for (int i = 0; i < MT; ++i)
#pragma unroll
      for (int j = 0; j < NTL; ++j)
#pragma unroll
        for (int r = 0; r < 16; ++r) acc[i][j][r] = 0.f;
  }
  __device__ static __forceinline__ void run(const Cx& X, const bf16_t* __restrict__ A, int lda, const bf16_t* __restrict__ B, int ldb,
                                             int K, char* smem, f32x16 (&acc)[MT][NTL]) {
    const int tid = X.tid, lane = tid & 63, w = tid >> 6;
    const int wm = w >> 1, wn = w & 1;
    bf16_t* dA = (bf16_t*)smem;
    bf16_t* dB = dA + 3 * 128 * 32;
    const int nk = K >> 5;
#define WSTAGE(buf, k0)                                                                                              \
  {                                                                                                                  \
    _Pragma("unroll") for (int i = 0; i < 2; ++i) {                                                                  \
      const int p = tid + 256 * i, r = p >> 2, c = (p & 3) ^ ((r >> 2) & 3);                                         \
      __builtin_amdgcn_global_load_lds((const unsigned*)(A + (size_t)r * lda + (k0) + c * 8),                        \
                                       (LAS unsigned*)(dA + (buf)*128 * 32 + p * 8), 16, 0, 0);                      \
    }                                                                                                                \
    _Pragma("unroll") for (int i = 0; i < 4; ++i) {                                                                  \
      const int p = tid + 256 * i, r = p >> 2, c = (p & 3) ^ ((r >> 2) & 3);                                         \
      __builtin_amdgcn_global_load_lds((const unsigned*)(B + (size_t)r * ldb + (k0) + c * 8),                        \
                                       (LAS unsigned*)(dB + (buf)*256 * 32 + p * 8), 16, 0, 0);                      \
    }                                                                                                                \
  }
    const int swz = ((lane & 31) >> 2) & 3, hh = lane >> 5;
    WSTAGE(0, 0);
    if (nk > 1) WSTAGE(1, 32);
    int buf = 0;
#pragma unroll 1
    for (int kt = 0; kt < nk; ++kt) {
      if (kt + 1 < nk) asm volatile("s_waitcnt vmcnt(6)" ::: "memory");
      else asm volatile("s_waitcnt vmcnt(0)" ::: "memory");
      __builtin_amdgcn_s_barrier();
      if (kt + 2 < nk) { const int nb = buf >= 1 ? buf - 1 : 2; WSTAGE(nb, (kt + 2) * 32); }
      const bf16_t* pa = dA + buf * 128 * 32 + (wm * 64 + (lane & 31)) * 32;
      const bf16_t* pb = dB + buf * 256 * 32 + (wn * 128 + (lane & 31)) * 32;
#pragma unroll
      for (int ks = 0; ks < 2; ++ks) {
        const int co = (((ks * 2 + hh) ^ swz) * 8);
        bf16x8 af[MT], bfr[NTL];
#pragma unroll
        for (int i = 0; i < MT; ++i) af[i] = *(const bf16x8*)(pa + i * 32 * 32 + co);
#pragma unroll
        for (int j = 0; j < NTL; ++j) bfr[j] = *(const bf16x8*)(pb + j * 32 * 32 + co);
#pragma unroll
        for (int i = 0; i < MT; ++i)
#pragma unroll
          for (int j = 0; j < NTL; ++j) acc[i][j] = __builtin_amdgcn_mfma_f32_32x32x16_bf16(af[i], bfr[j], acc[i][j], 0, 0, 0);
      }
      buf = buf == 2 ? 0 : buf + 1;
    }
    __syncthreads();
#undef WSTAGE
  }
};

#define ROW_OF(reg) (((reg) & 3) + 8 * ((reg) >> 2) + 4 * (lane >> 5))

__device__ __forceinline__ void job_mod(const Params& P, const Cx& X, char* smem, int job) {
  float* sc = (float*)smem;
  const int tid = X.tid;
  for (int i = tid; i < 5 * 1024; i += 256) {
    int r = i >> 10, k = i & 1023;
    float v = r < 4 ? P.in[1][r * 1024 + k] : P.in[3][k];
    sc[i] = v / (1.f + expf(-v));
  }
  __syncthreads();
  const int l = job / 96, n = (job % 96) * 64 + (tid & 63), w = tid >> 6;
  const float* W = P.in[4] + (size_t)l * 1024 * 6144;
  float a0 = 0, a1 = 0, a2 = 0, a3 = 0, a4 = 0;
#pragma unroll 16
  for (int k = w * 256; k < w * 256 + 256; ++k) {
    float wv = W[(size_t)k * 6144 + n];
    a0 += sc[k] * wv; a1 += sc[1024 + k] * wv; a2 += sc[2048 + k] * wv; a3 += sc[3072 + k] * wv; a4 += sc[4096 + k] * wv;
  }
  float* red = sc + 5 * 1024;
  red[(w * 5 + 0) * 64 + (tid & 63)] = a0; red[(w * 5 + 1) * 64 + (tid & 63)] = a1; red[(w * 5 + 2) * 64 + (tid & 63)] = a2;
  red[(w * 5 + 3) * 64 + (tid & 63)] = a3; red[(w * 5 + 4) * 64 + (tid & 63)] = a4;
  __syncthreads();
  float* modv = (float*)(X.ws + OFF_MOD);
  for (int i = tid; i < 320; i += 256) {
    int r = i >> 6, c = i & 63;
    int nn = (job % 96) * 64 + c;
    float s = red[(0 * 5 + r) * 64 + c] + red[(1 * 5 + r) * 64 + c] + red[(2 * 5 + r) * 64 + c] + red[(3 * 5 + r) * 64 + c];
    modv[(size_t)(l * 5 + r) * 6144 + nn] = s + P.in[5][l * 6144 + nn];
  }
  __syncthreads();
}

__device__ __forceinline__ void job_tables(const Params& P, const Cx& X, int job) {
  float2* tw = (float2*)(X.ws + OFF_TW);
  bf16_t* F1 = (bf16_t*)(X.ws + OFF_F1);
  bf16_t* F2 = (bf16_t*)(X.ws + OFF_F2);
  bf16_t* F256 = (bf16_t*)(X.ws + OFF_F256);
  float2* rope = (float2*)(X.ws + OFF_ROPE);
  for (int e = job * 4096 + X.tid; e < job * 4096 + 4096; e += 256) {
    int i = e;
    if (i < 4096) { tw[i] = make_float2(cospif(i / 2048.f), sinpif(i / 2048.f)); continue; }
    i -= 4096;
    if (i < 8192) {
      int R = i >> 6, t1 = i & 63;
      int f1 = (R >> 6) * 32 + (R & 31);
      int ph = (f1 * t1) & 63;
      F1[i] = f2bf(((R >> 5) & 1) ? -sinpif(ph / 32.f) : cospif(ph / 32.f));
      continue;
    }
    i -= 8192;
    if (i < 16384) {
      int m = i >> 7, k = i & 127;
      int f2 = m & 63, q = m >> 6, t2 = k & 63, p = k >> 6;
      int ph = (f2 * t2) & 63;
      float c = cospif(ph / 32.f), s = sinpif(ph / 32.f);
      float v = (q == 0) ? (p == 0 ? c : s) : (p == 0 ? -s : c);
      F2[i] = f2bf(v);
      continue;
    }
    i -= 16384;
    if (i < 131072) {
      int m = i >> 8, t = i & 255;
      int f = m & 255, q = m >> 8;
      int ph = (f * t) & 255;
      F256[i] = f2bf(q == 0 ? cospif(ph / 128.f) : -sinpif(ph / 128.f));
      continue;
    }
    i -= 131072;
    if (i < 65536) {
      int t = i >> 4, j = i & 15;
      float invf = powf(10000.f, -(float)(j & 7) / 8.f);
      float pos = (j < 8) ? (float)(t >> 6) : (float)(t & 63);
      float ang = pos * invf;
      rope[i] = make_float2(cosf(ang), sinf(ang));
    }
  }
}

__device__ __forceinline__ void cw_tile(const Cx& X, const float* __restrict__ src, int N, int lds_, bf16_t* __restrict__ dst, int ldd, const float* scale,
                        int perm, int tk, int tn, char* smem) {
  float* tile = (float*)smem;
  const int tid = X.tid;
  const int c = tid & 63, r0 = tid >> 6;
  const int ng = tn * 64 + c;
  float tv[16];
#pragma unroll
  for (int i = 0; i < 16; ++i) {
    int r = r0 + 4 * i;
    tv[i] = (ng < N) ? src[(size_t)(tk * 64 + r) * lds_ + ng] : 0.f;
    if (scale) tv[i] *= scale[tk * 64 + r];
  }
#pragma unroll
  for (int i = 0; i < 16; ++i) tile[(r0 + 4 * i) * 65 + c] = tv[i];
  __syncthreads();
#pragma unroll 4
  for (int i = 0; i < 16; ++i) {
    int nn = r0 + 4 * i;
    int n2 = tn * 64 + nn;
    if (n2 < N) {
      int drow = n2;
      if (perm) {
        int u = n2 < 2816 ? n2 : n2 - 2816;
        drow = (u >> 5) * 64 + (n2 < 2816 ? 0 : 32) + (u & 31);
      }
      dst[(size_t)drow * ldd + tk * 64 + c] = f2bf(tile[c * 65 + nn]);
    }
  }
  __syncthreads();
}

__device__ __forceinline__ void fold_job(const Params& P, const Cx& X, int layer, int fj, char* smem) {
  float* wt = (float*)smem;
  float* ct = wt + 4096;
  const int tid = X.tid;
  const int g = fj >> 4, n0 = (fj & 15) * 64;
  const float* src = P.in[28] + (size_t)layer * 512 * 1024;
  {
    float tw16[16];
#pragma unroll
    for (int k = 0; k < 16; ++k) { const int i = tid + 256 * k; tw16[k] = src[(size_t)(g * 64 + (i >> 6)) * 1024 + n0 + (i & 63)]; }
#pragma unroll
    for (int k = 0; k < 16; ++k) wt[tid + 256 * k] = tw16[k];
  }
  if (tid < 64) { ct[tid] = cospif(tid / 32.f); ct[64 + tid] = sinpif(tid / 32.f); }
  __syncthreads();
  bf16_t* dst = (bf16_t*)(X.ws + OFF_WMIX) + WE_FO;
  const int c = tid & 63, nq = tid >> 6;
#pragma unroll 1
  for (int ni = 0; ni < 16; ++ni) {
    int n = nq * 16 + ni;
    float sr = 0.f, si = 0.f;
#pragma unroll 4
    for (int cp = 0; cp < 64; ++cp) {
      float wv = wt[cp * 64 + n];
      int ph = (c * cp) & 63;
      sr += ct[ph] * wv;
      si += ct[64 + ph] * wv;
    }
    dst[(size_t)(n0 + n) * 1024 + g * 64 + c] = f2bf(sr * (1.f / 512.f));
    dst[(size_t)(n0 + n) * 1024 + 512 + g * 64 + c] = f2bf(si * (1.f / 512.f));
  }
  __syncthreads();
}

#define NCW1 2312
__device__ __forceinline__ void cw_mixer_job(const Params& P, const Cx& X, int layer, int j, char* smem) {
  bf16_t* W = (bf16_t*)(X.ws + OFF_WMIX);
  const float* src; const float* scale = nullptr; bf16_t* dst; int N, ldd, tk, tn;
  if (j >= 2184) { fold_job(P, X, layer, j - 2184, smem); return; }
  if (j < 1520) { src = P.in[7] + (size_t)layer * 1024 * 6048; N = 6048; dst = W + WE_IN; ldd = 1024; tk = j / 95; tn = j % 95; }
  else if (j < 1536) { j -= 1520; int d = j >> 3; src = P.in[11] + (size_t)(layer * 2 + d) * 64 * 512; N = 512; dst = W + WE_W2 + d * 32768; ldd = 64; tk = 0; tn = j & 7; }
  else if (j < 1552) { j -= 1536; int d = j >> 3; src = P.in[13] + (size_t)(layer * 2 + d) * 64 * 512; N = 512; dst = W + WE_A2 + d * 32768; ldd = 64; tk = 0; tn = j & 7; }
  else if (j < 1568) { j -= 1552; src = P.in[17] + (size_t)layer * 128 * 512; N = 512; dst = W + WE_G2; ldd = 128; tk = j >> 3; tn = j & 7; }
  else if (j < 1696) { j -= 1568; src = P.in[20] + (size_t)layer * 512 * 1024; N = 1024; dst = W + WE_RO; ldd = 512; tk = j >> 4; tn = j & 15; }
  else if (j < 1824) { j -= 1696; src = P.in[27] + (size_t)layer * 512 * 1024; N = 1024; dst = W + WE_MO; ldd = 512; tk = j >> 4; tn = j & 15; }
  else if (j < 1896) { j -= 1824; src = P.in[23] + (size_t)layer * 384 * 768; N = 768; dst = W + WE_UQ; ldd = 384; scale = P.in[21] + layer * 384; tk = j / 12; tn = j % 12; }
  else if (j < 1928) { j -= 1896; src = P.in[24] + (size_t)layer * 128 * 1024; N = 1024; dst = W + WE_UKV; ldd = 128; scale = P.in[22] + layer * 128; tk = j >> 4; tn = j & 15; }
  else { j -= 1928; src = P.in[29] + (size_t)layer * 1024 * 1024; N = 1024; dst = W + WE_OUT; ldd = 1024; tk = j >> 4; tn = j & 15; }
  cw_tile(X, src, N, N, dst, ldd, scale, 0, tk, tn, smem);
}
#define NCW2 2112
__device__ __forceinline__ void cw_ffn_job(const Params& P, const Cx& X, int layer, int j, char* smem) {
  bf16_t* W = (bf16_t*)(X.ws + OFF_WFFN);
  const float* src; bf16_t* dst; int N, ldd, tk, tn, perm;
  if (j < 1408) { src = P.in[31] + (size_t)layer * 1024 * 5632; N = 5632; dst = W + WF_IN; ldd = 1024; perm = 1; tk = j / 88; tn = j % 88; }
  else { j -= 1408; src = P.in[32] + (size_t)layer * 2816 * 1024; N = 1024; dst = W + WF_OUT; ldd = 2816; perm = 0; tk = j >> 4; tn = j & 15; }
  cw_tile(X, src, N, N, dst, ldd, nullptr, perm, tk, tn, smem);
}

__device__ __forceinline__ void norm_job(const Params& P, const Cx& X, int layer, int which, int job) {
  const int lane = X.tid & 63, w = X.tid >> 6;
  const int row = job * 4 + w;
  const float* src;
  if (which == 0) {
    if (row < NX) src = (layer == 0 ? P.in[0] : X.out) + (size_t)row * 1024;
    else src = (layer == 0 ? P.in[2] : (const float*)(X.ws + OFF_CS)) + (size_t)(row - NX) * 1024;
  } else {
    if (row < NX) src = X.out + (size_t)row * 1024;
    else src = (const float*)(X.ws + OFF_CS) + (size_t)(row - NX) * 1024;
  }
  const float* g = (which == 0 ? P.in[6] : P.in[30]) + layer * 1024;
  const float* modv = (const float*)(X.ws + OFF_MOD) + (size_t)(layer * 5 + mod_row(row)) * 6144;
  const float* shift = modv + (which == 0 ? 0 : 3072);
  const float* scale = modv + (which == 0 ? 1024 : 4096);
  float4 v[4];
  float ss = 0.f;
#pragma unroll
  for (int i = 0; i < 4; ++i) {
    v[i] = ((const float4*)src)[lane + 64 * i];
    ss += v[i].x * v[i].x + v[i].y * v[i].y + v[i].z * v[i].z + v[i].w * v[i].w;
  }
#pragma unroll
  for (int o = 32; o >= 1; o >>= 1) ss += __shfl_xor(ss, o);
  const float rstd = rsqrtf(ss * (1.f / 1024.f) + 1e-6f);
  bf16_t* dst = (bf16_t*)(X.ws + OFF_HBUF) + (size_t)row * 1024;
#pragma unroll
  for (int i = 0; i < 4; ++i) {
    int col = 4 * (lane + 64 * i);
    float4 gg = *(const float4*)(g + col), sh = *(const float4*)(shift + col), sc = *(const float4*)(scale + col);
    float y0 = v[i].x * rstd * gg.x * (1.f + sc.x) + sh.x;
    float y1 = v[i].y * rstd * gg.y * (1.f + sc.y) + sh.y;
    float y2 = v[i].z * rstd * gg.z * (1.f + sc.z) + sh.z;
    float y3 = v[i].w * rstd * gg.w * (1.f + sc.w) + sh.w;
    uint2 o;
    o.x = pack2(y0, y1); o.y = pack2(y2, y3);
    *(uint2*)(dst + col) = o;
  }
}

__device__ __forceinline__ void g1a_tile(const Params& P, const Cx& X, int t, char* smem) {
  const int lane = X.tid & 63, w = X.tid >> 6;
  const int mt = t % 136, nt = t / 136;
  const int m0 = mt * 128, n0 = nt * 128;
  f32x16 acc[2][2];
  G22::zero(acc);
  G22::run(X, (const bf16_t*)(X.ws + OFF_HBUF) + (size_t)m0 * 1024, 1024, (const bf16_t*)(X.ws + OFF_WMIX) + WE_IN + (size_t)n0 * 1024, 1024, 1024, smem, acc);
  bf16_t* zr = (bf16_t*)(X.ws + OFF_ZR);
  const int row0 = m0 + (w >> 1) * 64, col0 = n0 + (w & 1) * 64;
#pragma unroll
  for (int i = 0; i < 2; ++i)
#pragma unroll
    for (int j = 0; j < 2; ++j)
#pragma unroll
      for (int r = 0; r < 16; ++r) {
        int row = row0 + i * 32 + ROW_OF(r), col = col0 + j * 32 + (lane & 31);
        zr[(size_t)row * 1920 + col] = f2bf(acc[i][j][r]);
      }
}
__device__ __forceinline__ void g1b_tile(const Params& P, const Cx& X, int t, char* smem) {
  const int lane = X.tid & 63, w = X.tid >> 6;
  const int mt = t % 136, nt = t / 136;
  const int m0 = mt * 128, n0 = nt * 128;
  f32x16 acc[2][2];
  G22::zero(acc);
  G22::run(X, (const bf16_t*)(X.ws + OFF_HBUF) + (size_t)m0 * 1024, 1024, (const bf16_t*)(X.ws + OFF_WMIX) + WE_IN + (size_t)(1920 + n0) * 1024, 1024, 1024, smem, acc);
  bf16_t* zm = (bf16_t*)(X.ws + OFF_ZM);
  bf16_t* zf = (bf16_t*)(X.ws + OFF_ZF);
  const int row0 = m0 + (w >> 1) * 64, col0 = n0 + (w & 1) * 64;
#pragma unroll
  for (int i = 0; i < 2; ++i)
#pragma unroll
    for (int j = 0; j < 2; ++j)
#pragma unroll
      for (int r = 0; r < 16; ++r) {
        int row = row0 + i * 32 + ROW_OF(r), col = col0 + j * 32 + (lane & 31);
        bf16_t v = f2bf(acc[i][j][r]);
        if (col < 544) zm[(size_t)row * 544 + col] = v;
        else if (col < 1056) zf[(size_t)row * 512 + (col - 544)] = v;
      }
}

__device__ __forceinline__ void r1a_row(const Params& P, const Cx& X, int layer, int row) {
  const int tid = X.tid;
  const int ch = tid < 240 ? tid : 239;
  const int col0 = ch * 8;
  const bf16_t* zr = (const bf16_t*)(X.ws + OFF_ZR);
  bool hp, hn;
  if (row < NX) { int t = row & 4095; hp = t > 0; hn = t < 4095; }
  else { int j = (row - NX) & 255; hp = j > 0; hn = j < 255; }
  uint4 zc = *(const uint4*)(zr + (size_t)row * 1920 + col0);
  uint4 zp = make_uint4(0, 0, 0, 0), zn = make_uint4(0, 0, 0, 0);
  if (hp) zp = *(const uint4*)(zr + (size_t)(row - 1) * 1920 + col0);
  if (hn) zn = *(const uint4*)(zr + (size_t)(row + 1) * 1920 + col0);
  const float* mup = P.in[8] + layer * 1920 + col0;
  const float* mun = P.in[9] + layer * 1920 + col0;
  float zs[8];
  {
    const uint32_t c4[4] = {zc.x, zc.y, zc.z, zc.w}, p4[4] = {zp.x, zp.y, zp.z, zp.w}, n4[4] = {zn.x, zn.y, zn.z, zn.w};
#pragma unroll
    for (int i = 0; i < 4; ++i) {
      float c0 = lo16(c4[i]), c1 = hi16(c4[i]);
      zs[2 * i] = c0 + (lo16(p4[i]) - c0) * mup[2 * i] + (lo16(n4[i]) - c0) * mun[2 * i];
      zs[2 * i + 1] = c1 + (hi16(p4[i]) - c1) * mup[2 * i + 1] + (hi16(n4[i]) - c1) * mun[2 * i + 1];
    }
  }
  float ss = 0.f;
  float kv[8];
  const bool isk = (col0 >= 512 && col0 < 1024);
  {
    const float* kk_w = P.in[14] + layer * 512 + (isk ? col0 - 512 : 0);
#pragma unroll
    for (int i = 0; i < 8; ++i) { kv[i] = zs[i] * kk_w[i]; ss += kv[i] * kv[i]; }
  }
  ss += __shfl_xor(ss, 1); ss += __shfl_xor(ss, 2); ss += __shfl_xor(ss, 4);
  if (tid < 240) {
    uint4 o;
    if (col0 < 1536) {
      o.x = pack2(zs[0], zs[1]); o.y = pack2(zs[2], zs[3]); o.z = pack2(zs[4], zs[5]); o.w = pack2(zs[6], zs[7]);
      *(uint4*)((bf16_t*)(X.ws + OFF_RKV) + (size_t)row * 1536 + col0) = o;
      if (isk) {
        float inv = 1.f / fmaxf(sqrtf(ss), 1e-12f);
        o.x = pack2(kv[0] * inv, kv[1] * inv); o.y = pack2(kv[2] * inv, kv[3] * inv);
        o.z = pack2(kv[4] * inv, kv[5] * inv); o.w = pack2(kv[6] * inv, kv[7] * inv);
        *(uint4*)((bf16_t*)(X.ws + OFF_KK) + (size_t)row * 512 + (col0 - 512)) = o;
      }
    } else {
      float t[8];
      if (col0 < 1664) {
#pragma unroll
        for (int i = 0; i < 8; ++i) t[i] = tanhf(zs[i]);
      } else if (col0 < 1792) {
#pragma unroll
        for (int i = 0; i < 8; ++i) t[i] = zs[i];
      } else {
#pragma unroll
        for (int i = 0; i < 8; ++i) t[i] = 1.f / (1.f + expf(-zs[i]));
      }
      o.x = pack2(t[0], t[1]); o.y = pack2(t[2], t[3]); o.z = pack2(t[4], t[5]); o.w = pack2(t[6], t[7]);
      *(uint4*)((bf16_t*)(X.ws + OFF_LORA) + (size_t)row * 384 + (col0 - 1536)) = o;
    }
  }
}

__device__ __forceinline__ void r1b_tile(const Params& P, const Cx& X, int layer, int t, char* smem) {
  const int lane = X.tid & 63, w = X.tid >> 6;
  const int mt = t % 136, rest = t / 136;
  const int nt = rest & 3, type = rest >> 2;
  const int m0 = mt * 128, n0 = nt * 128;
  const bf16_t* lora = (const bf16_t*)(X.ws + OFF_LORA) + (size_t)m0 * 384;
  const bf16_t* W = (const bf16_t*)(X.ws + OFF_WMIX);
  f32x16 acc[2][2];
  G22::zero(acc);
  if (type < 2) G22::run(X, lora + type * 64, 384, W + WE_W2 + type * 32768 + (size_t)n0 * 64, 64, 64, smem, acc);
  else if (type < 4) G22::run(X, lora + 128 + (type - 2) * 64, 384, W + WE_A2 + (type - 2) * 32768 + (size_t)n0 * 64, 64, 64, smem, acc);
  else G22::run(X, lora + 256, 384, W + WE_G2 + (size_t)n0 * 128, 128, 128, smem, acc);
  const int row0 = m0 + (w >> 1) * 64, col0 = n0 + (w & 1) * 64;
  bf16_t* ld = (bf16_t*)(X.ws + OFF_LD);
  bf16_t* ab = (bf16_t*)(X.ws + OFF_A);
  bf16_t* gb = (bf16_t*)(X.ws + OFF_G);
#pragma unroll
  for (int j = 0; j < 2; ++j) {
    const int col = col0 + j * 32 + (lane & 31);
    float bias = 0.f;
    if (type < 2) bias = P.in[10][(layer * 2 + type) * 512 + col];
    else if (type < 4) bias = P.in[12][(layer * 2 + type - 2) * 512 + col];
#pragma unroll
    for (int i = 0; i < 2; ++i)
#pragma unroll
      for (int r = 0; r < 16; ++r) {
        int row = row0 + i * 32 + ROW_OF(r);
        float v = acc[i][j][r] + bias;
        if (type < 2) ld[(size_t)row * 1024 + type * 512 + col] = f2bf(-0.60653066f / (1.f + __expf(-v)));
        else if (type < 4) ab[(size_t)row * 1024 + (type - 2) * 512 + col] = f2bf(1.f / (1.f + __expf(-v)));
        else gb[(size_t)row * 512 + col] = f2bf(v);
      }
  }
}

template <int CTRL>
__device__ __forceinline__ float dpp_f(float x) {
  return __int_as_float(__builtin_amdgcn_update_dpp(0, __float_as_int(x), CTRL, 0xf, 0xf, false));
}
__device__ __forceinline__ float red16(float x) {
  x += dpp_f<0x128>(x);
  x += dpp_f<0x124>(x);
  x += dpp_f<0x4E>(x);
  x += dpp_f<0xB1>(x);
  return x;
}
__device__ __forceinline__ int scan_tokrow(int b, int dir, int i) {
  if (i < 256) return NX + b * 256 + (dir ? 255 - i : i);
  int t = i - 256;
  return b * 4096 + (dir ? 4095 - t : t);
}
typedef float f2_t __attribute__((ext_vector_type(2)));
__device__ __forceinline__ void scan_job(const Params& P, const Cx& X, int layer, int bj, char* smem) {
  const int tid = X.tid, lane = tid & 63, w = tid >> 6;
  const int s = bj >> 2, rq = bj & 3;
  const int dir = s >> 5, b = (s & 31) >> 3, h = s & 7;
  float* sv = (float*)smem;
  float* sy = sv + 2 * 16 * 6 * 64;
  const bf16_t* rkv = (const bf16_t*)(X.ws + OFF_RKV);
  const bf16_t* kkb = (const bf16_t*)(X.ws + OFF_KK);
  const bf16_t* ab = (const bf16_t*)(X.ws + OFF_A);
  const bf16_t* ldb = (const bf16_t*)(X.ws + OFF_LD);
  bf16_t* yout = (bf16_t*)(X.ws + (dir ? OFF_YB : OFF_YF));
  const int lst = tid >> 4, lch = (tid & 15) * 4;
  const float4 ka4 = *(const float4*)(P.in[15] + layer * 512 + h * 64 + lch);
  uint2 pr, pk, pv, pkk, pa, pl;
#define SLOAD(chunk)                                                          \
  {                                                                           \
    int row = scan_tokrow(b, dir, (chunk)*16 + lst);                          \
    const bf16_t* p0 = rkv + (size_t)row * 1536 + h * 64 + lch;               \
    pr = *(const uint2*)p0; pk = *(const uint2*)(p0 + 512); pv = *(const uint2*)(p0 + 1024); \
    pkk = *(const uint2*)(kkb + (size_t)row * 512 + h * 64 + lch);            \
    pa = *(const uint2*)(ab + (size_t)row * 1024 + dir * 512 + h * 64 + lch); \
    pl = *(const uint2*)(ldb + (size_t)row * 1024 + dir * 512 + h * 64 + lch);\
  }
#define SSTORE2(buf)                                                          \
  {                                                                           \
    float* d = sv + ((buf)*16 + lst) * 384 + lch;                             \
    float a0 = lo16(pa.x), a1 = hi16(pa.x), a2 = lo16(pa.y), a3 = hi16(pa.y); \
    float k0 = lo16(pk.x), k1 = hi16(pk.x), k2 = lo16(pk.y), k3 = hi16(pk.y); \
    float q0 = lo16(pkk.x), q1 = hi16(pkk.x), q2 = lo16(pkk.y), q3 = hi16(pkk.y); \
    *(float4*)(d) = make_float4(q0, q1, q2, q3);                              \
    *(float4*)(d + 64) = make_float4(__expf(lo16(pl.x)), __expf(hi16(pl.x)), __expf(lo16(pl.y)), __expf(hi16(pl.y))); \
    *(float4*)(d + 128) = make_float4(q0 * a0, q1 * a1, q2 * a2, q3 * a3);    \
    *(float4*)(d + 192) = make_float4(k0 * (1.f + (a0 - 1.f) * ka4.x), k1 * (1.f + (a1 - 1.f) * ka4.y), k2 * (1.f + (a2 - 1.f) * ka4.z), k3 * (1.f + (a3 - 1.f) * ka4.w)); \
    *(float4*)(d + 256) = make_float4(lo16(pr.x), hi16(pr.x), lo16(pr.y), hi16(pr.y)); \
    *(float4*)(d + 320) = make_float4(lo16(pv.x), hi16(pv.x), lo16(pv.y), hi16(pv.y)); \
  }
  SLOAD(0);
  SSTORE2(0);
  __syncthreads();
  const int rp = lane >> 4, ci = (lane & 15) * 4;
  const int vrow = rq * 16 + w * 4 + rp;
  float S0 = 0.f, S1 = 0.f, S2 = 0.f, S3 = 0.f, qy = 0.f;
  for (int chunk = 0; chunk < 272; ++chunk) {
    const int buf = chunk & 1;
    SLOAD(chunk + 1 < 272 ? chunk + 1 : 271);
    __builtin_amdgcn_sched_barrier(0);
    {
      const float* base = sv + buf * 16 * 384;
      float ysel = 0.f;
      qy = 0.f;
      float4 p0kk, p0w, p0b, p0kd, p0r, p1kk, p1w, p1b, p1kd, p1r;
      float p0v, p1v;
#define LDS_SET(S, st)                                     \
  {                                                        \
    const float* d = base + (st)*384;                      \
    S##kk = *(const float4*)(d + ci);                      \
    S##w = *(const float4*)(d + 64 + ci);                  \
    S##b = *(const float4*)(d + 128 + ci);                 \
    S##kd = *(const float4*)(d + 192 + ci);                \
    S##r = *(const float4*)(d + 256 + ci);                 \
    S##v = d[320 + vrow];                                  \
  }
#define DPPS "row_mask:0xf bank_mask:0xf bound_ctrl:1\n"
#define STEP(S, st)                                                                                   \
  {                                                                                                   \
    float t0, t1, u0, u1, u2, u3;                                                                     \
    asm volatile(                                                                                     \
        "v_mul_f32 %5, %0, %11\n"                                                                     \
        "v_mul_f32 %6, %1, %12\n"                                                                     \
        "v_fma_f32 %5, %2, %13, %5\n"                                                                 \
        "v_fma_f32 %6, %3, %14, %6\n"                                                                 \
        "v_mul_f32 %7, %27, %23\n"                                                                    \
        "v_add_f32 %5, %5, %6\n"                                                                      \
        "v_mul_f32 %8, %27, %24\n"                                                                    \
        "v_mul_f32 %9, %27, %25\n"                                                                    \
        "v_add_f32_dpp %5, %5, %5 row_ror:8 " DPPS                                                    \
        "v_add_f32_dpp %4, %4, %4 row_ror:8 " DPPS                                                    \
        "v_mul_f32 %10, %27, %26\n"                                                                   \
        "v_add_f32_dpp %5, %5, %5 row_ror:4 " DPPS                                                    \
        "v_add_f32_dpp %4, %4, %4 row_ror:4 " DPPS                                                    \
        "v_fma_f32 %7, %0, %15, %7\n"                                                                 \
        "v_add_f32_dpp %5, %5, %5 quad_perm:[2,3,0,1] " DPPS                                          \
        "v_add_f32_dpp %4, %4, %4 quad_perm:[2,3,0,1] " DPPS                                          \
        "v_fma_f32 %8, %1, %16, %8\n"                                                                 \
        "v_add_f32_dpp %5, %5, %5 quad_perm:[1,0,3,2] " DPPS                                          \
        "v_add_f32_dpp %4, %4, %4 quad_perm:[1,0,3,2] " DPPS                                          \
        "v_fma_f32 %9, %2, %17, %9\n"                                                                 \
        "v_fma_f32 %10, %3, %18, %10\n"                                                               \
        "v_fma_f32 %0, -%5, %19, %7\n"                                                                \
        "v_fma_f32 %1, -%5, %20, %8\n"                                                                \
        "v_fma_f32 %2, -%5, %21, %9\n"                                                                \
        "v_fma_f32 %3, -%5, %22, %10\n"                                                               \
        : "+v"(S0), "+v"(S1), "+v"(S2), "+v"(S3), "+v"(qy), "=&v"(t0), "=&v"(t1), "=&v"(u0), "=&v"(u1), \
          "=&v"(u2), "=&v"(u3)                                                                        \
        : "v"(S##kk.x), "v"(S##kk.y), "v"(S##kk.z), "v"(S##kk.w), "v"(S##w.x), "v"(S##w.y), "v"(S##w.z), \
          "v"(S##w.w), "v"(S##b.x), "v"(S##b.y), "v"(S##b.z), "v"(S##b.w), "v"(S##kd.x), "v"(S##kd.y), \
          "v"(S##kd.z), "v"(S##kd.w), "v"(S##v));                                                     \
                                                 \
    if ((st) > 0) ysel = ((lane & 15) == (st)-1) ? qy : ysel;                                         \
    qy = fmaf(S2, S##r.z, S0 * S##r.x) + fmaf(S3, S##r.w, S1 * S##r.y);                               \
  }
      LDS_SET(p0, 0);
#pragma unroll
      for (int st = 0; st < 16; st += 2) {
        LDS_SET(p1, st + 1);
        __builtin_amdgcn_sched_barrier(0);
        STEP(p0, st);
        if (st + 2 < 16) LDS_SET(p0, st + 2);
        __builtin_amdgcn_sched_barrier(0);
        STEP(p1, st + 1);
      }
#undef LDS_SET
#undef STEP
#undef DPPS
      qy = red16(qy);
      ysel = ((lane & 15) == 15) ? qy : ysel;
      sy[(buf * 16 + (lane & 15)) * 16 + w * 4 + rp] = ysel;
    }
    if (chunk + 1 < 272) SSTORE2(buf ^ 1);
    __syncthreads();
    {
      int st = tid >> 4, r = tid & 15;
      int row = scan_tokrow(b, dir, chunk * 16 + st);
      yout[(size_t)row * 512 + h * 64 + rq * 16 + r] = f2bf(sy[(buf * 16 + st) * 16 + r]);
    }
  }
#undef SLOAD
#undef SSTORE2
  __syncthreads();
}

__device__ __forceinline__ void s2_job(const Params& P, const Cx& X, int layer, int job) {
  const int tid = X.tid;
  const int row = job * 4 + (tid >> 6);
  const int c0 = (tid & 63) * 8;
  const bf16_t* rkv = (const bf16_t*)(X.ws + OFF_RKV) + (size_t)row * 1536;
  uint4 ur = *(const uint4*)(rkv + c0), uk = *(const uint4*)(rkv + 512 + c0), uv = *(const uint4*)(rkv + 1024 + c0);
  uint4 ua0 = *(const uint4*)((const bf16_t*)(X.ws + OFF_A) + (size_t)row * 1024 + c0);
  uint4 ua1 = *(const uint4*)((const bf16_t*)(X.ws + OFF_A) + (size_t)row * 1024 + 512 + c0);
  uint4 ug = *(const uint4*)((const bf16_t*)(X.ws + OFF_G) + (size_t)row * 512 + c0);
  uint4 uyf = *(const uint4*)((const bf16_t*)(X.ws + OFF_YF) + (size_t)row * 512 + c0);
  uint4 uyb = *(const uint4*)((const bf16_t*)(X.ws + OFF_YB) + (size_t)row * 512 + c0);
  const uint32_t r4[4] = {ur.x, ur.y, ur.z, ur.w}, k4[4] = {uk.x, uk.y, uk.z, uk.w}, v4[4] = {uv.x, uv.y, uv.z, uv.w};
  const uint32_t a04[4] = {ua0.x, ua0.y, ua0.z, ua0.w}, a14[4] = {ua1.x, ua1.y, ua1.z, ua1.w}, g4[4] = {ug.x, ug.y, ug.z, ug.w};
  const uint32_t yf4[4] = {uyf.x, uyf.y, uyf.z, uyf.w}, yb4[4] = {uyb.x, uyb.y, uyb.z, uyb.w};
  float y[8], vv[8], gg[8];
  float sum = 0.f, bon = 0.f;
  const float* rk = P.in[16] + layer * 512 + c0;
  const float* ka = P.in[15] + layer * 512 + c0;
#pragma unroll
  for (int i = 0; i < 4; ++i) {
#pragma unroll
    for (int hh = 0; hh < 2; ++hh) {
      int e = 2 * i + hh;
      float r = hh ? hi16(r4[i]) : lo16(r4[i]);
      float k = hh ? hi16(k4[i]) : lo16(k4[i]);
      float a0 = hh ? hi16(a04[i]) : lo16(a04[i]);
      float a1 = hh ? hi16(a14[i]) : lo16(a14[i]);
      y[e] = (hh ? hi16(yf4[i]) : lo16(yf4[i])) + (hh ? hi16(yb4[i]) : lo16(yb4[i]));
      vv[e] = hh ? hi16(v4[i]) : lo16(v4[i]);
      gg[e] = hh ? hi16(g4[i]) : lo16(g4[i]);
      sum += y[e];
      float ksum = k * (2.f + (a0 + a1 - 2.f) * ka[e]);
      bon += r * rk[e] * ksum;
    }
  }
  sum += __shfl_xor(sum, 1); sum += __shfl_xor(sum, 2); sum += __shfl_xor(sum, 4);
  bon += __shfl_xor(bon, 1); bon += __shfl_xor(bon, 2); bon += __shfl_xor(bon, 4);
  const float mu = sum * (1.f / 64.f);
  float var = 0.f;
#pragma unroll
  for (int e = 0; e < 8; ++e) { float d = y[e] - mu; var += d * d; }
  var += __shfl_xor(var, 1); var += __shfl_xor(var, 2); var += __shfl_xor(var, 4);
  const float rs = rsqrtf(var * (1.f / 64.f) + 64e-5f);
  const float* gw = P.in[18] + layer * 512 + c0;
  const float* gbi = P.in[19] + layer * 512 + c0;
  float o[8];
#pragma unroll
  for (int e = 0; e < 8; ++e) o[e] = ((y[e] - mu) * rs * gw[e] + gbi[e] + bon * vv[e]) * gg[e];
  uint4 ou;
  ou.x = pack2(o[0], o[1]); ou.y = pack2(o[2], o[3]); ou.z = pack2(o[4], o[5]); ou.w = pack2(o[6], o[7]);
  *(uint4*)((bf16_t*)(X.ws + OFF_RWO) + (size_t)row * 512 + c0) = ou;
}

__device__ __forceinline__ float red32(float x) {
  x += __shfl_xor(x, 1); x += __shfl_xor(x, 2); x += __shfl_xor(x, 4); x += __shfl_xor(x, 8); x += __shfl_xor(x, 16);
  return x;
}
#define QSCALE 0.14724444f
__device__ __forceinline__ void q1_q_tile(const Params& P, const Cx& X, int layer, int t, char* smem) {
  const int tid = X.tid, lane = tid & 63, w = tid >> 6;
  const int mt = t % 136, head = t / 136;
  const int m0 = mt * 128;
  const bf16_t* zm = (const bf16_t*)(X.ws + OFF_ZM);
  float* srs = (float*)(smem + 73728);
  {
    int r = tid >> 1, hf = tid & 1;
    const bf16_t* p = zm + (size_t)(m0 + r) * 544 + hf * 192;
    float ss = 0.f;
#pragma unroll 12
    for (int i = 0; i < 24; ++i) {
      uint4 u = *(const uint4*)(p + i * 8);
      ss += lo16(u.x) * lo16(u.x) + hi16(u.x) * hi16(u.x) + lo16(u.y) * lo16(u.y) + hi16(u.y) * hi16(u.y) +
            lo16(u.z) * lo16(u.z) + hi16(u.z) * hi16(u.z) + lo16(u.w) * lo16(u.w) + hi16(u.w) * hi16(u.w);
    }
    ss += __shfl_xor(ss, 1);
    if (hf == 0) srs[r] = rsqrtf(ss * (1.f / 384.f) + 1e-6f);
  }
  f32x16 acc[1][3];
  GQ::zero(acc);
  GQ::run(X, zm + (size_t)m0 * 544, 544, (const bf16_t*)(X.ws + OFF_WMIX) + WE_UQ + (size_t)head * 96 * 384, 384, 384, smem, acc);
  const int l5 = lane & 31;
  const float* gq = P.in[25] + layer * 96;
  const float g0 = gq[l5], g1 = gq[32 + l5], g2 = gq[64 + l5];
  const float2* rope = (const float2*)(X.ws + OFF_ROPE);
  bf16_t* qb = (bf16_t*)(X.ws + OFF_Q);
  float2 rcs[16];
#pragma unroll
  for (int r = 0; r < 16; ++r) {
    const int row = m0 + w * 32 + ROW_OF(r);
    rcs[r] = (row < NX) ? rope[(row & 4095) * 16 + (l5 >> 4) * 8 + (l5 & 7)] : make_float2(1.f, 0.f);
  }
#pragma unroll
  for (int r = 0; r < 16; ++r) {
    const int rl = w * 32 + ROW_OF(r);
    const int row = m0 + rl;
    const float rs = srs[rl];
    float x0 = acc[0][0][r] * rs, x1 = acc[0][1][r] * rs, x2 = acc[0][2][r] * rs;
    float ss = red32(x0 * x0 + x1 * x1 + x2 * x2);
    float rq = rsqrtf(ss * (1.f / 96.f) + 1e-6f);
    x0 *= rq * g0; x1 *= rq * g1; x2 *= rq * g2;
    bf16_t* dst;
    if (row < NX) {
      int tt = row & 4095, bb = row >> 12;
      float2 cs = rcs[r];
      float other = __shfl_xor(x2, 8);
      x2 = (l5 & 8) ? x2 * cs.x + other * cs.y : x2 * cs.x - other * cs.y;
      dst = qb + ((size_t)(bb * 8 + head) * 4096 + tt) * 96;
    } else {
      int j = (row - NX) & 255, bb = (row - NX) >> 8;
      dst = qb + (size_t)NX * 768 + ((size_t)(bb * 8 + head) * 256 + j) * 96;
    }
    dst[l5] = f2bf(x0 * QSCALE); dst[32 + l5] = f2bf(x1 * QSCALE); dst[64 + l5] = f2bf(x2 * QSCALE);
  }
}
__device__ __forceinline__ void q1_kv_tile(const Params& P, const Cx& X, int layer, int t, char* smem) {
  const int tid = X.tid, lane = tid & 63, w = tid >> 6;
  const int mt = t % 136, head = t / 136;
  const int m0 = mt * 128;
  const bf16_t* zm = (const bf16_t*)(X.ws + OFF_ZM);
  float* srs = (float*)(smem + 73728);
  {
    int r = tid >> 1, hf = tid & 1;
    const bf16_t* p = zm + (size_t)(m0 + r) * 544 + 384 + hf * 64;
    float ss = 0.f;
#pragma unroll
    for (int i = 0; i < 8; ++i) {
      uint4 u = *(const uint4*)(p + i * 8);
      ss += lo16(u.x) * lo16(u.x) + hi16(u.x) * hi16(u.x) + lo16(u.y) * lo16(u.y) + hi16(u.y) * hi16(u.y) +
            lo16(u.z) * lo16(u.z) + hi16(u.z) * hi16(u.z) + lo16(u.w) * lo16(u.w) + hi16(u.w) * hi16(u.w);
    }
    ss += __shfl_xor(ss, 1);
    if (hf == 0) srs[r] = rsqrtf(ss * (1.f / 128.f) + 1e-6f);
  }
  f32x16 acc[1][4];
  GKV::zero(acc);
  GKV::run(X, zm + (size_t)m0 * 544 + 384, 544, (const bf16_t*)(X.ws + OFF_WMIX) + WE_UKV + (size_t)head * 128 * 128, 128, 128, smem, acc);
  const int l5 = lane & 31;
  const float* gk = P.in[26] + layer * 96;
  const float g0 = gk[l5], g1 = gk[32 + l5], g2 = gk[64 + l5];
  const float2* rope = (const float2*)(X.ws + OFF_ROPE);
  bf16_t* kb = (bf16_t*)(X.ws + OFF_K);
  bf16_t* vt = (bf16_t*)(X.ws + OFF_VT);
  const bool isx = m0 < NX;
  const int bb = isx ? (m0 >> 12) : ((m0 - NX) >> 8);
  float vv0[16], vv1[16];
  float krv[16];
  float2 rcs[16];
#pragma unroll
  for (int r = 0; r < 16; ++r) {
    const int row = m0 + w * 32 + ROW_OF(r);
    krv[r] = bf2f(zm[(size_t)row * 544 + 512 + l5]);
    rcs[r] = isx ? rope[(row & 4095) * 16 + (l5 >> 4) * 8 + (l5 & 7)] : make_float2(1.f, 0.f);
  }
#pragma unroll
  for (int r = 0; r < 16; ++r) {
    const int rl = w * 32 + ROW_OF(r);
    const int row = m0 + rl;
    const float rs = srs[rl];
    float k0 = acc[0][0][r] * rs, k1 = acc[0][1][r] * rs;
    float kr = krv[r];
    float ss = red32(k0 * k0 + k1 * k1 + kr * kr);
    float rk = rsqrtf(ss * (1.f / 96.f) + 1e-6f);
    k0 *= rk * g0; k1 *= rk * g1; kr *= rk * g2;
    int key;
    if (isx) {
      int tt = row & 4095;
      float2 cs = rcs[r];
      float other = __shfl_xor(kr, 8);
      kr = (l5 & 8) ? kr * cs.x + other * cs.y : kr * cs.x - other * cs.y;
      key = 256 + tt;
    } else {
      key = (row - NX) & 255;
    }
    bf16_t* dst = kb + ((size_t)(bb * 8 + head) * 4352 + key) * 96;
    dst[l5] = f2bf(k0); dst[32 + l5] = f2bf(k1); dst[64 + l5] = f2bf(kr);
    vv0[r] = acc[0][2][r] * rs;
    vv1[r] = acc[0][3][r] * rs;
  }
#pragma unroll
  for (int g = 0; g < 4; ++g) {
    const int rl = w * 32 + 8 * g + 4 * (lane >> 5);
    const int row = m0 + rl;
    const int key = isx ? 256 + (row & 4095) : ((row - NX) & 255);
    uint2 o0, o1;
    o0.x = pack2(vv0[4 * g], vv0[4 * g + 1]); o0.y = pack2(vv0[4 * g + 2], vv0[4 * g + 3]);
    o1.x = pack2(vv1[4 * g], vv1[4 * g + 1]); o1.y = pack2(vv1[4 * g + 2], vv1[4 * g + 3]);
    *(uint2*)(vt + ((size_t)(bb * 8 + head) * 64 + l5) * 4352 + key) = o0;
    *(uint2*)(vt + ((size_t)(bb * 8 + head) * 64 + 32 + l5) * 4352 + key) = o1;
  }
}

__device__ __forceinline__ void fft1_tile(const Params& P, const Cx& X, int t, char* smem) {
  const int lane = X.tid & 63, w = X.tid >> 6;
  const int b = t >> 8, ntile = t & 255;
  const int n0 = ntile * 128;
  f32x16 acc[2][2];
  G22T::zero(acc);
  G22T::run(X, (const bf16_t*)(X.ws + OFF_F1), 64, (const bf16_t*)(X.ws + OFF_ZF) + (size_t)b * 4096 * 512 + n0, 32768, 64, smem, acc);
  const float2* tw = (const float2*)(X.ws + OFF_TW);
  bf16_t* out = (bf16_t*)(X.ws + OFF_FFT1);
  const int wm = w >> 1, wn = w & 1;
  const int t2 = n0 >> 9;
#pragma unroll
  for (int j = 0; j < 2; ++j) {
    const int ch = (n0 & 511) + wn * 64 + j * 32 + (lane & 31);
    float2 tcs[16];
#pragma unroll
    for (int r = 0; r < 16; ++r) tcs[r] = tw[t2 * (wm * 32 + ROW_OF(r))];
#pragma unroll
    for (int r = 0; r < 16; ++r) {
      const int f1 = wm * 32 + ROW_OF(r);
      float re = acc[0][j][r], im = acc[1][j][r];
      float2 cs = tcs[r];
      float re2 = re * cs.x + im * cs.y, im2 = im * cs.x - re * cs.y;
      size_t base = ((size_t)(b * 64 + f1) * 128) * 512 + ch;
      out[base + (size_t)t2 * 512] = f2bf(re2);
      out[base + (size_t)(64 + t2) * 512] = f2bf(im2);
    }
  }
}
__device__ __forceinline__ void fft2_tile(const Params& P, const Cx& X, int t, char* smem) {
  const int lane = X.tid & 63, w = X.tid >> 6;
  const int bf = t >> 2, ntile = t & 3;
  const int b = bf >> 6, f1 = bf & 63;
  const int n0 = ntile * 128;
  f32x16 acc[2][2];
  G22T::zero(acc);
  G22T::run(X, (const bf16_t*)(X.ws + OFF_F2), 128, (const bf16_t*)(X.ws + OFF_FFT1) + (size_t)bf * 128 * 512 + n0, 512, 128, smem, acc);
  bf16_t* Y = (bf16_t*)(X.ws + OFF_Y);
  const int wm = w >> 1, wn = w & 1;
#pragma unroll
  for (int i = 0; i < 2; ++i)
#pragma unroll
    for (int j = 0; j < 2; ++j)
#pragma unroll
      for (int r = 0; r < 16; ++r) {
        int m = wm * 64 + i * 32 + ROW_OF(r);
        int f2 = m & 63, q = m >> 6;
        int ch = n0 + wn * 64 + j * 32 + (lane & 31);
        Y[(size_t)(b * 4096 + f1 + 64 * f2) * 1024 + q * 512 + ch] = f2bf(acc[i][j][r]);
      }
}
__device__ __forceinline__ void ctxdft_tile(const Params& P, const Cx& X, int t, char* smem) {
  const int lane = X.tid & 63, w = X.tid >> 6;
  const int b = t >> 4, mt = (t >> 2) & 3, ntile = t & 3;
  const int n0 = ntile * 128;
  f32x16 acc[2][2];
  G22T::zero(acc);
  G22T::run(X, (const bf16_t*)(X.ws + OFF_F256) + (size_t)mt * 128 * 256, 256, (const bf16_t*)(X.ws + OFF_ZF) + (size_t)(NX + b * 256) * 512 + n0, 512, 256, smem, acc);
  bf16_t* Y = (bf16_t*)(X.ws + OFF_Y);
  const int wm = w >> 1, wn = w & 1;
#pragma unroll
  for (int i = 0; i < 2; ++i)
#pragma unroll
    for (int j = 0; j < 2; ++j)
#pragma unroll
      for (int r = 0; r < 16; ++r) {
        int m = mt * 128 + wm * 64 + i * 32 + ROW_OF(r);
        int f = m & 255, q = m >> 8;
        int ch = n0 + wn * 64 + j * 32 + (lane & 31);
        Y[(size_t)(NX + b * 256 + f) * 1024 + q * 512 + ch] = f2bf(acc[i][j][r] * 4.f);
      }
}

__device__ __forceinline__ void attn_item(const Params& P, const Cx& X, int it, bool isctx, char* smem) {
  const int tid = X.tid, lane = tid & 63, w = tid >> 6;
  int b, h, qb, nkt, qrow0;
  const bf16_t* qbase;
  if (!isctx) {
    b = it >> 8; h = (it >> 5) & 7; qb = it & 31; nkt = 68;
    qbase = (const bf16_t*)(X.ws + OFF_Q) + ((size_t)(b * 8 + h) * 4096 + qb * 128) * 96;
    qrow0 = b * 4096 + qb * 128;
  } else {
    b = it >> 4; h = (it >> 1) & 7; qb = it & 1; nkt = 4;
    qbase = (const bf16_t*)(X.ws + OFF_Q) + (size_t)NX * 768 + ((size_t)(b * 8 + h) * 256 + qb * 128) * 96;
    qrow0 = NX + b * 256 + qb * 128;
  }
  const bf16_t* kbase = (const bf16_t*)(X.ws + OFF_K) + (size_t)(b * 8 + h) * 4352 * 96;
  const bf16_t* vbase = (const bf16_t*)(X.ws + OFF_VT) + (size_t)(b * 8 + h) * 64 * 4352;
  bf16_t* sK = (bf16_t*)smem;
  bf16_t* sV = sK + 2 * 64 * 104;
  const int l5 = lane & 31, hh = lane >> 5;
  const bf16_t* qp = qbase + (size_t)(w * 32 + l5) * 96 + hh * 8;
  const bf16x8 qf0 = *(const bf16x8*)(qp), qf1 = *(const bf16x8*)(qp + 16), qf2 = *(const bf16x8*)(qp + 32);
  const bf16x8 qf3 = *(const bf16x8*)(qp + 48), qf4 = *(const bf16x8*)(qp + 64), qf5 = *(const bf16x8*)(qp + 80);
  uint4 rk0, rk1, rk2, rv0, rv1;
#define LK_(i, kt) (*(const uint4*)(kbase + (size_t)((kt)*64 + (tid + 256 * (i)) / 12) * 96 + ((tid + 256 * (i)) % 12) * 8))
#define LV_(i, kt) (*(const uint4*)(vbase + (size_t)((tid + 256 * (i)) >> 3) * 4352 + (kt)*64 + ((tid + 256 * (i)) & 7) * 8))
#define ALOAD(kt) { rk0 = LK_(0, kt); rk1 = LK_(1, kt); rk2 = LK_(2, kt); rv0 = LV_(0, kt); rv1 = LV_(1, kt); }
#define SK_(i, buf, v) *(uint4*)(sK + (buf)*64 * 104 + ((tid + 256 * (i)) / 12) * 104 + ((tid + 256 * (i)) % 12) * 8) = v
#define SV_(i, buf, v) *(uint4*)(sV + (buf)*64 * 72 + ((tid + 256 * (i)) >> 3) * 72 + ((tid + 256 * (i)) & 7) * 8) = v
#define ASTORE(buf) { SK_(0, buf, rk0); SK_(1, buf, rk1); SK_(2, buf, rk2); SV_(0, buf, rv0); SV_(1, buf, rv1); }
  f32x16 o[2];
#pragma unroll
  for (int r = 0; r < 16; ++r) { o[0][r] = 0.f; o[1][r] = 0.f; }
  float mrun = -1e30f, lrun = 0.f;
  ALOAD(0);
  ASTORE(0);
  __syncthreads();
  for (int kt = 0; kt < nkt; ++kt) {
    const int buf = kt & 1;
    if (kt + 1 < nkt) ALOAD(kt + 1);
    const bf16_t* pk = sK + buf * 64 * 104 + l5 * 104 + hh * 8;
    const bf16_t* pv = sV + buf * 64 * 72 + l5 * 72 + 4 * hh;
#pragma unroll
    for (int mt = 0; mt < 2; ++mt) {
      f32x16 sc;
#pragma unroll
      for (int r = 0; r < 16; ++r) sc[r] = 0.f;
#define QK(ks, qq) sc = __builtin_amdgcn_mfma_f32_32x32x16_bf16(*(const bf16x8*)(pk + mt * 32 * 104 + (ks)*16), qq, sc, 0, 0, 0)
      QK(0, qf0); QK(1, qf1); QK(2, qf2); QK(3, qf3); QK(4, qf4); QK(5, qf5);
#undef QK
      float mx = sc[0];
#pragma unroll
      for (int r = 1; r < 16; ++r) mx = fmaxf(mx, sc[r]);
      mx = fmaxf(mx, __shfl_xor(mx, 32));
      const float mnew = fmaxf(mrun, mx);
      if (__builtin_amdgcn_ballot_w64(mnew > mrun) != 0ull) {
        const float alpha = __builtin_amdgcn_exp2f(mrun - mnew);
        lrun *= alpha;
#pragma unroll
        for (int r = 0; r < 16; ++r) { o[0][r] *= alpha; o[1][r] *= alpha; }
        mrun = mnew;
      }
      float psum = 0.f;
#pragma unroll
      for (int r = 0; r < 16; ++r) { sc[r] = __builtin_amdgcn_exp2f(sc[r] - mrun); psum += sc[r]; }
      lrun += psum;
#pragma unroll
      for (int s2 = 0; s2 < 2; ++s2) {
        u32x4 pu;
        pu[0] = pack2(sc[8 * s2 + 0], sc[8 * s2 + 1]);
        pu[1] = pack2(sc[8 * s2 + 2], sc[8 * s2 + 3]);
        pu[2] = pack2(sc[8 * s2 + 4], sc[8 * s2 + 5]);
        pu[3] = pack2(sc[8 * s2 + 6], sc[8 * s2 + 7]);
        const bf16x8 pfv = __builtin_bit_cast(bf16x8, pu);
#pragma unroll
        for (int dt = 0; dt < 2; ++dt) {
          const bf16_t* p = pv + dt * 32 * 72 + mt * 32 + s2 * 16;
          uint2 v0 = *(const uint2*)(p), v1 = *(const uint2*)(p + 8);
          u32x4 vu;
          vu[0] = v0.x; vu[1] = v0.y; vu[2] = v1.x; vu[3] = v1.y;
          o[dt] = __builtin_amdgcn_mfma_f32_32x32x16_bf16(__builtin_bit_cast(bf16x8, vu), pfv, o[dt], 0, 0, 0);
        }
      }
    }
    if (kt + 1 < nkt) ASTORE(buf ^ 1);
    __syncthreads();
  }
#undef ALOAD
#undef ASTORE
#undef LK_
#undef LV_
#undef SK_
#undef SV_
  lrun += __shfl_xor(lrun, 32);
  const float inv = 1.f / lrun;
  bf16_t* dst = (bf16_t*)(X.ws + OFF_ATT) + (size_t)(qrow0 + w * 32 + l5) * 512 + h * 64;
#pragma unroll
  for (int dt = 0; dt < 2; ++dt)
#pragma unroll
    for (int g = 0; g < 4; ++g) {
      uint2 u;
      u.x = pack2(o[dt][4 * g] * inv, o[dt][4 * g + 1] * inv);
      u.y = pack2(o[dt][4 * g + 2] * inv, o[dt][4 * g + 3] * inv);
      *(uint2*)(dst + dt * 32 + 8 * g + 4 * hh) = u;
    }
}

__device__ __forceinline__ void mg_tile(const Params& P, const Cx& X, int t, int mtiles, char* smem) {
  const int lane = X.tid & 63, w = X.tid >> 6;
  const int mt = t % mtiles, nt = t / mtiles;
  const int m0 = mt * 128, c0 = nt * 128;
  const bf16_t* W = (const bf16_t*)(X.ws + OFF_WMIX);
  uint32_t mpk[2][2][8];
#pragma unroll
  for (int a = 0; a < 2; ++a)
#pragma unroll
    for (int c = 0; c < 2; ++c)
#pragma unroll
      for (int r = 0; r < 8; ++r) mpk[a][c][r] = 0u;
#pragma unroll 1
  for (int i = 0; i < 3; ++i) {
    f32x16 acc[2][2];
    G22::zero(acc);
    const bf16_t* Ai; const bf16_t* Bi; int ldi;
    if (i == 0) { Ai = (const bf16_t*)(X.ws + OFF_RWO) + (size_t)m0 * 512; Bi = W + WE_RO + (size_t)c0 * 512; ldi = 512; }
    else if (i == 1) { Ai = (const bf16_t*)(X.ws + OFF_ATT) + (size_t)m0 * 512; Bi = W + WE_MO + (size_t)c0 * 512; ldi = 512; }
    else { Ai = (const bf16_t*)(X.ws + OFF_Y) + (size_t)m0 * 1024; Bi = W + WE_FO + (size_t)c0 * 1024; ldi = 1024; }
    { const Cx Y1 = fresh(X); G22::run(Y1, Ai, ldi, Bi, ldi, ldi, smem, acc); }
    uint32_t opk[2][2][8];
#pragma unroll
    for (int a = 0; a < 2; ++a)
#pragma unroll
      for (int c = 0; c < 2; ++c)
#pragma unroll
        for (int r = 0; r < 8; ++r) opk[a][c][r] = pack2(acc[a][c][2 * r], acc[a][c][2 * r + 1]);
    __builtin_amdgcn_sched_barrier(0);
    G22::zero(acc);
    { const Cx Y2 = fresh(X); G22::run(Y2, (const bf16_t*)(X.ws + OFF_HBUF) + (size_t)m0 * 1024, 1024, W + WE_IN + (size_t)(2976 + i * 1024 + c0) * 1024, 1024, 1024, smem, acc); }
#pragma unroll
    for (int a = 0; a < 2; ++a)
#pragma unroll
      for (int c = 0; c < 2; ++c)
#pragma unroll
        for (int r = 0; r < 8; ++r) {
          const float m0v = lo16(mpk[a][c][r]) + lo16(opk[a][c][r]) / (1.f + __expf(-acc[a][c][2 * r]));
          const float m1v = hi16(mpk[a][c][r]) + hi16(opk[a][c][r]) / (1.f + __expf(-acc[a][c][2 * r + 1]));
          mpk[a][c][r] = pack2(m0v, m1v);
        }
  }
  bf16_t* mb = (bf16_t*)(X.ws + OFF_M);
  const int row0 = m0 + (w >> 1) * 64, col0 = c0 + (w & 1) * 64;
#pragma unroll
  for (int a = 0; a < 2; ++a)
#pragma unroll
    for (int c = 0; c < 2; ++c)
#pragma unroll
      for (int r = 0; r < 16; ++r)
        mb[(size_t)(row0 + a * 32 + ROW_OF(r)) * 1024 + col0 + c * 32 + (lane & 31)] = (bf16_t)((r & 1) ? (mpk[a][c][r >> 1] >> 16) : (mpk[a][c][r >> 1] & 0xffffu));
}

__device__ __forceinline__ void wo_tile(const Params& P, const Cx& X, int layer, int t, int mtiles, char* smem) {
  const int lane = X.tid & 63, w = X.tid >> 6;
  const int mt = t % mtiles, nt = t / mtiles;
  const int m0 = mt * 128, n0 = nt * 128;
  f32x16 acc[2][2];
  G22::zero(acc);
  G22::run(X, (const bf16_t*)(X.ws + OFF_M) + (size_t)m0 * 1024, 1024, (const bf16_t*)(X.ws + OFF_WMIX) + WE_OUT + (size_t)n0 * 1024, 1024, 1024, smem, acc);
  const int row0 = m0 + (w >> 1) * 64, col0 = n0 + (w & 1) * 64;
  const float* modv = (const float*)(X.ws + OFF_MOD) + (size_t)(layer * 5 + mod_row(m0)) * 6144 + 2048;
  const float* src; float* dst;
  if (m0 < NX) { src = (layer == 0 ? P.in[0] : X.out); dst = X.out; }
  else { src = (layer == 0 ? P.in[2] : (const float*)(X.ws + OFF_CS)) - (size_t)NX * 1024; dst = (float*)(X.ws + OFF_CS) - (size_t)NX * 1024; }
#pragma unroll
  for (int j = 0; j < 2; ++j) {
    const int col = col0 + j * 32 + (lane & 31);
    const float mg = modv[col];
#pragma unroll
    for (int i = 0; i < 2; ++i) {
      float t[16];
#pragma unroll
      for (int r = 0; r < 16; ++r) t[r] = src[(size_t)(row0 + i * 32 + ROW_OF(r)) * 1024 + col];
#pragma unroll
      for (int r = 0; r < 16; ++r) dst[(size_t)(row0 + i * 32 + ROW_OF(r)) * 1024 + col] = t[r] + mg * acc[i][j][r];
    }
  }
}
__device__ __forceinline__ void f1_tile(const Params& P, const Cx& X, int t, int mtiles, char* smem) {
  const int lane = X.tid & 63, w = X.tid >> 6;
  const int mt = t % mtiles, nt = t / mtiles;
  const int m0 = mt * 128, n0 = nt * 256;
  f32x16 acc[2][4];
  GemmW::zero(acc);
  GemmW::run(X, (const bf16_t*)(X.ws + OFF_HBUF) + (size_t)m0 * 1024, 1024, (const bf16_t*)(X.ws + OFF_WFFN) + WF_IN + (size_t)n0 * 1024, 1024, 1024, smem, acc);
  bf16_t* act = (bf16_t*)(X.ws + OFF_ACT);
  const int row0 = m0 + (w >> 1) * 64;
#pragma unroll
  for (int jp = 0; jp < 2; ++jp) {
    const int hid = ((n0 + (w & 1) * 128 + jp * 64) >> 6) * 32 + (lane & 31);
#pragma unroll
    for (int i = 0; i < 2; ++i)
#pragma unroll
      for (int r = 0; r < 16; ++r) {
        float g = acc[i][2 * jp][r], u = acc[i][2 * jp + 1][r];
        act[(size_t)(row0 + i * 32 + ROW_OF(r)) * 2816 + hid] = f2bf(g / (1.f + __expf(-g)) * u);
      }
  }
}
__device__ __forceinline__ void f2_tile(const Params& P, const Cx& X, int layer, int t, int mtiles, char* smem) {
  const int lane = X.tid & 63, w = X.tid >> 6;
  const int mt = t % mtiles, nt = t / mtiles;
  const int m0 = mt * 128, n0 = nt * 128;
  f32x16 acc[2][2];
  G22::zero(acc);
  G22::run(X, (const bf16_t*)(X.ws + OFF_ACT) + (size_t)m0 * 2816, 2816, (const bf16_t*)(X.ws + OFF_WFFN) + WF_OUT + (size_t)n0 * 2816, 2816, 2816, smem, acc);
  const int row0 = m0 + (w >> 1) * 64, col0 = n0 + (w & 1) * 64;
  const float* modv = (const float*)(X.ws + OFF_MOD) + (size_t)(layer * 5 + mod_row(m0)) * 6144 + 5120;
  float* dst = (m0 < NX) ? X.out : (float*)(X.ws + OFF_CS) - (size_t)NX * 1024;
#pragma unroll
  for (int j = 0; j < 2; ++j) {
    const int col = col0 + j * 32 + (lane & 31);
    const float mg = modv[col];
#pragma unroll
    for (int i = 0; i < 2; ++i) {
      float t[16];
#pragma unroll
      for (int r = 0; r < 16; ++r) t[r] = dst[(size_t)(row0 + i * 32 + ROW_OF(r)) * 1024 + col];
#pragma unroll
      for (int r = 0; r < 16; ++r) dst[(size_t)(row0 + i * 32 + ROW_OF(r)) * 1024 + col] = t[r] + mg * acc[i][j][r];
    }
  }
}

__device__ __forceinline__ void run_p(const Params& P, const Cx& X, int layer, int p, char* smem) {
  const int G = gridDim.x, B = blockIdx.x;
  if (p < 0) {
    if (!PON(14)) return;
    for (int j = B; j < 192 + 55 + NCW1; j += G) {
      if (j < 192) job_mod(P, fresh(X), smem, j);
      else if (j < 247) job_tables(P, fresh(X), j - 192);
      else cw_mixer_job(P, fresh(X), 0, j - 247, smem);
    }
    return;
  }
  const int mtiles = layer == 0 ? 136 : 128;
  switch (p) {
    case 0: if (!PON(0)) break;
      if (layer == 0) { for (int j = B; j < 4352; j += G) norm_job(P, fresh(X), layer, 0, j); }
      else { for (int j = B; j < NCW1 + 4352; j += G) { if (j < NCW1) cw_mixer_job(P, fresh(X), layer, j, smem); else norm_job(P, fresh(X), layer, 0, j - NCW1); } }
      break;
    case 1: if (!PON(1)) break; for (int j = B; j < 136 * 15; j += G) g1a_tile(P, fresh(X), j, smem); break;
    case 2: if (!PON(2)) break; for (int j = B; j < NTOK; j += G) r1a_row(P, fresh(X), layer, j); break;
    case 3: if (!PON(3)) break; for (int j = B; j < 136 * 20; j += G) r1b_tile(P, fresh(X), layer, j, smem); break;
    case 4: if (!PON(4)) break; {
      volatile int* sflag = (volatile int*)(smem + LDS_BYTES - 32);
      if (sflag[0]) {
        unsigned* ctr = (unsigned*)(X.ws + OFF_TICK) + 2048 + layer * 64 + sflag[2] * 8;
        for (;;) {
          __syncthreads();
          if (X.tid == 0) sflag[1] = (int)atomicAdd(ctr, 1u);
          __syncthreads();
          const int j = sflag[1];
          if (j >= 256) break;
          scan_job(P, fresh(X), layer, j, smem);
        }
      }
    } break;
    case 5: if (!PON(5)) break; for (int j = B; j < 4352; j += G) s2_job(P, fresh(X), layer, j); break;
    case 6: if (!PON(6)) break; for (int j = B; j < 136 * 9; j += G) g1b_tile(P, fresh(X), j, smem); break;
    case 7: if (!PON(7)) break;
      for (int j = B; j < 2176 + 1024; j += G) {
        if (j < 1088) q1_kv_tile(P, fresh(X), layer, j, smem);
        else if (j < 2176) { if (layer == 0 || (j - 1088) % 136 < 128) q1_q_tile(P, fresh(X), layer, j - 1088, smem); }
        else fft1_tile(P, fresh(X), j - 2176, smem);
      }
      break;
    case 8: if (!PON(8)) break; {
      const int nctx = layer == 0 ? 64 : 0;
      for (int j = B; j < 1024 + 1024 + 2 * nctx; j += G) {
        const bool isc = (j >= 2048 && j < 2048 + nctx);
        if (j < 1024 || isc) attn_item(P, fresh(X), isc ? j - 2048 : j, isc, smem);
        else if (j < 2048) fft2_tile(P, fresh(X), j - 1024, smem);
        else ctxdft_tile(P, fresh(X), j - 2048 - nctx, smem);
      }
    } break;
    case 9: if (!PON(9)) break; for (int j = B; j < mtiles * 8; j += G) mg_tile(P, fresh(X), j, mtiles, smem); break;
    case 10: if (!PON(10)) break;
      for (int j = B; j < mtiles * 8 + NCW2; j += G) { if (j < mtiles * 8) wo_tile(P, fresh(X), layer, j, mtiles, smem); else cw_ffn_job(P, fresh(X), layer, j - mtiles * 8, smem); }
      break;
    case 11: if (!PON(11)) break; for (int j = B; j < mtiles * 32; j += G) norm_job(P, fresh(X), layer, 1, j); break;
    case 12: if (!PON(12)) break; for (int j = B; j < mtiles * 22; j += G) f1_tile(P, fresh(X), j, mtiles, smem); break;
    case 13: if (!PON(13)) break; for (int j = B; j < mtiles * 8; j += G) f2_tile(P, fresh(X), layer, j, mtiles, smem); break;
  }
}

#if SINGLE
__global__ void __launch_bounds__(256, 2) fwd_kernel(Params P, int ph_lo, int ph_hi, int use_sync) {
  extern __shared__ __attribute__((aligned(16))) char smem[];
  volatile LAS unsigned* xst = (volatile LAS unsigned*)(smem + LDS_BYTES - 16);
  if (threadIdx.x == 0) { xst[0] = 0u; xst[1] = 0u; }
  __syncthreads();
  XcdBarrier xb = xcd_barrier_post((unsigned*)(P.ws + OFF_BAR), xst);
  if (threadIdx.x == 0) {
    const unsigned hwid = (unsigned)__builtin_amdgcn_s_getreg((31 << 11) | 4);
    const unsigned slot = ((xb_xcc_id() * 8u + ((hwid >> 13) & 7u)) * 2u + ((hwid >> 12) & 1u)) * 16u + ((hwid >> 8) & 15u);
    const unsigned t = atomicAdd((unsigned*)(P.ws + OFF_TICK) + slot, 1u);
    *(volatile int*)(smem + LDS_BYTES - 32) = (t == 0u) ? 1 : 0;
    *(volatile int*)(smem + LDS_BYTES - 24) = 0;
  }
  __syncthreads();
#pragma unroll 1
  for (int ph = ph_lo; ph < ph_hi; ++ph) {
    char* ws = P.ws; float* out = P.out; int tid = threadIdx.x;
    asm volatile("" : "+v"(tid));
    const Cx X{ws, out, tid};
    if (ph == 0) run_p(P, X, 0, -1, smem);
    else {
      run_p(P, X, (ph - 1) / 14, (ph - 1) % 14, smem);
      if (PROBE_P >= 0 && (ph - 1) % 14 == PROBE_P) {
#pragma unroll 1
        for (int rep = 0; rep < PROBE_N; ++rep) { xcd_barrier(xb); if (threadIdx.x == 0) *(volatile int*)(smem + LDS_BYTES - 24) = rep + 1; __syncthreads(); run_p(P, X, (ph - 1) / 14, PROBE_P, smem); }
        if (threadIdx.x == 0) *(volatile int*)(smem + LDS_BYTES - 24) = 0;
        __syncthreads();
      }
    }
    if (use_sync && ph + 1 < ph_hi) { if (use_sync == 2) cg::this_grid().sync(); else xcd_barrier(xb); }
  }
}

#else
template <int PP>
__global__ void __launch_bounds__(256) phase_kernel(Params P, int layer) {
  extern __shared__ __attribute__((aligned(16))) char smem[];
  const Cx X{P.ws, P.out, (int)threadIdx.x};
  run_p(P, X, layer, PP, smem);
}
#endif

extern "C" void kernel_launch(void* const* d_in, const int* in_sizes, int n_in, void* d_out, int out_size, void* d_ws,
                              size_t ws_size, hipStream_t stream) {
  static int grid = 0;
  if (grid == 0) {
    if (n_in != 33 || ws_size < OFF_END) { fprintf(stderr, "kernel_launch: unexpected n_in %d / ws_size %zu (need %zu)\n", n_in, ws_size, (size_t)OFF_END); grid = -1; return; }
    int dev = 0, cus = 0, per_cu = 0;
    hipGetDevice(&dev);
    hipDeviceGetAttribute(&cus, hipDeviceAttributeMultiprocessorCount, dev);
#if SINGLE
    hipFuncSetAttribute((const void*)fwd_kernel, hipFuncAttributeMaxDynamicSharedMemorySize, LDS_BYTES);
    hipOccupancyMaxActiveBlocksPerMultiprocessor(&per_cu, (const void*)fwd_kernel, 256, LDS_BYTES);
#else
#define SA(pp) hipFuncSetAttribute((const void*)phase_kernel<pp>, hipFuncAttributeMaxDynamicSharedMemorySize, LDS_BYTES)
    SA(-1); SA(0); SA(1); SA(2); SA(3); SA(4); SA(5); SA(6); SA(7); SA(8); SA(9); SA(10); SA(11); SA(12); SA(13);
    per_cu = 2;
#endif
    if (per_cu < 1) { fprintf(stderr, "kernel_launch: occupancy query returned %d\n", per_cu); grid = -1; return; }
    if (per_cu > 2) per_cu = 2;
    grid = cus * per_cu;
  }
  if (grid < 0) return;
  if (hipMemsetAsync((char*)d_ws + OFF_BAR, 0, 32768, stream) != hipSuccess) { fprintf(stderr, "kernel_launch: memset failed\n"); return; }
  Params P{};
  for (int i = 0; i < 33; ++i) P.in[i] = (const float*)d_in[i];
  P.out = (float*)d_out;
  P.ws = (char*)d_ws;
#if SINGLE
  int lo = 0, hi = NPH, us = 1;
  void* args[] = {&P, &lo, &hi, &us};
  hipError_t e = hipLaunchCooperativeKernel((const void*)fwd_kernel, dim3(grid), dim3(256), args, LDS_BYTES, stream);
  if (e != hipSuccess) fprintf(stderr, "cooperative launch failed: %s (grid %d)\n", hipGetErrorString(e), grid);
#else
#define LP(pp, ly) hipLaunchKernelGGL(phase_kernel<pp>, dim3(grid), dim3(256), LDS_BYTES, stream, P, ly)
  LP(-1, 0);
  for (int ly = 0; ly < 2; ++ly) {
    LP(0, ly); LP(1, ly); LP(2, ly); LP(3, ly); LP(4, ly); LP(5, ly); LP(6, ly); LP(7, ly); LP(8, ly); LP(9, ly); LP(10, ly); LP(11, ly); LP(12, ly); LP(13, ly);
  }
#endif
}
```

```cpp
#include <hip/hip_runtime.h>
#include <hip/hip_cooperative_groups.h>
#include <stdint.h>
#include <stdio.h>
namespace cg = cooperative_groups;

#ifndef SINGLE
#define SINGLE 1
#endif

#ifndef ONLYP
#define ONLYP -1
#endif
#define PON(x) (ONLYP < 0 || ONLYP == (x))

typedef unsigned short bf16_t;
typedef __attribute__((ext_vector_type(8))) short bf16x8;
typedef __attribute__((ext_vector_type(16))) float f32x16;
typedef __attribute__((ext_vector_type(4))) unsigned int u32x4;

#define NX 16384
#define NCX 1024
#define NTOK 17408
#define NPH 29
#ifndef PROBE_P
#define PROBE_P -1
#endif
#define PROBE_N 2
#define LDS_BYTES 77824

static constexpr size_t UU = 17825792ull;
static constexpr size_t OFF_HBUF = 0;
static constexpr size_t OFF_RKV = 2 * UU;
static constexpr size_t OFF_KK = 5 * UU;
static constexpr size_t OFF_ZR = 6 * UU;
static constexpr size_t OFF_LORA = 12 * UU + UU / 4;
static constexpr size_t OFF_LD = 6 * UU;
static constexpr size_t OFF_A = 8 * UU;
static constexpr size_t OFF_G = 10 * UU;
static constexpr size_t OFF_YF = 11 * UU;
static constexpr size_t OFF_YB = 12 * UU;
static constexpr size_t OFF_RWO = 5 * UU;
static constexpr size_t OFF_ZF = 2 * UU;
static constexpr size_t OFF_ZM = 3 * UU;
static constexpr size_t OFF_Q = 6 * UU;
static constexpr size_t OFF_K = 7 * UU + UU / 2;
static constexpr size_t OFF_VT = 9 * UU;
static constexpr size_t OFF_FFT1 = 10 * UU;
static constexpr size_t OFF_ATT = 12 * UU;
static constexpr size_t OFF_Y = 3 * UU;
static constexpr size_t OFF_M = 6 * UU;
static constexpr size_t OFF_ACT = 2 * UU;
static constexpr size_t OFF_WFFN = 9 * UU;
static constexpr size_t OFF_WMIX = 13 * UU;
static constexpr size_t WE_IN = 0;
static constexpr size_t WE_W2 = WE_IN + 6048ull * 1024;
static constexpr size_t WE_A2 = WE_W2 + 65536;
static constexpr size_t WE_G2 = WE_A2 + 65536;
static constexpr size_t WE_RO = WE_G2 + 65536;
static constexpr size_t WE_MO = WE_RO + 524288;
static constexpr size_t WE_FO = WE_MO + 524288;
static constexpr size_t WE_UQ = WE_FO + 1048576;
static constexpr size_t WE_UKV = WE_UQ + 294912;
static constexpr size_t WE_OUT = WE_UKV + 131072;
static constexpr size_t WE_END = WE_OUT + 1048576;
static constexpr size_t WF_IN = 0;
static constexpr size_t WF_OUT = 5632ull * 1024;
static constexpr size_t OFF_SMALL = OFF_WMIX + WE_END * 2;
static constexpr size_t OFF_CS = OFF_SMALL;
static constexpr size_t OFF_MOD = OFF_CS + 4194304;
static constexpr size_t OFF_TW = OFF_MOD + 245760;
static constexpr size_t OFF_F1 = OFF_TW + 32768;
static constexpr size_t OFF_F2 = OFF_F1 + 16384;
static constexpr size_t OFF_F256 = OFF_F2 + 32768;
static constexpr size_t OFF_ROPE = OFF_F256 + 262144;
static constexpr size_t OFF_BAR = OFF_ROPE + 524288;
static constexpr size_t OFF_TICK = OFF_BAR + 16384;
static constexpr size_t OFF_END = OFF_TICK + 16384;

struct Cx {
  char* ws;
  float* out;
  int tid;
};

struct Params {
  const float* in[33];
  float* out;
  char* ws;
};

__device__ __forceinline__ float bf2f(bf16_t v) { return __uint_as_float(((uint32_t)v) << 16); }
typedef __bf16 bf16v2_t __attribute__((ext_vector_type(2)));
typedef float f32v2_t __attribute__((ext_vector_type(2)));
__device__ __forceinline__ uint32_t pack2(float a, float b) {
  f32v2_t v; v[0] = a; v[1] = b;
  return __builtin_bit_cast(uint32_t, __builtin_convertvector(v, bf16v2_t));
}
__device__ __forceinline__ bf16_t f2bf(float f) { return (bf16_t)(pack2(f, 0.f) & 0xffffu); }
__device__ __forceinline__ float lo16(uint32_t u) { return __uint_as_float(u << 16); }
__device__ __forceinline__ float hi16(uint32_t u) { return __uint_as_float(u & 0xffff0000u); }
__device__ __forceinline__ float sigmoidf_(float v) { return 1.f / (1.f + __expf(-v)); }
__device__ __forceinline__ int mod_row(int row) { return row < NX ? (row >> 12) : 4; }

__device__ __forceinline__ Cx fresh(const Cx& X) {
  int t = X.tid;
  asm volatile("" : "+v"(t));
  return Cx{X.ws, X.out, t};
}

#define XB_TMO      128
#define XB_XCNT(j)  (256  + 64 * (j))
#define XB_XSUB(j)  (1280 + 64 * (j))
#define XB_XGEN(j)  (2304 + 64 * (j))
#define XB_TOP      3328
#define XB_TOPGEN   3392
#define XCD_BAR_WORDS 3456
#define XB_SPIN_CAP (1u << 18)
#define LAS __attribute__((address_space(3)))

__device__ __forceinline__ unsigned xb_ld(unsigned* p)              { return __hip_atomic_load(p, __ATOMIC_RELAXED, __HIP_MEMORY_SCOPE_AGENT); }
__device__ __forceinline__ unsigned xb_add(unsigned* p, unsigned v) { return __hip_atomic_fetch_add(p, v, __ATOMIC_RELAXED, __HIP_MEMORY_SCOPE_AGENT); }
__device__ __forceinline__ unsigned xb_xcc_id() { return (unsigned)__builtin_amdgcn_s_getreg((3 << 11) | 20) & 0xFu; }
#define XB_SPIN(cond, bar) do { unsigned _sp = 0; while (cond) { __builtin_amdgcn_s_sleep(1); \
    if ((++_sp & 255u) == 0u) { if (xb_ld(&(bar)[XB_TMO])) break; if (_sp > XB_SPIN_CAP) { atomicAdd(&(bar)[XB_TMO], 1u); break; } } } } while (0)

struct XcdBarrier {
    unsigned* bar; unsigned x;
    volatile LAS unsigned* st;
};

__device__ __forceinline__ XcdBarrier xcd_barrier_post(unsigned* bar, volatile LAS unsigned* st) {
    XcdBarrier b; b.bar = bar; b.x = xb_xcc_id(); b.st = st;
    if (threadIdx.x == 0) (void)xb_add(&bar[XB_XCNT(b.x)], 1u);
    return b;
}
__device__ __forceinline__ void xcd_barrier_complete(unsigned* bar, unsigned x, unsigned& nloc, unsigned& nx) {
    const unsigned G = gridDim.x * gridDim.y * gridDim.z;
    unsigned sum, cnt, mine, sp = 0u;
    for (;;) {
        sum = 0u; cnt = 0u; mine = 0u;
#pragma unroll
        for (unsigned j = 0; j < 16; ++j) { const unsigned c = xb_ld(&bar[XB_XCNT(j)]); sum += c; cnt += (c > 0u) ? 1u : 0u; mine = (j == x) ? c : mine; }
        if (sum == G) break;
        __builtin_amdgcn_s_sleep(1);
        if ((++sp & 255u) == 0u) { if (xb_ld(&bar[XB_TMO])) break; if (sp > XB_SPIN_CAP) { atomicAdd(&bar[XB_TMO], 1u); break; } }
    }
    nloc = mine > 0u ? mine : 1u; nx = cnt > 0u ? cnt : 1u;
}

__device__ __forceinline__ void xcd_barrier(const XcdBarrier& b) {
    asm volatile("s_waitcnt vmcnt(0)" ::: "memory");
    __syncthreads();
    if (threadIdx.x == 0) {
        unsigned* bar = b.bar;
        __builtin_amdgcn_s_waitcnt(0);
        unsigned nloc = b.st[0], nx = b.st[1];
        if (nloc == 0u) { xcd_barrier_complete(bar, b.x, nloc, nx); b.st[0] = nloc; b.st[1] = nx; }
        const unsigned old = xb_add(&bar[XB_XSUB(b.x)], 1u);
        const unsigned gen = old / nloc;
        if (old + 1u == (gen + 1u) * nloc) {
            __builtin_amdgcn_fence(__ATOMIC_RELEASE, "agent");
            asm volatile("s_waitcnt vmcnt(0)" ::: "memory");
            const unsigned og = xb_add(&bar[XB_TOP], 1u);
            const unsigned tg = og / nx;
            if (og + 1u == (tg + 1u) * nx) xb_add(&bar[XB_TOPGEN], 1u);
            else XB_SPIN(xb_ld(&bar[XB_TOPGEN]) == tg, bar);
            __builtin_amdgcn_fence(__ATOMIC_ACQUIRE, "agent");
            xb_add(&bar[XB_XGEN(b.x)], 1u);
            asm volatile("s_waitcnt vmcnt(0)" ::: "memory");
        } else {
            XB_SPIN(xb_ld(&bar[XB_XGEN(b.x)]) == gen, bar);
            __builtin_amdgcn_fence(__ATOMIC_ACQUIRE, "agent");
            asm volatile("s_waitcnt vmcnt(0)" ::: "memory");
        }
    }
    __syncthreads();
}


template <int BM, int BN, int WGM, int WGN, bool TRB>
struct Gemm {
  static constexpr int WM = BM / WGM, WN = BN / WGN, MT = WM / 32, NTL = WN / 32;
  static constexpr int CA = BM * 8 / 256, CB = BN * 8 / 256;
  static constexpr int SA_ELEMS = BM * 72, SB_ELEMS = BN * 72;

  __device__ static __forceinline__ void zero(f32x16 (&acc)[MT][NTL]) {
#pragma unroll
    for (int i = 0; i < MT; ++i)
#pragma unroll
      for (int j = 0; j < NTL; ++j)
#pragma unroll
        for (int r = 0; r < 16; ++r) acc[i][j][r] = 0.f;
  }

  __device__ static __forceinline__ void run(const Cx& X, const bf16_t* __restrict__ A, int lda, const bf16_t* __restrict__ B, int ldb,
                                             int K, char* smem, f32x16 (&acc)[MT][NTL]) {
    const int tid = X.tid, lane = tid & 63, w = tid >> 6;
    const int wm = w / WGN, wn = w % WGN;
    bf16_t* sA = (bf16_t*)smem;
    bf16_t* sB = sA + 2 * SA_ELEMS;
    uint4 ra0, ra1, ra2, ra3, rb0, rb1, rb2 = make_uint4(0, 0, 0, 0), rb3 = make_uint4(0, 0, 0, 0);
    uint4 qa0, qa1, qa2, qa3, qb0, qb1, qb2 = make_uint4(0, 0, 0, 0), qb3 = make_uint4(0, 0, 0, 0);
    static_assert(CA == 4 && CB >= 2 && CB <= 4, "tile loader shape");
    const int nk = K >> 6;
#define LDA_(i, k0) (*(const uint4*)(A + (size_t)((tid + 256 * (i)) >> 3) * lda + (k0) + ((tid + 256 * (i)) & 7) * 8))
#define LDB_(i, k0)                                                                                                        \
  (!TRB ? *(const uint4*)(B + (size_t)((tid + 256 * (i)) >> 3) * ldb + (k0) + ((tid + 256 * (i)) & 7) * 8)                 \
        : *(const uint4*)(B + (size_t)((k0) + (tid + 256 * (i)) / (BN / 8)) * ldb + ((tid + 256 * (i)) % (BN / 8)) * 8))
#define GLOAD(R, k0)                                                                           \
  {                                                                                            \
    R##a0 = LDA_(0, k0); R##a1 = LDA_(1, k0); R##a2 = LDA_(2, k0); R##a3 = LDA_(3, k0);        \
    R##b0 = LDB_(0, k0); R##b1 = LDB_(1, k0);                                                  \
    if (CB > 2) R##b2 = LDB_(2, k0);                                                           \
    if (CB > 3) R##b3 = LDB_(3, k0);                                                           \
  }
#define STA_(i, buf, v) *(uint4*)(sA + (buf)*SA_ELEMS + ((tid + 256 * (i)) >> 3) * 72 + ((tid + 256 * (i)) & 7) * 8) = v
#define STB_(i, buf, v)                                                                                       \
  {                                                                                                           \
    const int c_ = tid + 256 * (i);                                                                           \
    if (!TRB) *(uint4*)(sB + (buf)*SB_ELEMS + (c_ >> 3) * 72 + (c_ & 7) * 8) = v;                             \
    else {                                                                                                    \
      bf16_t* p = sB + (buf)*SB_ELEMS + (c_ % (BN / 8)) * 8 * 72 + c_ / (BN / 8);                             \
      p[0] = (bf16_t)(v.x & 0xffff); p[72] = (bf16_t)(v.x >> 16);                                             \
      p[144] = (bf16_t)(v.y & 0xffff); p[216] = (bf16_t)(v.y >> 16);                                          \
      p[288] = (bf16_t)(v.z & 0xffff); p[360] = (bf16_t)(v.z >> 16);                                          \
      p[432] = (bf16_t)(v.w & 0xffff); p[504] = (bf16_t)(v.w >> 16);                                          \
    }                                                                                                         \
  }
#define SSTORE(R, buf)                                                                         \
  {                                                                                            \
    STA_(0, buf, R##a0); STA_(1, buf, R##a1); STA_(2, buf, R##a2); STA_(3, buf, R##a3);        \
    STB_(0, buf, R##b0); STB_(1, buf, R##b1);                                                  \
    if (CB > 2) STB_(2, buf, R##b2);                                                           \
    if (CB > 3) STB_(3, buf, R##b3);                                                           \
  }
#define COMPUTE(buf)                                                                                               \
  {                                                                                                                \
    const bf16_t* pa = sA + (buf)*SA_ELEMS + (wm * WM + (lane & 31)) * 72 + (lane >> 5) * 8;                       \
    const bf16_t* pb = sB + (buf)*SB_ELEMS + (wn * WN + (lane & 31)) * 72 + (lane >> 5) * 8;                       \
    _Pragma("unroll") for (int ks = 0; ks < 4; ++ks) {                                                             \
      bf16x8 af[MT], bfr[NTL];                                                                                     \
      _Pragma("unroll") for (int i = 0; i < MT; ++i) af[i] = *(const bf16x8*)(pa + i * 32 * 72 + ks * 16);         \
      _Pragma("unroll") for (int j = 0; j < NTL; ++j) bfr[j] = *(const bf16x8*)(pb + j * 32 * 72 + ks * 16);       \
      _Pragma("unroll") for (int i = 0; i < MT; ++i)                                                               \
        _Pragma("unroll") for (int j = 0; j < NTL; ++j)                                                            \
          acc[i][j] = __builtin_amdgcn_mfma_f32_32x32x16_bf16(af[i], bfr[j], acc[i][j], 0, 0, 0);                  \
    }                                                                                                              \
  }
    if (!TRB) {
      bf16_t* dA = sA;
      bf16_t* dB = sA + 2 * BM * 64;
#define DSTAGE(buf, k0)                                                                                              \
  {                                                                                                                  \
    _Pragma("unroll") for (int i = 0; i < CA; ++i) {                                                                 \
      const int p = tid + 256 * i, r = p >> 3, c = (p & 7) ^ ((r >> 1) & 7);                                         \
      __builtin_amdgcn_global_load_lds((const unsigned*)(A + (size_t)r * lda + (k0) + c * 8),                        \
                                       (LAS unsigned*)(dA + (buf)*BM * 64 + p * 8), 16, 0, 0);                       \
    }                                                                                                                \
    _Pragma("unroll") for (int i = 0; i < CB; ++i) {                                                                 \
      const int p = tid + 256 * i, r = p >> 3, c = (p & 7) ^ ((r >> 1) & 7);                                         \
      __builtin_amdgcn_global_load_lds((const unsigned*)(B + (size_t)r * ldb + (k0) + c * 8),                        \
                                       (LAS unsigned*)(dB + (buf)*BN * 64 + p * 8), 16, 0, 0);                       \
    }                                                                                                                \
  }
      const int swz = (lane >> 1) & 7, hh = lane >> 5;
      DSTAGE(0, 0);
      asm volatile("s_waitcnt vmcnt(0)" ::: "memory");
      __syncthreads();
#pragma unroll 1
      for (int kt = 0; kt < nk; ++kt) {
        const int buf = kt & 1;
        if (kt + 1 < nk) DSTAGE(buf ^ 1, (kt + 1) * 64);
        const bf16_t* pa = dA + buf * BM * 64 + (wm * WM + (lane & 31)) * 64;
        const bf16_t* pb = dB + buf * BN * 64 + (wn * WN + (lane & 31)) * 64;
#pragma unroll
        for (int ks = 0; ks < 4; ++ks) {
          const int co = (((ks * 2 + hh) ^ swz) * 8);
          bf16x8 af[MT], bfr[NTL];
#pragma unroll
          for (int i = 0; i < MT; ++i) af[i] = *(const bf16x8*)(pa + i * 32 * 64 + co);
#pragma unroll
          for (int j = 0; j < NTL; ++j) bfr[j] = *(const bf16x8*)(pb + j * 32 * 64 + co);
#pragma unroll
          for (int i = 0; i < MT; ++i)
#pragma unroll
            for (int j = 0; j < NTL; ++j) acc[i][j] = __builtin_amdgcn_mfma_f32_32x32x16_bf16(af[i], bfr[j], acc[i][j], 0, 0, 0);
        }
        asm volatile("s_waitcnt vmcnt(0)" ::: "memory");
        __syncthreads();
      }
#undef DSTAGE
    } else {
    GLOAD(r, 0);
    if (nk > 1) GLOAD(q, 64);
    SSTORE(r, 0);
    __syncthreads();
    for (int kt = 0; kt < nk; kt += 2) {
      if (kt + 2 < nk) GLOAD(r, (kt + 2) * 64);
      COMPUTE(0);
      if (kt + 1 < nk) SSTORE(q, 1);
      __syncthreads();
      if (kt + 1 >= nk) break;
      if (kt + 3 < nk) GLOAD(q, (kt + 3) * 64);
      COMPUTE(1);
      if (kt + 2 < nk) SSTORE(r, 0);
      __syncthreads();
    }
    }
#undef COMPUTE
#undef GLOAD
#undef SSTORE
#undef LDA_
#undef LDB_
#undef STA_
#undef STB_
  }
};

typedef Gemm<128, 128, 2, 2, false> G22;
typedef Gemm<128, 128, 2, 2, true> G22T;
typedef Gemm<128, 64, 2, 2, false> GMG;
typedef Gemm<128, 96, 4, 1, false> GQ;
typedef Gemm<128, 128, 4, 1, false> GKV;

struct GemmW {
  static constexpr int MT = 2, NTL = 4;
  __device__ static __forceinline__ void zero(f32x16 (&acc)[MT][NTL]) {
#pragma unroll
    for (int i = 0; i < MT; ++i)
#pragma unroll
      for (int j = 0; j < NTL; ++j)
#pragma unroll
        for (int r = 0; r < 16; ++r) acc[i][j][r] = 0.f;
  }
  __device__ static __forceinline__ void run(const Cx& X, const bf16_t* __restrict__ A, int lda, const bf16_t* __restrict__ B, int ldb,
                                             int K, char* smem, f32x16 (&acc)[MT][NTL]) {
    const int tid = X.tid, lane = tid & 63, w = tid >> 6;
    const int wm = w >> 1, wn = w & 1;
    bf16_t* dA = (bf16_t*)smem;
    bf16_t* dB = dA + 3 * 128 * 32;
    const int nk = K >> 5;
#define WSTAGE(buf, k0)                                                                                              \
  {                                                                                                                  \
    _Pragma("unroll") for (int i = 0; i < 2; ++i) {                                                                  \
      const int p = tid + 256 * i, r = p >> 2, c = (p & 3) ^ ((r >> 2) & 3);                                         \
      __builtin_amdgcn_global_load_lds((const unsigned*)(A + (size_t)r * lda + (k0) + c * 8),                        \
                                       (LAS unsigned*)(dA + (buf)*128 * 32 + p * 8), 16, 0, 0);                      \
    }                                                                                                                \
    _Pragma("unroll") for (int i = 0; i < 4; ++i) {                                                                  \
      const int p = tid + 256 * i, r = p >> 2, c = (p & 3) ^ ((r >> 2) & 3);                                         \
      __builtin_amdgcn_global_load_lds((const unsigned*)(B + (size_t)r * ldb + (k0) + c * 8),                        \
                                       (LAS unsigned*)(dB + (buf)*256 * 32 + p * 8), 16, 0, 0);                      \
    }                                                                                                                \
  }
    const int swz = ((lane & 31) >> 2) & 3, hh = lane >> 5;
    WSTAGE(0, 0);
    if (nk > 1) WSTAGE(1, 32);
    int buf = 0;
#pragma unroll 1
    for (int kt = 0; kt < nk; ++kt) {
      if (kt + 1 < nk) asm volatile("s_waitcnt vmcnt(6)" ::: "memory");
      else asm volatile("s_waitcnt vmcnt(0)" ::: "memory");
      __builtin_amdgcn_s_barrier();
      if (kt + 2 < nk) { const int nb = buf >= 1 ? buf - 1 : 2; WSTAGE(nb, (kt + 2) * 32); }
      const bf16_t* pa = dA + buf * 128 * 32 + (wm * 64 + (lane & 31)) * 32;
      const bf16_t* pb = dB + buf * 256 * 32 + (wn * 128 + (lane & 31)) * 32;
#pragma unroll
      for (int ks = 0; ks < 2; ++ks) {
        const int co = (((ks * 2 + hh) ^ swz) * 8);
        bf16x8 af[MT], bfr[NTL];
#pragma unroll
        for (int i = 0; i < MT; ++i) af[i] = *(const bf16x8*)(pa + i * 32 * 32 + co);
#pragma unroll
        for (int j = 0; j < NTL; ++j) bfr[j] = *(const bf16x8*)(pb + j * 32 * 32 + co);
#pragma unroll
        for (int i = 0; i < MT; ++i)
#pragma unroll
          for (int j = 0; j < NTL; ++j) acc[i][j] = __builtin_amdgcn_mfma_f32_32x32x16_bf16(af[i], bfr[j], acc[i][j], 0, 0, 0);
      }
      buf = buf == 2 ? 0 : buf + 1;
    }
    __syncthreads();
#undef WSTAGE
  }
};

#define ROW_OF(reg) (((reg) & 3) + 8 * ((reg) >> 2) + 4 * (lane >> 5))

__device__ __forceinline__ void job_mod(const Params& P, const Cx& X, char* smem, int job) {
  float* sc = (float*)smem;
  const int tid = X.tid;
  for (int i = tid; i < 5 * 1024; i += 256) {
    int r = i >> 10, k = i & 1023;
    float v = r < 4 ? P.in[1][r * 1024 + k] : P.in[3][k];
    sc[i] = v / (1.f + expf(-v));
  }
  __syncthreads();
  const int l = job / 96, n = (job % 96) * 64 + (tid & 63), w = tid >> 6;
  const float* W = P.in[4] + (size_t)l * 1024 * 6144;
  float a0 = 0, a1 = 0, a2 = 0, a3 = 0, a4 = 0;
#pragma unroll 16
  for (int k = w * 256; k < w * 256 + 256; ++k) {
    float wv = W[(size_t)k * 6144 + n];
    a0 += sc[k] * wv; a1 += sc[1024 + k] * wv; a2 += sc[2048 + k] * wv; a3 += sc[3072 + k] * wv; a4 += sc[4096 + k] * wv;
  }
  float* red = sc + 5 * 1024;
  red[(w * 5 + 0) * 64 + (tid & 63)] = a0; red[(w * 5 + 1) * 64 + (tid & 63)] = a1; red[(w * 5 + 2) * 64 + (tid & 63)] = a2;
  red[(w * 5 + 3) * 64 + (tid & 63)] = a3; red[(w * 5 + 4) * 64 + (tid & 63)] = a4;
  __syncthreads();
  float* modv = (float*)(X.ws + OFF_MOD);
  for (int i = tid; i < 320; i += 256) {
    int r = i >> 6, c = i & 63;
    int nn = (job % 96) * 64 + c;
    float s = red[(0 * 5 + r) * 64 + c] + red[(1 * 5 + r) * 64 + c] + red[(2 * 5 + r) * 64 + c] + red[(3 * 5 + r) * 64 + c];
    modv[(size_t)(l * 5 + r) * 6144 + nn] = s + P.in[5][l * 6144 + nn];
  }
  __syncthreads();
}

__device__ __forceinline__ void job_tables(const Params& P, const Cx& X, int job) {
  float2* tw = (float2*)(X.ws + OFF_TW);
  bf16_t* F1 = (bf16_t*)(X.ws + OFF_F1);
  bf16_t* F2 = (bf16_t*)(X.ws + OFF_F2);
  bf16_t* F256 = (bf16_t*)(X.ws + OFF_F256);
  float2* rope = (float2*)(X.ws + OFF_ROPE);
  for (int e = job * 4096 + X.tid; e < job * 4096 + 4096; e += 256) {
    int i = e;
    if (i < 4096) { tw[i] = make_float2(cospif(i / 2048.f), sinpif(i / 2048.f)); continue; }
    i -= 4096;
    if (i < 8192) {
      int R = i >> 6, t1 = i & 63;
      int f1 = (R >> 6) * 32 + (R & 31);
      int ph = (f1 * t1) & 63;
      F1[i] = f2bf(((R >> 5) & 1) ? -sinpif(ph / 32.f) : cospif(ph / 32.f));
      continue;
    }
    i -= 8192;
    if (i < 16384) {
      int m = i >> 7, k = i & 127;
      int f2 = m & 63, q = m >> 6, t2 = k & 63, p = k >> 6;
      int ph = (f2 * t2) & 63;
      float c = cospif(ph / 32.f), s = sinpif(ph / 32.f);
      float v = (q == 0) ? (p == 0 ? c : s) : (p == 0 ? -s : c);
      F2[i] = f2bf(v);
      continue;
    }
    i -= 16384;
    if (i < 131072) {
      int m = i >> 8, t = i & 255;
      int f = m & 255, q = m >> 8;
      int ph = (f * t) & 255;
      F256[i] = f2bf(q == 0 ? cospif(ph / 128.f) : -sinpif(ph / 128.f));
      continue;
    }
    i -= 131072;
    if (i < 65536) {
      int t = i >> 4, j = i & 15;
      float invf = powf(10000.f, -(float)(j & 7) / 8.f);
      float pos = (j < 8) ? (float)(t >> 6) : (float)(t & 63);
      float ang = pos * invf;
      rope[i] = make_float2(cosf(ang), sinf(ang));
    }
  }
}

__device__ __forceinline__ void cw_tile(const Cx& X, const float* __restrict__ src, int N, int lds_, bf16_t* __restrict__ dst, int ldd, const float* scale,
                        int perm, int tk, int tn, char* smem) {
  float* tile = (float*)smem;
  const int tid = X.tid;
  const int c = tid & 63, r0 = tid >> 6;
  const int ng = tn * 64 + c;
  float tv[16];
#pragma unroll
  for (int i = 0; i < 16; ++i) {
    int r = r0 + 4 * i;
    tv[i] = (ng < N) ? src[(size_t)(tk * 64 + r) * lds_ + ng] : 0.f;
    if (scale) tv[i] *= scale[tk * 64 + r];
  }
#pragma unroll
  for (int i = 0; i < 16; ++i) tile[(r0 + 4 * i) * 65 + c] = tv[i];
  __syncthreads();
#pragma unroll 4
  for (int i = 0; i < 16; ++i) {
    int nn = r0 + 4 * i;
    int n2 = tn * 64 + nn;
    if (n2 < N) {
      int drow = n2;
      if (perm) {
        int u = n2 < 2816 ? n2 : n2 - 2816;
        drow = (u >> 5) * 64 + (n2 < 2816 ? 0 : 32) + (u & 31);
      }
      dst[(size_t)drow * ldd + tk * 64 + c] = f2bf(tile[c * 65 + nn]);
    }
  }
  __syncthreads();
}

__device__ __forceinline__ void fold_job(const Params& P, const Cx& X, int layer, int fj, char* smem) {
  float* wt = (float*)smem;
  float* ct = wt + 4096;
  const int tid = X.tid;
  const int g = fj >> 4, n0 = (fj & 15) * 64;
  const float* src = P.in[28] + (size_t)layer * 512 * 1024;
  {
    float tw16[16];
#pragma unroll
    for (int k = 0; k < 16; ++k) { const int i = tid + 256 * k; tw16[k] = src[(size_t)(g * 64 + (i >> 6)) * 1024 + n0 + (i & 63)]; }
#pragma unroll
    for (int k = 0; k < 16; ++k) wt[tid + 256 * k] = tw16[k];
  }
  if (tid < 64) { ct[tid] = cospif(tid / 32.f); ct[64 + tid] = sinpif(tid / 32.f); }
  __syncthreads();
  bf16_t* dst = (bf16_t*)(X.ws + OFF_WMIX) + WE_FO;
  const int c = tid & 63, nq = tid >> 6;
#pragma unroll 1
  for (int ni = 0; ni < 16; ++ni) {
    int n = nq * 16 + ni;
    float sr = 0.f, si = 0.f;
#pragma unroll 4
    for (int cp = 0; cp < 64; ++cp) {
      float wv = wt[cp * 64 + n];
      int ph = (c * cp) & 63;
      sr += ct[ph] * wv;
      si += ct[64 + ph] * wv;
    }
    dst[(size_t)(n0 + n) * 1024 + g * 64 + c] = f2bf(sr * (1.f / 512.f));
    dst[(size_t)(n0 + n) * 1024 + 512 + g * 64 + c] = f2bf(si * (1.f / 512.f));
  }
  __syncthreads();
}

#define NCW1 2312
__device__ __forceinline__ void cw_mixer_job(const Params& P, const Cx& X, int layer, int j, char* smem) {
  bf16_t* W = (bf16_t*)(X.ws + OFF_WMIX);
  const float* src; const float* scale = nullptr; bf16_t* dst; int N, ldd, tk, tn;
  if (j >= 2184) { fold_job(P, X, layer, j - 2184, smem); return; }
  if (j < 1520) { src = P.in[7] + (size_t)layer * 1024 * 6048; N = 6048; dst = W + WE_IN; ldd = 1024; tk = j / 95; tn = j % 95; }
  else if (j < 1536) { j -= 1520; int d = j >> 3; src = P.in[11] + (size_t)(layer * 2 + d) * 64 * 512; N = 512; dst = W + WE_W2 + d * 32768; ldd = 64; tk = 0; tn = j & 7; }
  else if (j < 1552) { j -= 1536; int d = j >> 3; src = P.in[13] + (size_t)(layer * 2 + d) * 64 * 512; N = 512; dst = W + WE_A2 + d * 32768; ldd = 64; tk = 0; tn = j & 7; }
  else if (j < 1568) { j -= 1552; src = P.in[17] + (size_t)layer * 128 * 512; N = 512; dst = W + WE_G2; ldd = 128; tk = j >> 3; tn = j & 7; }
  else if (j < 1696) { j -= 1568; src = P.in[20] + (size_t)layer * 512 * 1024; N = 1024; dst = W + WE_RO; ldd = 512; tk = j >> 4; tn = j & 15; }
  else if (j < 1824) { j -= 1696; src = P.in[27] + (size_t)layer * 512 * 1024; N = 1024; dst = W + WE_MO; ldd = 512; tk = j >> 4; tn = j & 15; }
  else if (j < 1896) { j -= 1824; src = P.in[23] + (size_t)layer * 384 * 768; N = 768; dst = W + WE_UQ; ldd = 384; scale = P.in[21] + layer * 384; tk = j / 12; tn = j % 12; }
  else if (j < 1928) { j -= 1896; src = P.in[24] + (size_t)layer * 128 * 1024; N = 1024; dst = W + WE_UKV; ldd = 128; scale = P.in[22] + layer * 128; tk = j >> 4; tn = j & 15; }
  else { j -= 1928; src = P.in[29] + (size_t)layer * 1024 * 1024; N = 1024; dst = W + WE_OUT; ldd = 1024; tk = j >> 4; tn = j & 15; }
  cw_tile(X, src, N, N, dst, ldd, scale, 0, tk, tn, smem);
}
#define NCW2 2112
__device__ __forceinline__ void cw_ffn_job(const Params& P, const Cx& X, int layer, int j, char* smem) {
  bf16_t* W = (bf16_t*)(X.ws + OFF_WFFN);
  const float* src; bf16_t* dst; int N, ldd, tk, tn, perm;
  if (j < 1408) { src = P.in[31] + (size_t)layer * 1024 * 5632; N = 5632; dst = W + WF_IN; ldd = 1024; perm = 1; tk = j / 88; tn = j % 88; }
  else { j -= 1408; src = P.in[32] + (size_t)layer * 2816 * 1024; N = 1024; dst = W + WF_OUT; ldd = 2816; perm = 0; tk = j >> 4; tn = j & 15; }
  cw_tile(X, src, N, N, dst, ldd, nullptr, perm, tk, tn, smem);
}

__device__ __forceinline__ void norm_job(const Params& P, const Cx& X, int layer, int which, int job) {
  const int lane = X.tid & 63, w = X.tid >> 6;
  const int row = job * 4 + w;
  const float* src;
  if (which == 0) {
    if (row < NX) src = (layer == 0 ? P.in[0] : X.out) + (size_t)row * 1024;
    else src = (layer == 0 ? P.in[2] : (const float*)(X.ws + OFF_CS)) + (size_t)(row - NX) * 1024;
  } else {
    if (row < NX) src = X.out + (size_t)row * 1024;
    else src = (const float*)(X.ws + OFF_CS) + (size_t)(row - NX) * 1024;
  }
  const float* g = (which == 0 ? P.in[6] : P.in[30]) + layer * 1024;
  const float* modv = (const float*)(X.ws + OFF_MOD) + (size_t)(layer * 5 + mod_row(row)) * 6144;
  const float* shift = modv + (which == 0 ? 0 : 3072);
  const float* scale = modv + (which == 0 ? 1024 : 4096);
  float4 v[4];
  float ss = 0.f;
#pragma unroll
  for (int i = 0; i < 4; ++i) {
    v[i] = ((const float4*)src)[lane + 64 * i];
    ss += v[i].x * v[i].x + v[i].y * v[i].y + v[i].z * v[i].z + v[i].w * v[i].w;
  }
#pragma unroll
  for (int o = 32; o >= 1; o >>= 1) ss += __shfl_xor(ss, o);
  const float rstd = rsqrtf(ss * (1.f / 1024.f) + 1e-6f);
  bf16_t* dst = (bf16_t*)(X.ws + OFF_HBUF) + (size_t)row * 1024;
#pragma unroll
  for (int i = 0; i < 4; ++i) {
    int col = 4 * (lane + 64 * i);
    float4 gg = *(const float4*)(g + col), sh = *(const float4*)(shift + col), sc = *(const float4*)(scale + col);
    float y0 = v[i].x * rstd * gg.x * (1.f + sc.x) + sh.x;
    float y1 = v[i].y * rstd * gg.y * (1.f + sc.y) + sh.y;
    float y2 = v[i].z * rstd * gg.z * (1.f + sc.z) + sh.z;
    float y3 = v[i].w * rstd * gg.w * (1.f + sc.w) + sh.w;
    uint2 o;
    o.x = pack2(y0, y1); o.y = pack2(y2, y3);
    *(uint2*)(dst + col) = o;
  }
}

__device__ __forceinline__ void g1a_tile(const Params& P, const Cx& X, int t, char* smem) {
  const int lane = X.tid & 63, w = X.tid >> 6;
  const int mt = t % 136, nt = t / 136;
  const int m0 = mt * 128, n0 = nt * 128;
  f32x16 acc[2][2];
  G22::zero(acc);
  G22::run(X, (const bf16_t*)(X.ws + OFF_HBUF) + (size_t)m0 * 1024, 1024, (const bf16_t*)(X.ws + OFF_WMIX) + WE_IN + (size_t)n0 * 1024, 1024, 1024, smem, acc);
  bf16_t* zr = (bf16_t*)(X.ws + OFF_ZR);
  const int row0 = m0 + (w >> 1) * 64, col0 = n0 + (w & 1) * 64;
#pragma unroll
  for (int i = 0; i < 2; ++i)
#pragma unroll
    for (int j = 0; j < 2; ++j)
#pragma unroll
      for (int r = 0; r < 16; ++r) {
        int row = row0 + i * 32 + ROW_OF(r), col = col0 + j * 32 + (lane & 31);
        zr[(size_t)row * 1920 + col] = f2bf(acc[i][j][r]);
      }
}
__device__ __forceinline__ void g1b_tile(const Params& P, const Cx& X, int t, char* smem) {
  const int lane = X.tid & 63, w = X.tid >> 6;
  const int mt = t % 136, nt = t / 136;
  const int m0 = mt * 128, n0 = nt * 128;
  f32x16 acc[2][2];
  G22::zero(acc);
  G22::run(X, (const bf16_t*)(X.ws + OFF_HBUF) + (size_t)m0 * 1024, 1024, (const bf16_t*)(X.ws + OFF_WMIX) + WE_IN + (size_t)(1920 + n0) * 1024, 1024, 1024, smem, acc);
  bf16_t* zm = (bf16_t*)(X.ws + OFF_ZM);
  bf16_t* zf = (bf16_t*)(X.ws + OFF_ZF);
  const int row0 = m0 + (w >> 1) * 64, col0 = n0 + (w & 1) * 64;
#pragma unroll
  for (int i = 0; i < 2; ++i)
#pragma unroll
    for (int j = 0; j < 2; ++j)
#pragma unroll
      for (int r = 0; r < 16; ++r) {
        int row = row0 + i * 32 + ROW_OF(r), col = col0 + j * 32 + (lane & 31);
        bf16_t v = f2bf(acc[i][j][r]);
        if (col < 544) zm[(size_t)row * 544 + col] = v;
        else if (col < 1056) zf[(size_t)row * 512 + (col - 544)] = v;
      }
}

__device__ __forceinline__ void r1a_job(const Params& P, const Cx& X, int layer, int job) {
  const int tid = X.tid;
  const int ch = tid < 240 ? tid : 239;
  const int col0 = ch * 8;
  const bf16_t* zr = (const bf16_t*)(X.ws + OFF_ZR);
  const int rowb = job * 8;
  int pos, len;
  if (rowb < NX) { pos = rowb & 4095; len = 4096; } else { pos = (rowb - NX) & 255; len = 256; }
  const bool isk = (col0 >= 512 && col0 < 1024);
  float mup[8], mun[8], kkw[8];
  {
    const float4 a0 = *(const float4*)(P.in[8] + layer * 1920 + col0), a1 = *(const float4*)(P.in[8] + layer * 1920 + col0 + 4);
    const float4 b0 = *(const float4*)(P.in[9] + layer * 1920 + col0), b1 = *(const float4*)(P.in[9] + layer * 1920 + col0 + 4);
    const float* kp = P.in[14] + layer * 512 + (isk ? col0 - 512 : 0);
    const float4 c0 = *(const float4*)kp, c1 = *(const float4*)(kp + 4);
    mup[0] = a0.x; mup[1] = a0.y; mup[2] = a0.z; mup[3] = a0.w; mup[4] = a1.x; mup[5] = a1.y; mup[6] = a1.z; mup[7] = a1.w;
    mun[0] = b0.x; mun[1] = b0.y; mun[2] = b0.z; mun[3] = b0.w; mun[4] = b1.x; mun[5] = b1.y; mun[6] = b1.z; mun[7] = b1.w;
    kkw[0] = c0.x; kkw[1] = c0.y; kkw[2] = c0.z; kkw[3] = c0.w; kkw[4] = c1.x; kkw[5] = c1.y; kkw[6] = c1.z; kkw[7] = c1.w;
  }
  uint4 zw[10];
#pragma unroll
  for (int i = 0; i < 10; ++i) {
    const int pp = pos - 1 + i;
    zw[i] = make_uint4(0, 0, 0, 0);
    if (pp >= 0 && pp < len) zw[i] = *(const uint4*)(zr + (size_t)(rowb - 1 + i) * 1920 + col0);
  }
#pragma unroll
  for (int i8 = 0; i8 < 8; ++i8) {
    const int row = rowb + i8;
    const uint4 zp = zw[i8], zc = zw[i8 + 1], zn = zw[i8 + 2];
    float zs[8];
    {
      const uint32_t c4[4] = {zc.x, zc.y, zc.z, zc.w}, p4[4] = {zp.x, zp.y, zp.z, zp.w}, n4[4] = {zn.x, zn.y, zn.z, zn.w};
#pragma unroll
      for (int i = 0; i < 4; ++i) {
        float c0 = lo16(c4[i]), c1 = hi16(c4[i]);
        zs[2 * i] = c0 + (lo16(p4[i]) - c0) * mup[2 * i] + (lo16(n4[i]) - c0) * mun[2 * i];
        zs[2 * i + 1] = c1 + (hi16(p4[i]) - c1) * mup[2 * i + 1] + (hi16(n4[i]) - c1) * mun[2 * i + 1];
      }
    }
    if (tid < 240) {
      uint4 o;
      if (col0 < 1536) {
        o.x = pack2(zs[0], zs[1]); o.y = pack2(zs[2], zs[3]); o.z = pack2(zs[4], zs[5]); o.w = pack2(zs[6], zs[7]);
        *(uint4*)((bf16_t*)(X.ws + OFF_RKV) + (size_t)row * 1536 + col0) = o;
      } else {
        float t[8];
        if (col0 < 1664) {
#pragma unroll
          for (int i = 0; i < 8; ++i) t[i] = 1.f - 2.f / (1.f + __expf(2.f * zs[i]));
        } else if (col0 < 1792) {
#pragma unroll
          for (int i = 0; i < 8; ++i) t[i] = zs[i];
        } else {
#pragma unroll
          for (int i = 0; i < 8; ++i) t[i] = 1.f / (1.f + __expf(-zs[i]));
        }
        o.x = pack2(t[0], t[1]); o.y = pack2(t[2], t[3]); o.z = pack2(t[4], t[5]); o.w = pack2(t[6], t[7]);
        *(uint4*)((bf16_t*)(X.ws + OFF_LORA) + (size_t)row * 384 + (col0 - 1536)) = o;
      }
    }
  }
}

__device__ __forceinline__ void r1b_tile(const Params& P, const Cx& X, int layer, int t, char* smem) {
  const int lane = X.tid & 63, w = X.tid >> 6;
  const int mt = t % 136, rest = t / 136;
  const int nt = rest & 3, type = rest >> 2;
  const int m0 = mt * 128, n0 = nt * 128;
  const bf16_t* lora = (const bf16_t*)(X.ws + OFF_LORA) + (size_t)m0 * 384;
  const bf16_t* W = (const bf16_t*)(X.ws + OFF_WMIX);
  f32x16 acc[2][2];
  G22::zero(acc);
  if (type < 2) G22::run(X, lora + type * 64, 384, W + WE_W2 + type * 32768 + (size_t)n0 * 64, 64, 64, smem, acc);
  else if (type < 4) G22::run(X, lora + 128 + (type - 2) * 64, 384, W + WE_A2 + (type - 2) * 32768 + (size_t)n0 * 64, 64, 64, smem, acc);
  else G22::run(X, lora + 256, 384, W + WE_G2 + (size_t)n0 * 128, 128, 128, smem, acc);
  const int row0 = m0 + (w >> 1) * 64, col0 = n0 + (w & 1) * 64;
  bf16_t* ld = (bf16_t*)(X.ws + OFF_LD);
  bf16_t* ab = (bf16_t*)(X.ws + OFF_A);
  bf16_t* gb = (bf16_t*)(X.ws + OFF_G);
#pragma unroll
  for (int j = 0; j < 2; ++j) {
    const int col = col0 + j * 32 + (lane & 31);
    float bias = 0.f;
    if (type < 2) bias = P.in[10][(layer * 2 + type) * 512 + col];
    else if (type < 4) bias = P.in[12][(layer * 2 + type - 2) * 512 + col];
#pragma unroll
    for (int i = 0; i < 2; ++i)
#pragma unroll
      for (int r = 0; r < 16; ++r) {
        int row = row0 + i * 32 + ROW_OF(r);
        float v = acc[i][j][r] + bias;
        if (type < 2) ld[(size_t)row * 1024 + type * 512 + col] = f2bf(-0.60653066f / (1.f + __expf(-v)));
        else if (type < 4) ab[(size_t)row * 1024 + (type - 2) * 512 + col] = f2bf(1.f / (1.f + __expf(-v)));
        else gb[(size_t)row * 512 + col] = f2bf(v);
      }
  }
}

template <int CTRL>
__device__ __forceinline__ float dpp_f(float x) {
  return __int_as_float(__builtin_amdgcn_update_dpp(0, __float_as_int(x), CTRL, 0xf, 0xf, false));
}
__device__ __forceinline__ float red16(float x) {
  x += dpp_f<0x128>(x);
  x += dpp_f<0x124>(x);
  x += dpp_f<0x4E>(x);
  x += dpp_f<0xB1>(x);
  return x;
}
__device__ __forceinline__ int scan_tokrow(int b, int dir, int i) {
  if (i < 256) return NX + b * 256 + (dir ? 255 - i : i);
  int t = i - 256;
  return b * 4096 + (dir ? 4095 - t : t);
}
typedef float f2_t __attribute__((ext_vector_type(2)));
__device__ __forceinline__ void scan_job(const Params& P, const Cx& X, int layer, int bj, char* smem) {
  const int tid = X.tid, lane = tid & 63, w = tid >> 6;
  const int s = bj >> 2, rq = bj & 3;
  const int dir = s >> 5, b = (s & 31) >> 3, h = s & 7;
  float* sv = (float*)smem;
  float* sy = sv + 2 * 16 * 6 * 64;
  const bf16_t* rkv = (const bf16_t*)(X.ws + OFF_RKV);
  const bf16_t* ab = (const bf16_t*)(X.ws + OFF_A);
  const bf16_t* ldb = (const bf16_t*)(X.ws + OFF_LD);
  bf16_t* yout = (bf16_t*)(X.ws + (dir ? OFF_YB : OFF_YF));
  const int lst = tid >> 4, lch = (tid & 15) * 4;
  const float4 ka4 = *(const float4*)(P.in[15] + layer * 512 + h * 64 + lch);
  const float4 kw4 = *(const float4*)(P.in[14] + layer * 512 + h * 64 + lch);
  uint2 pr, pk, pv, pa, pl;
#define SLOAD(chunk)                                                          \
  {                                                                           \
    int row = scan_tokrow(b, dir, (chunk)*16 + lst);                          \
    const bf16_t* p0 = rkv + (size_t)row * 1536 + h * 64 + lch;               \
    pr = *(const uint2*)p0; pk = *(const uint2*)(p0 + 512); pv = *(const uint2*)(p0 + 1024); \
    pa = *(const uint2*)(ab + (size_t)row * 1024 + dir * 512 + h * 64 + lch); \
    pl = *(const uint2*)(ldb + (size_t)row * 1024 + dir * 512 + h * 64 + lch);\
  }
#define SSTORE2(buf)                                                          \
  {                                                                           \
    float* d = sv + ((buf)*16 + lst) * 384 + lch;                             \
    float a0 = lo16(pa.x), a1 = hi16(pa.x), a2 = lo16(pa.y), a3 = hi16(pa.y); \
    float k0 = lo16(pk.x), k1 = hi16(pk.x), k2 = lo16(pk.y), k3 = hi16(pk.y); \
    float q0 = k0 * kw4.x, q1 = k1 * kw4.y, q2 = k2 * kw4.z, q3 = k3 * kw4.w;    \
    {                                                                         \
      const float ssq = red16(q0 * q0 + q1 * q1 + q2 * q2 + q3 * q3);         \
      const float inv = 1.f / fmaxf(sqrtf(ssq), 1e-12f);                      \
      q0 *= inv; q1 *= inv; q2 *= inv; q3 *= inv;                             \
    }                                                                         \
    *(float4*)(d) = make_float4(q0, q1, q2, q3);                              \
    *(float4*)(d + 64) = make_float4(__expf(lo16(pl.x)), __expf(hi16(pl.x)), __expf(lo16(pl.y)), __expf(hi16(pl.y))); \
    *(float4*)(d + 128) = make_float4(q0 * a0, q1 * a1, q2 * a2, q3 * a3);    \
    *(float4*)(d + 192) = make_float4(k0 * (1.f + (a0 - 1.f) * ka4.x), k1 * (1.f + (a1 - 1.f) * ka4.y), k2 * (1.f + (a2 - 1.f) * ka4.z), k3 * (1.f + (a3 - 1.f) * ka4.w)); \
    *(float4*)(d + 256) = make_float4(lo16(pr.x), hi16(pr.x), lo16(pr.y), hi16(pr.y)); \
    *(float4*)(d + 320) = make_float4(lo16(pv.x), hi16(pv.x), lo16(pv.y), hi16(pv.y)); \
  }
  SLOAD(0);
  SSTORE2(0);
  __syncthreads();
  const int rp = lane >> 4, ci = (lane & 15) * 4;
  const int vrow = rq * 16 + w * 4 + rp;
  float S0 = 0.f, S1 = 0.f, S2 = 0.f, S3 = 0.f, qy = 0.f;
  for (int chunk = 0; chunk < 272; ++chunk) {
    const int buf = chunk & 1;
    SLOAD(chunk + 1 < 272 ? chunk + 1 : 271);
    __builtin_amdgcn_sched_barrier(0);
    {
      const float* base = sv + buf * 16 * 384;
      float ysel = 0.f;
      qy = 0.f;
      float4 p0kk, p0w, p0b, p0kd, p0r, p1kk, p1w, p1b, p1kd, p1r;
      float p0v, p1v;
#define LDS_SET(S, st)                                     \
  {                                                        \
    const float* d = base + (st)*384;                      \
    S##kk = *(const float4*)(d + ci);                      \
    S##w = *(const float4*)(d + 64 + ci);                  \
    S##b = *(const float4*)(d + 128 + ci);                 \
    S##kd = *(const float4*)(d + 192 + ci);                \
    S##r = *(const float4*)(d + 256 + ci);                 \
    S##v = d[320 + vrow];                                  \
  }
#define DPPS "row_mask:0xf bank_mask:0xf bound_ctrl:1\n"
#define STEP(S, st)                                                                                   \
  {                                                                                                   \
    float t0, t1, u0, u1, u2, u3;                                                                     \
    asm volatile(                                                                                     \
        "v_mul_f32 %5, %0, %11\n"                                                                     \
        "v_mul_f32 %6, %1, %12\n"                                                                     \
        "v_fma_f32 %5, %2, %13, %5\n"                                                                 \
        "v_fma_f32 %6, %3, %14, %6\n"                                                                 \
        "v_mul_f32 %7, %27, %23\n"                                                                    \
        "v_add_f32 %5, %5, %6\n"                                                                      \
        "v_mul_f32 %8, %27, %24\n"                                                                    \
        "v_mul_f32 %9, %27, %25\n"                                                                    \
        "v_add_f32_dpp %5, %5, %5 row_ror:8 " DPPS                                                    \
        "v_add_f32_dpp %4, %4, %4 row_ror:8 " DPPS                                                    \
        "v_mul_f32 %10, %27, %26\n"                                                                   \
        "v_add_f32_dpp %5, %5, %5 row_ror:4 " DPPS                                                    \
        "v_add_f32_dpp %4, %4, %4 row_ror:4 " DPPS                                                    \
        "v_fma_f32 %7, %0, %15, %7\n"                                                                 \
        "v_add_f32_dpp %5, %5, %5 quad_perm:[2,3,0,1] " DPPS                                          \
        "v_add_f32_dpp %4, %4, %4 quad_perm:[2,3,0,1] " DPPS                                          \
        "v_fma_f32 %8, %1, %16, %8\n"                                                                 \
        "v_add_f32_dpp %5, %5, %5 quad_perm:[1,0,3,2] " DPPS                                          \
        "v_add_f32_dpp %4, %4, %4 quad_perm:[1,0,3,2] " DPPS                                          \
        "v_fma_f32 %9, %2, %17, %9\n"                                                                 \
        "v_fma_f32 %10, %3, %18, %10\n"                                                               \
        "v_fma_f32 %0, -%5, %19, %7\n"                                                                \
        "v_fma_f32 %1, -%5, %20, %8\n"                                                                \
        "v_fma_f32 %2, -%5, %21, %9\n"                                                                \
        "v_fma_f32 %3, -%5, %22, %10\n"                                                               \
        : "+v"(S0), "+v"(S1), "+v"(S2), "+v"(S3), "+v"(qy), "=&v"(t0), "=&v"(t1), "=&v"(u0), "=&v"(u1), \
          "=&v"(u2), "=&v"(u3)                                                                        \
        : "v"(S##kk.x), "v"(S##kk.y), "v"(S##kk.z), "v"(S##kk.w), "v"(S##w.x), "v"(S##w.y), "v"(S##w.z), \
          "v"(S##w.w), "v"(S##b.x), "v"(S##b.y), "v"(S##b.z), "v"(S##b.w), "v"(S##kd.x), "v"(S##kd.y), \
          "v"(S##kd.z), "v"(S##kd.w), "v"(S##v));                                                     \
                                                 \
    if ((st) > 0) ysel = ((lane & 15) == (st)-1) ? qy : ysel;                                         \
    qy = fmaf(S2, S##r.z, S0 * S##r.x) + fmaf(S3, S##r.w, S1 * S##r.y);                               \
  }
      LDS_SET(p0, 0);
#pragma unroll
      for (int st = 0; st < 16; st += 2) {
        LDS_SET(p1, st + 1);
        __builtin_amdgcn_sched_barrier(0);
        STEP(p0, st);
        if (st + 2 < 16) LDS_SET(p0, st + 2);
        __builtin_amdgcn_sched_barrier(0);
        STEP(p1, st + 1);
      }
#undef LDS_SET
#undef STEP
#undef DPPS
      qy = red16(qy);
      ysel = ((lane & 15) == 15) ? qy : ysel;
      sy[(buf * 16 + (lane & 15)) * 16 + w * 4 + rp] = ysel;
    }
    if (chunk + 1 < 272) SSTORE2(buf ^ 1);
    __syncthreads();
    {
      int st = tid >> 4, r = tid & 15;
      int row = scan_tokrow(b, dir, chunk * 16 + st);
      yout[(size_t)row * 512 + h * 64 + rq * 16 + r] = f2bf(sy[(buf * 16 + st) * 16 + r]);
    }
  }
#undef SLOAD
#undef SSTORE2
  __syncthreads();
}

__device__ __forceinline__ void s2_job(const Params& P, const Cx& X, int layer, int job) {
  const int tid = X.tid;
  const int row = job * 4 + (tid >> 6);
  const int c0 = (tid & 63) * 8;
  const bf16_t* rkv = (const bf16_t*)(X.ws + OFF_RKV) + (size_t)row * 1536;
  uint4 ur = *(const uint4*)(rkv + c0), uk = *(const uint4*)(rkv + 512 + c0), uv = *(const uint4*)(rkv + 1024 + c0);
  uint4 ua0 = *(const uint4*)((const bf16_t*)(X.ws + OFF_A) + (size_t)row * 1024 + c0);
  uint4 ua1 = *(const uint4*)((const bf16_t*)(X.ws + OFF_A) + (size_t)row * 1024 + 512 + c0);
  uint4 ug = *(const uint4*)((const bf16_t*)(X.ws + OFF_G) + (size_t)row * 512 + c0);
  uint4 uyf = *(const uint4*)((const bf16_t*)(X.ws + OFF_YF) + (size_t)row * 512 + c0);
  uint4 uyb = *(const uint4*)((const bf16_t*)(X.ws + OFF_YB) + (size_t)row * 512 + c0);
  const uint32_t r4[4] = {ur.x, ur.y, ur.z, ur.w}, k4[4] = {uk.x, uk.y, uk.z, uk.w}, v4[4] = {uv.x, uv.y, uv.z, uv.w};
  const uint32_t a04[4] = {ua0.x, ua0.y, ua0.z, ua0.w}, a14[4] = {ua1.x, ua1.y, ua1.z, ua1.w}, g4[4] = {ug.x, ug.y, ug.z, ug.w};
  const uint32_t yf4[4] = {uyf.x, uyf.y, uyf.z, uyf.w}, yb4[4] = {uyb.x, uyb.y, uyb.z, uyb.w};
  float y[8], vv[8], gg[8];
  float sum = 0.f, bon = 0.f;
  const float* rk = P.in[16] + layer * 512 + c0;
  const float* ka = P.in[15] + layer * 512 + c0;
#pragma unroll
  for (int i = 0; i < 4; ++i) {
#pragma unroll
    for (int hh = 0; hh < 2; ++hh) {
      int e = 2 * i + hh;
      float r = hh ? hi16(r4[i]) : lo16(r4[i]);
      float k = hh ? hi16(k4[i]) : lo16(k4[i]);
      float a0 = hh ? hi16(a04[i]) : lo16(a04[i]);
      float a1 = hh ? hi16(a14[i]) : lo16(a14[i]);
      y[e] = (hh ? hi16(yf4[i]) : lo16(yf4[i])) + (hh ? hi16(yb4[i]) : lo16(yb4[i]));
      vv[e] = hh ? hi16(v4[i]) : lo16(v4[i]);
      gg[e] = hh ? hi16(g4[i]) : lo16(g4[i]);
      sum += y[e];
      float ksum = k * (2.f + (a0 + a1 - 2.f) * ka[e]);
      bon += r * rk[e] * ksum;
    }
  }
  sum += __shfl_xor(sum, 1); sum += __shfl_xor(sum, 2); sum += __shfl_xor(sum, 4);
  bon += __shfl_xor(bon, 1); bon += __shfl_xor(bon, 2); bon += __shfl_xor(bon, 4);
  const float mu = sum * (1.f / 64.f);
  float var = 0.f;
#pragma unroll
  for (int e = 0; e < 8; ++e) { float d = y[e] - mu; var += d * d; }
  var += __shfl_xor(var, 1); var += __shfl_xor(var, 2); var += __shfl_xor(var, 4);
  const float rs = rsqrtf(var * (1.f / 64.f) + 64e-5f);
  const float* gw = P.in[18] + layer * 512 + c0;
  const float* gbi = P.in[19] + layer * 512 + c0;
  float o[8];
#pragma unroll
  for (int e = 0; e < 8; ++e) o[e] = ((y[e] - mu) * rs * gw[e] + gbi[e] + bon * vv[e]) * gg[e];
  uint4 ou;
  ou.x = pack2(o[0], o[1]); ou.y = pack2(o[2], o[3]); ou.z = pack2(o[4], o[5]); ou.w = pack2(o[6], o[7]);
  *(uint4*)((bf16_t*)(X.ws + OFF_RWO) + (size_t)row * 512 + c0) = ou;
}

__device__ __forceinline__ float red32(float x) {
  x += __shfl_xor(x, 1); x += __shfl_xor(x, 2); x += __shfl_xor(x, 4); x += __shfl_xor(x, 8); x += __shfl_xor(x, 16);
  return x;
}
#define QSCALE 0.14724444f
__device__ __forceinline__ void q1_q_tile(const Params& P, const Cx& X, int layer, int t, char* smem) {
  const int tid = X.tid, lane = tid & 63, w = tid >> 6;
  const int mt = t % 136, head = t / 136;
  const int m0 = mt * 128;
  const bf16_t* zm = (const bf16_t*)(X.ws + OFF_ZM);
  float* srs = (float*)(smem + 73728);
  {
    int r = tid >> 1, hf = tid & 1;
    const bf16_t* p = zm + (size_t)(m0 + r) * 544 + hf * 192;
    float ss = 0.f;
#pragma unroll 12
    for (int i = 0; i < 24; ++i) {
      uint4 u = *(const uint4*)(p + i * 8);
      ss += lo16(u.x) * lo16(u.x) + hi16(u.x) * hi16(u.x) + lo16(u.y) * lo16(u.y) + hi16(u.y) * hi16(u.y) +
            lo16(u.z) * lo16(u.z) + hi16(u.z) * hi16(u.z) + lo16(u.w) * lo16(u.w) + hi16(u.w) * hi16(u.w);
    }
    ss += __shfl_xor(ss, 1);
    if (hf == 0) srs[r] = rsqrtf(ss * (1.f / 384.f) + 1e-6f);
  }
  f32x16 acc[1][3];
  GQ::zero(acc);
  GQ::run(X, zm + (size_t)m0 * 544, 544, (const bf16_t*)(X.ws + OFF_WMIX) + WE_UQ + (size_t)head * 96 * 384, 384, 384, smem, acc);
  const int l5 = lane & 31;
  const float* gq = P.in[25] + layer * 96;
  const float g0 = gq[l5], g1 = gq[32 + l5], g2 = gq[64 + l5];
  const float2* rope = (const float2*)(X.ws + OFF_ROPE);
  bf16_t* qb = (bf16_t*)(X.ws + OFF_Q);
  float2 rcs[16];
#pragma unroll
  for (int r = 0; r < 16; ++r) {
    const int row = m0 + w * 32 + ROW_OF(r);
    rcs[r] = (row < NX) ? rope[(row & 4095) * 16 + (l5 >> 4) * 8 + (l5 & 7)] : make_float2(1.f, 0.f);
  }
#pragma unroll
  for (int r = 0; r < 16; ++r) {
    const int rl = w * 32 + ROW_OF(r);
    const int row = m0 + rl;
    const float rs = srs[rl];
    float x0 = acc[0][0][r] * rs, x1 = acc[0][1][r] * rs, x2 = acc[0][2][r] * rs;
    float ss = red32(x0 * x0 + x1 * x1 + x2 * x2);
    float rq = rsqrtf(ss * (1.f / 96.f) + 1e-6f);
    x0 *= rq * g0; x1 *= rq * g1; x2 *= rq * g2;
    bf16_t* dst;
    if (row < NX) {
      int tt = row & 4095, bb = row >> 12;
      float2 cs = rcs[r];
      float other = __shfl_xor(x2, 8);
      x2 = (l5 & 8) ? x2 * cs.x + other * cs.y : x2 * cs.x - other * cs.y;
      dst = qb + ((size_t)(bb * 8 + head) * 4096 + tt) * 96;
    } else {
      int j = (row - NX) & 255, bb = (row - NX) >> 8;
      dst = qb + (size_t)NX * 768 + ((size_t)(bb * 8 + head) * 256 + j) * 96;
    }
    dst[l5] = f2bf(x0 * QSCALE); dst[32 + l5] = f2bf(x1 * QSCALE); dst[64 + l5] = f2bf(x2 * QSCALE);
  }
}
__device__ __forceinline__ void q1_kv_tile(const Params& P, const Cx& X, int layer, int t, char* smem) {
  const int tid = X.tid, lane = tid & 63, w = tid >> 6;
  const int mt = t % 136, head = t / 136;
  const int m0 = mt * 128;
  const bf16_t* zm = (const bf16_t*)(X.ws + OFF_ZM);
  float* srs = (float*)(smem + 73728);
  {
    int r = tid >> 1, hf = tid & 1;
    const bf16_t* p = zm + (size_t)(m0 + r) * 544 + 384 + hf * 64;
    float ss = 0.f;
#pragma unroll
    for (int i = 0; i < 8; ++i) {
      uint4 u = *(const uint4*)(p + i * 8);
      ss += lo16(u.x) * lo16(u.x) + hi16(u.x) * hi16(u.x) + lo16(u.y) * lo16(u.y) + hi16(u.y) * hi16(u.y) +
            lo16(u.z) * lo16(u.z) + hi16(u.z) * hi16(u.z) + lo16(u.w) * lo16(u.w) + hi16(u.w) * hi16(u.w);
    }
    ss += __shfl_xor(ss, 1);
    if (hf == 0) srs[r] = rsqrtf(ss * (1.f / 128.f) + 1e-6f);
  }
  f32x16 acc[1][4];
  GKV::zero(acc);
  GKV::run(X, zm + (size_t)m0 * 544 + 384, 544, (const bf16_t*)(X.ws + OFF_WMIX) + WE_UKV + (size_t)head * 128 * 128, 128, 128, smem, acc);
  const int l5 = lane & 31;
  const float* gk = P.in[26] + layer * 96;
  const float g0 = gk[l5], g1 = gk[32 + l5], g2 = gk[64 + l5];
  const float2* rope = (const float2*)(X.ws + OFF_ROPE);
  bf16_t* kb = (bf16_t*)(X.ws + OFF_K);
  bf16_t* vt = (bf16_t*)(X.ws + OFF_VT);
  const bool isx = m0 < NX;
  const int bb = isx ? (m0 >> 12) : ((m0 - NX) >> 8);
  float vv0[16], vv1[16];
  float krv[16];
  float2 rcs[16];
#pragma unroll
  for (int r = 0; r < 16; ++r) {
    const int row = m0 + w * 32 + ROW_OF(r);
    krv[r] = bf2f(zm[(size_t)row * 544 + 512 + l5]);
    rcs[r] = isx ? rope[(row & 4095) * 16 + (l5 >> 4) * 8 + (l5 & 7)] : make_float2(1.f, 0.f);
  }
#pragma unroll
  for (int r = 0; r < 16; ++r) {
    const int rl = w * 32 + ROW_OF(r);
    const int row = m0 + rl;
    const float rs = srs[rl];
    float k0 = acc[0][0][r] * rs, k1 = acc[0][1][r] * rs;
    float kr = krv[r];
    float ss = red32(k0 * k0 + k1 * k1 + kr * kr);
    float rk = rsqrtf(ss * (1.f / 96.f) + 1e-6f);
    k0 *= rk * g0; k1 *= rk * g1; kr *= rk * g2;
    int key;
    if (isx) {
      int tt = row & 4095;
      float2 cs = rcs[r];
      float other = __shfl_xor(kr, 8);
      kr = (l5 & 8) ? kr * cs.x + other * cs.y : kr * cs.x - other * cs.y;
      key = 256 + tt;
    } else {
      key = (row - NX) & 255;
    }
    bf16_t* dst = kb + ((size_t)(bb * 8 + head) * 4352 + key) * 96;
    dst[l5] = f2bf(k0); dst[32 + l5] = f2bf(k1); dst[64 + l5] = f2bf(kr);
    vv0[r] = acc[0][2][r] * rs;
    vv1[r] = acc[0][3][r] * rs;
  }
#pragma unroll
  for (int g = 0; g < 4; ++g) {
    const int rl = w * 32 + 8 * g + 4 * (lane >> 5);
    const int row = m0 + rl;
    const int key = isx ? 256 + (row & 4095) : ((row - NX) & 255);
    uint2 o0, o1;
    o0.x = pack2(vv0[4 * g], vv0[4 * g + 1]); o0.y = pack2(vv0[4 * g + 2], vv0[4 * g + 3]);
    o1.x = pack2(vv1[4 * g], vv1[4 * g + 1]); o1.y = pack2(vv1[4 * g + 2], vv1[4 * g + 3]);
    *(uint2*)(vt + ((size_t)(bb * 8 + head) * 64 + l5) * 4352 + key) = o0;
    *(uint2*)(vt + ((size_t)(bb * 8 + head) * 64 + 32 + l5) * 4352 + key) = o1;
  }
}

__device__ __forceinline__ void fft1_tile(const Params& P, const Cx& X, int t, char* smem) {
  const int lane = X.tid & 63, w = X.tid >> 6;
  const int b = t >> 8, ntile = t & 255;
  const int n0 = ntile * 128;
  f32x16 acc[2][2];
  G22T::zero(acc);
  G22T::run(X, (const bf16_t*)(X.ws + OFF_F1), 64, (const bf16_t*)(X.ws + OFF_ZF) + (size_t)b * 4096 * 512 + n0, 32768, 64, smem, acc);
  const float2* tw = (const float2*)(X.ws + OFF_TW);
  bf16_t* out = (bf16_t*)(X.ws + OFF_FFT1);
  const int wm = w >> 1, wn = w & 1;
  const int t2 = n0 >> 9;
#pragma unroll
  for (int j = 0; j < 2; ++j) {
    const int ch = (n0 & 511) + wn * 64 + j * 32 + (lane & 31);
    float2 tcs[16];
#pragma unroll
    for (int r = 0; r < 16; ++r) tcs[r] = tw[t2 * (wm * 32 + ROW_OF(r))];
#pragma unroll
    for (int r = 0; r < 16; ++r) {
      const int f1 = wm * 32 + ROW_OF(r);
      float re = acc[0][j][r], im = acc[1][j][r];
      float2 cs = tcs[r];
      float re2 = re * cs.x + im * cs.y, im2 = im * cs.x - re * cs.y;
      size_t base = ((size_t)(b * 64 + f1) * 128) * 512 + ch;
      out[base + (size_t)t2 * 512] = f2bf(re2);
      out[base + (size_t)(64 + t2) * 512] = f2bf(im2);
    }
  }
}
__device__ __forceinline__ void fft2_tile(const Params& P, const Cx& X, int t, char* smem) {
  const int lane = X.tid & 63, w = X.tid >> 6;
  const int bf = t >> 2, ntile = t & 3;
  const int b = bf >> 6, f1 = bf & 63;
  const int n0 = ntile * 128;
  f32x16 acc[2][2];
  G22T::zero(acc);
  G22T::run(X, (const bf16_t*)(X.ws + OFF_F2), 128, (const bf16_t*)(X.ws + OFF_FFT1) + (size_t)bf * 128 * 512 + n0, 512, 128, smem, acc);
  bf16_t* Y = (bf16_t*)(X.ws + OFF_Y);
  const int wm = w >> 1, wn = w & 1;
#pragma unroll
  for (int i = 0; i < 2; ++i)
#pragma unroll
    for (int j = 0; j < 2; ++j)
#pragma unroll
      for (int r = 0; r < 16; ++r) {
        int m = wm * 64 + i * 32 + ROW_OF(r);
        int f2 = m & 63, q = m >> 6;
        int ch = n0 + wn * 64 + j * 32 + (lane & 31);
        Y[(size_t)(b * 4096 + f1 + 64 * f2) * 1024 + q * 512 + ch] = f2bf(acc[i][j][r]);
      }
}
__device__ __forceinline__ void ctxdft_tile(const Params& P, const Cx& X, int t, char* smem) {
  const int lane = X.tid & 63, w = X.tid >> 6;
  const int b = t >> 4, mt = (t >> 2) & 3, ntile = t & 3;
  const int n0 = ntile * 128;
  f32x16 acc[2][2];
  G22T::zero(acc);
  G22T::run(X, (const bf16_t*)(X.ws + OFF_F256) + (size_t)mt * 128 * 256, 256, (const bf16_t*)(X.ws + OFF_ZF) + (size_t)(NX + b * 256) * 512 + n0, 512, 256, smem, acc);
  bf16_t* Y = (bf16_t*)(X.ws + OFF_Y);
  const int wm = w >> 1, wn = w & 1;
#pragma unroll
  for (int i = 0; i < 2; ++i)
#pragma unroll
    for (int j = 0; j < 2; ++j)
#pragma unroll
      for (int r = 0; r < 16; ++r) {
        int m = mt * 128 + wm * 64 + i * 32 + ROW_OF(r);
        int f = m & 255, q = m >> 8;
        int ch = n0 + wn * 64 + j * 32 + (lane & 31);
        Y[(size_t)(NX + b * 256 + f) * 1024 + q * 512 + ch] = f2bf(acc[i][j][r] * 4.f);
      }
}

__device__ __forceinline__ void attn_item(const Params& P, const Cx& X, int it, bool isctx, char* smem) {
  const int tid = X.tid, lane = tid & 63, w = tid >> 6;
  int b, h, qb, nkt, qrow0;
  const bf16_t* qbase;
  if (!isctx) {
    b = it >> 8; h = (it >> 5) & 7; qb = it & 31; nkt = 68;
    qbase = (const bf16_t*)(X.ws + OFF_Q) + ((size_t)(b * 8 + h) * 4096 + qb * 128) * 96;
    qrow0 = b * 4096 + qb * 128;
  } else {
    b = it >> 4; h = (it >> 1) & 7; qb = it & 1; nkt = 4;
    qbase = (const bf16_t*)(X.ws + OFF_Q) + (size_t)NX * 768 + ((size_t)(b * 8 + h) * 256 + qb * 128) * 96;
    qrow0 = NX + b * 256 + qb * 128;
  }
  const bf16_t* kbase = (const bf16_t*)(X.ws + OFF_K) + (size_t)(b * 8 + h) * 4352 * 96;
  const bf16_t* vbase = (const bf16_t*)(X.ws + OFF_VT) + (size_t)(b * 8 + h) * 64 * 4352;
  bf16_t* sK = (bf16_t*)smem;
  bf16_t* sV = sK + 2 * 64 * 104;
  const int l5 = lane & 31, hh = lane >> 5;
  const bf16_t* qp = qbase + (size_t)(w * 32 + l5) * 96 + hh * 8;
  const bf16x8 qf0 = *(const bf16x8*)(qp), qf1 = *(const bf16x8*)(qp + 16), qf2 = *(const bf16x8*)(qp + 32);
  const bf16x8 qf3 = *(const bf16x8*)(qp + 48), qf4 = *(const bf16x8*)(qp + 64), qf5 = *(const bf16x8*)(qp + 80);
  uint4 rk0, rk1, rk2, rv0, rv1;
#define LK_(i, kt) (*(const uint4*)(kbase + (size_t)((kt)*64 + (tid + 256 * (i)) / 12) * 96 + ((tid + 256 * (i)) % 12) * 8))
#define LV_(i, kt) (*(const uint4*)(vbase + (size_t)((tid + 256 * (i)) >> 3) * 4352 + (kt)*64 + ((tid + 256 * (i)) & 7) * 8))
#define ALOAD(kt) { rk0 = LK_(0, kt); rk1 = LK_(1, kt); rk2 = LK_(2, kt); rv0 = LV_(0, kt); rv1 = LV_(1, kt); }
#define SK_(i, buf, v) *(uint4*)(sK + (buf)*64 * 104 + ((tid + 256 * (i)) / 12) * 104 + ((tid + 256 * (i)) % 12) * 8) = v
#define SV_(i, buf, v) *(uint4*)(sV + (buf)*64 * 72 + ((tid + 256 * (i)) >> 3) * 72 + ((tid + 256 * (i)) & 7) * 8) = v
#define ASTORE(buf) { SK_(0, buf, rk0); SK_(1, buf, rk1); SK_(2, buf, rk2); SV_(0, buf, rv0); SV_(1, buf, rv1); }
  f32x16 o[2];
#pragma unroll
  for (int r = 0; r < 16; ++r) { o[0][r] = 0.f; o[1][r] = 0.f; }
  float mrun = -1e30f, lrun = 0.f;
  ALOAD(0);
  ASTORE(0);
  __syncthreads();
  for (int kt = 0; kt < nkt; ++kt) {
    const int buf = kt & 1;
    if (kt + 1 < nkt) ALOAD(kt + 1);
    const bf16_t* pk = sK + buf * 64 * 104 + l5 * 104 + hh * 8;
    const bf16_t* pv = sV + buf * 64 * 72 + l5 * 72 + 4 * hh;
#pragma unroll
    for (int mt = 0; mt < 2; ++mt) {
      f32x16 sc;
#pragma unroll
      for (int r = 0; r < 16; ++r) sc[r] = 0.f;
#define QK(ks, qq) sc = __builtin_amdgcn_mfma_f32_32x32x16_bf16(*(const bf16x8*)(pk + mt * 32 * 104 + (ks)*16), qq, sc, 0, 0, 0)
      QK(0, qf0); QK(1, qf1); QK(2, qf2); QK(3, qf3); QK(4, qf4); QK(5, qf5);
#undef QK
      float mx = sc[0];
#pragma unroll
      for (int r = 1; r < 16; ++r) mx = fmaxf(mx, sc[r]);
      mx = fmaxf(mx, __shfl_xor(mx, 32));
      const float mnew = fmaxf(mrun, mx);
      if (__builtin_amdgcn_ballot_w64(mnew > mrun) != 0ull) {
        const float alpha = __builtin_amdgcn_exp2f(mrun - mnew);
        lrun *= alpha;
#pragma unroll
        for (int r = 0; r < 16; ++r) { o[0][r] *= alpha; o[1][r] *= alpha; }
        mrun = mnew;
      }
      float psum = 0.f;
#pragma unroll
      for (int r = 0; r < 16; ++r) { sc[r] = __builtin_amdgcn_exp2f(sc[r] - mrun); psum += sc[r]; }
      lrun += psum;
#pragma unroll
      for (int s2 = 0; s2 < 2; ++s2) {
        u32x4 pu;
        pu[0] = pack2(sc[8 * s2 + 0], sc[8 * s2 + 1]);
        pu[1] = pack2(sc[8 * s2 + 2], sc[8 * s2 + 3]);
        pu[2] = pack2(sc[8 * s2 + 4], sc[8 * s2 + 5]);
        pu[3] = pack2(sc[8 * s2 + 6], sc[8 * s2 + 7]);
        const bf16x8 pfv = __builtin_bit_cast(bf16x8, pu);
#pragma unroll
        for (int dt = 0; dt < 2; ++dt) {
          const bf16_t* p = pv + dt * 32 * 72 + mt * 32 + s2 * 16;
          uint2 v0 = *(const uint2*)(p), v1 = *(const uint2*)(p + 8);
          u32x4 vu;
          vu[0] = v0.x; vu[1] = v0.y; vu[2] = v1.x; vu[3] = v1.y;
          o[dt] = __builtin_amdgcn_mfma_f32_32x32x16_bf16(__builtin_bit_cast(bf16x8, vu), pfv, o[dt], 0, 0, 0);
        }
      }
    }
    if (kt + 1 < nkt) ASTORE(buf ^ 1);
    __syncthreads();
  }
#undef ALOAD
#undef ASTORE
#undef LK_
#undef LV_
#undef SK_
#undef SV_
  lrun += __shfl_xor(lrun, 32);
  const float inv = 1.f / lrun;
  bf16_t* dst = (bf16_t*)(X.ws + OFF_ATT) + (size_t)(qrow0 + w * 32 + l5) * 512 + h * 64;
#pragma unroll
  for (int dt = 0; dt < 2; ++dt)
#pragma unroll
    for (int g = 0; g < 4; ++g) {
      uint2 u;
      u.x = pack2(o[dt][4 * g] * inv, o[dt][4 * g + 1] * inv);
      u.y = pack2(o[dt][4 * g + 2] * inv, o[dt][4 * g + 3] * inv);
      *(uint2*)(dst + dt * 32 + 8 * g + 4 * hh) = u;
    }
}

__device__ __forceinline__ void mg_tile(const Params& P, const Cx& X, int t, int mtiles, char* smem) {
  const int lane = X.tid & 63, w = X.tid >> 6;
  const int mt = t % mtiles, nt = t / mtiles;
  const int m0 = mt * 128, c0 = nt * 128;
  const bf16_t* W = (const bf16_t*)(X.ws + OFF_WMIX);
  uint32_t mpk[2][2][8];
#pragma unroll
  for (int a = 0; a < 2; ++a)
#pragma unroll
    for (int c = 0; c < 2; ++c)
#pragma unroll
      for (int r = 0; r < 8; ++r) mpk[a][c][r] = 0u;
#pragma unroll 1
  for (int i = 0; i < 3; ++i) {
    f32x16 acc[2][2];
    G22::zero(acc);
    const bf16_t* Ai; const bf16_t* Bi; int ldi;
    if (i == 0) { Ai = (const bf16_t*)(X.ws + OFF_RWO) + (size_t)m0 * 512; Bi = W + WE_RO + (size_t)c0 * 512; ldi = 512; }
    else if (i == 1) { Ai = (const bf16_t*)(X.ws + OFF_ATT) + (size_t)m0 * 512; Bi = W + WE_MO + (size_t)c0 * 512; ldi = 512; }
    else { Ai = (const bf16_t*)(X.ws + OFF_Y) + (size_t)m0 * 1024; Bi = W + WE_FO + (size_t)c0 * 1024; ldi = 1024; }
    { const Cx Y1 = fresh(X); G22::run(Y1, Ai, ldi, Bi, ldi, ldi, smem, acc); }
    uint32_t opk[2][2][8];
#pragma unroll
    for (int a = 0; a < 2; ++a)
#pragma unroll
      for (int c = 0; c < 2; ++c)
#pragma unroll
        for (int r = 0; r < 8; ++r) opk[a][c][r] = pack2(acc[a][c][2 * r], acc[a][c][2 * r + 1]);
    __builtin_amdgcn_sched_barrier(0);
    G22::zero(acc);
    { const Cx Y2 = fresh(X); G22::run(Y2, (const bf16_t*)(X.ws + OFF_HBUF) + (size_t)m0 * 1024, 1024, W + WE_IN + (size_t)(2976 + i * 1024 + c0) * 1024, 1024, 1024, smem, acc); }
#pragma unroll
    for (int a = 0; a < 2; ++a)
#pragma unroll
      for (int c = 0; c < 2; ++c)
#pragma unroll
        for (int r = 0; r < 8; ++r) {
          const float m0v = lo16(mpk[a][c][r]) + lo16(opk[a][c][r]) / (1.f + __expf(-acc[a][c][2 * r]));
          const float m1v = hi16(mpk[a][c][r]) + hi16(opk[a][c][r]) / (1.f + __expf(-acc[a][c][2 * r + 1]));
          mpk[a][c][r] = pack2(m0v, m1v);
        }
  }
  bf16_t* mb = (bf16_t*)(X.ws + OFF_M);
  const int row0 = m0 + (w >> 1) * 64, col0 = c0 + (w & 1) * 64;
#pragma unroll
  for (int a = 0; a < 2; ++a)
#pragma unroll
    for (int c = 0; c < 2; ++c)
#pragma unroll
      for (int r = 0; r < 16; ++r)
        mb[(size_t)(row0 + a * 32 + ROW_OF(r)) * 1024 + col0 + c * 32 + (lane & 31)] = (bf16_t)((r & 1) ? (mpk[a][c][r >> 1] >> 16) : (mpk[a][c][r >> 1] & 0xffffu));
}

__device__ __forceinline__ void wo_tile(const Params& P, const Cx& X, int layer, int t, int mtiles, char* smem) {
  const int lane = X.tid & 63, w = X.tid >> 6;
  const int mt = t % mtiles, nt = t / mtiles;
  const int m0 = mt * 128, n0 = nt * 128;
  f32x16 acc[2][2];
  G22::zero(acc);
  G22::run(X, (const bf16_t*)(X.ws + OFF_M) + (size_t)m0 * 1024, 1024, (const bf16_t*)(X.ws + OFF_WMIX) + WE_OUT + (size_t)n0 * 1024, 1024, 1024, smem, acc);
  const int row0 = m0 + (w >> 1) * 64, col0 = n0 + (w & 1) * 64;
  const float* modv = (const float*)(X.ws + OFF_MOD) + (size_t)(layer * 5 + mod_row(m0)) * 6144 + 2048;
  const float* src; float* dst;
  if (m0 < NX) { src = (layer == 0 ? P.in[0] : X.out); dst = X.out; }
  else { src = (layer == 0 ? P.in[2] : (const float*)(X.ws + OFF_CS)) - (size_t)NX * 1024; dst = (float*)(X.ws + OFF_CS) - (size_t)NX * 1024; }
#pragma unroll
  for (int j = 0; j < 2; ++j) {
    const int col = col0 + j * 32 + (lane & 31);
    const float mg = modv[col];
#pragma unroll
    for (int i = 0; i < 2; ++i) {
      float t[16];
#pragma unroll
      for (int r = 0; r < 16; ++r) t[r] = src[(size_t)(row0 + i * 32 + ROW_OF(r)) * 1024 + col];
#pragma unroll
      for (int r = 0; r < 16; ++r) dst[(size_t)(row0 + i * 32 + ROW_OF(r)) * 1024 + col] = t[r] + mg * acc[i][j][r];
    }
  }
}
__device__ __forceinline__ void f1_tile(const Params& P, const Cx& X, int t, int mtiles, char* smem) {
  const int lane = X.tid & 63, w = X.tid >> 6;
  const int mt = t % mtiles, nt = t / mtiles;
  const int m0 = mt * 128, n0 = nt * 256;
  f32x16 acc[2][4];
  GemmW::zero(acc);
  GemmW::run(X, (const bf16_t*)(X.ws + OFF_HBUF) + (size_t)m0 * 1024, 1024, (const bf16_t*)(X.ws + OFF_WFFN) + WF_IN + (size_t)n0 * 1024, 1024, 1024, smem, acc);
  bf16_t* act = (bf16_t*)(X.ws + OFF_ACT);
  const int row0 = m0 + (w >> 1) * 64;
#pragma unroll
  for (int jp = 0; jp < 2; ++jp) {
    const int hid = ((n0 + (w & 1) * 128 + jp * 64) >> 6) * 32 + (lane & 31);
#pragma unroll
    for (int i = 0; i < 2; ++i)
#pragma unroll
      for (int r = 0; r < 16; ++r) {
        float g = acc[i][2 * jp][r], u = acc[i][2 * jp + 1][r];
        act[(size_t)(row0 + i * 32 + ROW_OF(r)) * 2816 + hid] = f2bf(g / (1.f + __expf(-g)) * u);
      }
  }
}
__device__ __forceinline__ void f2_tile(const Params& P, const Cx& X, int layer, int t, int mtiles, char* smem) {
  const int lane = X.tid & 63, w = X.tid >> 6;
  const int mt = t % mtiles, nt = t / mtiles;
  const int m0 = mt * 128, n0 = nt * 128;
  f32x16 acc[2][2];
  G22::zero(acc);
  G22::run(X, (const bf16_t*)(X.ws + OFF_ACT) + (size_t)m0 * 2816, 2816, (const bf16_t*)(X.ws + OFF_WFFN) + WF_OUT + (size_t)n0 * 2816, 2816, 2816, smem, acc);
  const int row0 = m0 + (w >> 1) * 64, col0 = n0 + (w & 1) * 64;
  const float* modv = (const float*)(X.ws + OFF_MOD) + (size_t)(layer * 5 + mod_row(m0)) * 6144 + 5120;
  float* dst = (m0 < NX) ? X.out : (float*)(X.ws + OFF_CS) - (size_t)NX * 1024;
#pragma unroll
  for (int j = 0; j < 2; ++j) {
    const int col = col0 + j * 32 + (lane & 31);
    const float mg = modv[col];
#pragma unroll
    for (int i = 0; i < 2; ++i) {
      float t[16];
#pragma unroll
      for (int r = 0; r < 16; ++r) t[r] = dst[(size_t)(row0 + i * 32 + ROW_OF(r)) * 1024 + col];
#pragma unroll
      for (int r = 0; r < 16; ++r) dst[(size_t)(row0 + i * 32 + ROW_OF(r)) * 1024 + col] = t[r] + mg * acc[i][j][r];
    }
  }
}

__device__ __forceinline__ void run_p(const Params& P, const Cx& X, int layer, int p, char* smem) {
  const int G = gridDim.x, B = blockIdx.x;
  if (p < 0) {
    if (!PON(14)) return;
    for (int j = B; j < 192 + 55 + NCW1; j += G) {
      if (j < 192) job_mod(P, fresh(X), smem, j);
      else if (j < 247) job_tables(P, fresh(X), j - 192);
      else cw_mixer_job(P, fresh(X), 0, j - 247, smem);
    }
    return;
  }
  const int mtiles = layer == 0 ? 136 : 128;
  switch (p) {
    case 0: if (!PON(0)) break;
      if (layer == 0) { for (int j = B; j < 4352; j += G) norm_job(P, fresh(X), layer, 0, j); }
      else { for (int j = B; j < NCW1 + 4352; j += G) { if (j < NCW1) cw_mixer_job(P, fresh(X), layer, j, smem); else norm_job(P, fresh(X), layer, 0, j - NCW1); } }
      break;
    case 1: if (!PON(1)) break; for (int j = B; j < 136 * 15; j += G) g1a_tile(P, fresh(X), j, smem); break;
    case 2: if (!PON(2)) break; for (int j = B; j < NTOK / 8; j += G) r1a_job(P, fresh(X), layer, j); break;
    case 3: if (!PON(3)) break; for (int j = B; j < 136 * 20; j += G) r1b_tile(P, fresh(X), layer, j, smem); break;
    case 4: if (!PON(4)) break; {
      volatile int* sflag = (volatile int*)(smem + LDS_BYTES - 32);
      if (sflag[0]) {
        unsigned* ctr = (unsigned*)(X.ws + OFF_TICK) + 2048 + layer * 64 + sflag[2] * 8;
        for (;;) {
          __syncthreads();
          if (X.tid == 0) sflag[1] = (int)atomicAdd(ctr, 1u);
          __syncthreads();
          const int j = sflag[1];
          if (j >= 256) break;
          scan_job(P, fresh(X), layer, j, smem);
        }
      }
    } break;
    case 5: if (!PON(5)) break; for (int j = B; j < 4352; j += G) s2_job(P, fresh(X), layer, j); break;
    case 6: if (!PON(6)) break; for (int j = B; j < 136 * 9; j += G) g1b_tile(P, fresh(X), j, smem); break;
    case 7: if (!PON(7)) break;
      for (int j = B; j < 2176 + 1024; j += G) {
        if (j < 1088) q1_kv_tile(P, fresh(X), layer, j, smem);
        else if (j < 2176) { if (layer == 0 || (j - 1088) % 136 < 128) q1_q_tile(P, fresh(X), layer, j - 1088, smem); }
        else fft1_tile(P, fresh(X), j - 2176, smem);
      }
      break;
    case 8: if (!PON(8)) break; {
      const int nctx = layer == 0 ? 64 : 0;
      for (int j = B; j < 1024 + 1024 + 2 * nctx; j += G) {
        const bool isc = (j >= 2048 && j < 2048 + nctx);
        if (j < 1024 || isc) attn_item(P, fresh(X), isc ? j - 2048 : j, isc, smem);
        else if (j < 2048) fft2_tile(P, fresh(X), j - 1024, smem);
        else ctxdft_tile(P, fresh(X), j - 2048 - nctx, smem);
      }
    } break;
    case 9: if (!PON(9)) break; for (int j = B; j < mtiles * 8; j += G) mg_tile(P, fresh(X), j, mtiles, smem); break;
    case 10: if (!PON(10)) break;
      for (int j = B; j < mtiles * 8 + NCW2; j += G) { if (j < mtiles * 8) wo_tile(P, fresh(X), layer, j, mtiles, smem); else cw_ffn_job(P, fresh(X), layer, j - mtiles * 8, smem); }
      break;
    case 11: if (!PON(11)) break; for (int j = B; j < mtiles * 32; j += G) norm_job(P, fresh(X), layer, 1, j); break;
    case 12: if (!PON(12)) break; for (int j = B; j < mtiles * 22; j += G) f1_tile(P, fresh(X), j, mtiles, smem); break;
    case 13: if (!PON(13)) break; for (int j = B; j < mtiles * 8; j += G) f2_tile(P, fresh(X), layer, j, mtiles, smem); break;
  }
}

#if SINGLE
__global__ void __launch_bounds__(256, 2) fwd_kernel(Params P, int ph_lo, int ph_hi, int use_sync) {
  extern __shared__ __attribute__((aligned(16))) char smem[];
  volatile LAS unsigned* xst = (volatile LAS unsigned*)(smem + LDS_BYTES - 16);
  if (threadIdx.x == 0) { xst[0] = 0u; xst[1] = 0u; }
  __syncthreads();
  XcdBarrier xb = xcd_barrier_post((unsigned*)(P.ws + OFF_BAR), xst);
  if (threadIdx.x == 0) {
    const unsigned hwid = (unsigned)__builtin_amdgcn_s_getreg((31 << 11) | 4);
    const unsigned slot = ((xb_xcc_id() * 8u + ((hwid >> 13) & 7u)) * 2u + ((hwid >> 12) & 1u)) * 16u + ((hwid >> 8) & 15u);
    const unsigned t = atomicAdd((unsigned*)(P.ws + OFF_TICK) + slot, 1u);
    *(volatile int*)(smem + LDS_BYTES - 32) = (t == 0u) ? 1 : 0;
    *(volatile int*)(smem + LDS_BYTES - 24) = 0;
  }
  __syncthreads();
#pragma unroll 1
  for (int ph = ph_lo; ph < ph_hi; ++ph) {
    char* ws = P.ws; float* out = P.out; int tid = threadIdx.x;
    asm volatile("" : "+v"(tid));
    const Cx X{ws, out, tid};
    if (ph == 0) run_p(P, X, 0, -1, smem);
    else {
      run_p(P, X, (ph - 1) / 14, (ph - 1) % 14, smem);
      if (PROBE_P >= 0 && (ph - 1) % 14 == PROBE_P) {
#pragma unroll 1
        for (int rep = 0; rep < PROBE_N; ++rep) { xcd_barrier(xb); if (threadIdx.x == 0) *(volatile int*)(smem + LDS_BYTES - 24) = rep + 1; __syncthreads(); run_p(P, X, (ph - 1) / 14, PROBE_P, smem); }
        if (threadIdx.x == 0) *(volatile int*)(smem + LDS_BYTES - 24) = 0;
        __syncthreads();
      }
    }
    if (use_sync && ph + 1 < ph_hi) { if (use_sync == 2) cg::this_grid().sync(); else xcd_barrier(xb); }
  }
}

#else
template <int PP>
__global__ void __launch_bounds__(256) phase_kernel(Params P, int layer) {
  extern __shared__ __attribute__((aligned(16))) char smem[];
  const Cx X{P.ws, P.out, (int)threadIdx.x};
  run_p(P, X, layer, PP, smem);
}
#endif

extern "C" void kernel_launch(void* const* d_in, const int* in_sizes, int n_in, void* d_out, int out_size, void* d_ws,
                              size_t ws_size, hipStream_t stream) {
  static int grid = 0;
  if (grid == 0) {
    if (n_in != 33 || ws_size < OFF_END) { fprintf(stderr, "kernel_launch: unexpected n_in %d / ws_size %zu (need %zu)\n", n_in, ws_size, (size_t)OFF_END); grid = -1; return; }
    int dev = 0, cus = 0, per_cu = 0;
    hipGetDevice(&dev);
    hipDeviceGetAttribute(&cus, hipDeviceAttributeMultiprocessorCount, dev);
#if SINGLE
    hipFuncSetAttribute((const void*)fwd_kernel, hipFuncAttributeMaxDynamicSharedMemorySize, LDS_BYTES);
    hipOccupancyMaxActiveBlocksPerMultiprocessor(&per_cu, (const void*)fwd_kernel, 256, LDS_BYTES);
#else
#define SA(pp) hipFuncSetAttribute((const void*)phase_kernel<pp>, hipFuncAttributeMaxDynamicSharedMemorySize, LDS_BYTES)
    SA(-1); SA(0); SA(1); SA(2); SA(3); SA(4); SA(5); SA(6); SA(7); SA(8); SA(9); SA(10); SA(11); SA(12); SA(13);
    per_cu = 2;
#endif
    if (per_cu < 1) { fprintf(stderr, "kernel_launch: occupancy query returned %d\n", per_cu); grid = -1; return; }
    if (per_cu > 2) per_cu = 2;
    grid = cus * per_cu;
  }
  if (grid < 0) return;
  if (hipMemsetAsync((char*)d_ws + OFF_BAR, 0, 32768, stream) != hipSuccess) { fprintf(stderr, "kernel_launch: memset failed\n"); return; }
  Params P{};
  for (int i = 0; i < 33; ++i) P.in[i] = (const float*)d_in[i];
  P.out = (float*)d_out;
  P.ws = (char*)d_ws;
#if SINGLE
  int lo = 0, hi = NPH, us = 1;
  void* args[] = {&P, &lo, &hi, &us};
  hipError_t e = hipLaunchCooperativeKernel((const void*)fwd_kernel, dim3(grid), dim3(256), args, LDS_BYTES, stream);
  if (e != hipSuccess) fprintf(stderr, "cooperative launch failed: %s (grid %d)\n", hipGetErrorString(e), grid);
#else
#define LP(pp, ly) hipLaunchKernelGGL(phase_kernel<pp>, dim3(grid), dim3(256), LDS_BYTES, stream, P, ly)
  LP(-1, 0);
  for (int ly = 0; ly < 2; ++ly) {
    LP(0, ly); LP(1, ly); LP(2, ly); LP(3, ly); LP(4, ly); LP(5, ly); LP(6, ly); LP(7, ly); LP(8, ly); LP(9, ly); LP(10, ly); LP(11, ly); LP(12, ly); LP(13, ly);
  }
#endif
}
```

```cpp
#include <hip/hip_runtime.h>
#include <hip/hip_cooperative_groups.h>
#include <stdint.h>
#include <stdio.h>
namespace cg = cooperative_groups;

#ifndef SINGLE
#define SINGLE 1
#endif

#ifndef ONLYP
#define ONLYP -1
#endif
#define PON(x) (ONLYP < 0 || ONLYP == (x))

typedef unsigned short bf16_t;
typedef __attribute__((ext_vector_type(8))) short bf16x8;
typedef __attribute__((ext_vector_type(16))) float f32x16;
typedef __attribute__((ext_vector_type(4))) unsigned int u32x4;

#define NX 16384
#define NCX 1024
#define NTOK 17408
#define NPH 29
#ifndef PROBE_P
#define PROBE_P -1
#endif
#define PROBE_N 2
#define LDS_BYTES 77824

static constexpr size_t UU = 17825792ull;
static constexpr size_t OFF_HBUF = 0;
static constexpr size_t OFF_RKV = 2 * UU;
static constexpr size_t OFF_KK = 5 * UU;
static constexpr size_t OFF_ZR = 6 * UU;
static constexpr size_t OFF_LORA = 12 * UU + UU / 4;
static constexpr size_t OFF_LD = 6 * UU;
static constexpr size_t OFF_A = 8 * UU;
static constexpr size_t OFF_G = 10 * UU;
static constexpr size_t OFF_YF = 11 * UU;
static constexpr size_t OFF_YB = 12 * UU;
static constexpr size_t OFF_RWO = 5 * UU;
static constexpr size_t OFF_ZF = 2 * UU;
static constexpr size_t OFF_ZM = 3 * UU;
static constexpr size_t OFF_Q = 6 * UU;
static constexpr size_t OFF_K = 7 * UU + UU / 2;
static constexpr size_t OFF_VT = 9 * UU;
static constexpr size_t OFF_FFT1 = 10 * UU;
static constexpr size_t OFF_ATT = 12 * UU;
static constexpr size_t OFF_Y = 3 * UU;
static constexpr size_t OFF_M = 6 * UU;
static constexpr size_t OFF_ACT = 2 * UU;
static constexpr size_t OFF_WFFN = 9 * UU;
static constexpr size_t OFF_WMIX = 13 * UU;
static constexpr size_t WE_IN = 0;
static constexpr size_t WE_W2 = WE_IN + 6048ull * 1024;
static constexpr size_t WE_A2 = WE_W2 + 65536;
static constexpr size_t WE_G2 = WE_A2 + 65536;
static constexpr size_t WE_RO = WE_G2 + 65536;
static constexpr size_t WE_MO = WE_RO + 524288;
static constexpr size_t WE_FO = WE_MO + 524288;
static constexpr size_t WE_UQ = WE_FO + 1048576;
static constexpr size_t WE_UKV = WE_UQ + 294912;
static constexpr size_t WE_OUT = WE_UKV + 131072;
static constexpr size_t WE_END = WE_OUT + 1048576;
static constexpr size_t WF_IN = 0;
static constexpr size_t WF_OUT = 5632ull * 1024;
static constexpr size_t OFF_SMALL = OFF_WMIX + WE_END * 2;
static constexpr size_t OFF_CS = OFF_SMALL;
static constexpr size_t OFF_MOD = OFF_CS + 4194304;
static constexpr size_t OFF_TW = OFF_MOD + 245760;
static constexpr size_t OFF_F1 = OFF_TW + 32768;
static constexpr size_t OFF_F2 = OFF_F1 + 16384;
static constexpr size_t OFF_F256 = OFF_F2 + 32768;
static constexpr size_t OFF_ROPE = OFF_F256 + 262144;
static constexpr size_t OFF_BAR = OFF_ROPE + 524288;
static constexpr size_t OFF_TICK = OFF_BAR + 16384;
static constexpr size_t OFF_END = OFF_TICK + 16384;

struct Cx {
  char* ws;
  float* out;
  int tid;
};

struct Params {
  const float* in[33];
  float* out;
  char* ws;
};

__device__ __forceinline__ float bf2f(bf16_t v) { return __uint_as_float(((uint32_t)v) << 16); }
typedef __bf16 bf16v2_t __attribute__((ext_vector_type(2)));
typedef float f32v2_t __attribute__((ext_vector_type(2)));
__device__ __forceinline__ uint32_t pack2(float a, float b) {
  f32v2_t v; v[0] = a; v[1] = b;
  return __builtin_bit_cast(uint32_t, __builtin_convertvector(v, bf16v2_t));
}
__device__ __forceinline__ bf16_t f2bf(float f) { return (bf16_t)(pack2(f, 0.f) & 0xffffu); }
__device__ __forceinline__ float lo16(uint32_t u) { return __uint_as_float(u << 16); }
__device__ __forceinline__ float hi16(uint32_t u) { return __uint_as_float(u & 0xffff0000u); }
__device__ __forceinline__ float sigmoidf_(float v) { return 1.f / (1.f + __expf(-v)); }
__device__ __forceinline__ int mod_row(int row) { return row < NX ? (row >> 12) : 4; }

__device__ __forceinline__ Cx fresh(const Cx& X) {
  int t = X.tid;
  asm volatile("" : "+v"(t));
  return Cx{X.ws, X.out, t};
}

#define XB_TMO      128
#define XB_XCNT(j)  (256  + 64 * (j))
#define XB_XSUB(j)  (1280 + 64 * (j))
#define XB_XGEN(j)  (2304 + 64 * (j))
#define XB_TOP      3328
#define XB_TOPGEN   3392
#define XCD_BAR_WORDS 3456
#define XB_SPIN_CAP (1u << 18)
#define LAS __attribute__((address_space(3)))

__device__ __forceinline__ unsigned xb_ld(unsigned* p)              { return __hip_atomic_load(p, __ATOMIC_RELAXED, __HIP_MEMORY_SCOPE_AGENT); }
__device__ __forceinline__ unsigned xb_add(unsigned* p, unsigned v) { return __hip_atomic_fetch_add(p, v, __ATOMIC_RELAXED, __HIP_MEMORY_SCOPE_AGENT); }
__device__ __forceinline__ unsigned xb_xcc_id() { return (unsigned)__builtin_amdgcn_s_getreg((3 << 11) | 20) & 0xFu; }
#define XB_SPIN(cond, bar) do { unsigned _sp = 0; while (cond) { __builtin_amdgcn_s_sleep(1); \
    if ((++_sp & 255u) == 0u) { if (xb_ld(&(bar)[XB_TMO])) break; if (_sp > XB_SPIN_CAP) { atomicAdd(&(bar)[XB_TMO], 1u); break; } } } } while (0)

struct XcdBarrier {
    unsigned* bar; unsigned x;
    volatile LAS unsigned* st;
};

__device__ __forceinline__ XcdBarrier xcd_barrier_post(unsigned* bar, volatile LAS unsigned* st) {
    XcdBarrier b; b.bar = bar; b.x = xb_xcc_id(); b.st = st;
    if (threadIdx.x == 0) (void)xb_add(&bar[XB_XCNT(b.x)], 1u);
    return b;
}
__device__ __forceinline__ void xcd_barrier_complete(unsigned* bar, unsigned x, unsigned& nloc, unsigned& nx) {
    const unsigned G = gridDim.x * gridDim.y * gridDim.z;
    unsigned sum, cnt, mine, sp = 0u;
    for (;;) {
        sum = 0u; cnt = 0u; mine = 0u;
#pragma unroll
        for (unsigned j = 0; j < 16; ++j) { const unsigned c = xb_ld(&bar[XB_XCNT(j)]); sum += c; cnt += (c > 0u) ? 1u : 0u; mine = (j == x) ? c : mine; }
        if (sum == G) break;
        __builtin_amdgcn_s_sleep(1);
        if ((++sp & 255u) == 0u) { if (xb_ld(&bar[XB_TMO])) break; if (sp > XB_SPIN_CAP) { atomicAdd(&bar[XB_TMO], 1u); break; } }
    }
    nloc = mine > 0u ? mine : 1u; nx = cnt > 0u ? cnt : 1u;
}

__device__ __forceinline__ void xcd_barrier(const XcdBarrier& b) {
    asm volatile("s_waitcnt vmcnt(0)" ::: "memory");
    __syncthreads();
    if (threadIdx.x == 0) {
        unsigned* bar = b.bar;
        __builtin_amdgcn_s_waitcnt(0);
        unsigned nloc = b.st[0], nx = b.st[1];
        if (nloc == 0u) { xcd_barrier_complete(bar, b.x, nloc, nx); b.st[0] = nloc; b.st[1] = nx; }
        const unsigned old = xb_add(&bar[XB_XSUB(b.x)], 1u);
        const unsigned gen = old / nloc;
        if (old + 1u == (gen + 1u) * nloc) {
            __builtin_amdgcn_fence(__ATOMIC_RELEASE, "agent");
            asm volatile("s_waitcnt vmcnt(0)" ::: "memory");
            const unsigned og = xb_add(&bar[XB_TOP], 1u);
            const unsigned tg = og / nx;
            if (og + 1u == (tg + 1u) * nx) xb_add(&bar[XB_TOPGEN], 1u);
            else XB_SPIN(xb_ld(&bar[XB_TOPGEN]) == tg, bar);
            __builtin_amdgcn_fence(__ATOMIC_ACQUIRE, "agent");
            xb_add(&bar[XB_XGEN(b.x)], 1u);
            asm volatile("s_waitcnt vmcnt(0)" ::: "memory");
        } else {
            XB_SPIN(xb_ld(&bar[XB_XGEN(b.x)]) == gen, bar);
            __builtin_amdgcn_fence(__ATOMIC_ACQUIRE, "agent");
            asm volatile("s_waitcnt vmcnt(0)" ::: "memory");
        }
    }
    __syncthreads();
}


template <int BM, int BN, int WGM, int WGN, bool TRB>
struct Gemm {
  static constexpr int WM = BM / WGM, WN = BN / WGN, MT = WM / 32, NTL = WN / 32;
  static constexpr int CA = BM * 8 / 256, CB = BN * 8 / 256;
  static constexpr int SA_ELEMS = BM * 72, SB_ELEMS = BN * 72;

  __device__ static __forceinline__ void zero(f32x16 (&acc)[MT][NTL]) {
#pragma unroll
    for (int i = 0; i < MT; ++i)
#pragma unroll
      for (int j = 0; j < NTL; ++j)
#pragma unroll
        for (int r = 0; r < 16; ++r) acc[i][j][r] = 0.f;
  }

  __device__ static __forceinline__ void run(const Cx& X, const bf16_t* __restrict__ A, int lda, const bf16_t* __restrict__ B, int ldb,
                                             int K, char* smem, f32x16 (&acc)[MT][NTL]) {
    const int tid = X.tid, lane = tid & 63, w = tid >> 6;
    const int wm = w / WGN, wn = w % WGN;
    bf16_t* sA = (bf16_t*)smem;
    bf16_t* sB = sA + 2 * SA_ELEMS;
    uint4 ra0, ra1, ra2, ra3, rb0, rb1, rb2 = make_uint4(0, 0, 0, 0), rb3 = make_uint4(0, 0, 0, 0);
    uint4 qa0, qa1, qa2, qa3, qb0, qb1, qb2 = make_uint4(0, 0, 0, 0), qb3 = make_uint4(0, 0, 0, 0);
    static_assert(CA == 4 && CB >= 2 && CB <= 4, "tile loader shape");
    const int nk = K >> 6;
#define LDA_(i, k0) (*(const uint4*)(A + (size_t)((tid + 256 * (i)) >> 3) * lda + (k0) + ((tid + 256 * (i)) & 7) * 8))
#define LDB_(i, k0)                                                                                                        \
  (!TRB ? *(const uint4*)(B + (size_t)((tid + 256 * (i)) >> 3) * ldb + (k0) + ((tid + 256 * (i)) & 7) * 8)                 \
        : *(const uint4*)(B + (size_t)((k0) + (tid + 256 * (i)) / (BN / 8)) * ldb + ((tid + 256 * (i)) % (BN / 8)) * 8))
#define GLOAD(R, k0)                                                                           \
  {                                                                                            \
    R##a0 = LDA_(0, k0); R##a1 = LDA_(1, k0); R##a2 = LDA_(2, k0); R##a3 = LDA_(3, k0);        \
    R##b0 = LDB_(0, k0); R##b1 = LDB_(1, k0);                                                  \
    if (CB > 2) R##b2 = LDB_(2, k0);                                                           \
    if (CB > 3) R##b3 = LDB_(3, k0);                                                           \
  }
#define STA_(i, buf, v) *(uint4*)(sA + (buf)*SA_ELEMS + ((tid + 256 * (i)) >> 3) * 72 + ((tid + 256 * (i)) & 7) * 8) = v
#define STB_(i, buf, v)                                                                                       \
  {                                                                                                           \
    const int c_ = tid + 256 * (i);                                                                           \
    if (!TRB) *(uint4*)(sB + (buf)*SB_ELEMS + (c_ >> 3) * 72 + (c_ & 7) * 8) = v;                             \
    else {                                                                                                    \
      bf16_t* p = sB + (buf)*SB_ELEMS + (c_ % (BN / 8)) * 8 * 72 + c_ / (BN / 8);                             \
      p[0] = (bf16_t)(v.x & 0xffff); p[72] = (bf16_t)(v.x >> 16);                                             \
      p[144] = (bf16_t)(v.y & 0xffff); p[216] = (bf16_t)(v.y >> 16);                                          \
      p[288] = (bf16_t)(v.z & 0xffff); p[360] = (bf16_t)(v.z >> 16);                                          \
      p[432] = (bf16_t)(v.w & 0xffff); p[504] = (bf16_t)(v.w >> 16);                                          \
    }                                                                                                         \
  }
#define SSTORE(R, buf)                                                                         \
  {                                                                                            \
    STA_(0, buf, R##a0); STA_(1, buf, R##a1); STA_(2, buf, R##a2); STA_(3, buf, R##a3);        \
    STB_(0, buf, R##b0); STB_(1, buf, R##b1);                                                  \
    if (CB > 2) STB_(2, buf, R##b2);                                                           \
    if (CB > 3) STB_(3, buf, R##b3);                                                           \
  }
#define COMPUTE(buf)                                                                                               \
  {                                                                                                                \
    const bf16_t* pa = sA + (buf)*SA_ELEMS + (wm * WM + (lane & 31)) * 72 + (lane >> 5) * 8;                       \
    const bf16_t* pb = sB + (buf)*SB_ELEMS + (wn * WN + (lane & 31)) * 72 + (lane >> 5) * 8;                       \
    _Pragma("unroll") for (int ks = 0; ks < 4; ++ks) {                                                             \
      bf16x8 af[MT], bfr[NTL];                                                                                     \
      _Pragma("unroll") for (int i = 0; i < MT; ++i) af[i] = *(const bf16x8*)(pa + i * 32 * 72 + ks * 16);         \
      _Pragma("unroll") for (int j = 0; j < NTL; ++j) bfr[j] = *(const bf16x8*)(pb + j * 32 * 72 + ks * 16);       \
      _Pragma("unroll") for (int i = 0; i < MT; ++i)                                                               \
        _Pragma("unroll") for (int j = 0; j < NTL; ++j)                                                            \
          acc[i][j] = __builtin_amdgcn_mfma_f32_32x32x16_bf16(af[i], bfr[j], acc[i][j], 0, 0, 0);                  \
    }                                                                                                              \
  }
    if (!TRB) {
      bf16_t* dA = sA;
      bf16_t* dB = sA + 2 * BM * 64;
#define DSTAGE(buf, k0)                                                                                              \
  {                                                                                                                  \
    _Pragma("unroll") for (int i = 0; i < CA; ++i) {                                                                 \
      const int p = tid + 256 * i, r = p >> 3, c = (p & 7) ^ ((r >> 1) & 7);                                         \
      __builtin_amdgcn_global_load_lds((const unsigned*)(A + (size_t)r * lda + (k0) + c * 8),                        \
                                       (LAS unsigned*)(dA + (buf)*BM * 64 + p * 8), 16, 0, 0);                       \
    }                                                                                                                \
    _Pragma("unroll") for (int i = 0; i < CB; ++i) {                                                                 \
      const int p = tid + 256 * i, r = p >> 3, c = (p & 7) ^ ((r >> 1) & 7);                                         \
      __builtin_amdgcn_global_load_lds((const unsigned*)(B + (size_t)r * ldb + (k0) + c * 8),                        \
                                       (LAS unsigned*)(dB + (buf)*BN * 64 + p * 8), 16, 0, 0);                       \
    }                                                                                                                \
  }
      const int swz = (lane >> 1) & 7, hh = lane >> 5;
      DSTAGE(0, 0);
      asm volatile("s_waitcnt vmcnt(0)" ::: "memory");
      __syncthreads();
#pragma unroll 1
      for (int kt = 0; kt < nk; ++kt) {
        const int buf = kt & 1;
        if (kt + 1 < nk) DSTAGE(buf ^ 1, (kt + 1) * 64);
        const bf16_t* pa = dA + buf * BM * 64 + (wm * WM + (lane & 31)) * 64;
        const bf16_t* pb = dB + buf * BN * 64 + (wn * WN + (lane & 31)) * 64;
#pragma unroll
        for (int ks = 0; ks < 4; ++ks) {
          const int co = (((ks * 2 + hh) ^ swz) * 8);
          bf16x8 af[MT], bfr[NTL];
#pragma unroll
          for (int i = 0; i < MT; ++i) af[i] = *(const bf16x8*)(pa + i * 32 * 64 + co);
#pragma unroll
          for (int j = 0; j < NTL; ++j) bfr[j] = *(const bf16x8*)(pb + j * 32 * 64 + co);
#pragma unroll
          for (int i = 0; i < MT; ++i)
#pragma unroll
            for (int j = 0; j < NTL; ++j) acc[i][j] = __builtin_amdgcn_mfma_f32_32x32x16_bf16(af[i], bfr[j], acc[i][j], 0, 0, 0);
        }
        asm volatile("s_waitcnt vmcnt(0)" ::: "memory");
        __syncthreads();
      }
#undef DSTAGE
    } else {
    GLOAD(r, 0);
    if (nk > 1) GLOAD(q, 64);
    SSTORE(r, 0);
    __syncthreads();
    for (int kt = 0; kt < nk; kt += 2) {
      if (kt + 2 < nk) GLOAD(r, (kt + 2) * 64);
      COMPUTE(0);
      if (kt + 1 < nk) SSTORE(q, 1);
      __syncthreads();
      if (kt + 1 >= nk) break;
      if (kt + 3 < nk) GLOAD(q, (kt + 3) * 64);
      COMPUTE(1);
      if (kt + 2 < nk) SSTORE(r, 0);
      __syncthreads();
    }
    }
#undef COMPUTE
#undef GLOAD
#undef SSTORE
#undef LDA_
#undef LDB_
#undef STA_
#undef STB_
  }
};

typedef Gemm<128, 128, 2, 2, false> G22;
typedef Gemm<128, 128, 2, 2, true> G22T;
typedef Gemm<128, 64, 2, 2, false> GMG;
typedef Gemm<128, 96, 4, 1, false> GQ;
typedef Gemm<128, 128, 4, 1, false> GKV;

struct GemmW {
  static constexpr int MT = 2, NTL = 4;
  __device__ static __forceinline__ void zero(f32x16 (&acc)[MT][NTL]) {
#pragma unroll
    for (int i = 0; i < MT; ++i)
#pragma unroll
      for (int j = 0; j < NTL; ++j)
#pragma unroll
        for (int r = 0; r < 16; ++r) acc[i][j][r] = 0.f;
  }
  __device__ static __forceinline__ void run(const Cx& X, const bf16_t* __restrict__ A, int lda, const bf16_t* __restrict__ B, int ldb,
                                             int K, char* smem, f32x16 (&acc)[MT][NTL]) {
    const int tid = X.tid, lane = tid & 63, w = tid >> 6;
    const int wm = w >> 1, wn = w & 1;
    bf16_t* dA = (bf16_t*)smem;
    bf16_t* dB = dA + 3 * 128 * 32;
    const int nk = K >> 5;
#define WSTAGE(buf, k0)                                                                                              \
  {                                                                                                                  \
    _Pragma("unroll") for (int i = 0; i < 2; ++i) {                                                                  \
      const int p = tid + 256 * i, r = p >> 2, c = (p & 3) ^ ((r >> 2) & 3);                                         \
      __builtin_amdgcn_global_load_lds((const unsigned*)(A + (size_t)r * lda + (k0) + c * 8),                        \
                                       (LAS unsigned*)(dA + (buf)*128 * 32 + p * 8), 16, 0, 0);                      \
    }                                                                                                                \
    _Pragma("unroll") for (int i = 0; i < 4; ++i) {                                                                  \
      const int p = tid + 256 * i, r = p >> 2, c = (p & 3) ^ ((r >> 2) & 3);                                         \
      __builtin_amdgcn_global_load_lds((const unsigned*)(B + (size_t)r * ldb + (k0) + c * 8),                        \
                                       (LAS unsigned*)(dB + (buf)*256 * 32 + p * 8), 16, 0, 0);                      \
    }                                                                                                                \
  }
    const int swz = ((lane & 31) >> 2) & 3, hh = lane >> 5;
    WSTAGE(0, 0);
    if (nk > 1) WSTAGE(1, 32);
    int buf = 0;
#pragma unroll 1
    for (int kt = 0; kt < nk; ++kt) {
      if (kt + 1 < nk) asm volatile("s_waitcnt vmcnt(6)" ::: "memory");
      else asm volatile("s_waitcnt vmcnt(0)" ::: "memory");
      __builtin_amdgcn_s_barrier();
      if (kt + 2 < nk) { const int nb = buf >= 1 ? buf - 1 : 2; WSTAGE(nb, (kt + 2) * 32); }
      const bf16_t* pa = dA + buf * 128 * 32 + (wm * 64 + (lane & 31)) * 32;
      const bf16_t* pb = dB + buf * 256 * 32 + (wn * 128 + (lane & 31)) * 32;
#pragma unroll
      for (int ks = 0; ks < 2; ++ks) {
        const int co = (((ks * 2 + hh) ^ swz) * 8);
        bf16x8 af[MT], bfr[NTL];
#pragma unroll
        for (int i = 0; i < MT; ++i) af[i] = *(const bf16x8*)(pa + i * 32 * 32 + co);
#pragma unroll
        for (int j = 0; j < NTL; ++j) bfr[j] = *(const bf16x8*)(pb + j * 32 * 32 + co);
#pragma unroll
        for (int i = 0; i < MT; ++i)
#pragma unroll
          for (int j = 0; j < NTL; ++j) acc[i][j] = __builtin_amdgcn_mfma_f32_32x32x16_bf16(af[i], bfr[j], acc[i][j], 0, 0, 0);
      }
      buf = buf == 2 ? 0 : buf + 1;
    }
    __syncthreads();
#undef WSTAGE
  }
};

#define ROW_OF(reg) (((reg) & 3) + 8 * ((reg) >> 2) + 4 * (lane >> 5))

__device__ __forceinline__ void job_mod(const Params& P, const Cx& X, char* smem, int job) {
  float* sc = (float*)smem;
  const int tid = X.tid;
  for (int i = tid; i < 5 * 1024; i += 256) {
    int r = i >> 10, k = i & 1023;
    float v = r < 4 ? P.in[1][r * 1024 + k] : P.in[3][k];
    sc[i] = v / (1.f + expf(-v));
  }
  __syncthreads();
  const int l = job / 96, n = (job % 96) * 64 + (tid & 63), w = tid >> 6;
  const float* W = P.in[4] + (size_t)l * 1024 * 6144;
  float a0 = 0, a1 = 0, a2 = 0, a3 = 0, a4 = 0;
#pragma unroll 16
  for (int k = w * 256; k < w * 256 + 256; ++k) {
    float wv = W[(size_t)k * 6144 + n];
    a0 += sc[k] * wv; a1 += sc[1024 + k] * wv; a2 += sc[2048 + k] * wv; a3 += sc[3072 + k] * wv; a4 += sc[4096 + k] * wv;
  }
  float* red = sc + 5 * 1024;
  red[(w * 5 + 0) * 64 + (tid & 63)] = a0; red[(w * 5 + 1) * 64 + (tid & 63)] = a1; red[(w * 5 + 2) * 64 + (tid & 63)] = a2;
  red[(w * 5 + 3) * 64 + (tid & 63)] = a3; red[(w * 5 + 4) * 64 + (tid & 63)] = a4;
  __syncthreads();
  float* modv = (float*)(X.ws + OFF_MOD);
  for (int i = tid; i < 320; i += 256) {
    int r = i >> 6, c = i & 63;
    int nn = (job % 96) * 64 + c;
    float s = red[(0 * 5 + r) * 64 + c] + red[(1 * 5 + r) * 64 + c] + red[(2 * 5 + r) * 64 + c] + red[(3 * 5 + r) * 64 + c];
    modv[(size_t)(l * 5 + r) * 6144 + nn] = s + P.in[5][l * 6144 + nn];
  }
  __syncthreads();
}

__device__ __forceinline__ void job_tables(const Params& P, const Cx& X, int job) {
  float2* tw = (float2*)(X.ws + OFF_TW);
  bf16_t* F1 = (bf16_t*)(X.ws + OFF_F1);
  bf16_t* F2 = (bf16_t*)(X.ws + OFF_F2);
  bf16_t* F256 = (bf16_t*)(X.ws + OFF_F256);
  float2* rope = (float2*)(X.ws + OFF_ROPE);
  for (int e = job * 4096 + X.tid; e < job * 4096 + 4096; e += 256) {
    int i = e;
    if (i < 4096) { tw[i] = make_float2(cospif(i / 2048.f), sinpif(i / 2048.f)); continue; }
    i -= 4096;
    if (i < 8192) {
      int R = i >> 6, t1 = i & 63;
      int f1 = (R >> 6) * 32 + (R & 31);
      int ph = (f1 * t1) & 63;
      F1[i] = f2bf(((R >> 5) & 1) ? -sinpif(ph / 32.f) : cospif(ph / 32.f));
      continue;
    }
    i -= 8192;
    if (i < 16384) {
      int m = i >> 7, k = i & 127;
      int f2 = m & 63, q = m >> 6, t2 = k & 63, p = k >> 6;
      int ph = (f2 * t2) & 63;
      float c = cospif(ph / 32.f), s = sinpif(ph / 32.f);
      float v = (q == 0) ? (p == 0 ? c : s) : (p == 0 ? -s : c);
      F2[i] = f2bf(v);
      continue;
    }
    i -= 16384;
    if (i < 131072) {
      int m = i >> 8, t = i & 255;
      int f = m & 255, q = m >> 8;
      int ph = (f * t) & 255;
      F256[i] = f2bf(q == 0 ? cospif(ph / 128.f) : -sinpif(ph / 128.f));
      continue;
    }
    i -= 131072;
    if (i < 65536) {
      int t = i >> 4, j = i & 15;
      float invf = powf(10000.f, -(float)(j & 7) / 8.f);
      float pos = (j < 8) ? (float)(t >> 6) : (float)(t & 63);
      float ang = pos * invf;
      rope[i] = make_float2(cosf(ang), sinf(ang));
    }
  }
}

__device__ __forceinline__ void cw_tile(const Cx& X, const float* __restrict__ src, int N, int lds_, bf16_t* __restrict__ dst, int ldd, const float* scale,
                        int perm, int tk, int tn, char* smem) {
  float* tile = (float*)smem;
  const int tid = X.tid;
  const int c = tid & 63, r0 = tid >> 6;
  const int ng = tn * 64 + c;
  float tv[16];
#pragma unroll
  for (int i = 0; i < 16; ++i) {
    int r = r0 + 4 * i;
    tv[i] = (ng < N) ? src[(size_t)(tk * 64 + r) * lds_ + ng] : 0.f;
    if (scale) tv[i] *= scale[tk * 64 + r];
  }
#pragma unroll
  for (int i = 0; i < 16; ++i) tile[(r0 + 4 * i) * 65 + c] = tv[i];
  __syncthreads();
#pragma unroll 4
  for (int i = 0; i < 16; ++i) {
    int nn = r0 + 4 * i;
    int n2 = tn * 64 + nn;
    if (n2 < N) {
      int drow = n2;
      if (perm) {
        int u = n2 < 2816 ? n2 : n2 - 2816;
        drow = (u >> 5) * 64 + (n2 < 2816 ? 0 : 32) + (u & 31);
      }
      dst[(size_t)drow * ldd + tk * 64 + c] = f2bf(tile[c * 65 + nn]);
    }
  }
  __syncthreads();
}

__device__ __forceinline__ void fold_job(const Params& P, const Cx& X, int layer, int fj, char* smem) {
  float* wt = (float*)smem;
  float* ct = wt + 4096;
  const int tid = X.tid;
  const int g = fj >> 4, n0 = (fj & 15) * 64;
  const float* src = P.in[28] + (size_t)layer * 512 * 1024;
  {
    float tw16[16];
#pragma unroll
    for (int k = 0; k < 16; ++k) { const int i = tid + 256 * k; tw16[k] = src[(size_t)(g * 64 + (i >> 6)) * 1024 + n0 + (i & 63)]; }
#pragma unroll
    for (int k = 0; k < 16; ++k) wt[tid + 256 * k] = tw16[k];
  }
  if (tid < 64) { ct[tid] = cospif(tid / 32.f); ct[64 + tid] = sinpif(tid / 32.f); }
  __syncthreads();
  bf16_t* dst = (bf16_t*)(X.ws + OFF_WMIX) + WE_FO;
  const int c = tid & 63, nq = tid >> 6;
#pragma unroll 1
  for (int ni = 0; ni < 16; ++ni) {
    int n = nq * 16 + ni;
    float sr = 0.f, si = 0.f;
#pragma unroll 4
    for (int cp = 0; cp < 64; ++cp) {
      float wv = wt[cp * 64 + n];
      int ph = (c * cp) & 63;
      sr += ct[ph] * wv;
      si += ct[64 + ph] * wv;
    }
    dst[(size_t)(n0 + n) * 1024 + g * 64 + c] = f2bf(sr * (1.f / 512.f));
    dst[(size_t)(n0 + n) * 1024 + 512 + g * 64 + c] = f2bf(si * (1.f / 512.f));
  }
  __syncthreads();
}

#define NCW1 2312
__device__ __forceinline__ void cw_mixer_job(const Params& P, const Cx& X, int layer, int j, char* smem) {
  bf16_t* W = (bf16_t*)(X.ws + OFF_WMIX);
  const float* src; const float* scale = nullptr; bf16_t* dst; int N, ldd, tk, tn;
  if (j >= 2184) { fold_job(P, X, layer, j - 2184, smem); return; }
  if (j < 1520) { src = P.in[7] + (size_t)layer * 1024 * 6048; N = 6048; dst = W + WE_IN; ldd = 1024; tk = j / 95; tn = j % 95; }
  else if (j < 1536) { j -= 1520; int d = j >> 3; src = P.in[11] + (size_t)(layer * 2 + d) * 64 * 512; N = 512; dst = W + WE_W2 + d * 32768; ldd = 64; tk = 0; tn = j & 7; }
  else if (j < 1552) { j -= 1536; int d = j >> 3; src = P.in[13] + (size_t)(layer * 2 + d) * 64 * 512; N = 512; dst = W + WE_A2 + d * 32768; ldd = 64; tk = 0; tn = j & 7; }
  else if (j < 1568) { j -= 1552; src = P.in[17] + (size_t)layer * 128 * 512; N = 512; dst = W + WE_G2; ldd = 128; tk = j >> 3; tn = j & 7; }
  else if (j < 1696) { j -= 1568; src = P.in[20] + (size_t)layer * 512 * 1024; N = 1024; dst = W + WE_RO; ldd = 512; tk = j >> 4; tn = j & 15; }
  else if (j < 1824) { j -= 1696; src = P.in[27] + (size_t)layer * 512 * 1024; N = 1024; dst = W + WE_MO; ldd = 512; tk = j >> 4; tn = j & 15; }
  else if (j < 1896) { j -= 1824; src = P.in[23] + (size_t)layer * 384 * 768; N = 768; dst = W + WE_UQ; ldd = 384; scale = P.in[21] + layer * 384; tk = j / 12; tn = j % 12; }
  else if (j < 1928) { j -= 1896; src = P.in[24] + (size_t)layer * 128 * 1024; N = 1024; dst = W + WE_UKV; ldd = 128; scale = P.in[22] + layer * 128; tk = j >> 4; tn = j & 15; }
  else { j -= 1928; src = P.in[29] + (size_t)layer * 1024 * 1024; N = 1024; dst = W + WE_OUT; ldd = 1024; tk = j >> 4; tn = j & 15; }
  cw_tile(X, src, N, N, dst, ldd, scale, 0, tk, tn, smem);
}
#define NCW2 2112
__device__ __forceinline__ void cw_ffn_job(const Params& P, const Cx& X, int layer, int j, char* smem) {
  bf16_t* W = (bf16_t*)(X.ws + OFF_WFFN);
  const float* src; bf16_t* dst; int N, ldd, tk, tn, perm;
  if (j < 1408) { src = P.in[31] + (size_t)layer * 1024 * 5632; N = 5632; dst = W + WF_IN; ldd = 1024; perm = 1; tk = j / 88; tn = j % 88; }
  else { j -= 1408; src = P.in[32] + (size_t)layer * 2816 * 1024; N = 1024; dst = W + WF_OUT; ldd = 2816; perm = 0; tk = j >> 4; tn = j & 15; }
  cw_tile(X, src, N, N, dst, ldd, nullptr, perm, tk, tn, smem);
}

__device__ __forceinline__ void norm_job(const Params& P, const Cx& X, int layer, int which, int job) {
  const int lane = X.tid & 63, w = X.tid >> 6;
  const int rowa = job * 8 + w * 2;
  const float* g = (which == 0 ? P.in[6] : P.in[30]) + layer * 1024;
  float4 v[2][4];
#pragma unroll
  for (int q = 0; q < 2; ++q) {
    const int row = rowa + q;
    const float* src;
    if (which == 0) {
      if (row < NX) src = (layer == 0 ? P.in[0] : X.out) + (size_t)row * 1024;
      else src = (layer == 0 ? P.in[2] : (const float*)(X.ws + OFF_CS)) + (size_t)(row - NX) * 1024;
    } else {
      if (row < NX) src = X.out + (size_t)row * 1024;
      else src = (const float*)(X.ws + OFF_CS) + (size_t)(row - NX) * 1024;
    }
#pragma unroll
    for (int i = 0; i < 4; ++i) v[q][i] = ((const float4*)src)[lane + 64 * i];
  }
#pragma unroll
  for (int q = 0; q < 2; ++q) {
    const int row = rowa + q;
    const float* modv = (const float*)(X.ws + OFF_MOD) + (size_t)(layer * 5 + mod_row(row)) * 6144;
    const float* shift = modv + (which == 0 ? 0 : 3072);
    const float* scale = modv + (which == 0 ? 1024 : 4096);
    float ss = 0.f;
#pragma unroll
    for (int i = 0; i < 4; ++i) ss += v[q][i].x * v[q][i].x + v[q][i].y * v[q][i].y + v[q][i].z * v[q][i].z + v[q][i].w * v[q][i].w;
#pragma unroll
    for (int o = 32; o >= 1; o >>= 1) ss += __shfl_xor(ss, o);
    const float rstd = rsqrtf(ss * (1.f / 1024.f) + 1e-6f);
    bf16_t* dst = (bf16_t*)(X.ws + OFF_HBUF) + (size_t)row * 1024;
#pragma unroll
    for (int i = 0; i < 4; ++i) {
      int col = 4 * (lane + 64 * i);
      float4 gg = *(const float4*)(g + col), sh = *(const float4*)(shift + col), sc = *(const float4*)(scale + col);
      float y0 = v[q][i].x * rstd * gg.x * (1.f + sc.x) + sh.x;
      float y1 = v[q][i].y * rstd * gg.y * (1.f + sc.y) + sh.y;
      float y2 = v[q][i].z * rstd * gg.z * (1.f + sc.z) + sh.z;
      float y3 = v[q][i].w * rstd * gg.w * (1.f + sc.w) + sh.w;
      uint2 o;
      o.x = pack2(y0, y1); o.y = pack2(y2, y3);
      *(uint2*)(dst + col) = o;
    }
  }
}

__device__ __forceinline__ void g1a_tile(const Params& P, const Cx& X, int t, char* smem) {
  const int lane = X.tid & 63, w = X.tid >> 6;
  const int mt = t % 136, nt = t / 136;
  const int m0 = mt * 128, n0 = nt * 128;
  f32x16 acc[2][2];
  G22::zero(acc);
  G22::run(X, (const bf16_t*)(X.ws + OFF_HBUF) + (size_t)m0 * 1024, 1024, (const bf16_t*)(X.ws + OFF_WMIX) + WE_IN + (size_t)n0 * 1024, 1024, 1024, smem, acc);
  bf16_t* zr = (bf16_t*)(X.ws + OFF_ZR);
  const int row0 = m0 + (w >> 1) * 64, col0 = n0 + (w & 1) * 64;
#pragma unroll
  for (int i = 0; i < 2; ++i)
#pragma unroll
    for (int j = 0; j < 2; ++j)
#pragma unroll
      for (int r = 0; r < 16; ++r) {
        int row = row0 + i * 32 + ROW_OF(r), col = col0 + j * 32 + (lane & 31);
        zr[(size_t)row * 1920 + col] = f2bf(acc[i][j][r]);
      }
}
__device__ __forceinline__ void g1b_tile(const Params& P, const Cx& X, int t, char* smem) {
  const int lane = X.tid & 63, w = X.tid >> 6;
  const int mt = t % 136, nt = t / 136;
  const int m0 = mt * 128, n0 = nt * 128;
  f32x16 acc[2][2];
  G22::zero(acc);
  G22::run(X, (const bf16_t*)(X.ws + OFF_HBUF) + (size_t)m0 * 1024, 1024, (const bf16_t*)(X.ws + OFF_WMIX) + WE_IN + (size_t)(1920 + n0) * 1024, 1024, 1024, smem, acc);
  bf16_t* zm = (bf16_t*)(X.ws + OFF_ZM);
  bf16_t* zf = (bf16_t*)(X.ws + OFF_ZF);
  const int row0 = m0 + (w >> 1) * 64, col0 = n0 + (w & 1) * 64;
#pragma unroll
  for (int i = 0; i < 2; ++i)
#pragma unroll
    for (int j = 0; j < 2; ++j)
#pragma unroll
      for (int r = 0; r < 16; ++r) {
        int row = row0 + i * 32 + ROW_OF(r), col = col0 + j * 32 + (lane & 31);
        bf16_t v = f2bf(acc[i][j][r]);
        if (col < 544) zm[(size_t)row * 544 + col] = v;
        else if (col < 1056) zf[(size_t)row * 512 + (col - 544)] = v;
      }
}

__device__ __forceinline__ void r1a_job(const Params& P, const Cx& X, int layer, int job) {
  const int tid = X.tid;
  const int ch = tid < 240 ? tid : 239;
  const int col0 = ch * 8;
  const bf16_t* zr = (const bf16_t*)(X.ws + OFF_ZR);
  const int rowb = job * 8;
  int pos, len;
  if (rowb < NX) { pos = rowb & 4095; len = 4096; } else { pos = (rowb - NX) & 255; len = 256; }
  const bool isk = (col0 >= 512 && col0 < 1024);
  float mup[8], mun[8], kkw[8];
  {
    const float4 a0 = *(const float4*)(P.in[8] + layer * 1920 + col0), a1 = *(const float4*)(P.in[8] + layer * 1920 + col0 + 4);
    const float4 b0 = *(const float4*)(P.in[9] + layer * 1920 + col0), b1 = *(const float4*)(P.in[9] + layer * 1920 + col0 + 4);
    const float* kp = P.in[14] + layer * 512 + (isk ? col0 - 512 : 0);
    const float4 c0 = *(const float4*)kp, c1 = *(const float4*)(kp + 4);
    mup[0] = a0.x; mup[1] = a0.y; mup[2] = a0.z; mup[3] = a0.w; mup[4] = a1.x; mup[5] = a1.y; mup[6] = a1.z; mup[7] = a1.w;
    mun[0] = b0.x; mun[1] = b0.y; mun[2] = b0.z; mun[3] = b0.w; mun[4] = b1.x; mun[5] = b1.y; mun[6] = b1.z; mun[7] = b1.w;
    kkw[0] = c0.x; kkw[1] = c0.y; kkw[2] = c0.z; kkw[3] = c0.w; kkw[4] = c1.x; kkw[5] = c1.y; kkw[6] = c1.z; kkw[7] = c1.w;
  }
  uint4 zw[10];
#pragma unroll
  for (int i = 0; i < 10; ++i) {
    const int pp = pos - 1 + i;
    zw[i] = make_uint4(0, 0, 0, 0);
    if (pp >= 0 && pp < len) zw[i] = *(const uint4*)(zr + (size_t)(rowb - 1 + i) * 1920 + col0);
  }
#pragma unroll
  for (int i8 = 0; i8 < 8; ++i8) {
    const int row = rowb + i8;
    const uint4 zp = zw[i8], zc = zw[i8 + 1], zn = zw[i8 + 2];
    float zs[8];
    {
      const uint32_t c4[4] = {zc.x, zc.y, zc.z, zc.w}, p4[4] = {zp.x, zp.y, zp.z, zp.w}, n4[4] = {zn.x, zn.y, zn.z, zn.w};
#pragma unroll
      for (int i = 0; i < 4; ++i) {
        float c0 = lo16(c4[i]), c1 = hi16(c4[i]);
        zs[2 * i] = c0 + (lo16(p4[i]) - c0) * mup[2 * i] + (lo16(n4[i]) - c0) * mun[2 * i];
        zs[2 * i + 1] = c1 + (hi16(p4[i]) - c1) * mup[2 * i + 1] + (hi16(n4[i]) - c1) * mun[2 * i + 1];
      }
    }
    if (tid < 240) {
      uint4 o;
      if (col0 < 1536) {
        o.x = pack2(zs[0], zs[1]); o.y = pack2(zs[2], zs[3]); o.z = pack2(zs[4], zs[5]); o.w = pack2(zs[6], zs[7]);
        *(uint4*)((bf16_t*)(X.ws + OFF_RKV) + (size_t)row * 1536 + col0) = o;
      } else {
        float t[8];
        if (col0 < 1664) {
#pragma unroll
          for (int i = 0; i < 8; ++i) t[i] = 1.f - 2.f / (1.f + __expf(2.f * zs[i]));
        } else if (col0 < 1792) {
#pragma unroll
          for (int i = 0; i < 8; ++i) t[i] = zs[i];
        } else {
#pragma unroll
          for (int i = 0; i < 8; ++i) t[i] = 1.f / (1.f + __expf(-zs[i]));
        }
        o.x = pack2(t[0], t[1]); o.y = pack2(t[2], t[3]); o.z = pack2(t[4], t[5]); o.w = pack2(t[6], t[7]);
        *(uint4*)((bf16_t*)(X.ws + OFF_LORA) + (size_t)row * 384 + (col0 - 1536)) = o;
      }
    }
  }
}

__device__ __forceinline__ void r1b_tile(const Params& P, const Cx& X, int layer, int t, char* smem) {
  const int lane = X.tid & 63, w = X.tid >> 6;
  const int mt = t % 136, rest = t / 136;
  const int nt = rest & 3, type = rest >> 2;
  const int m0 = mt * 128, n0 = nt * 128;
  const bf16_t* lora = (const bf16_t*)(X.ws + OFF_LORA) + (size_t)m0 * 384;
  const bf16_t* W = (const bf16_t*)(X.ws + OFF_WMIX);
  f32x16 acc[2][2];
  G22::zero(acc);
  if (type < 2) G22::run(X, lora + type * 64, 384, W + WE_W2 + type * 32768 + (size_t)n0 * 64, 64, 64, smem, acc);
  else if (type < 4) G22::run(X, lora + 128 + (type - 2) * 64, 384, W + WE_A2 + (type - 2) * 32768 + (size_t)n0 * 64, 64, 64, smem, acc);
  else G22::run(X, lora + 256, 384, W + WE_G2 + (size_t)n0 * 128, 128, 128, smem, acc);
  const int row0 = m0 + (w >> 1) * 64, col0 = n0 + (w & 1) * 64;
  bf16_t* ld = (bf16_t*)(X.ws + OFF_LD);
  bf16_t* ab = (bf16_t*)(X.ws + OFF_A);
  bf16_t* gb = (bf16_t*)(X.ws + OFF_G);
#pragma unroll
  for (int j = 0; j < 2; ++j) {
    const int col = col0 + j * 32 + (lane & 31);
    float bias = 0.f;
    if (type < 2) bias = P.in[10][(layer * 2 + type) * 512 + col];
    else if (type < 4) bias = P.in[12][(layer * 2 + type - 2) * 512 + col];
#pragma unroll
    for (int i = 0; i < 2; ++i)
#pragma unroll
      for (int r = 0; r < 16; ++r) {
        int row = row0 + i * 32 + ROW_OF(r);
        float v = acc[i][j][r] + bias;
        if (type < 2) ld[(size_t)row * 1024 + type * 512 + col] = f2bf(-0.60653066f / (1.f + __expf(-v)));
        else if (type < 4) ab[(size_t)row * 1024 + (type - 2) * 512 + col] = f2bf(1.f / (1.f + __expf(-v)));
        else gb[(size_t)row * 512 + col] = f2bf(v);
      }
  }
}

template <int CTRL>
__device__ __forceinline__ float dpp_f(float x) {
  return __int_as_float(__builtin_amdgcn_update_dpp(0, __float_as_int(x), CTRL, 0xf, 0xf, false));
}
__device__ __forceinline__ float red16(float x) {
  x += dpp_f<0x128>(x);
  x += dpp_f<0x124>(x);
  x += dpp_f<0x4E>(x);
  x += dpp_f<0xB1>(x);
  return x;
}
__device__ __forceinline__ int scan_tokrow(int b, int dir, int i) {
  if (i < 256) return NX + b * 256 + (dir ? 255 - i : i);
  int t = i - 256;
  return b * 4096 + (dir ? 4095 - t : t);
}
typedef float f2_t __attribute__((ext_vector_type(2)));
__device__ __forceinline__ void scan_job(const Params& P, const Cx& X, int layer, int bj, char* smem) {
  const int tid = X.tid, lane = tid & 63, w = tid >> 6;
  const int s = bj >> 2, rq = bj & 3;
  const int dir = s >> 5, b = (s & 31) >> 3, h = s & 7;
  float* sv = (float*)smem;
  float* sy = sv + 2 * 16 * 6 * 64;
  const bf16_t* rkv = (const bf16_t*)(X.ws + OFF_RKV);
  const bf16_t* ab = (const bf16_t*)(X.ws + OFF_A);
  const bf16_t* ldb = (const bf16_t*)(X.ws + OFF_LD);
  bf16_t* yout = (bf16_t*)(X.ws + (dir ? OFF_YB : OFF_YF));
  const int lst = tid >> 4, lch = (tid & 15) * 4;
  const float4 ka4 = *(const float4*)(P.in[15] + layer * 512 + h * 64 + lch);
  const float4 kw4 = *(const float4*)(P.in[14] + layer * 512 + h * 64 + lch);
  uint2 pr, pk, pv, pa, pl;
#define SLOAD(chunk)                                                          \
  {                                                                           \
    int row = scan_tokrow(b, dir, (chunk)*16 + lst);                          \
    const bf16_t* p0 = rkv + (size_t)row * 1536 + h * 64 + lch;               \
    pr = *(const uint2*)p0; pk = *(const uint2*)(p0 + 512); pv = *(const uint2*)(p0 + 1024); \
    pa = *(const uint2*)(ab + (size_t)row * 1024 + dir * 512 + h * 64 + lch); \
    pl = *(const uint2*)(ldb + (size_t)row * 1024 + dir * 512 + h * 64 + lch);\
  }
#define SSTORE2(buf)                                                          \
  {                                                                           \
    float* d = sv + ((buf)*16 + lst) * 384 + lch;                             \
    float a0 = lo16(pa.x), a1 = hi16(pa.x), a2 = lo16(pa.y), a3 = hi16(pa.y); \
    float k0 = lo16(pk.x), k1 = hi16(pk.x), k2 = lo16(pk.y), k3 = hi16(pk.y); \
    float q0 = k0 * kw4.x, q1 = k1 * kw4.y, q2 = k2 * kw4.z, q3 = k3 * kw4.w;    \
    {                                                                         \
      const float ssq = red16(q0 * q0 + q1 * q1 + q2 * q2 + q3 * q3);         \
      const float inv = 1.f / fmaxf(sqrtf(ssq), 1e-12f);                      \
      q0 *= inv; q1 *= inv; q2 *= inv; q3 *= inv;                             \
    }                                                                         \
    *(float4*)(d) = make_float4(q0, q1, q2, q3);                              \
    *(float4*)(d + 64) = make_float4(__expf(lo16(pl.x)), __expf(hi16(pl.x)), __expf(lo16(pl.y)), __expf(hi16(pl.y))); \
    *(float4*)(d + 128) = make_float4(q0 * a0, q1 * a1, q2 * a2, q3 * a3);    \
    *(float4*)(d + 192) = make_float4(k0 * (1.f + (a0 - 1.f) * ka4.x), k1 * (1.f + (a1 - 1.f) * ka4.y), k2 * (1.f + (a2 - 1.f) * ka4.z), k3 * (1.f + (a3 - 1.f) * ka4.w)); \
    *(float4*)(d + 256) = make_float4(lo16(pr.x), hi16(pr.x), lo16(pr.y), hi16(pr.y)); \
    *(float4*)(d + 320) = make_float4(lo16(pv.x), hi16(pv.x), lo16(pv.y), hi16(pv.y)); \
  }
  SLOAD(0);
  SSTORE2(0);
  __syncthreads();
  const int rp = lane >> 4, ci = (lane & 15) * 4;
  const int vrow = rq * 16 + w * 4 + rp;
  float S0 = 0.f, S1 = 0.f, S2 = 0.f, S3 = 0.f, qy = 0.f;
  for (int chunk = 0; chunk < 272; ++chunk) {
    const int buf = chunk & 1;
    SLOAD(chunk + 1 < 272 ? chunk + 1 : 271);
    __builtin_amdgcn_sched_barrier(0);
    {
      const float* base = sv + buf * 16 * 384;
      float ysel = 0.f;
      qy = 0.f;
      float4 p0kk, p0w, p0b, p0kd, p0r, p1kk, p1w, p1b, p1kd, p1r;
      float p0v, p1v;
#define LDS_SET(S, st)                                     \
  {                                                        \
    const float* d = base + (st)*384;                      \
    S##kk = *(const float4*)(d + ci);                      \
    S##w = *(const float4*)(d + 64 + ci);                  \
    S##b = *(const float4*)(d + 128 + ci);                 \
    S##kd = *(const float4*)(d + 192 + ci);                \
    S##r = *(const float4*)(d + 256 + ci);                 \
    S##v = d[320 + vrow];                                  \
  }
#define DPPS "row_mask:0xf bank_mask:0xf bound_ctrl:1\n"
#define STEP(S, st)                                                                                   \
  {                                                                                                   \
    float t0, t1, u0, u1, u2, u3;                                                                     \
    asm volatile(                                                                                     \
        "v_mul_f32 %5, %0, %11\n"                                                                     \
        "v_mul_f32 %6, %1, %12\n"                                                                     \
        "v_fma_f32 %5, %2, %13, %5\n"                                                                 \
        "v_fma_f32 %6, %3, %14, %6\n"                                                                 \
        "v_mul_f32 %7, %27, %23\n"                                                                    \
        "v_add_f32 %5, %5, %6\n"                                                                      \
        "v_mul_f32 %8, %27, %24\n"                                                                    \
        "v_mul_f32 %9, %27, %25\n"                                                                    \
        "v_add_f32_dpp %5, %5, %5 row_ror:8 " DPPS                                                    \
        "v_add_f32_dpp %4, %4, %4 row_ror:8 " DPPS                                                    \
        "v_mul_f32 %10, %27, %26\n"                                                                   \
        "v_add_f32_dpp %5, %5, %5 row_ror:4 " DPPS                                                    \
        "v_add_f32_dpp %4, %4, %4 row_ror:4 " DPPS                                                    \
        "v_fma_f32 %7, %0, %15, %7\n"                                                                 \
        "v_add_f32_dpp %5, %5, %5 quad_perm:[2,3,0,1] " DPPS                                          \
        "v_add_f32_dpp %4, %4, %4 quad_perm:[2,3,0,1] " DPPS                                          \
        "v_fma_f32 %8, %1, %16, %8\n"                                                                 \
        "v_add_f32_dpp %5, %5, %5 quad_perm:[1,0,3,2] " DPPS                                          \
        "v_add_f32_dpp %4, %4, %4 quad_perm:[1,0,3,2] " DPPS                                          \
        "v_fma_f32 %9, %2, %17, %9\n"                                                                 \
        "v_fma_f32 %10, %3, %18, %10\n"                                                               \
        "v_fma_f32 %0, -%5, %19, %7\n"                                                                \
        "v_fma_f32 %1, -%5, %20, %8\n"                                                                \
        "v_fma_f32 %2, -%5, %21, %9\n"                                                                \
        "v_fma_f32 %3, -%5, %22, %10\n"                                                               \
        : "+v"(S0), "+v"(S1), "+v"(S2), "+v"(S3), "+v"(qy), "=&v"(t0), "=&v"(t1), "=&v"(u0), "=&v"(u1), \
          "=&v"(u2), "=&v"(u3)                                                                        \
        : "v"(S##kk.x), "v"(S##kk.y), "v"(S##kk.z), "v"(S##kk.w), "v"(S##w.x), "v"(S##w.y), "v"(S##w.z), \
          "v"(S##w.w), "v"(S##b.x), "v"(S##b.y), "v"(S##b.z), "v"(S##b.w), "v"(S##kd.x), "v"(S##kd.y), \
          "v"(S##kd.z), "v"(S##kd.w), "v"(S##v));                                                     \
                                                 \
    if ((st) > 0) ysel = ((lane & 15) == (st)-1) ? qy : ysel;                                         \
    qy = fmaf(S2, S##r.z, S0 * S##r.x) + fmaf(S3, S##r.w, S1 * S##r.y);                               \
  }
      LDS_SET(p0, 0);
#pragma unroll
      for (int st = 0; st < 16; st += 2) {
        LDS_SET(p1, st + 1);
        __builtin_amdgcn_sched_barrier(0);
        STEP(p0, st);
        if (st + 2 < 16) LDS_SET(p0, st + 2);
        __builtin_amdgcn_sched_barrier(0);
        STEP(p1, st + 1);
      }
#undef LDS_SET
#undef STEP
#undef DPPS
      qy = red16(qy);
      ysel = ((lane & 15) == 15) ? qy : ysel;
      sy[(buf * 16 + (lane & 15)) * 16 + w * 4 + rp] = ysel;
    }
    if (chunk + 1 < 272) SSTORE2(buf ^ 1);
    __syncthreads();
    {
      int st = tid >> 4, r = tid & 15;
      int row = scan_tokrow(b, dir, chunk * 16 + st);
      yout[(size_t)row * 512 + h * 64 + rq * 16 + r] = f2bf(sy[(buf * 16 + st) * 16 + r]);
    }
  }
#undef SLOAD
#undef SSTORE2
  __syncthreads();
}

__device__ __forceinline__ void s2_job(const Params& P, const Cx& X, int layer, int job) {
  const int tid = X.tid;
  const int row = job * 4 + (tid >> 6);
  const int c0 = (tid & 63) * 8;
  const bf16_t* rkv = (const bf16_t*)(X.ws + OFF_RKV) + (size_t)row * 1536;
  uint4 ur = *(const uint4*)(rkv + c0), uk = *(const uint4*)(rkv + 512 + c0), uv = *(const uint4*)(rkv + 1024 + c0);
  uint4 ua0 = *(const uint4*)((const bf16_t*)(X.ws + OFF_A) + (size_t)row * 1024 + c0);
  uint4 ua1 = *(const uint4*)((const bf16_t*)(X.ws + OFF_A) + (size_t)row * 1024 + 512 + c0);
  uint4 ug = *(const uint4*)((const bf16_t*)(X.ws + OFF_G) + (size_t)row * 512 + c0);
  uint4 uyf = *(const uint4*)((const bf16_t*)(X.ws + OFF_YF) + (size_t)row * 512 + c0);
  uint4 uyb = *(const uint4*)((const bf16_t*)(X.ws + OFF_YB) + (size_t)row * 512 + c0);
  const uint32_t r4[4] = {ur.x, ur.y, ur.z, ur.w}, k4[4] = {uk.x, uk.y, uk.z, uk.w}, v4[4] = {uv.x, uv.y, uv.z, uv.w};
  const uint32_t a04[4] = {ua0.x, ua0.y, ua0.z, ua0.w}, a14[4] = {ua1.x, ua1.y, ua1.z, ua1.w}, g4[4] = {ug.x, ug.y, ug.z, ug.w};
  const uint32_t yf4[4] = {uyf.x, uyf.y, uyf.z, uyf.w}, yb4[4] = {uyb.x, uyb.y, uyb.z, uyb.w};
  float y[8], vv[8], gg[8];
  float sum = 0.f, bon = 0.f;
  const float* rk = P.in[16] + layer * 512 + c0;
  const float* ka = P.in[15] + layer * 512 + c0;
#pragma unroll
  for (int i = 0; i < 4; ++i) {
#pragma unroll
    for (int hh = 0; hh < 2; ++hh) {
      int e = 2 * i + hh;
      float r = hh ? hi16(r4[i]) : lo16(r4[i]);
      float k = hh ? hi16(k4[i]) : lo16(k4[i]);
      float a0 = hh ? hi16(a04[i]) : lo16(a04[i]);
      float a1 = hh ? hi16(a14[i]) : lo16(a14[i]);
      y[e] = (hh ? hi16(yf4[i]) : lo16(yf4[i])) + (hh ? hi16(yb4[i]) : lo16(yb4[i]));
      vv[e] = hh ? hi16(v4[i]) : lo16(v4[i]);
      gg[e] = hh ? hi16(g4[i]) : lo16(g4[i]);
      sum += y[e];
      float ksum = k * (2.f + (a0 + a1 - 2.f) * ka[e]);
      bon += r * rk[e] * ksum;
    }
  }
  sum += __shfl_xor(sum, 1); sum += __shfl_xor(sum, 2); sum += __shfl_xor(sum, 4);
  bon += __shfl_xor(bon, 1); bon += __shfl_xor(bon, 2); bon += __shfl_xor(bon, 4);
  const float mu = sum * (1.f / 64.f);
  float var = 0.f;
#pragma unroll
  for (int e = 0; e < 8; ++e) { float d = y[e] - mu; var += d * d; }
  var += __shfl_xor(var, 1); var += __shfl_xor(var, 2); var += __shfl_xor(var, 4);
  const float rs = rsqrtf(var * (1.f / 64.f) + 64e-5f);
  const float* gw = P.in[18] + layer * 512 + c0;
  const float* gbi = P.in[19] + layer * 512 + c0;
  float o[8];
#pragma unroll
  for (int e = 0; e < 8; ++e) o[e] = ((y[e] - mu) * rs * gw[e] + gbi[e] + bon * vv[e]) * gg[e];
  uint4 ou;
  ou.x = pack2(o[0], o[1]); ou.y = pack2(o[2], o[3]); ou.z = pack2(o[4], o[5]); ou.w = pack2(o[6], o[7]);
  *(uint4*)((bf16_t*)(X.ws + OFF_RWO) + (size_t)row * 512 + c0) = ou;
}

__device__ __forceinline__ float red32(float x) {
  x += __shfl_xor(x, 1); x += __shfl_xor(x, 2); x += __shfl_xor(x, 4); x += __shfl_xor(x, 8); x += __shfl_xor(x, 16);
  return x;
}
#define QSCALE 0.14724444f
__device__ __forceinline__ void q1_q_tile(const Params& P, const Cx& X, int layer, int t, char* smem) {
  const int tid = X.tid, lane = tid & 63, w = tid >> 6;
  const int mt = t % 136, head = t / 136;
  const int m0 = mt * 128;
  const bf16_t* zm = (const bf16_t*)(X.ws + OFF_ZM);
  float* srs = (float*)(smem + 73728);
  {
    int r = tid >> 1, hf = tid & 1;
    const bf16_t* p = zm + (size_t)(m0 + r) * 544 + hf * 192;
    float ss = 0.f;
#pragma unroll 12
    for (int i = 0; i < 24; ++i) {
      uint4 u = *(const uint4*)(p + i * 8);
      ss += lo16(u.x) * lo16(u.x) + hi16(u.x) * hi16(u.x) + lo16(u.y) * lo16(u.y) + hi16(u.y) * hi16(u.y) +
            lo16(u.z) * lo16(u.z) + hi16(u.z) * hi16(u.z) + lo16(u.w) * lo16(u.w) + hi16(u.w) * hi16(u.w);
    }
    ss += __shfl_xor(ss, 1);
    if (hf == 0) srs[r] = rsqrtf(ss * (1.f / 384.f) + 1e-6f);
  }
  f32x16 acc[1][3];
  GQ::zero(acc);
  GQ::run(X, zm + (size_t)m0 * 544, 544, (const bf16_t*)(X.ws + OFF_WMIX) + WE_UQ + (size_t)head * 96 * 384, 384, 384, smem, acc);
  const int l5 = lane & 31;
  const float* gq = P.in[25] + layer * 96;
  const float g0 = gq[l5], g1 = gq[32 + l5], g2 = gq[64 + l5];
  const float2* rope = (const float2*)(X.ws + OFF_ROPE);
  bf16_t* qb = (bf16_t*)(X.ws + OFF_Q);
  float2 rcs[16];
#pragma unroll
  for (int r = 0; r < 16; ++r) {
    const int row = m0 + w * 32 + ROW_OF(r);
    rcs[r] = (row < NX) ? rope[(row & 4095) * 16 + (l5 >> 4) * 8 + (l5 & 7)] : make_float2(1.f, 0.f);
  }
#pragma unroll
  for (int r = 0; r < 16; ++r) {
    const int rl = w * 32 + ROW_OF(r);
    const int row = m0 + rl;
    const float rs = srs[rl];
    float x0 = acc[0][0][r] * rs, x1 = acc[0][1][r] * rs, x2 = acc[0][2][r] * rs;
    float ss = red32(x0 * x0 + x1 * x1 + x2 * x2);
    float rq = rsqrtf(ss * (1.f / 96.f) + 1e-6f);
    x0 *= rq * g0; x1 *= rq * g1; x2 *= rq * g2;
    bf16_t* dst;
    if (row < NX) {
      int tt = row & 4095, bb = row >> 12;
      float2 cs = rcs[r];
      float other = __shfl_xor(x2, 8);
      x2 = (l5 & 8) ? x2 * cs.x + other * cs.y : x2 * cs.x - other * cs.y;
      dst = qb + ((size_t)(bb * 8 + head) * 4096 + tt) * 96;
    } else {
      int j = (row - NX) & 255, bb = (row - NX) >> 8;
      dst = qb + (size_t)NX * 768 + ((size_t)(bb * 8 + head) * 256 + j) * 96;
    }
    dst[l5] = f2bf(x0 * QSCALE); dst[32 + l5] = f2bf(x1 * QSCALE); dst[64 + l5] = f2bf(x2 * QSCALE);
  }
}
__device__ __forceinline__ void q1_kv_tile(const Params& P, const Cx& X, int layer, int t, char* smem) {
  const int tid = X.tid, lane = tid & 63, w = tid >> 6;
  const int mt = t % 136, head = t / 136;
  const int m0 = mt * 128;
  const bf16_t* zm = (const bf16_t*)(X.ws + OFF_ZM);
  float* srs = (float*)(smem + 73728);
  {
    int r = tid >> 1, hf = tid & 1;
    const bf16_t* p = zm + (size_t)(m0 + r) * 544 + 384 + hf * 64;
    float ss = 0.f;
#pragma unroll
    for (int i = 0; i < 8; ++i) {
      uint4 u = *(const uint4*)(p + i * 8);
      ss += lo16(u.x) * lo16(u.x) + hi16(u.x) * hi16(u.x) + lo16(u.y) * lo16(u.y) + hi16(u.y) * hi16(u.y) +
            lo16(u.z) * lo16(u.z) + hi16(u.z) * hi16(u.z) + lo16(u.w) * lo16(u.w) + hi16(u.w) * hi16(u.w);
    }
    ss += __shfl_xor(ss, 1);
    if (hf == 0) srs[r] = rsqrtf(ss * (1.f / 128.f) + 1e-6f);
  }
  f32x16 acc[1][4];
  GKV::zero(acc);
  GKV::run(X, zm + (size_t)m0 * 544 + 384, 544, (const bf16_t*)(X.ws + OFF_WMIX) + WE_UKV + (size_t)head * 128 * 128, 128, 128, smem, acc);
  const int l5 = lane & 31;
  const float* gk = P.in[26] + layer * 96;
  const float g0 = gk[l5], g1 = gk[32 + l5], g2 = gk[64 + l5];
  const float2* rope = (const float2*)(X.ws + OFF_ROPE);
  bf16_t* kb = (bf16_t*)(X.ws + OFF_K);
  bf16_t* vt = (bf16_t*)(X.ws + OFF_VT);
  const bool isx = m0 < NX;
  const int bb = isx ? (m0 >> 12) : ((m0 - NX) >> 8);
  float vv0[16], vv1[16];
  float krv[16];
  float2 rcs[16];
#pragma unroll
  for (int r = 0; r < 16; ++r) {
    const int row = m0 + w * 32 + ROW_OF(r);
    krv[r] = bf2f(zm[(size_t)row * 544 + 512 + l5]);
    rcs[r] = isx ? rope[(row & 4095) * 16 + (l5 >> 4) * 8 + (l5 & 7)] : make_float2(1.f, 0.f);
  }
#pragma unroll
  for (int r = 0; r < 16; ++r) {
    const int rl = w * 32 + ROW_OF(r);
    const int row = m0 + rl;
    const float rs = srs[rl];
    float k0 = acc[0][0][r] * rs, k1 = acc[0][1][r] * rs;
    float kr = krv[r];
    float ss = red32(k0 * k0 + k1 * k1 + kr * kr);
    float rk = rsqrtf(ss * (1.f / 96.f) + 1e-6f);
    k0 *= rk * g0; k1 *= rk * g1; kr *= rk * g2;
    int key;
    if (isx) {
      int tt = row & 4095;
      float2 cs = rcs[r];
      float other = __shfl_xor(kr, 8);
      kr = (l5 & 8) ? kr * cs.x + other * cs.y : kr * cs.x - other * cs.y;
      key = 256 + tt;
    } else {
      key = (row - NX) & 255;
    }
    bf16_t* dst = kb + ((size_t)(bb * 8 + head) * 4352 + key) * 96;
    dst[l5] = f2bf(k0); dst[32 + l5] = f2bf(k1); dst[64 + l5] = f2bf(kr);
    vv0[r] = acc[0][2][r] * rs;
    vv1[r] = acc[0][3][r] * rs;
  }
#pragma unroll
  for (int g = 0; g < 4; ++g) {
    const int rl = w * 32 + 8 * g + 4 * (lane >> 5);
    const int row = m0 + rl;
    const int key = isx ? 256 + (row & 4095) : ((row - NX) & 255);
    uint2 o0, o1;
    o0.x = pack2(vv0[4 * g], vv0[4 * g + 1]); o0.y = pack2(vv0[4 * g + 2], vv0[4 * g + 3]);
    o1.x = pack2(vv1[4 * g], vv1[4 * g + 1]); o1.y = pack2(vv1[4 * g + 2], vv1[4 * g + 3]);
    *(uint2*)(vt + ((size_t)(bb * 8 + head) * 64 + l5) * 4352 + key) = o0;
    *(uint2*)(vt + ((size_t)(bb * 8 + head) * 64 + 32 + l5) * 4352 + key) = o1;
  }
}

__device__ __forceinline__ void fft1_tile(const Params& P, const Cx& X, int t, char* smem) {
  const int lane = X.tid & 63, w = X.tid >> 6;
  const int b = t >> 8, ntile = t & 255;
  const int n0 = ntile * 128;
  f32x16 acc[2][2];
  G22T::zero(acc);
  G22T::run(X, (const bf16_t*)(X.ws + OFF_F1), 64, (const bf16_t*)(X.ws + OFF_ZF) + (size_t)b * 4096 * 512 + n0, 32768, 64, smem, acc);
  const float2* tw = (const float2*)(X.ws + OFF_TW);
  bf16_t* out = (bf16_t*)(X.ws + OFF_FFT1);
  const int wm = w >> 1, wn = w & 1;
  const int t2 = n0 >> 9;
#pragma unroll
  for (int j = 0; j < 2; ++j) {
    const int ch = (n0 & 511) + wn * 64 + j * 32 + (lane & 31);
    float2 tcs[16];
#pragma unroll
    for (int r = 0; r < 16; ++r) tcs[r] = tw[t2 * (wm * 32 + ROW_OF(r))];
#pragma unroll
    for (int r = 0; r < 16; ++r) {
      const int f1 = wm * 32 + ROW_OF(r);
      float re = acc[0][j][r], im = acc[1][j][r];
      float2 cs = tcs[r];
      float re2 = re * cs.x + im * cs.y, im2 = im * cs.x - re * cs.y;
      size_t base = ((size_t)(b * 64 + f1) * 128) * 512 + ch;
      out[base + (size_t)t2 * 512] = f2bf(re2);
      out[base + (size_t)(64 + t2) * 512] = f2bf(im2);
    }
  }
}
__device__ __forceinline__ void fft2_tile(const Params& P, const Cx& X, int t, char* smem) {
  const int lane = X.tid & 63, w = X.tid >> 6;
  const int bf = t >> 2, ntile = t & 3;
  const int b = bf >> 6, f1 = bf & 63;
  const int n0 = ntile * 128;
  f32x16 acc[2][2];
  G22T::zero(acc);
  G22T::run(X, (const bf16_t*)(X.ws + OFF_F2), 128, (const bf16_t*)(X.ws + OFF_FFT1) + (size_t)bf * 128 * 512 + n0, 512, 128, smem, acc);
  bf16_t* Y = (bf16_t*)(X.ws + OFF_Y);
  const int wm = w >> 1, wn = w & 1;
#pragma unroll
  for (int i = 0; i < 2; ++i)
#pragma unroll
    for (int j = 0; j < 2; ++j)
#pragma unroll
      for (int r = 0; r < 16; ++r) {
        int m = wm * 64 + i * 32 + ROW_OF(r);
        int f2 = m & 63, q = m >> 6;
        int ch = n0 + wn * 64 + j * 32 + (lane & 31);
        Y[(size_t)(b * 4096 + f1 + 64 * f2) * 1024 + q * 512 + ch] = f2bf(acc[i][j][r]);
      }
}
__device__ __forceinline__ void ctxdft_tile(const Params& P, const Cx& X, int t, char* smem) {
  const int lane = X.tid & 63, w = X.tid >> 6;
  const int b = t >> 4, mt = (t >> 2) & 3, ntile = t & 3;
  const int n0 = ntile * 128;
  f32x16 acc[2][2];
  G22T::zero(acc);
  G22T::run(X, (const bf16_t*)(X.ws + OFF_F256) + (size_t)mt * 128 * 256, 256, (const bf16_t*)(X.ws + OFF_ZF) + (size_t)(NX + b * 256) * 512 + n0, 512, 256, smem, acc);
  bf16_t* Y = (bf16_t*)(X.ws + OFF_Y);
  const int wm = w >> 1, wn = w & 1;
#pragma unroll
  for (int i = 0; i < 2; ++i)
#pragma unroll
    for (int j = 0; j < 2; ++j)
#pragma unroll
      for (int r = 0; r < 16; ++r) {
        int m = mt * 128 + wm * 64 + i * 32 + ROW_OF(r);
        int f = m & 255, q = m >> 8;
        int ch = n0 + wn * 64 + j * 32 + (lane & 31);
        Y[(size_t)(NX + b * 256 + f) * 1024 + q * 512 + ch] = f2bf(acc[i][j][r] * 4.f);
      }
}

__device__ __forceinline__ void attn_item(const Params& P, const Cx& X, int it, bool isctx, char* smem) {
  const int tid = X.tid, lane = tid & 63, w = tid >> 6;
  int b, h, qb, nkt, qrow0;
  const bf16_t* qbase;
  if (!isctx) {
    b = it >> 8; h = (it >> 5) & 7; qb = it & 31; nkt = 68;
    qbase = (const bf16_t*)(X.ws + OFF_Q) + ((size_t)(b * 8 + h) * 4096 + qb * 128) * 96;
    qrow0 = b * 4096 + qb * 128;
  } else {
    b = it >> 4; h = (it >> 1) & 7; qb = it & 1; nkt = 4;
    qbase = (const bf16_t*)(X.ws + OFF_Q) + (size_t)NX * 768 + ((size_t)(b * 8 + h) * 256 + qb * 128) * 96;
    qrow0 = NX + b * 256 + qb * 128;
  }
  const bf16_t* kbase = (const bf16_t*)(X.ws + OFF_K) + (size_t)(b * 8 + h) * 4352 * 96;
  const bf16_t* vbase = (const bf16_t*)(X.ws + OFF_VT) + (size_t)(b * 8 + h) * 64 * 4352;
  bf16_t* sK = (bf16_t*)smem;
  bf16_t* sV = sK + 2 * 64 * 104;
  const int l5 = lane & 31, hh = lane >> 5;
  const bf16_t* qp = qbase + (size_t)(w * 32 + l5) * 96 + hh * 8;
  const bf16x8 qf0 = *(const bf16x8*)(qp), qf1 = *(const bf16x8*)(qp + 16), qf2 = *(const bf16x8*)(qp + 32);
  const bf16x8 qf3 = *(const bf16x8*)(qp + 48), qf4 = *(const bf16x8*)(qp + 64), qf5 = *(const bf16x8*)(qp + 80);
  uint4 rk0, rk1, rk2, rv0, rv1;
#define LK_(i, kt) (*(const uint4*)(kbase + (size_t)((kt)*64 + (tid + 256 * (i)) / 12) * 96 + ((tid + 256 * (i)) % 12) * 8))
#define LV_(i, kt) (*(const uint4*)(vbase + (size_t)((tid + 256 * (i)) >> 3) * 4352 + (kt)*64 + ((tid + 256 * (i)) & 7) * 8))
#define ALOAD(kt) { rk0 = LK_(0, kt); rk1 = LK_(1, kt); rk2 = LK_(2, kt); rv0 = LV_(0, kt); rv1 = LV_(1, kt); }
#define SK_(i, buf, v) *(uint4*)(sK + (buf)*64 * 104 + ((tid + 256 * (i)) / 12) * 104 + ((tid + 256 * (i)) % 12) * 8) = v
#define SV_(i, buf, v) *(uint4*)(sV + (buf)*64 * 72 + ((tid + 256 * (i)) >> 3) * 72 + ((tid + 256 * (i)) & 7) * 8) = v
#define ASTORE(buf) { SK_(0, buf, rk0); SK_(1, buf, rk1); SK_(2, buf, rk2); SV_(0, buf, rv0); SV_(1, buf, rv1); }
  f32x16 o[2];
#pragma unroll
  for (int r = 0; r < 16; ++r) { o[0][r] = 0.f; o[1][r] = 0.f; }
  float mrun = -1e30f, lrun = 0.f;
  ALOAD(0);
  ASTORE(0);
  __syncthreads();
  for (int kt = 0; kt < nkt; ++kt) {
    const int buf = kt & 1;
    if (kt + 1 < nkt) ALOAD(kt + 1);
    const bf16_t* pk = sK + buf * 64 * 104 + l5 * 104 + hh * 8;
    const bf16_t* pv = sV + buf * 64 * 72 + l5 * 72 + 4 * hh;
#pragma unroll
    for (int mt = 0; mt < 2; ++mt) {
      f32x16 sc;
#pragma unroll
      for (int r = 0; r < 16; ++r) sc[r] = 0.f;
#define QK(ks, qq) sc = __builtin_amdgcn_mfma_f32_32x32x16_bf16(*(const bf16x8*)(pk + mt * 32 * 104 + (ks)*16), qq, sc, 0, 0, 0)
      QK(0, qf0); QK(1, qf1); QK(2, qf2); QK(3, qf3); QK(4, qf4); QK(5, qf5);
#undef QK
      float mx = sc[0];
#pragma unroll
      for (int r = 1; r < 16; ++r) mx = fmaxf(mx, sc[r]);
      mx = fmaxf(mx, __shfl_xor(mx, 32));
      const float mnew = fmaxf(mrun, mx);
      if (__builtin_amdgcn_ballot_w64(mnew > mrun) != 0ull) {
        const float alpha = __builtin_amdgcn_exp2f(mrun - mnew);
        lrun *= alpha;
#pragma unroll
        for (int r = 0; r < 16; ++r) { o[0][r] *= alpha; o[1][r] *= alpha; }
        mrun = mnew;
      }
      float psum = 0.f;
#pragma unroll
      for (int r = 0; r < 16; ++r) { sc[r] = __builtin_amdgcn_exp2f(sc[r] - mrun); psum += sc[r]; }
      lrun += psum;
#pragma unroll
      for (int s2 = 0; s2 < 2; ++s2) {
        u32x4 pu;
        pu[0] = pack2(sc[8 * s2 + 0], sc[8 * s2 + 1]);
        pu[1] = pack2(sc[8 * s2 + 2], sc[8 * s2 + 3]);
        pu[2] = pack2(sc[8 * s2 + 4], sc[8 * s2 + 5]);
        pu[3] = pack2(sc[8 * s2 + 6], sc[8 * s2 + 7]);
        const bf16x8 pfv = __builtin_bit_cast(bf16x8, pu);
#pragma unroll
        for (int dt = 0; dt < 2; ++dt) {
          const bf16_t* p = pv + dt * 32 * 72 + mt * 32 + s2 * 16;
          uint2 v0 = *(const uint2*)(p), v1 = *(const uint2*)(p + 8);
          u32x4 vu;
          vu[0] = v0.x; vu[1] = v0.y; vu[2] = v1.x; vu[3] = v1.y;
          o[dt] = __builtin_amdgcn_mfma_f32_32x32x16_bf16(__builtin_bit_cast(bf16x8, vu), pfv, o[dt], 0, 0, 0);
        }
      }
    }
    if (kt + 1 < nkt) ASTORE(buf ^ 1);
    __syncthreads();
  }
#undef ALOAD
#undef ASTORE
#undef LK_
#undef LV_
#undef SK_
#undef SV_
  lrun += __shfl_xor(lrun, 32);
  const float inv = 1.f / lrun;
  bf16_t* dst = (bf16_t*)(X.ws + OFF_ATT) + (size_t)(qrow0 + w * 32 + l5) * 512 + h * 64;
#pragma unroll
  for (int dt = 0; dt < 2; ++dt)
#pragma unroll
    for (int g = 0; g < 4; ++g) {
      uint2 u;
      u.x = pack2(o[dt][4 * g] * inv, o[dt][4 * g + 1] * inv);
      u.y = pack2(o[dt][4 * g + 2] * inv, o[dt][4 * g + 3] * inv);
      *(uint2*)(dst + dt * 32 + 8 * g + 4 * hh) = u;
    }
}

__device__ __forceinline__ void mg_tile(const Params& P, const Cx& X, int t, int mtiles, char* smem) {
  const int lane = X.tid & 63, w = X.tid >> 6;
  const int mt = t % mtiles, nt = t / mtiles;
  const int m0 = mt * 128, c0 = nt * 128;
  const bf16_t* W = (const bf16_t*)(X.ws + OFF_WMIX);
  uint32_t mpk[2][2][8];
#pragma unroll
  for (int a = 0; a < 2; ++a)
#pragma unroll
    for (int c = 0; c < 2; ++c)
#pragma unroll
      for (int r = 0; r < 8; ++r) mpk[a][c][r] = 0u;
#pragma unroll 1
  for (int i = 0; i < 3; ++i) {
    f32x16 acc[2][2];
    G22::zero(acc);
    const bf16_t* Ai; const bf16_t* Bi; int ldi;
    if (i == 0) { Ai = (const bf16_t*)(X.ws + OFF_RWO) + (size_t)m0 * 512; Bi = W + WE_RO + (size_t)c0 * 512; ldi = 512; }
    else if (i == 1) { Ai = (const bf16_t*)(X.ws + OFF_ATT) + (size_t)m0 * 512; Bi = W + WE_MO + (size_t)c0 * 512; ldi = 512; }
    else { Ai = (const bf16_t*)(X.ws + OFF_Y) + (size_t)m0 * 1024; Bi = W + WE_FO + (size_t)c0 * 1024; ldi = 1024; }
    { const Cx Y1 = fresh(X); G22::run(Y1, Ai, ldi, Bi, ldi, ldi, smem, acc); }
    uint32_t opk[2][2][8];
#pragma unroll
    for (int a = 0; a < 2; ++a)
#pragma unroll
      for (int c = 0; c < 2; ++c)
#pragma unroll
        for (int r = 0; r < 8; ++r) opk[a][c][r] = pack2(acc[a][c][2 * r], acc[a][c][2 * r + 1]);
    __builtin_amdgcn_sched_barrier(0);
    G22::zero(acc);
    { const Cx Y2 = fresh(X); G22::run(Y2, (const bf16_t*)(X.ws + OFF_HBUF) + (size_t)m0 * 1024, 1024, W + WE_IN + (size_t)(2976 + i * 1024 + c0) * 1024, 1024, 1024, smem, acc); }
#pragma unroll
    for (int a = 0; a < 2; ++a)
#pragma unroll
      for (int c = 0; c < 2; ++c)
#pragma unroll
        for (int r = 0; r < 8; ++r) {
          const float m0v = lo16(mpk[a][c][r]) + lo16(opk[a][c][r]) / (1.f + __expf(-acc[a][c][2 * r]));
          const float m1v = hi16(mpk[a][c][r]) + hi16(opk[a][c][r]) / (1.f + __expf(-acc[a][c][2 * r + 1]));
          mpk[a][c][r] = pack2(m0v, m1v);
        }
  }
  bf16_t* mb = (bf16_t*)(X.ws + OFF_M);
  const int row0 = m0 + (w >> 1) * 64, col0 = c0 + (w & 1) * 64;
#pragma unroll
  for (int a = 0; a < 2; ++a)
#pragma unroll
    for (int c = 0; c < 2; ++c)
#pragma unroll
      for (int r = 0; r < 16; ++r)
        mb[(size_t)(row0 + a * 32 + ROW_OF(r)) * 1024 + col0 + c * 32 + (lane & 31)] = (bf16_t)((r & 1) ? (mpk[a][c][r >> 1] >> 16) : (mpk[a][c][r >> 1] & 0xffffu));
}

__device__ __forceinline__ void wo_tile(const Params& P, const Cx& X, int layer, int t, int mtiles, char* smem) {
  const int lane = X.tid & 63, w = X.tid >> 6;
  const int mt = t % mtiles, nt = t / mtiles;
  const int m0 = mt * 128, n0 = nt * 128;
  f32x16 acc[2][2];
  G22::zero(acc);
  G22::run(X, (const bf16_t*)(X.ws + OFF_M) + (size_t)m0 * 1024, 1024, (const bf16_t*)(X.ws + OFF_WMIX) + WE_OUT + (size_t)n0 * 1024, 1024, 1024, smem, acc);
  const int row0 = m0 + (w >> 1) * 64, col0 = n0 + (w & 1) * 64;
  const float* modv = (const float*)(X.ws + OFF_MOD) + (size_t)(layer * 5 + mod_row(m0)) * 6144 + 2048;
  const float* src; float* dst;
  if (m0 < NX) { src = (layer == 0 ? P.in[0] : X.out); dst = X.out; }
  else { src = (layer == 0 ? P.in[2] : (const float*)(X.ws + OFF_CS)) - (size_t)NX * 1024; dst = (float*)(X.ws + OFF_CS) - (size_t)NX * 1024; }
#pragma unroll
  for (int j = 0; j < 2; ++j) {
    const int col = col0 + j * 32 + (lane & 31);
    const float mg = modv[col];
#pragma unroll
    for (int i = 0; i < 2; ++i) {
      float t[16];
#pragma unroll
      for (int r = 0; r < 16; ++r) t[r] = src[(size_t)(row0 + i * 32 + ROW_OF(r)) * 1024 + col];
#pragma unroll
      for (int r = 0; r < 16; ++r) dst[(size_t)(row0 + i * 32 + ROW_OF(r)) * 1024 + col] = t[r] + mg * acc[i][j][r];
    }
  }
}
__device__ __forceinline__ void f1_tile(const Params& P, const Cx& X, int t, int mtiles, char* smem) {
  const int lane = X.tid & 63, w = X.tid >> 6;
  const int mt = t % mtiles, nt = t / mtiles;
  const int m0 = mt * 128, n0 = nt * 256;
  f32x16 acc[2][4];
  GemmW::zero(acc);
  GemmW::run(X, (const bf16_t*)(X.ws + OFF_HBUF) + (size_t)m0 * 1024, 1024, (const bf16_t*)(X.ws + OFF_WFFN) + WF_IN + (size_t)n0 * 1024, 1024, 1024, smem, acc);
  bf16_t* act = (bf16_t*)(X.ws + OFF_ACT);
  const int row0 = m0 + (w >> 1) * 64;
#pragma unroll
  for (int jp = 0; jp < 2; ++jp) {
    const int hid = ((n0 + (w & 1) * 128 + jp * 64) >> 6) * 32 + (lane & 31);
#pragma unroll
    for (int i = 0; i < 2; ++i)
#pragma unroll
      for (int r = 0; r < 16; ++r) {
        float g = acc[i][2 * jp][r], u = acc[i][2 * jp + 1][r];
        act[(size_t)(row0 + i * 32 + ROW_OF(r)) * 2816 + hid] = f2bf(g / (1.f + __expf(-g)) * u);
      }
  }
}
__device__ __forceinline__ void f2_tile(const Params& P, const Cx& X, int layer, int t, int mtiles, char* smem) {
  const int lane = X.tid & 63, w = X.tid >> 6;
  const int mt = t % mtiles, nt = t / mtiles;
  const int m0 = mt * 128, n0 = nt * 128;
  f32x16 acc[2][2];
  G22::zero(acc);
  G22::run(X, (const bf16_t*)(X.ws + OFF_ACT) + (size_t)m0 * 2816, 2816, (const bf16_t*)(X.ws + OFF_WFFN) + WF_OUT + (size_t)n0 * 2816, 2816, 2816, smem, acc);
  const int row0 = m0 + (w >> 1) * 64, col0 = n0 + (w & 1) * 64;
  const float* modv = (const float*)(X.ws + OFF_MOD) + (size_t)(layer * 5 + mod_row(m0)) * 6144 + 5120;
  float* dst = (m0 < NX) ? X.out : (float*)(X.ws + OFF_CS) - (size_t)NX * 1024;
#pragma unroll
  for (int j = 0; j < 2; ++j) {
    const int col = col0 + j * 32 + (lane & 31);
    const float mg = modv[col];
#pragma unroll
    for (int i = 0; i < 2; ++i) {
      float t[16];
#pragma unroll
      for (int r = 0; r < 16; ++r) t[r] = dst[(size_t)(row0 + i * 32 + ROW_OF(r)) * 1024 + col];
#pragma unroll
      for (int r = 0; r < 16; ++r) dst[(size_t)(row0 + i * 32 + ROW_OF(r)) * 1024 + col] = t[r] + mg * acc[i][j][r];
    }
  }
}

__device__ __forceinline__ void run_p(const Params& P, const Cx& X, int layer, int p, char* smem) {
  const int G = gridDim.x, B = blockIdx.x;
  if (p < 0) {
    if (!PON(14)) return;
    for (int j = B; j < 192 + 55 + NCW1; j += G) {
      if (j < 192) job_mod(P, fresh(X), smem, j);
      else if (j < 247) job_tables(P, fresh(X), j - 192);
      else cw_mixer_job(P, fresh(X), 0, j - 247, smem);
    }
    return;
  }
  const int mtiles = layer == 0 ? 136 : 128;
  switch (p) {
    case 0: if (!PON(0)) break;
      if (layer == 0) { for (int j = B; j < 2176; j += G) norm_job(P, fresh(X), layer, 0, j); }
      else { for (int j = B; j < NCW1 + 2176; j += G) { if (j < NCW1) cw_mixer_job(P, fresh(X), layer, j, smem); else norm_job(P, fresh(X), layer, 0, j - NCW1); } }
      break;
    case 1: if (!PON(1)) break; for (int j = B; j < 136 * 15; j += G) g1a_tile(P, fresh(X), j, smem); break;
    case 2: if (!PON(2)) break; for (int j = B; j < NTOK / 8; j += G) r1a_job(P, fresh(X), layer, j); break;
    case 3: if (!PON(3)) break; for (int j = B; j < 136 * 20; j += G) r1b_tile(P, fresh(X), layer, j, smem); break;
    case 4: if (!PON(4)) break; {
      volatile int* sflag = (volatile int*)(smem + LDS_BYTES - 32);
      if (sflag[0]) {
        unsigned* ctr = (unsigned*)(X.ws + OFF_TICK) + 2048 + layer * 64 + sflag[2] * 8;
        for (;;) {
          __syncthreads();
          if (X.tid == 0) sflag[1] = (int)atomicAdd(ctr, 1u);
          __syncthreads();
          const int j = sflag[1];
          if (j >= 256) break;
          scan_job(P, fresh(X), layer, j, smem);
        }
      }
    } break;
    case 5: if (!PON(5)) break; for (int j = B; j < 4352; j += G) s2_job(P, fresh(X), layer, j); break;
    case 6: if (!PON(6)) break; for (int j = B; j < 136 * 9; j += G) g1b_tile(P, fresh(X), j, smem); break;
    case 7: if (!PON(7)) break;
      for (int j = B; j < 2176 + 1024; j += G) {
        if (j < 1088) q1_kv_tile(P, fresh(X), layer, j, smem);
        else if (j < 2176) { if (layer == 0 || (j - 1088) % 136 < 128) q1_q_tile(P, fresh(X), layer, j - 1088, smem); }
        else fft1_tile(P, fresh(X), j - 2176, smem);
      }
      break;
    case 8: if (!PON(8)) break; {
      const int nctx = layer == 0 ? 64 : 0;
      for (int j = B; j < 1024 + 1024 + 2 * nctx; j += G) {
        const bool isc = (j >= 2048 && j < 2048 + nctx);
        if (j < 1024 || isc) attn_item(P, fresh(X), isc ? j - 2048 : j, isc, smem);
        else if (j < 2048) fft2_tile(P, fresh(X), j - 1024, smem);
        else ctxdft_tile(P, fresh(X), j - 2048 - nctx, smem);
      }
    } break;
    case 9: if (!PON(9)) break; for (int j = B; j < mtiles * 8; j += G) mg_tile(P, fresh(X), j, mtiles, smem); break;
    case 10: if (!PON(10)) break;
      for (int j = B; j < mtiles * 8 + NCW2; j += G) { if (j < mtiles * 8) wo_tile(P, fresh(X), layer, j, mtiles, smem); else cw_ffn_job(P, fresh(X), layer, j - mtiles * 8, smem); }
      break;
    case 11: if (!PON(11)) break; for (int j = B; j < mtiles * 16; j += G) norm_job(P, fresh(X), layer, 1, j); break;
    case 12: if (!PON(12)) break; for (int j = B; j < mtiles * 22; j += G) f1_tile(P, fresh(X), j, mtiles, smem); break;
    case 13: if (!PON(13)) break; for (int j = B; j < mtiles * 8; j += G) f2_tile(P, fresh(X), layer, j, mtiles, smem); break;
  }
}

#if SINGLE
__global__ void __launch_bounds__(256, 2) fwd_kernel(Params P, int ph_lo, int ph_hi, int use_sync) {
  extern __shared__ __attribute__((aligned(16))) char smem[];
  volatile LAS unsigned* xst = (volatile LAS unsigned*)(smem + LDS_BYTES - 16);
  if (threadIdx.x == 0) { xst[0] = 0u; xst[1] = 0u; }
  __syncthreads();
  XcdBarrier xb = xcd_barrier_post((unsigned*)(P.ws + OFF_BAR), xst);
  if (threadIdx.x == 0) {
    const unsigned hwid = (unsigned)__builtin_amdgcn_s_getreg((31 << 11) | 4);
    const unsigned slot = ((xb_xcc_id() * 8u + ((hwid >> 13) & 7u)) * 2u + ((hwid >> 12) & 1u)) * 16u + ((hwid >> 8) & 15u);
    const unsigned t = atomicAdd((unsigned*)(P.ws + OFF_TICK) + slot, 1u);
    *(volatile int*)(smem + LDS_BYTES - 32) = (t == 0u) ? 1 : 0;
    *(volatile int*)(smem + LDS_BYTES - 24) = 0;
  }
  __syncthreads();
#pragma unroll 1
  for (int ph = ph_lo; ph < ph_hi; ++ph) {
    char* ws = P.ws; float* out = P.out; int tid = threadIdx.x;
    asm volatile("" : "+v"(tid));
    const Cx X{ws, out, tid};
    if (ph == 0) run_p(P, X, 0, -1, smem);
    else {
      run_p(P, X, (ph - 1) / 14, (ph - 1) % 14, smem);
      if (PROBE_P >= 0 && (ph - 1) % 14 == PROBE_P) {
#pragma unroll 1
        for (int rep = 0; rep < PROBE_N; ++rep) { xcd_barrier(xb); if (threadIdx.x == 0) *(volatile int*)(smem + LDS_BYTES - 24) = rep + 1; __syncthreads(); run_p(P, X, (ph - 1) / 14, PROBE_P, smem); }
        if (threadIdx.x == 0) *(volatile int*)(smem + LDS_BYTES - 24) = 0;
        __syncthreads();
      }
    }
    if (use_sync && ph + 1 < ph_hi) { if (use_sync == 2) cg::this_grid().sync(); else xcd_barrier(xb); }
  }
}

#else
template <int PP>
__global__ void __launch_bounds__(256) phase_kernel(Params P, int layer) {
  extern __shared__ __attribute__((aligned(16))) char smem[];
  const Cx X{P.ws, P.out, (int)threadIdx.x};
  run_p(P, X, layer, PP, smem);
}
#endif

extern "C" void kernel_launch(void* const* d_in, const int* in_sizes, int n_in, void* d_out, int out_size, void* d_ws,
                              size_t ws_size, hipStream_t stream) {
  static int grid = 0;
  if (grid == 0) {
    if (n_in != 33 || ws_size < OFF_END) { fprintf(stderr, "kernel_launch: unexpected n_in %d / ws_size %zu (need %zu)\n", n_in, ws_size, (size_t)OFF_END); grid = -1; return; }
    int dev = 0, cus = 0, per_cu = 0;
    hipGetDevice(&dev);
    hipDeviceGetAttribute(&cus, hipDeviceAttributeMultiprocessorCount, dev);
#if SINGLE
    hipFuncSetAttribute((const void*)fwd_kernel, hipFuncAttributeMaxDynamicSharedMemorySize, LDS_BYTES);
    hipOccupancyMaxActiveBlocksPerMultiprocessor(&per_cu, (const void*)fwd_kernel, 256, LDS_BYTES);
#else
#define SA(pp) hipFuncSetAttribute((const void*)phase_kernel<pp>, hipFuncAttributeMaxDynamicSharedMemorySize, LDS_BYTES)
    SA(-1); SA(0); SA(1); SA(2); SA(3); SA(4); SA(5); SA(6); SA(7); SA(8); SA(9); SA(10); SA(11); SA(12); SA(13);
    per_cu = 2;
#endif
    if (per_cu < 1) { fprintf(stderr, "kernel_launch: occupancy query returned %d\n", per_cu); grid = -1; return; }
    if (per_cu > 2) per_cu = 2;
    grid = cus * per_cu;
  }
  if (grid < 0) return;
  if (hipMemsetAsync((char*)d_ws + OFF_BAR, 0, 32768, stream) != hipSuccess) { fprintf(stderr, "kernel_launch: memset failed\n"); return; }
  Params P{};
  for (int i = 0; i < 33; ++i) P.in[i] = (const float*)d_in[i];
  P.out = (float*)d_out;
  P.ws = (char*)d_ws;
#if SINGLE
  int lo = 0, hi = NPH, us = 1;
  void* args[] = {&P, &lo, &hi, &us};
  hipError_t e = hipLaunchCooperativeKernel((const void*)fwd_kernel, dim3(grid), dim3(256), args, LDS_BYTES, stream);
  if (e != hipSuccess) fprintf(stderr, "cooperative launch failed: %s (grid %d)\n", hipGetErrorString(e), grid);
#else
#define LP(pp, ly) hipLaunchKernelGGL(phase_kernel<pp>, dim3(grid), dim3(256), LDS_BYTES, stream, P, ly)
  LP(-1, 0);
  for (int ly = 0; ly < 2; ++ly) {
    LP(0, ly); LP(1, ly); LP(2, ly); LP(3, ly); LP(4, ly); LP(5, ly); LP(6, ly); LP(7, ly); LP(8, ly); LP(9, ly); LP(10, ly); LP(11, ly); LP(12, ly); LP(13, ly);
  }
#endif
}
```

```cpp
#include <hip/hip_runtime.h>
#include <hip/hip_cooperative_groups.h>
#include <stdint.h>
#include <stdio.h>
namespace cg = cooperative_groups;

#ifndef SINGLE
#define SINGLE 1
#endif

#ifndef ONLYP
#define ONLYP -1
#endif
#define PON(x) (ONLYP < 0 || ONLYP == (x))

typedef unsigned short bf16_t;
typedef __attribute__((ext_vector_type(8))) short bf16x8;
typedef __attribute__((ext_vector_type(16))) float f32x16;
typedef __attribute__((ext_vector_type(4))) unsigned int u32x4;

#define NX 16384
#define NCX 1024
#define NTOK 17408
#define NPH 29
#ifndef PROBE_P
#define PROBE_P -1
#endif
#define PROBE_N 2
#define LDS_BYTES 77824

static constexpr size_t UU = 17825792ull;
static constexpr size_t OFF_HBUF = 0;
static constexpr size_t OFF_RKV = 2 * UU;
static constexpr size_t OFF_KK = 5 * UU;
static constexpr size_t OFF_ZR = 6 * UU;
static constexpr size_t OFF_LORA = 12 * UU + UU / 4;
static constexpr size_t OFF_LD = 6 * UU;
static constexpr size_t OFF_A = 8 * UU;
static constexpr size_t OFF_G = 10 * UU;
static constexpr size_t OFF_YF = 11 * UU;
static constexpr size_t OFF_YB = 12 * UU;
static constexpr size_t OFF_RWO = 5 * UU;
static constexpr size_t OFF_ZF = 2 * UU;
static constexpr size_t OFF_ZM = 3 * UU;
static constexpr size_t OFF_Q = 6 * UU;
static constexpr size_t OFF_K = 7 * UU + UU / 2;
static constexpr size_t OFF_VT = 9 * UU;
static constexpr size_t OFF_FFT1 = 10 * UU;
static constexpr size_t OFF_ATT = 12 * UU;
static constexpr size_t OFF_Y = 3 * UU;
static constexpr size_t OFF_M = 6 * UU;
static constexpr size_t OFF_ACT = 2 * UU;
static constexpr size_t OFF_WFFN = 9 * UU;
static constexpr size_t OFF_WMIX = 13 * UU;
static constexpr size_t WE_IN = 0;
static constexpr size_t WE_W2 = WE_IN + 6048ull * 1024;
static constexpr size_t WE_A2 = WE_W2 + 65536;
static constexpr size_t WE_G2 = WE_A2 + 65536;
static constexpr size_t WE_RO = WE_G2 + 65536;
static constexpr size_t WE_MO = WE_RO + 524288;
static constexpr size_t WE_FO = WE_MO + 524288;
static constexpr size_t WE_UQ = WE_FO + 1048576;
static constexpr size_t WE_UKV = WE_UQ + 294912;
static constexpr size_t WE_OUT = WE_UKV + 131072;
static constexpr size_t WE_END = WE_OUT + 1048576;
static constexpr size_t WF_IN = 0;
static constexpr size_t WF_OUT = 5632ull * 1024;
static constexpr size_t OFF_SMALL = OFF_WMIX + WE_END * 2;
static constexpr size_t OFF_CS = OFF_SMALL;
static constexpr size_t OFF_MOD = OFF_CS + 4194304;
static constexpr size_t OFF_TW = OFF_MOD + 245760;
static constexpr size_t OFF_F1 = OFF_TW + 32768;
static constexpr size_t OFF_F2 = OFF_F1 + 16384;
static constexpr size_t OFF_F256 = OFF_F2 + 32768;
static constexpr size_t OFF_ROPE = OFF_F256 + 262144;
static constexpr size_t OFF_BAR = OFF_ROPE + 524288;
static constexpr size_t OFF_TICK = OFF_BAR + 16384;
static constexpr size_t OFF_END = OFF_TICK + 16384;

struct Cx {
  char* ws;
  float* out;
  int tid;
};

struct Params {
  const float* in[33];
  float* out;
  char* ws;
};

__device__ __forceinline__ float bf2f(bf16_t v) { return __uint_as_float(((uint32_t)v) << 16); }
typedef __bf16 bf16v2_t __attribute__((ext_vector_type(2)));
typedef float f32v2_t __attribute__((ext_vector_type(2)));
__device__ __forceinline__ uint32_t pack2(float a, float b) {
  f32v2_t v; v[0] = a; v[1] = b;
  return __builtin_bit_cast(uint32_t, __builtin_convertvector(v, bf16v2_t));
}
__device__ __forceinline__ bf16_t f2bf(float f) { return (bf16_t)(pack2(f, 0.f) & 0xffffu); }
__device__ __forceinline__ float lo16(uint32_t u) { return __uint_as_float(u << 16); }
__device__ __forceinline__ float hi16(uint32_t u) { return __uint_as_float(u & 0xffff0000u); }
__device__ __forceinline__ float sigmoidf_(float v) { return 1.f / (1.f + __expf(-v)); }
__device__ __forceinline__ int mod_row(int row) { return row < NX ? (row >> 12) : 4; }

__device__ __forceinline__ Cx fresh(const Cx& X) {
  int t = X.tid;
  asm volatile("" : "+v"(t));
  return Cx{X.ws, X.out, t};
}

#define XB_TMO      128
#define XB_XCNT(j)  (256  + 64 * (j))
#define XB_XSUB(j)  (1280 + 64 * (j))
#define XB_XGEN(j)  (2304 + 64 * (j))
#define XB_TOP      3328
#define XB_TOPGEN   3392
#define XCD_BAR_WORDS 3456
#define XB_SPIN_CAP (1u << 18)
#define LAS __attribute__((address_space(3)))

__device__ __forceinline__ unsigned xb_ld(unsigned* p)              { return __hip_atomic_load(p, __ATOMIC_RELAXED, __HIP_MEMORY_SCOPE_AGENT); }
__device__ __forceinline__ unsigned xb_add(unsigned* p, unsigned v) { return __hip_atomic_fetch_add(p, v, __ATOMIC_RELAXED, __HIP_MEMORY_SCOPE_AGENT); }
__device__ __forceinline__ unsigned xb_xcc_id() { return (unsigned)__builtin_amdgcn_s_getreg((3 << 11) | 20) & 0xFu; }
#define XB_SPIN(cond, bar) do { unsigned _sp = 0; while (cond) { __builtin_amdgcn_s_sleep(1); \
    if ((++_sp & 255u) == 0u) { if (xb_ld(&(bar)[XB_TMO])) break; if (_sp > XB_SPIN_CAP) { atomicAdd(&(bar)[XB_TMO], 1u); break; } } } } while (0)

struct XcdBarrier {
    unsigned* bar; unsigned x;
    volatile LAS unsigned* st;
};

__device__ __forceinline__ XcdBarrier xcd_barrier_post(unsigned* bar, volatile LAS unsigned* st) {
    XcdBarrier b; b.bar = bar; b.x = xb_xcc_id(); b.st = st;
    if (threadIdx.x == 0) (void)xb_add(&bar[XB_XCNT(b.x)], 1u);
    return b;
}
__device__ __forceinline__ void xcd_barrier_complete(unsigned* bar, unsigned x, unsigned& nloc, unsigned& nx) {
    const unsigned G = gridDim.x * gridDim.y * gridDim.z;
    unsigned sum, cnt, mine, sp = 0u;
    for (;;) {
        sum = 0u; cnt = 0u; mine = 0u;
#pragma unroll
        for (unsigned j = 0; j < 16; ++j) { const unsigned c = xb_ld(&bar[XB_XCNT(j)]); sum += c; cnt += (c > 0u) ? 1u : 0u; mine = (j == x) ? c : mine; }
        if (sum == G) break;
        __builtin_amdgcn_s_sleep(1);
        if ((++sp & 255u) == 0u) { if (xb_ld(&bar[XB_TMO])) break; if (sp > XB_SPIN_CAP) { atomicAdd(&bar[XB_TMO], 1u); break; } }
    }
    nloc = mine > 0u ? mine : 1u; nx = cnt > 0u ? cnt : 1u;
}

__device__ __forceinline__ void xcd_barrier(const XcdBarrier& b) {
    asm volatile("s_waitcnt vmcnt(0)" ::: "memory");
    __syncthreads();
    if (threadIdx.x == 0) {
        unsigned* bar = b.bar;
        __builtin_amdgcn_s_waitcnt(0);
        unsigned nloc = b.st[0], nx = b.st[1];
        if (nloc == 0u) { xcd_barrier_complete(bar, b.x, nloc, nx); b.st[0] = nloc; b.st[1] = nx; }
        const unsigned old = xb_add(&bar[XB_XSUB(b.x)], 1u);
        const unsigned gen = old / nloc;
        if (old + 1u == (gen + 1u) * nloc) {
            __builtin_amdgcn_fence(__ATOMIC_RELEASE, "agent");
            asm volatile("s_waitcnt vmcnt(0)" ::: "memory");
            const unsigned og = xb_add(&bar[XB_TOP], 1u);
            const unsigned tg = og / nx;
            if (og + 1u == (tg + 1u) * nx) xb_add(&bar[XB_TOPGEN], 1u);
            else XB_SPIN(xb_ld(&bar[XB_TOPGEN]) == tg, bar);
            __builtin_amdgcn_fence(__ATOMIC_ACQUIRE, "agent");
            xb_add(&bar[XB_XGEN(b.x)], 1u);
            asm volatile("s_waitcnt vmcnt(0)" ::: "memory");
        } else {
            XB_SPIN(xb_ld(&bar[XB_XGEN(b.x)]) == gen, bar);
            __builtin_amdgcn_fence(__ATOMIC_ACQUIRE, "agent");
            asm volatile("s_waitcnt vmcnt(0)" ::: "memory");
        }
    }
    __syncthreads();
}


template <int BM, int BN, int WGM, int WGN, bool TRB>
struct Gemm {
  static constexpr int WM = BM / WGM, WN = BN / WGN, MT = WM / 32, NTL = WN / 32;
  static constexpr int CA = BM * 8 / 256, CB = BN * 8 / 256;
  static constexpr int SA_ELEMS = BM * 72, SB_ELEMS = BN * 72;

  __device__ static __forceinline__ void zero(f32x16 (&acc)[MT][NTL]) {
#pragma unroll
    for (int i = 0; i < MT; ++i)
#pragma unroll
      for (int j = 0; j < NTL; ++j)
#pragma unroll
        for (int r = 0; r < 16; ++r) acc[i][j][r] = 0.f;
  }

  __device__ static __forceinline__ void run(const Cx& X, const bf16_t* __restrict__ A, int lda, const bf16_t* __restrict__ B, int ldb,
                                             int K, char* smem, f32x16 (&acc)[MT][NTL]) {
    const int tid = X.tid, lane = tid & 63, w = tid >> 6;
    const int wm = w / WGN, wn = w % WGN;
    bf16_t* sA = (bf16_t*)smem;
    bf16_t* sB = sA + 2 * SA_ELEMS;
    uint4 ra0, ra1, ra2, ra3, rb0, rb1, rb2 = make_uint4(0, 0, 0, 0), rb3 = make_uint4(0, 0, 0, 0);
    uint4 qa0, qa1, qa2, qa3, qb0, qb1, qb2 = make_uint4(0, 0, 0, 0), qb3 = make_uint4(0, 0, 0, 0);
    static_assert(CA == 4 && CB >= 2 && CB <= 4, "tile loader shape");
    const int nk = K >> 6;
#define LDA_(i, k0) (*(const uint4*)(A + (size_t)((tid + 256 * (i)) >> 3) * lda + (k0) + ((tid + 256 * (i)) & 7) * 8))
#define LDB_(i, k0)                                                                                                        \
  (!TRB ? *(const uint4*)(B + (size_t)((tid + 256 * (i)) >> 3) * ldb + (k0) + ((tid + 256 * (i)) & 7) * 8)                 \
        : *(const uint4*)(B + (size_t)((k0) + (tid + 256 * (i)) / (BN / 8)) * ldb + ((tid + 256 * (i)) % (BN / 8)) * 8))
#define GLOAD(R, k0)                                                                           \
  {                                                                                            \
    R##a0 = LDA_(0, k0); R##a1 = LDA_(1, k0); R##a2 = LDA_(2, k0); R##a3 = LDA_(3, k0);        \
    R##b0 = LDB_(0, k0); R##b1 = LDB_(1, k0);                                                  \
    if (CB > 2) R##b2 = LDB_(2, k0);                                                           \
    if (CB > 3) R##b3 = LDB_(3, k0);                                                           \
  }
#define STA_(i, buf, v) *(uint4*)(sA + (buf)*SA_ELEMS + ((tid + 256 * (i)) >> 3) * 72 + ((tid + 256 * (i)) & 7) * 8) = v
#define STB_(i, buf, v)                                                                                       \
  {                                                                                                           \
    const int c_ = tid + 256 * (i);                                                                           \
    if (!TRB) *(uint4*)(sB + (buf)*SB_ELEMS + (c_ >> 3) * 72 + (c_ & 7) * 8) = v;                             \
    else {                                                                                                    \
      bf16_t* p = sB + (buf)*SB_ELEMS + (c_ % (BN / 8)) * 8 * 72 + c_ / (BN / 8);                             \
      p[0] = (bf16_t)(v.x & 0xffff); p[72] = (bf16_t)(v.x >> 16);                                             \
      p[144] = (bf16_t)(v.y & 0xffff); p[216] = (bf16_t)(v.y >> 16);                                          \
      p[288] = (bf16_t)(v.z & 0xffff); p[360] = (bf16_t)(v.z >> 16);                                          \
      p[432] = (bf16_t)(v.w & 0xffff); p[504] = (bf16_t)(v.w >> 16);                                          \
    }                                                                                                         \
  }
#define SSTORE(R, buf)                                                                         \
  {                                                                                            \
    STA_(0, buf, R##a0); STA_(1, buf, R##a1); STA_(2, buf, R##a2); STA_(3, buf, R##a3);        \
    STB_(0, buf, R##b0); STB_(1, buf, R##b1);                                                  \
    if (CB > 2) STB_(2, buf, R##b2);                                                           \
    if (CB > 3) STB_(3, buf, R##b3);                                                           \
  }
#define COMPUTE(buf)                                                                                               \
  {                                                                                                                \
    const bf16_t* pa = sA + (buf)*SA_ELEMS + (wm * WM + (lane & 31)) * 72 + (lane >> 5) * 8;                       \
    const bf16_t* pb = sB + (buf)*SB_ELEMS + (wn * WN + (lane & 31)) * 72 + (lane >> 5) * 8;                       \
    _Pragma("unroll") for (int ks = 0; ks < 4; ++ks) {                                                             \
      bf16x8 af[MT], bfr[NTL];                                                                                     \
      _Pragma("unroll") for (int i = 0; i < MT; ++i) af[i] = *(const bf16x8*)(pa + i * 32 * 72 + ks * 16);         \
      _Pragma("unroll") for (int j = 0; j < NTL; ++j) bfr[j] = *(const bf16x8*)(pb + j * 32 * 72 + ks * 16);       \
      _Pragma("unroll") for (int i = 0; i < MT; ++i)                                                               \
        _Pragma("unroll") for (int j = 0; j < NTL; ++j)                                                            \
          acc[i][j] = __builtin_amdgcn_mfma_f32_32x32x16_bf16(af[i], bfr[j], acc[i][j], 0, 0, 0);                  \
    }                                                                                                              \
  }
    if (!TRB) {
      bf16_t* dA = sA;
      bf16_t* dB = sA + 2 * BM * 64;
#define DSTAGE(buf, k0)                                                                                              \
  {                                                                                                                  \
    _Pragma("unroll") for (int i = 0; i < CA; ++i) {                                                                 \
      const int p = tid + 256 * i, r = p >> 3, c = (p & 7) ^ ((r >> 1) & 7);                                         \
      __builtin_amdgcn_global_load_lds((const unsigned*)(A + (size_t)r * lda + (k0) + c * 8),                        \
                                       (LAS unsigned*)(dA + (buf)*BM * 64 + p * 8), 16, 0, 0);                       \
    }                                                                                                                \
    _Pragma("unroll") for (int i = 0; i < CB; ++i) {                                                                 \
      const int p = tid + 256 * i, r = p >> 3, c = (p & 7) ^ ((r >> 1) & 7);                                         \
      __builtin_amdgcn_global_load_lds((const unsigned*)(B + (size_t)r * ldb + (k0) + c * 8),                        \
                                       (LAS unsigned*)(dB + (buf)*BN * 64 + p * 8), 16, 0, 0);                       \
    }                                                                                                                \
  }
      const int swz = (lane >> 1) & 7, hh = lane >> 5;
      DSTAGE(0, 0);
      asm volatile("s_waitcnt vmcnt(0)" ::: "memory");
      __syncthreads();
#pragma unroll 1
      for (int kt = 0; kt < nk; ++kt) {
        const int buf = kt & 1;
        if (kt + 1 < nk) DSTAGE(buf ^ 1, (kt + 1) * 64);
        const bf16_t* pa = dA + buf * BM * 64 + (wm * WM + (lane & 31)) * 64;
        const bf16_t* pb = dB + buf * BN * 64 + (wn * WN + (lane & 31)) * 64;
#pragma unroll
        for (int ks = 0; ks < 4; ++ks) {
          const int co = (((ks * 2 + hh) ^ swz) * 8);
          bf16x8 af[MT], bfr[NTL];
#pragma unroll
          for (int i = 0; i < MT; ++i) af[i] = *(const bf16x8*)(pa + i * 32 * 64 + co);
#pragma unroll
          for (int j = 0; j < NTL; ++j) bfr[j] = *(const bf16x8*)(pb + j * 32 * 64 + co);
#pragma unroll
          for (int i = 0; i < MT; ++i)
#pragma unroll
            for (int j = 0; j < NTL; ++j) acc[i][j] = __builtin_amdgcn_mfma_f32_32x32x16_bf16(af[i], bfr[j], acc[i][j], 0, 0, 0);
        }
        asm volatile("s_waitcnt vmcnt(0)" ::: "memory");
        __syncthreads();
      }
#undef DSTAGE
    } else {
    GLOAD(r, 0);
    if (nk > 1) GLOAD(q, 64);
    SSTORE(r, 0);
    __syncthreads();
    for (int kt = 0; kt < nk; kt += 2) {
      if (kt + 2 < nk) GLOAD(r, (kt + 2) * 64);
      COMPUTE(0);
      if (kt + 1 < nk) SSTORE(q, 1);
      __syncthreads();
      if (kt + 1 >= nk) break;
      if (kt + 3 < nk) GLOAD(q, (kt + 3) * 64);
      COMPUTE(1);
      if (kt + 2 < nk) SSTORE(r, 0);
      __syncthreads();
    }
    }
#undef COMPUTE
#undef GLOAD
#undef SSTORE
#undef LDA_
#undef LDB_
#undef STA_
#undef STB_
  }
};

typedef Gemm<128, 128, 2, 2, false> G22;
typedef Gemm<128, 128, 2, 2, true> G22T;
typedef Gemm<128, 64, 2, 2, false> GMG;
typedef Gemm<128, 96, 4, 1, false> GQ;
typedef Gemm<128, 128, 4, 1, false> GKV;

struct GemmW {
  static constexpr int MT = 2, NTL = 4;
  __device__ static __forceinline__ void zero(f32x16 (&acc)[MT][NTL]) {
#pragma unroll
    for (int i = 0; i < MT; ++i)
#pragma unroll
      for (int j = 0; j < NTL; ++j)
#pragma unroll
        for (int r = 0; r < 16; ++r) acc[i][j][r] = 0.f;
  }
  __device__ static __forceinline__ void run(const Cx& X, const bf16_t* __restrict__ A, int lda, const bf16_t* __restrict__ B, int ldb,
                                             int K, char* smem, f32x16 (&acc)[MT][NTL]) {
    const int tid = X.tid, lane = tid & 63, w = tid >> 6;
    const int wm = w >> 1, wn = w & 1;
    bf16_t* dA = (bf16_t*)smem;
    bf16_t* dB = dA + 3 * 128 * 32;
    const int nk = K >> 5;
#define WSTAGE(buf, k0)                                                                                              \
  {                                                                                                                  \
    _Pragma("unroll") for (int i = 0; i < 2; ++i) {                                                                  \
      const int p = tid + 256 * i, r = p >> 2, c = (p & 3) ^ ((r >> 2) & 3);                                         \
      __builtin_amdgcn_global_load_lds((const unsigned*)(A + (size_t)r * lda + (k0) + c * 8),                        \
                                       (LAS unsigned*)(dA + (buf)*128 * 32 + p * 8), 16, 0, 0);                      \
    }                                                                                                                \
    _Pragma("unroll") for (int i = 0; i < 4; ++i) {                                                                  \
      const int p = tid + 256 * i, r = p >> 2, c = (p & 3) ^ ((r >> 2) & 3);                                         \
      __builtin_amdgcn_global_load_lds((const unsigned*)(B + (size_t)r * ldb + (k0) + c * 8),                        \
                                       (LAS unsigned*)(dB + (buf)*256 * 32 + p * 8), 16, 0, 0);                      \
    }                                                                                                                \
  }
    const int swz = ((lane & 31) >> 2) & 3, hh = lane >> 5;
    WSTAGE(0, 0);
    if (nk > 1) WSTAGE(1, 32);
    int buf = 0;
#pragma unroll 1
    for (int kt = 0; kt < nk; ++kt) {
      if (kt + 1 < nk) asm volatile("s_waitcnt vmcnt(6)" ::: "memory");
      else asm volatile("s_waitcnt vmcnt(0)" ::: "memory");
      __builtin_amdgcn_s_barrier();
      if (kt + 2 < nk) { const int nb = buf >= 1 ? buf - 1 : 2; WSTAGE(nb, (kt + 2) * 32); }
      const bf16_t* pa = dA + buf * 128 * 32 + (wm * 64 + (lane & 31)) * 32;
      const bf16_t* pb = dB + buf * 256 * 32 + (wn * 128 + (lane & 31)) * 32;
#pragma unroll
      for (int ks = 0; ks < 2; ++ks) {
        const int co = (((ks * 2 + hh) ^ swz) * 8);
        bf16x8 af[MT], bfr[NTL];
#pragma unroll
        for (int i = 0; i < MT; ++i) af[i] = *(const bf16x8*)(pa + i * 32 * 32 + co);
#pragma unroll
        for (int j = 0; j < NTL; ++j) bfr[j] = *(const bf16x8*)(pb + j * 32 * 32 + co);
#pragma unroll
        for (int i = 0; i < MT; ++i)
#pragma unroll
          for (int j = 0; j < NTL; ++j) acc[i][j] = __builtin_amdgcn_mfma_f32_32x32x16_bf16(af[i], bfr[j], acc[i][j], 0, 0, 0);
      }
      buf = buf == 2 ? 0 : buf + 1;
    }
    __syncthreads();
#undef WSTAGE
  }
};

#define ROW_OF(reg) (((reg) & 3) + 8 * ((reg) >> 2) + 4 * (lane >> 5))

__device__ __forceinline__ void job_mod(const Params& P, const Cx& X, char* smem, int job) {
  float* sc = (float*)smem;
  const int tid = X.tid;
  for (int i = tid; i < 5 * 1024; i += 256) {
    int r = i >> 10, k = i & 1023;
    float v = r < 4 ? P.in[1][r * 1024 + k] : P.in[3][k];
    sc[i] = v / (1.f + expf(-v));
  }
  __syncthreads();
  const int l = job / 96, n = (job % 96) * 64 + (tid & 63), w = tid >> 6;
  const float* W = P.in[4] + (size_t)l * 1024 * 6144;
  float a0 = 0, a1 = 0, a2 = 0, a3 = 0, a4 = 0;
#pragma unroll 16
  for (int k = w * 256; k < w * 256 + 256; ++k) {
    float wv = W[(size_t)k * 6144 + n];
    a0 += sc[k] * wv; a1 += sc[1024 + k] * wv; a2 += sc[2048 + k] * wv; a3 += sc[3072 + k] * wv; a4 += sc[4096 + k] * wv;
  }
  float* red = sc + 5 * 1024;
  red[(w * 5 + 0) * 64 + (tid & 63)] = a0; red[(w * 5 + 1) * 64 + (tid & 63)] = a1; red[(w * 5 + 2) * 64 + (tid & 63)] = a2;
  red[(w * 5 + 3) * 64 + (tid & 63)] = a3; red[(w * 5 + 4) * 64 + (tid & 63)] = a4;
  __syncthreads();
  float* modv = (float*)(X.ws + OFF_MOD);
  for (int i = tid; i < 320; i += 256) {
    int r = i >> 6, c = i & 63;
    int nn = (job % 96) * 64 + c;
    float s = red[(0 * 5 + r) * 64 + c] + red[(1 * 5 + r) * 64 + c] + red[(2 * 5 + r) * 64 + c] + red[(3 * 5 + r) * 64 + c];
    modv[(size_t)(l * 5 + r) * 6144 + nn] = s + P.in[5][l * 6144 + nn];
  }
  __syncthreads();
}

__device__ __forceinline__ void job_tables(const Params& P, const Cx& X, int job) {
  float2* tw = (float2*)(X.ws + OFF_TW);
  bf16_t* F1 = (bf16_t*)(X.ws + OFF_F1);
  bf16_t* F2 = (bf16_t*)(X.ws + OFF_F2);
  bf16_t* F256 = (bf16_t*)(X.ws + OFF_F256);
  float2* rope = (float2*)(X.ws + OFF_ROPE);
  for (int e = job * 4096 + X.tid; e < job * 4096 + 4096; e += 256) {
    int i = e;
    if (i < 4096) { tw[i] = make_float2(cospif(i / 2048.f), sinpif(i / 2048.f)); continue; }
    i -= 4096;
    if (i < 8192) {
      int R = i >> 6, t1 = i & 63;
      int f1 = (R >> 6) * 32 + (R & 31);
      int ph = (f1 * t1) & 63;
      F1[i] = f2bf(((R >> 5) & 1) ? -sinpif(ph / 32.f) : cospif(ph / 32.f));
      continue;
    }
    i -= 8192;
    if (i < 16384) {
      int m = i >> 7, k = i & 127;
      int f2 = m & 63, q = m >> 6, t2 = k & 63, p = k >> 6;
      int ph = (f2 * t2) & 63;
      float c = cospif(ph / 32.f), s = sinpif(ph / 32.f);
      float v = (q == 0) ? (p == 0 ? c : s) : (p == 0 ? -s : c);
      F2[i] = f2bf(v);
      continue;
    }
    i -= 16384;
    if (i < 131072) {
      int m = i >> 8, t = i & 255;
      int f = m & 255, q = m >> 8;
      int ph = (f * t) & 255;
      F256[i] = f2bf(q == 0 ? cospif(ph / 128.f) : -sinpif(ph / 128.f));
      continue;
    }
    i -= 131072;
    if (i < 65536) {
      int t = i >> 4, j = i & 15;
      float invf = powf(10000.f, -(float)(j & 7) / 8.f);
      float pos = (j < 8) ? (float)(t >> 6) : (float)(t & 63);
      float ang = pos * invf;
      rope[i] = make_float2(cosf(ang), sinf(ang));
    }
  }
}

__device__ __forceinline__ void cw_tile(const Cx& X, const float* __restrict__ src, int N, int lds_, bf16_t* __restrict__ dst, int ldd, const float* scale,
                        int perm, int tk, int tn, char* smem) {
  float* tile = (float*)smem;
  const int tid = X.tid;
  const int c = tid & 63, r0 = tid >> 6;
  const int ng = tn * 64 + c;
  float tv[16];
#pragma unroll
  for (int i = 0; i < 16; ++i) {
    int r = r0 + 4 * i;
    tv[i] = (ng < N) ? src[(size_t)(tk * 64 + r) * lds_ + ng] : 0.f;
    if (scale) tv[i] *= scale[tk * 64 + r];
  }
#pragma unroll
  for (int i = 0; i < 16; ++i) tile[(r0 + 4 * i) * 65 + c] = tv[i];
  __syncthreads();
#pragma unroll 4
  for (int i = 0; i < 16; ++i) {
    int nn = r0 + 4 * i;
    int n2 = tn * 64 + nn;
    if (n2 < N) {
      int drow = n2;
      if (perm) {
        int u = n2 < 2816 ? n2 : n2 - 2816;
        drow = (u >> 5) * 64 + (n2 < 2816 ? 0 : 32) + (u & 31);
      }
      dst[(size_t)drow * ldd + tk * 64 + c] = f2bf(tile[c * 65 + nn]);
    }
  }
  __syncthreads();
}

__device__ __forceinline__ void fold_job(const Params& P, const Cx& X, int layer, int fj, char* smem) {
  float* wt = (float*)smem;
  float* ct = wt + 4096;
  const int tid = X.tid;
  const int g = fj >> 4, n0 = (fj & 15) * 64;
  const float* src = P.in[28] + (size_t)layer * 512 * 1024;
  {
    float tw16[16];
#pragma unroll
    for (int k = 0; k < 16; ++k) { const int i = tid + 256 * k; tw16[k] = src[(size_t)(g * 64 + (i >> 6)) * 1024 + n0 + (i & 63)]; }
#pragma unroll
    for (int k = 0; k < 16; ++k) wt[tid + 256 * k] = tw16[k];
  }
  if (tid < 64) { ct[tid] = cospif(tid / 32.f); ct[64 + tid] = sinpif(tid / 32.f); }
  __syncthreads();
  bf16_t* dst = (bf16_t*)(X.ws + OFF_WMIX) + WE_FO;
  const int c = tid & 63, nq = tid >> 6;
#pragma unroll 1
  for (int ni = 0; ni < 16; ++ni) {
    int n = nq * 16 + ni;
    float sr = 0.f, si = 0.f;
#pragma unroll 4
    for (int cp = 0; cp < 64; ++cp) {
      float wv = wt[cp * 64 + n];
      int ph = (c * cp) & 63;
      sr += ct[ph] * wv;
      si += ct[64 + ph] * wv;
    }
    dst[(size_t)(n0 + n) * 1024 + g * 64 + c] = f2bf(sr * (1.f / 512.f));
    dst[(size_t)(n0 + n) * 1024 + 512 + g * 64 + c] = f2bf(si * (1.f / 512.f));
  }
  __syncthreads();
}

#define NCW1 2312
__device__ __forceinline__ void cw_mixer_job(const Params& P, const Cx& X, int layer, int j, char* smem) {
  bf16_t* W = (bf16_t*)(X.ws + OFF_WMIX);
  const float* src; const float* scale = nullptr; bf16_t* dst; int N, ldd, tk, tn;
  if (j >= 2184) { fold_job(P, X, layer, j - 2184, smem); return; }
  if (j < 1520) { src = P.in[7] + (size_t)layer * 1024 * 6048; N = 6048; dst = W + WE_IN; ldd = 1024; tk = j / 95; tn = j % 95; }
  else if (j < 1536) { j -= 1520; int d = j >> 3; src = P.in[11] + (size_t)(layer * 2 + d) * 64 * 512; N = 512; dst = W + WE_W2 + d * 32768; ldd = 64; tk = 0; tn = j & 7; }
  else if (j < 1552) { j -= 1536; int d = j >> 3; src = P.in[13] + (size_t)(layer * 2 + d) * 64 * 512; N = 512; dst = W + WE_A2 + d * 32768; ldd = 64; tk = 0; tn = j & 7; }
  else if (j < 1568) { j -= 1552; src = P.in[17] + (size_t)layer * 128 * 512; N = 512; dst = W + WE_G2; ldd = 128; tk = j >> 3; tn = j & 7; }
  else if (j < 1696) { j -= 1568; src = P.in[20] + (size_t)layer * 512 * 1024; N = 1024; dst = W + WE_RO; ldd = 512; tk = j >> 4; tn = j & 15; }
  else if (j < 1824) { j -= 1696; src = P.in[27] + (size_t)layer * 512 * 1024; N = 1024; dst = W + WE_MO; ldd = 512; tk = j >> 4; tn = j & 15; }
  else if (j < 1896) { j -= 1824; src = P.in[23] + (size_t)layer * 384 * 768; N = 768; dst = W + WE_UQ; ldd = 384; scale = P.in[21] + layer * 384; tk = j / 12; tn = j % 12; }
  else if (j < 1928) { j -= 1896; src = P.in[24] + (size_t)layer * 128 * 1024; N = 1024; dst = W + WE_UKV; ldd = 128; scale = P.in[22] + layer * 128; tk = j >> 4; tn = j & 15; }
  else { j -= 1928; src = P.in[29] + (size_t)layer * 1024 * 1024; N = 1024; dst = W + WE_OUT; ldd = 1024; tk = j >> 4; tn = j & 15; }
  cw_tile(X, src, N, N, dst, ldd, scale, 0, tk, tn, smem);
}
#define NCW2 2112
__device__ __forceinline__ void cw_ffn_job(const Params& P, const Cx& X, int layer, int j, char* smem) {
  bf16_t* W = (bf16_t*)(X.ws + OFF_WFFN);
  const float* src; bf16_t* dst; int N, ldd, tk, tn, perm;
  if (j < 1408) { src = P.in[31] + (size_t)layer * 1024 * 5632; N = 5632; dst = W + WF_IN; ldd = 1024; perm = 1; tk = j / 88; tn = j % 88; }
  else { j -= 1408; src = P.in[32] + (size_t)layer * 2816 * 1024; N = 1024; dst = W + WF_OUT; ldd = 2816; perm = 0; tk = j >> 4; tn = j & 15; }
  cw_tile(X, src, N, N, dst, ldd, nullptr, perm, tk, tn, smem);
}

__device__ __forceinline__ void norm_job(const Params& P, const Cx& X, int layer, int which, int job) {
  const int lane = X.tid & 63, w = X.tid >> 6;
  const int rowa = job * 8 + w * 2;
  const float* g = (which == 0 ? P.in[6] : P.in[30]) + layer * 1024;
  float4 v[2][4];
#pragma unroll
  for (int q = 0; q < 2; ++q) {
    const int row = rowa + q;
    const float* src;
    if (which == 0) {
      if (row < NX) src = (layer == 0 ? P.in[0] : X.out) + (size_t)row * 1024;
      else src = (layer == 0 ? P.in[2] : (const float*)(X.ws + OFF_CS)) + (size_t)(row - NX) * 1024;
    } else {
      if (row < NX) src = X.out + (size_t)row * 1024;
      else src = (const float*)(X.ws + OFF_CS) + (size_t)(row - NX) * 1024;
    }
#pragma unroll
    for (int i = 0; i < 4; ++i) v[q][i] = ((const float4*)src)[lane + 64 * i];
  }
#pragma unroll
  for (int q = 0; q < 2; ++q) {
    const int row = rowa + q;
    const float* modv = (const float*)(X.ws + OFF_MOD) + (size_t)(layer * 5 + mod_row(row)) * 6144;
    const float* shift = modv + (which == 0 ? 0 : 3072);
    const float* scale = modv + (which == 0 ? 1024 : 4096);
    float ss = 0.f;
#pragma unroll
    for (int i = 0; i < 4; ++i) ss += v[q][i].x * v[q][i].x + v[q][i].y * v[q][i].y + v[q][i].z * v[q][i].z + v[q][i].w * v[q][i].w;
#pragma unroll
    for (int o = 32; o >= 1; o >>= 1) ss += __shfl_xor(ss, o);
    const float rstd = rsqrtf(ss * (1.f / 1024.f) + 1e-6f);
    bf16_t* dst = (bf16_t*)(X.ws + OFF_HBUF) + (size_t)row * 1024;
#pragma unroll
    for (int i = 0; i < 4; ++i) {
      int col = 4 * (lane + 64 * i);
      float4 gg = *(const float4*)(g + col), sh = *(const float4*)(shift + col), sc = *(const float4*)(scale + col);
      float y0 = v[q][i].x * rstd * gg.x * (1.f + sc.x) + sh.x;
      float y1 = v[q][i].y * rstd * gg.y * (1.f + sc.y) + sh.y;
      float y2 = v[q][i].z * rstd * gg.z * (1.f + sc.z) + sh.z;
      float y3 = v[q][i].w * rstd * gg.w * (1.f + sc.w) + sh.w;
      uint2 o;
      o.x = pack2(y0, y1); o.y = pack2(y2, y3);
      *(uint2*)(dst + col) = o;
    }
  }
}

__device__ __forceinline__ void g1a_tile(const Params& P, const Cx& X, int t, char* smem) {
  const int lane = X.tid & 63, w = X.tid >> 6;
  const int mt = t % 136, nt = t / 136;
  const int m0 = mt * 128, n0 = nt * 128;
  f32x16 acc[2][2];
  G22::zero(acc);
  G22::run(X, (const bf16_t*)(X.ws + OFF_HBUF) + (size_t)m0 * 1024, 1024, (const bf16_t*)(X.ws + OFF_WMIX) + WE_IN + (size_t)n0 * 1024, 1024, 1024, smem, acc);
  bf16_t* zr = (bf16_t*)(X.ws + OFF_ZR);
  const int row0 = m0 + (w >> 1) * 64, col0 = n0 + (w & 1) * 64;
#pragma unroll
  for (int i = 0; i < 2; ++i)
#pragma unroll
    for (int j = 0; j < 2; ++j)
#pragma unroll
      for (int r = 0; r < 16; ++r) {
        int row = row0 + i * 32 + ROW_OF(r), col = col0 + j * 32 + (lane & 31);
        zr[(size_t)row * 1920 + col] = f2bf(acc[i][j][r]);
      }
}
__device__ __forceinline__ void g1b_tile(const Params& P, const Cx& X, int t, char* smem) {
  const int lane = X.tid & 63, w = X.tid >> 6;
  const int mt = t % 136, nt = t / 136;
  const int m0 = mt * 128, n0 = nt * 128;
  f32x16 acc[2][2];
  G22::zero(acc);
  G22::run(X, (const bf16_t*)(X.ws + OFF_HBUF) + (size_t)m0 * 1024, 1024, (const bf16_t*)(X.ws + OFF_WMIX) + WE_IN + (size_t)(1920 + n0) * 1024, 1024, 1024, smem, acc);
  bf16_t* zm = (bf16_t*)(X.ws + OFF_ZM);
  bf16_t* zf = (bf16_t*)(X.ws + OFF_ZF);
  const int row0 = m0 + (w >> 1) * 64, col0 = n0 + (w & 1) * 64;
#pragma unroll
  for (int i = 0; i < 2; ++i)
#pragma unroll
    for (int j = 0; j < 2; ++j)
#pragma unroll
      for (int r = 0; r < 16; ++r) {
        int row = row0 + i * 32 + ROW_OF(r), col = col0 + j * 32 + (lane & 31);
        bf16_t v = f2bf(acc[i][j][r]);
        if (col < 544) zm[(size_t)row * 544 + col] = v;
        else if (col < 1056) zf[(size_t)row * 512 + (col - 544)] = v;
      }
}

__device__ __forceinline__ void r1a_job(const Params& P, const Cx& X, int layer, int job) {
  const int tid = X.tid;
  const int ch = tid < 240 ? tid : 239;
  const int col0 = ch * 8;
  const bf16_t* zr = (const bf16_t*)(X.ws + OFF_ZR);
  const int rowb = job * 8;
  int pos, len;
  if (rowb < NX) { pos = rowb & 4095; len = 4096; } else { pos = (rowb - NX) & 255; len = 256; }
  const bool isk = (col0 >= 512 && col0 < 1024);
  float mup[8], mun[8], kkw[8];
  {
    const float4 a0 = *(const float4*)(P.in[8] + layer * 1920 + col0), a1 = *(const float4*)(P.in[8] + layer * 1920 + col0 + 4);
    const float4 b0 = *(const float4*)(P.in[9] + layer * 1920 + col0), b1 = *(const float4*)(P.in[9] + layer * 1920 + col0 + 4);
    const float* kp = P.in[14] + layer * 512 + (isk ? col0 - 512 : 0);
    const float4 c0 = *(const float4*)kp, c1 = *(const float4*)(kp + 4);
    mup[0] = a0.x; mup[1] = a0.y; mup[2] = a0.z; mup[3] = a0.w; mup[4] = a1.x; mup[5] = a1.y; mup[6] = a1.z; mup[7] = a1.w;
    mun[0] = b0.x; mun[1] = b0.y; mun[2] = b0.z; mun[3] = b0.w; mun[4] = b1.x; mun[5] = b1.y; mun[6] = b1.z; mun[7] = b1.w;
    kkw[0] = c0.x; kkw[1] = c0.y; kkw[2] = c0.z; kkw[3] = c0.w; kkw[4] = c1.x; kkw[5] = c1.y; kkw[6] = c1.z; kkw[7] = c1.w;
  }
  uint4 zw[10];
#pragma unroll
  for (int i = 0; i < 10; ++i) {
    const int pp = pos - 1 + i;
    zw[i] = make_uint4(0, 0, 0, 0);
    if (pp >= 0 && pp < len) zw[i] = *(const uint4*)(zr + (size_t)(rowb - 1 + i) * 1920 + col0);
  }
#pragma unroll
  for (int i8 = 0; i8 < 8; ++i8) {
    const int row = rowb + i8;
    const uint4 zp = zw[i8], zc = zw[i8 + 1], zn = zw[i8 + 2];
    float zs[8];
    {
      const uint32_t c4[4] = {zc.x, zc.y, zc.z, zc.w}, p4[4] = {zp.x, zp.y, zp.z, zp.w}, n4[4] = {zn.x, zn.y, zn.z, zn.w};
#pragma unroll
      for (int i = 0; i < 4; ++i) {
        float c0 = lo16(c4[i]), c1 = hi16(c4[i]);
        zs[2 * i] = c0 + (lo16(p4[i]) - c0) * mup[2 * i] + (lo16(n4[i]) - c0) * mun[2 * i];
        zs[2 * i + 1] = c1 + (hi16(p4[i]) - c1) * mup[2 * i + 1] + (hi16(n4[i]) - c1) * mun[2 * i + 1];
      }
    }
    if (tid < 240) {
      uint4 o;
      if (col0 < 1536) {
        o.x = pack2(zs[0], zs[1]); o.y = pack2(zs[2], zs[3]); o.z = pack2(zs[4], zs[5]); o.w = pack2(zs[6], zs[7]);
        *(uint4*)((bf16_t*)(X.ws + OFF_RKV) + (size_t)row * 1536 + col0) = o;
      } else {
        float t[8];
        if (col0 < 1664) {
#pragma unroll
          for (int i = 0; i < 8; ++i) t[i] = 1.f - 2.f / (1.f + __expf(2.f * zs[i]));
        } else if (col0 < 1792) {
#pragma unroll
          for (int i = 0; i < 8; ++i) t[i] = zs[i];
        } else {
#pragma unroll
          for (int i = 0; i < 8; ++i) t[i] = 1.f / (1.f + __expf(-zs[i]));
        }
        o.x = pack2(t[0], t[1]); o.y = pack2(t[2], t[3]); o.z = pack2(t[4], t[5]); o.w = pack2(t[6], t[7]);
        *(uint4*)((bf16_t*)(X.ws + OFF_LORA) + (size_t)row * 384 + (col0 - 1536)) = o;
      }
    }
  }
}

__device__ __forceinline__ void r1b_tile(const Params& P, const Cx& X, int layer, int t, char* smem) {
  const int lane = X.tid & 63, w = X.tid >> 6;
  const int mt = t % 136, rest = t / 136;
  const int nt = rest & 3, type = rest >> 2;
  const int m0 = mt * 128, n0 = nt * 128;
  const bf16_t* lora = (const bf16_t*)(X.ws + OFF_LORA) + (size_t)m0 * 384;
  const bf16_t* W = (const bf16_t*)(X.ws + OFF_WMIX);
  f32x16 acc[2][2];
  G22::zero(acc);
  if (type < 2) G22::run(X, lora + type * 64, 384, W + WE_W2 + type * 32768 + (size_t)n0 * 64, 64, 64, smem, acc);
  else if (type < 4) G22::run(X, lora + 128 + (type - 2) * 64, 384, W + WE_A2 + (type - 2) * 32768 + (size_t)n0 * 64, 64, 64, smem, acc);
  else G22::run(X, lora + 256, 384, W + WE_G2 + (size_t)n0 * 128, 128, 128, smem, acc);
  const int row0 = m0 + (w >> 1) * 64, col0 = n0 + (w & 1) * 64;
  bf16_t* ld = (bf16_t*)(X.ws + OFF_LD);
  bf16_t* ab = (bf16_t*)(X.ws + OFF_A);
  bf16_t* gb = (bf16_t*)(X.ws + OFF_G);
  float biasv[2] = {0.f, 0.f};
#pragma unroll
  for (int j = 0; j < 2; ++j) {
    const int col = col0 + j * 32 + (lane & 31);
    if (type < 2) biasv[j] = P.in[10][(layer * 2 + type) * 512 + col];
    else if (type < 4) biasv[j] = P.in[12][(layer * 2 + type - 2) * 512 + col];
  }
#pragma unroll
  for (int j = 0; j < 2; ++j) {
    const int col = col0 + j * 32 + (lane & 31);
    const float bias = biasv[j];
#pragma unroll
    for (int i = 0; i < 2; ++i)
#pragma unroll
      for (int r = 0; r < 16; ++r) {
        int row = row0 + i * 32 + ROW_OF(r);
        float v = acc[i][j][r] + bias;
        if (type < 2) ld[(size_t)row * 1024 + type * 512 + col] = f2bf(-0.60653066f / (1.f + __expf(-v)));
        else if (type < 4) ab[(size_t)row * 1024 + (type - 2) * 512 + col] = f2bf(1.f / (1.f + __expf(-v)));
        else gb[(size_t)row * 512 + col] = f2bf(v);
      }
  }
}

template <int CTRL>
__device__ __forceinline__ float dpp_f(float x) {
  return __int_as_float(__builtin_amdgcn_update_dpp(0, __float_as_int(x), CTRL, 0xf, 0xf, false));
}
__device__ __forceinline__ float red16(float x) {
  x += dpp_f<0x128>(x);
  x += dpp_f<0x124>(x);
  x += dpp_f<0x4E>(x);
  x += dpp_f<0xB1>(x);
  return x;
}
__device__ __forceinline__ int scan_tokrow(int b, int dir, int i) {
  if (i < 256) return NX + b * 256 + (dir ? 255 - i : i);
  int t = i - 256;
  return b * 4096 + (dir ? 4095 - t : t);
}
typedef float f2_t __attribute__((ext_vector_type(2)));
__device__ __forceinline__ void scan_job(const Params& P, const Cx& X, int layer, int bj, char* smem) {
  const int tid = X.tid, lane = tid & 63, w = tid >> 6;
  const int s = bj >> 2, rq = bj & 3;
  const int dir = s >> 5, b = (s & 31) >> 3, h = s & 7;
  float* sv = (float*)smem;
  float* sy = sv + 2 * 16 * 6 * 64;
  const bf16_t* rkv = (const bf16_t*)(X.ws + OFF_RKV);
  const bf16_t* ab = (const bf16_t*)(X.ws + OFF_A);
  const bf16_t* ldb = (const bf16_t*)(X.ws + OFF_LD);
  bf16_t* yout = (bf16_t*)(X.ws + (dir ? OFF_YB : OFF_YF));
  const int lst = tid >> 4, lch = (tid & 15) * 4;
  const float4 ka4 = *(const float4*)(P.in[15] + layer * 512 + h * 64 + lch);
  const float4 kw4 = *(const float4*)(P.in[14] + layer * 512 + h * 64 + lch);
  uint2 pr, pk, pv, pa, pl;
#define SLOAD(chunk)                                                          \
  {                                                                           \
    int row = scan_tokrow(b, dir, (chunk)*16 + lst);                          \
    const bf16_t* p0 = rkv + (size_t)row * 1536 + h * 64 + lch;               \
    pr = *(const uint2*)p0; pk = *(const uint2*)(p0 + 512); pv = *(const uint2*)(p0 + 1024); \
    pa = *(const uint2*)(ab + (size_t)row * 1024 + dir * 512 + h * 64 + lch); \
    pl = *(const uint2*)(ldb + (size_t)row * 1024 + dir * 512 + h * 64 + lch);\
  }
#define SSTORE2(buf)                                                          \
  {                                                                           \
    float* d = sv + ((buf)*16 + lst) * 384 + lch;                             \
    float a0 = lo16(pa.x), a1 = hi16(pa.x), a2 = lo16(pa.y), a3 = hi16(pa.y); \
    float k0 = lo16(pk.x), k1 = hi16(pk.x), k2 = lo16(pk.y), k3 = hi16(pk.y); \
    float q0 = k0 * kw4.x, q1 = k1 * kw4.y, q2 = k2 * kw4.z, q3 = k3 * kw4.w;    \
    {                                                                         \
      const float ssq = red16(q0 * q0 + q1 * q1 + q2 * q2 + q3 * q3);         \
      const float inv = 1.f / fmaxf(sqrtf(ssq), 1e-12f);                      \
      q0 *= inv; q1 *= inv; q2 *= inv; q3 *= inv;                             \
    }                                                                         \
    *(float4*)(d) = make_float4(q0, q1, q2, q3);                              \
    *(float4*)(d + 64) = make_float4(__expf(lo16(pl.x)), __expf(hi16(pl.x)), __expf(lo16(pl.y)), __expf(hi16(pl.y))); \
    *(float4*)(d + 128) = make_float4(q0 * a0, q1 * a1, q2 * a2, q3 * a3);    \
    *(float4*)(d + 192) = make_float4(k0 * (1.f + (a0 - 1.f) * ka4.x), k1 * (1.f + (a1 - 1.f) * ka4.y), k2 * (1.f + (a2 - 1.f) * ka4.z), k3 * (1.f + (a3 - 1.f) * ka4.w)); \
    *(float4*)(d + 256) = make_float4(lo16(pr.x), hi16(pr.x), lo16(pr.y), hi16(pr.y)); \
    *(float4*)(d + 320) = make_float4(lo16(pv.x), hi16(pv.x), lo16(pv.y), hi16(pv.y)); \
  }
  SLOAD(0);
  SSTORE2(0);
  __syncthreads();
  const int rp = lane >> 4, ci = (lane & 15) * 4;
  const int vrow = rq * 16 + w * 4 + rp;
  float S0 = 0.f, S1 = 0.f, S2 = 0.f, S3 = 0.f, qy = 0.f;
  for (int chunk = 0; chunk < 272; ++chunk) {
    const int buf = chunk & 1;
    SLOAD(chunk + 1 < 272 ? chunk + 1 : 271);
    __builtin_amdgcn_sched_barrier(0);
    {
      const float* base = sv + buf * 16 * 384;
      float ysel = 0.f;
      qy = 0.f;
      float4 p0kk, p0w, p0b, p0kd, p0r, p1kk, p1w, p1b, p1kd, p1r;
      float p0v, p1v;
#define LDS_SET(S, st)                                     \
  {                                                        \
    const float* d = base + (st)*384;                      \
    S##kk = *(const float4*)(d + ci);                      \
    S##w = *(const float4*)(d + 64 + ci);                  \
    S##b = *(const float4*)(d + 128 + ci);                 \
    S##kd = *(const float4*)(d + 192 + ci);                \
    S##r = *(const float4*)(d + 256 + ci);                 \
    S##v = d[320 + vrow];                                  \
  }
#define DPPS "row_mask:0xf bank_mask:0xf bound_ctrl:1\n"
#define STEP(S, st)                                                                                   \
  {                                                                                                   \
    float t0, t1, u0, u1, u2, u3;                                                                     \
    asm volatile(                                                                                     \
        "v_mul_f32 %5, %0, %11\n"                                                                     \
        "v_mul_f32 %6, %1, %12\n"                                                                     \
        "v_fma_f32 %5, %2, %13, %5\n"                                                                 \
        "v_fma_f32 %6, %3, %14, %6\n"                                                                 \
        "v_mul_f32 %7, %27, %23\n"                                                                    \
        "v_add_f32 %5, %5, %6\n"                                                                      \
        "v_mul_f32 %8, %27, %24\n"                                                                    \
        "v_mul_f32 %9, %27, %25\n"                                                                    \
        "v_add_f32_dpp %5, %5, %5 row_ror:8 " DPPS                                                    \
        "v_add_f32_dpp %4, %4, %4 row_ror:8 " DPPS                                                    \
        "v_mul_f32 %10, %27, %26\n"                                                                   \
        "v_add_f32_dpp %5, %5, %5 row_ror:4 " DPPS                                                    \
        "v_add_f32_dpp %4, %4, %4 row_ror:4 " DPPS                                                    \
        "v_fma_f32 %7, %0, %15, %7\n"                                                                 \
        "v_add_f32_dpp %5, %5, %5 quad_perm:[2,3,0,1] " DPPS                                          \
        "v_add_f32_dpp %4, %4, %4 quad_perm:[2,3,0,1] " DPPS                                          \
        "v_fma_f32 %8, %1, %16, %8\n"                                                                 \
        "v_add_f32_dpp %5, %5, %5 quad_perm:[1,0,3,2] " DPPS                                          \
        "v_add_f32_dpp %4, %4, %4 quad_perm:[1,0,3,2] " DPPS                                          \
        "v_fma_f32 %9, %2, %17, %9\n"                                                                 \
        "v_fma_f32 %10, %3, %18, %10\n"                                                               \
        "v_fma_f32 %0, -%5, %19, %7\n"                                                                \
        "v_fma_f32 %1, -%5, %20, %8\n"                                                                \
        "v_fma_f32 %2, -%5, %21, %9\n"                                                                \
        "v_fma_f32 %3, -%5, %22, %10\n"                                                               \
        : "+v"(S0), "+v"(S1), "+v"(S2), "+v"(S3), "+v"(qy), "=&v"(t0), "=&v"(t1), "=&v"(u0), "=&v"(u1), \
          "=&v"(u2), "=&v"(u3)                                                                        \
        : "v"(S##kk.x), "v"(S##kk.y), "v"(S##kk.z), "v"(S##kk.w), "v"(S##w.x), "v"(S##w.y), "v"(S##w.z), \
          "v"(S##w.w), "v"(S##b.x), "v"(S##b.y), "v"(S##b.z), "v"(S##b.w), "v"(S##kd.x), "v"(S##kd.y), \
          "v"(S##kd.z), "v"(S##kd.w), "v"(S##v));                                                     \
                                                 \
    if ((st) > 0) ysel = ((lane & 15) == (st)-1) ? qy : ysel;                                         \
    qy = fmaf(S2, S##r.z, S0 * S##r.x) + fmaf(S3, S##r.w, S1 * S##r.y);                               \
  }
      LDS_SET(p0, 0);
#pragma unroll
      for (int st = 0; st < 16; st += 2) {
        LDS_SET(p1, st + 1);
        __builtin_amdgcn_sched_barrier(0);
        STEP(p0, st);
        if (st + 2 < 16) LDS_SET(p0, st + 2);
        __builtin_amdgcn_sched_barrier(0);
        STEP(p1, st + 1);
      }
#undef LDS_SET
#undef STEP
#undef DPPS
      qy = red16(qy);
      ysel = ((lane & 15) == 15) ? qy : ysel;
      sy[(buf * 16 + (lane & 15)) * 16 + w * 4 + rp] = ysel;
    }
    if (chunk + 1 < 272) SSTORE2(buf ^ 1);
    __syncthreads();
    {
      int st = tid >> 4, r = tid & 15;
      int row = scan_tokrow(b, dir, chunk * 16 + st);
      yout[(size_t)row * 512 + h * 64 + rq * 16 + r] = f2bf(sy[(buf * 16 + st) * 16 + r]);
    }
  }
#undef SLOAD
#undef SSTORE2
  __syncthreads();
}

__device__ __forceinline__ void s2_job(const Params& P, const Cx& X, int layer, int job) {
  const int tid = X.tid;
  const int row = job * 4 + (tid >> 6);
  const int c0 = (tid & 63) * 8;
  const bf16_t* rkv = (const bf16_t*)(X.ws + OFF_RKV) + (size_t)row * 1536;
  uint4 ur = *(const uint4*)(rkv + c0), uk = *(const uint4*)(rkv + 512 + c0), uv = *(const uint4*)(rkv + 1024 + c0);
  uint4 ua0 = *(const uint4*)((const bf16_t*)(X.ws + OFF_A) + (size_t)row * 1024 + c0);
  uint4 ua1 = *(const uint4*)((const bf16_t*)(X.ws + OFF_A) + (size_t)row * 1024 + 512 + c0);
  uint4 ug = *(const uint4*)((const bf16_t*)(X.ws + OFF_G) + (size_t)row * 512 + c0);
  uint4 uyf = *(const uint4*)((const bf16_t*)(X.ws + OFF_YF) + (size_t)row * 512 + c0);
  uint4 uyb = *(const uint4*)((const bf16_t*)(X.ws + OFF_YB) + (size_t)row * 512 + c0);
  const uint32_t r4[4] = {ur.x, ur.y, ur.z, ur.w}, k4[4] = {uk.x, uk.y, uk.z, uk.w}, v4[4] = {uv.x, uv.y, uv.z, uv.w};
  const uint32_t a04[4] = {ua0.x, ua0.y, ua0.z, ua0.w}, a14[4] = {ua1.x, ua1.y, ua1.z, ua1.w}, g4[4] = {ug.x, ug.y, ug.z, ug.w};
  const uint32_t yf4[4] = {uyf.x, uyf.y, uyf.z, uyf.w}, yb4[4] = {uyb.x, uyb.y, uyb.z, uyb.w};
  float y[8], vv[8], gg[8];
  float sum = 0.f, bon = 0.f;
  const float* rk = P.in[16] + layer * 512 + c0;
  const float* ka = P.in[15] + layer * 512 + c0;
#pragma unroll
  for (int i = 0; i < 4; ++i) {
#pragma unroll
    for (int hh = 0; hh < 2; ++hh) {
      int e = 2 * i + hh;
      float r = hh ? hi16(r4[i]) : lo16(r4[i]);
      float k = hh ? hi16(k4[i]) : lo16(k4[i]);
      float a0 = hh ? hi16(a04[i]) : lo16(a04[i]);
      float a1 = hh ? hi16(a14[i]) : lo16(a14[i]);
      y[e] = (hh ? hi16(yf4[i]) : lo16(yf4[i])) + (hh ? hi16(yb4[i]) : lo16(yb4[i]));
      vv[e] = hh ? hi16(v4[i]) : lo16(v4[i]);
      gg[e] = hh ? hi16(g4[i]) : lo16(g4[i]);
      sum += y[e];
      float ksum = k * (2.f + (a0 + a1 - 2.f) * ka[e]);
      bon += r * rk[e] * ksum;
    }
  }
  sum += __shfl_xor(sum, 1); sum += __shfl_xor(sum, 2); sum += __shfl_xor(sum, 4);
  bon += __shfl_xor(bon, 1); bon += __shfl_xor(bon, 2); bon += __shfl_xor(bon, 4);
  const float mu = sum * (1.f / 64.f);
  float var = 0.f;
#pragma unroll
  for (int e = 0; e < 8; ++e) { float d = y[e] - mu; var += d * d; }
  var += __shfl_xor(var, 1); var += __shfl_xor(var, 2); var += __shfl_xor(var, 4);
  const float rs = rsqrtf(var * (1.f / 64.f) + 64e-5f);
  const float* gw = P.in[18] + layer * 512 + c0;
  const float* gbi = P.in[19] + layer * 512 + c0;
  float o[8];
#pragma unroll
  for (int e = 0; e < 8; ++e) o[e] = ((y[e] - mu) * rs * gw[e] + gbi[e] + bon * vv[e]) * gg[e];
  uint4 ou;
  ou.x = pack2(o[0], o[1]); ou.y = pack2(o[2], o[3]); ou.z = pack2(o[4], o[5]); ou.w = pack2(o[6], o[7]);
  *(uint4*)((bf16_t*)(X.ws + OFF_RWO) + (size_t)row * 512 + c0) = ou;
}

__device__ __forceinline__ float red32(float x) {
  x += __shfl_xor(x, 1); x += __shfl_xor(x, 2); x += __shfl_xor(x, 4); x += __shfl_xor(x, 8); x += __shfl_xor(x, 16);
  return x;
}
#define QSCALE 0.14724444f
__device__ __forceinline__ void q1_q_tile(const Params& P, const Cx& X, int layer, int t, char* smem) {
  const int tid = X.tid, lane = tid & 63, w = tid >> 6;
  const int mt = t % 136, head = t / 136;
  const int m0 = mt * 128;
  const bf16_t* zm = (const bf16_t*)(X.ws + OFF_ZM);
  float* srs = (float*)(smem + 73728);
  {
    int r = tid >> 1, hf = tid & 1;
    const bf16_t* p = zm + (size_t)(m0 + r) * 544 + hf * 192;
    float ss = 0.f;
#pragma unroll 12
    for (int i = 0; i < 24; ++i) {
      uint4 u = *(const uint4*)(p + i * 8);
      ss += lo16(u.x) * lo16(u.x) + hi16(u.x) * hi16(u.x) + lo16(u.y) * lo16(u.y) + hi16(u.y) * hi16(u.y) +
            lo16(u.z) * lo16(u.z) + hi16(u.z) * hi16(u.z) + lo16(u.w) * lo16(u.w) + hi16(u.w) * hi16(u.w);
    }
    ss += __shfl_xor(ss, 1);
    if (hf == 0) srs[r] = rsqrtf(ss * (1.f / 384.f) + 1e-6f);
  }
  f32x16 acc[1][3];
  GQ::zero(acc);
  GQ::run(X, zm + (size_t)m0 * 544, 544, (const bf16_t*)(X.ws + OFF_WMIX) + WE_UQ + (size_t)head * 96 * 384, 384, 384, smem, acc);
  const int l5 = lane & 31;
  const float* gq = P.in[25] + layer * 96;
  const float g0 = gq[l5], g1 = gq[32 + l5], g2 = gq[64 + l5];
  const float2* rope = (const float2*)(X.ws + OFF_ROPE);
  bf16_t* qb = (bf16_t*)(X.ws + OFF_Q);
  float2 rcs[16];
#pragma unroll
  for (int r = 0; r < 16; ++r) {
    const int row = m0 + w * 32 + ROW_OF(r);
    rcs[r] = (row < NX) ? rope[(row & 4095) * 16 + (l5 >> 4) * 8 + (l5 & 7)] : make_float2(1.f, 0.f);
  }
#pragma unroll
  for (int r = 0; r < 16; ++r) {
    const int rl = w * 32 + ROW_OF(r);
    const int row = m0 + rl;
    const float rs = srs[rl];
    float x0 = acc[0][0][r] * rs, x1 = acc[0][1][r] * rs, x2 = acc[0][2][r] * rs;
    float ss = red32(x0 * x0 + x1 * x1 + x2 * x2);
    float rq = rsqrtf(ss * (1.f / 96.f) + 1e-6f);
    x0 *= rq * g0; x1 *= rq * g1; x2 *= rq * g2;
    bf16_t* dst;
    if (row < NX) {
      int tt = row & 4095, bb = row >> 12;
      float2 cs = rcs[r];
      float other = __shfl_xor(x2, 8);
      x2 = (l5 & 8) ? x2 * cs.x + other * cs.y : x2 * cs.x - other * cs.y;
      dst = qb + ((size_t)(bb * 8 + head) * 4096 + tt) * 96;
    } else {
      int j = (row - NX) & 255, bb = (row - NX) >> 8;
      dst = qb + (size_t)NX * 768 + ((size_t)(bb * 8 + head) * 256 + j) * 96;
    }
    dst[l5] = f2bf(x0 * QSCALE); dst[32 + l5] = f2bf(x1 * QSCALE); dst[64 + l5] = f2bf(x2 * QSCALE);
  }
}
__device__ __forceinline__ void q1_kv_tile(const Params& P, const Cx& X, int layer, int t, char* smem) {
  const int tid = X.tid, lane = tid & 63, w = tid >> 6;
  const int mt = t % 136, head = t / 136;
  const int m0 = mt * 128;
  const bf16_t* zm = (const bf16_t*)(X.ws + OFF_ZM);
  float* srs = (float*)(smem + 73728);
  {
    int r = tid >> 1, hf = tid & 1;
    const bf16_t* p = zm + (size_t)(m0 + r) * 544 + 384 + hf * 64;
    float ss = 0.f;
#pragma unroll
    for (int i = 0; i < 8; ++i) {
      uint4 u = *(const uint4*)(p + i * 8);
      ss += lo16(u.x) * lo16(u.x) + hi16(u.x) * hi16(u.x) + lo16(u.y) * lo16(u.y) + hi16(u.y) * hi16(u.y) +
            lo16(u.z) * lo16(u.z) + hi16(u.z) * hi16(u.z) + lo16(u.w) * lo16(u.w) + hi16(u.w) * hi16(u.w);
    }
    ss += __shfl_xor(ss, 1);
    if (hf == 0) srs[r] = rsqrtf(ss * (1.f / 128.f) + 1e-6f);
  }
  f32x16 acc[1][4];
  GKV::zero(acc);
  GKV::run(X, zm + (size_t)m0 * 544 + 384, 544, (const bf16_t*)(X.ws + OFF_WMIX) + WE_UKV + (size_t)head * 128 * 128, 128, 128, smem, acc);
  const int l5 = lane & 31;
  const float* gk = P.in[26] + layer * 96;
  const float g0 = gk[l5], g1 = gk[32 + l5], g2 = gk[64 + l5];
  const float2* rope = (const float2*)(X.ws + OFF_ROPE);
  bf16_t* kb = (bf16_t*)(X.ws + OFF_K);
  bf16_t* vt = (bf16_t*)(X.ws + OFF_VT);
  const bool isx = m0 < NX;
  const int bb = isx ? (m0 >> 12) : ((m0 - NX) >> 8);
  float vv0[16], vv1[16];
  float krv[16];
  float2 rcs[16];
#pragma unroll
  for (int r = 0; r < 16; ++r) {
    const int row = m0 + w * 32 + ROW_OF(r);
    krv[r] = bf2f(zm[(size_t)row * 544 + 512 + l5]);
    rcs[r] = isx ? rope[(row & 4095) * 16 + (l5 >> 4) * 8 + (l5 & 7)] : make_float2(1.f, 0.f);
  }
#pragma unroll
  for (int r = 0; r < 16; ++r) {
    const int rl = w * 32 + ROW_OF(r);
    const int row = m0 + rl;
    const float rs = srs[rl];
    float k0 = acc[0][0][r] * rs, k1 = acc[0][1][r] * rs;
    float kr = krv[r];
    float ss = red32(k0 * k0 + k1 * k1 + kr * kr);
    float rk = rsqrtf(ss * (1.f / 96.f) + 1e-6f);
    k0 *= rk * g0; k1 *= rk * g1; kr *= rk * g2;
    int key;
    if (isx) {
      int tt = row & 4095;
      float2 cs = rcs[r];
      float other = __shfl_xor(kr, 8);
      kr = (l5 & 8) ? kr * cs.x + other * cs.y : kr * cs.x - other * cs.y;
      key = 256 + tt;
    } else {
      key = (row - NX) & 255;
    }
    bf16_t* dst = kb + ((size_t)(bb * 8 + head) * 4352 + key) * 96;
    dst[l5] = f2bf(k0); dst[32 + l5] = f2bf(k1); dst[64 + l5] = f2bf(kr);
    vv0[r] = acc[0][2][r] * rs;
    vv1[r] = acc[0][3][r] * rs;
  }
#pragma unroll
  for (int g = 0; g < 4; ++g) {
    const int rl = w * 32 + 8 * g + 4 * (lane >> 5);
    const int row = m0 + rl;
    const int key = isx ? 256 + (row & 4095) : ((row - NX) & 255);
    uint2 o0, o1;
    o0.x = pack2(vv0[4 * g], vv0[4 * g + 1]); o0.y = pack2(vv0[4 * g + 2], vv0[4 * g + 3]);
    o1.x = pack2(vv1[4 * g], vv1[4 * g + 1]); o1.y = pack2(vv1[4 * g + 2], vv1[4 * g + 3]);
    *(uint2*)(vt + ((size_t)(bb * 8 + head) * 64 + l5) * 4352 + key) = o0;
    *(uint2*)(vt + ((size_t)(bb * 8 + head) * 64 + 32 + l5) * 4352 + key) = o1;
  }
}

__device__ __forceinline__ void fft1_tile(const Params& P, const Cx& X, int t, char* smem) {
  const int lane = X.tid & 63, w = X.tid >> 6;
  const int b = t >> 8, ntile = t & 255;
  const int n0 = ntile * 128;
  f32x16 acc[2][2];
  G22T::zero(acc);
  G22T::run(X, (const bf16_t*)(X.ws + OFF_F1), 64, (const bf16_t*)(X.ws + OFF_ZF) + (size_t)b * 4096 * 512 + n0, 32768, 64, smem, acc);
  const float2* tw = (const float2*)(X.ws + OFF_TW);
  bf16_t* out = (bf16_t*)(X.ws + OFF_FFT1);
  const int wm = w >> 1, wn = w & 1;
  const int t2 = n0 >> 9;
#pragma unroll
  for (int j = 0; j < 2; ++j) {
    const int ch = (n0 & 511) + wn * 64 + j * 32 + (lane & 31);
    float2 tcs[16];
#pragma unroll
    for (int r = 0; r < 16; ++r) tcs[r] = tw[t2 * (wm * 32 + ROW_OF(r))];
#pragma unroll
    for (int r = 0; r < 16; ++r) {
      const int f1 = wm * 32 + ROW_OF(r);
      float re = acc[0][j][r], im = acc[1][j][r];
      float2 cs = tcs[r];
      float re2 = re * cs.x + im * cs.y, im2 = im * cs.x - re * cs.y;
      size_t base = ((size_t)(b * 64 + f1) * 128) * 512 + ch;
      out[base + (size_t)t2 * 512] = f2bf(re2);
      out[base + (size_t)(64 + t2) * 512] = f2bf(im2);
    }
  }
}
__device__ __forceinline__ void fft2_tile(const Params& P, const Cx& X, int t, char* smem) {
  const int lane = X.tid & 63, w = X.tid >> 6;
  const int bf = t >> 2, ntile = t & 3;
  const int b = bf >> 6, f1 = bf & 63;
  const int n0 = ntile * 128;
  f32x16 acc[2][2];
  G22T::zero(acc);
  G22T::run(X, (const bf16_t*)(X.ws + OFF_F2), 128, (const bf16_t*)(X.ws + OFF_FFT1) + (size_t)bf * 128 * 512 + n0, 512, 128, smem, acc);
  bf16_t* Y = (bf16_t*)(X.ws + OFF_Y);
  const int wm = w >> 1, wn = w & 1;
#pragma unroll
  for (int i = 0; i < 2; ++i)
#pragma unroll
    for (int j = 0; j < 2; ++j)
#pragma unroll
      for (int r = 0; r < 16; ++r) {
        int m = wm * 64 + i * 32 + ROW_OF(r);
        int f2 = m & 63, q = m >> 6;
        int ch = n0 + wn * 64 + j * 32 + (lane & 31);
        Y[(size_t)(b * 4096 + f1 + 64 * f2) * 1024 + q * 512 + ch] = f2bf(acc[i][j][r]);
      }
}
__device__ __forceinline__ void ctxdft_tile(const Params& P, const Cx& X, int t, char* smem) {
  const int lane = X.tid & 63, w = X.tid >> 6;
  const int b = t >> 4, mt = (t >> 2) & 3, ntile = t & 3;
  const int n0 = ntile * 128;
  f32x16 acc[2][2];
  G22T::zero(acc);
  G22T::run(X, (const bf16_t*)(X.ws + OFF_F256) + (size_t)mt * 128 * 256, 256, (const bf16_t*)(X.ws + OFF_ZF) + (size_t)(NX + b * 256) * 512 + n0, 512, 256, smem, acc);
  bf16_t* Y = (bf16_t*)(X.ws + OFF_Y);
  const int wm = w >> 1, wn = w & 1;
#pragma unroll
  for (int i = 0; i < 2; ++i)
#pragma unroll
    for (int j = 0; j < 2; ++j)
#pragma unroll
      for (int r = 0; r < 16; ++r) {
        int m = mt * 128 + wm * 64 + i * 32 + ROW_OF(r);
        int f = m & 255, q = m >> 8;
        int ch = n0 + wn * 64 + j * 32 + (lane & 31);
        Y[(size_t)(NX + b * 256 + f) * 1024 + q * 512 + ch] = f2bf(acc[i][j][r] * 4.f);
      }
}

__device__ __forceinline__ void attn_item(const Params& P, const Cx& X, int it, bool isctx, char* smem) {
  const int tid = X.tid, lane = tid & 63, w = tid >> 6;
  int b, h, qb, nkt, qrow0;
  const bf16_t* qbase;
  if (!isctx) {
    b = it >> 8; h = (it >> 5) & 7; qb = it & 31; nkt = 68;
    qbase = (const bf16_t*)(X.ws + OFF_Q) + ((size_t)(b * 8 + h) * 4096 + qb * 128) * 96;
    qrow0 = b * 4096 + qb * 128;
  } else {
    b = it >> 4; h = (it >> 1) & 7; qb = it & 1; nkt = 4;
    qbase = (const bf16_t*)(X.ws + OFF_Q) + (size_t)NX * 768 + ((size_t)(b * 8 + h) * 256 + qb * 128) * 96;
    qrow0 = NX + b * 256 + qb * 128;
  }
  const bf16_t* kbase = (const bf16_t*)(X.ws + OFF_K) + (size_t)(b * 8 + h) * 4352 * 96;
  const bf16_t* vbase = (const bf16_t*)(X.ws + OFF_VT) + (size_t)(b * 8 + h) * 64 * 4352;
  bf16_t* sK = (bf16_t*)smem;
  bf16_t* sV = sK + 2 * 64 * 104;
  const int l5 = lane & 31, hh = lane >> 5;
  const bf16_t* qp = qbase + (size_t)(w * 32 + l5) * 96 + hh * 8;
  const bf16x8 qf0 = *(const bf16x8*)(qp), qf1 = *(const bf16x8*)(qp + 16), qf2 = *(const bf16x8*)(qp + 32);
  const bf16x8 qf3 = *(const bf16x8*)(qp + 48), qf4 = *(const bf16x8*)(qp + 64), qf5 = *(const bf16x8*)(qp + 80);
  uint4 rk0, rk1, rk2, rv0, rv1;
#define LK_(i, kt) (*(const uint4*)(kbase + (size_t)((kt)*64 + (tid + 256 * (i)) / 12) * 96 + ((tid + 256 * (i)) % 12) * 8))
#define LV_(i, kt) (*(const uint4*)(vbase + (size_t)((tid + 256 * (i)) >> 3) * 4352 + (kt)*64 + ((tid + 256 * (i)) & 7) * 8))
#define ALOAD(kt) { rk0 = LK_(0, kt); rk1 = LK_(1, kt); rk2 = LK_(2, kt); rv0 = LV_(0, kt); rv1 = LV_(1, kt); }
#define SK_(i, buf, v) *(uint4*)(sK + (buf)*64 * 104 + ((tid + 256 * (i)) / 12) * 104 + ((tid + 256 * (i)) % 12) * 8) = v
#define SV_(i, buf, v) *(uint4*)(sV + (buf)*64 * 72 + ((tid + 256 * (i)) >> 3) * 72 + ((tid + 256 * (i)) & 7) * 8) = v
#define ASTORE(buf) { SK_(0, buf, rk0); SK_(1, buf, rk1); SK_(2, buf, rk2); SV_(0, buf, rv0); SV_(1, buf, rv1); }
  f32x16 o[2];
#pragma unroll
  for (int r = 0; r < 16; ++r) { o[0][r] = 0.f; o[1][r] = 0.f; }
  float mrun = -1e30f, lrun = 0.f;
  ALOAD(0);
  ASTORE(0);
  __syncthreads();
  for (int kt = 0; kt < nkt; ++kt) {
    const int buf = kt & 1;
    if (kt + 1 < nkt) ALOAD(kt + 1);
    const bf16_t* pk = sK + buf * 64 * 104 + l5 * 104 + hh * 8;
    const bf16_t* pv = sV + buf * 64 * 72 + l5 * 72 + 4 * hh;
#pragma unroll
    for (int mt = 0; mt < 2; ++mt) {
      f32x16 sc;
#pragma unroll
      for (int r = 0; r < 16; ++r) sc[r] = 0.f;
#define QK(ks, qq) sc = __builtin_amdgcn_mfma_f32_32x32x16_bf16(*(const bf16x8*)(pk + mt * 32 * 104 + (ks)*16), qq, sc, 0, 0, 0)
      QK(0, qf0); QK(1, qf1); QK(2, qf2); QK(3, qf3); QK(4, qf4); QK(5, qf5);
#undef QK
      float mx = sc[0];
#pragma unroll
      for (int r = 1; r < 16; ++r) mx = fmaxf(mx, sc[r]);
      mx = fmaxf(mx, __shfl_xor(mx, 32));
      const float mnew = fmaxf(mrun, mx);
      if (__builtin_amdgcn_ballot_w64(mnew > mrun) != 0ull) {
        const float alpha = __builtin_amdgcn_exp2f(mrun - mnew);
        lrun *= alpha;
#pragma unroll
        for (int r = 0; r < 16; ++r) { o[0][r] *= alpha; o[1][r] *= alpha; }
        mrun = mnew;
      }
      float psum = 0.f;
#pragma unroll
      for (int r = 0; r < 16; ++r) { sc[r] = __builtin_amdgcn_exp2f(sc[r] - mrun); psum += sc[r]; }
      lrun += psum;
#pragma unroll
      for (int s2 = 0; s2 < 2; ++s2) {
        u32x4 pu;
        pu[0] = pack2(sc[8 * s2 + 0], sc[8 * s2 + 1]);
        pu[1] = pack2(sc[8 * s2 + 2], sc[8 * s2 + 3]);
        pu[2] = pack2(sc[8 * s2 + 4], sc[8 * s2 + 5]);
        pu[3] = pack2(sc[8 * s2 + 6], sc[8 * s2 + 7]);
        const bf16x8 pfv = __builtin_bit_cast(bf16x8, pu);
#pragma unroll
        for (int dt = 0; dt < 2; ++dt) {
          const bf16_t* p = pv + dt * 32 * 72 + mt * 32 + s2 * 16;
          uint2 v0 = *(const uint2*)(p), v1 = *(const uint2*)(p + 8);
          u32x4 vu;
          vu[0] = v0.x; vu[1] = v0.y; vu[2] = v1.x; vu[3] = v1.y;
          o[dt] = __builtin_amdgcn_mfma_f32_32x32x16_bf16(__builtin_bit_cast(bf16x8, vu), pfv, o[dt], 0, 0, 0);
        }
      }
    }
    if (kt + 1 < nkt) ASTORE(buf ^ 1);
    __syncthreads();
  }
#undef ALOAD
#undef ASTORE
#undef LK_
#undef LV_
#undef SK_
#undef SV_
  lrun += __shfl_xor(lrun, 32);
  const float inv = 1.f / lrun;
  bf16_t* dst = (bf16_t*)(X.ws + OFF_ATT) + (size_t)(qrow0 + w * 32 + l5) * 512 + h * 64;
#pragma unroll
  for (int dt = 0; dt < 2; ++dt)
#pragma unroll
    for (int g = 0; g < 4; ++g) {
      uint2 u;
      u.x = pack2(o[dt][4 * g] * inv, o[dt][4 * g + 1] * inv);
      u.y = pack2(o[dt][4 * g + 2] * inv, o[dt][4 * g + 3] * inv);
      *(uint2*)(dst + dt * 32 + 8 * g + 4 * hh) = u;
    }
}

__device__ __forceinline__ void mg_tile(const Params& P, const Cx& X, int t, int mtiles, char* smem) {
  const int lane = X.tid & 63, w = X.tid >> 6;
  const int mt = t % mtiles, nt = t / mtiles;
  const int m0 = mt * 128, c0 = nt * 128;
  const bf16_t* W = (const bf16_t*)(X.ws + OFF_WMIX);
  uint32_t mpk[2][2][8];
#pragma unroll
  for (int a = 0; a < 2; ++a)
#pragma unroll
    for (int c = 0; c < 2; ++c)
#pragma unroll
      for (int r = 0; r < 8; ++r) mpk[a][c][r] = 0u;
#pragma unroll 1
  for (int i = 0; i < 3; ++i) {
    f32x16 acc[2][2];
    G22::zero(acc);
    const bf16_t* Ai; const bf16_t* Bi; int ldi;
    if (i == 0) { Ai = (const bf16_t*)(X.ws + OFF_RWO) + (size_t)m0 * 512; Bi = W + WE_RO + (size_t)c0 * 512; ldi = 512; }
    else if (i == 1) { Ai = (const bf16_t*)(X.ws + OFF_ATT) + (size_t)m0 * 512; Bi = W + WE_MO + (size_t)c0 * 512; ldi = 512; }
    else { Ai = (const bf16_t*)(X.ws + OFF_Y) + (size_t)m0 * 1024; Bi = W + WE_FO + (size_t)c0 * 1024; ldi = 1024; }
    { const Cx Y1 = fresh(X); G22::run(Y1, Ai, ldi, Bi, ldi, ldi, smem, acc); }
    uint32_t opk[2][2][8];
#pragma unroll
    for (int a = 0; a < 2; ++a)
#pragma unroll
      for (int c = 0; c < 2; ++c)
#pragma unroll
        for (int r = 0; r < 8; ++r) opk[a][c][r] = pack2(acc[a][c][2 * r], acc[a][c][2 * r + 1]);
    __builtin_amdgcn_sched_barrier(0);
    G22::zero(acc);
    { const Cx Y2 = fresh(X); G22::run(Y2, (const bf16_t*)(X.ws + OFF_HBUF) + (size_t)m0 * 1024, 1024, W + WE_IN + (size_t)(2976 + i * 1024 + c0) * 1024, 1024, 1024, smem, acc); }
#pragma unroll
    for (int a = 0; a < 2; ++a)
#pragma unroll
      for (int c = 0; c < 2; ++c)
#pragma unroll
        for (int r = 0; r < 8; ++r) {
          const float m0v = lo16(mpk[a][c][r]) + lo16(opk[a][c][r]) / (1.f + __expf(-acc[a][c][2 * r]));
          const float m1v = hi16(mpk[a][c][r]) + hi16(opk[a][c][r]) / (1.f + __expf(-acc[a][c][2 * r + 1]));
          mpk[a][c][r] = pack2(m0v, m1v);
        }
  }
  bf16_t* mb = (bf16_t*)(X.ws + OFF_M);
  const int row0 = m0 + (w >> 1) * 64, col0 = c0 + (w & 1) * 64;
#pragma unroll
  for (int a = 0; a < 2; ++a)
#pragma unroll
    for (int c = 0; c < 2; ++c)
#pragma unroll
      for (int r = 0; r < 16; ++r)
        mb[(size_t)(row0 + a * 32 + ROW_OF(r)) * 1024 + col0 + c * 32 + (lane & 31)] = (bf16_t)((r & 1) ? (mpk[a][c][r >> 1] >> 16) : (mpk[a][c][r >> 1] & 0xffffu));
}

__device__ __forceinline__ void wo_tile(const Params& P, const Cx& X, int layer, int t, int mtiles, char* smem) {
  const int lane = X.tid & 63, w = X.tid >> 6;
  const int mt = t % mtiles, nt = t / mtiles;
  const int m0 = mt * 128, n0 = nt * 128;
  f32x16 acc[2][2];
  G22::zero(acc);
  G22::run(X, (const bf16_t*)(X.ws + OFF_M) + (size_t)m0 * 1024, 1024, (const bf16_t*)(X.ws + OFF_WMIX) + WE_OUT + (size_t)n0 * 1024, 1024, 1024, smem, acc);
  const int row0 = m0 + (w >> 1) * 64, col0 = n0 + (w & 1) * 64;
  const float* modv = (const float*)(X.ws + OFF_MOD) + (size_t)(layer * 5 + mod_row(m0)) * 6144 + 2048;
  const float* src; float* dst;
  if (m0 < NX) { src = (layer == 0 ? P.in[0] : X.out); dst = X.out; }
  else { src = (layer == 0 ? P.in[2] : (const float*)(X.ws + OFF_CS)) - (size_t)NX * 1024; dst = (float*)(X.ws + OFF_CS) - (size_t)NX * 1024; }
#pragma unroll
  for (int j = 0; j < 2; ++j) {
    const int col = col0 + j * 32 + (lane & 31);
    const float mg = modv[col];
#pragma unroll
    for (int i = 0; i < 2; ++i) {
      float t[16];
#pragma unroll
      for (int r = 0; r < 16; ++r) t[r] = src[(size_t)(row0 + i * 32 + ROW_OF(r)) * 1024 + col];
#pragma unroll
      for (int r = 0; r < 16; ++r) dst[(size_t)(row0 + i * 32 + ROW_OF(r)) * 1024 + col] = t[r] + mg * acc[i][j][r];
    }
  }
}
__device__ __forceinline__ void f1_tile(const Params& P, const Cx& X, int t, int mtiles, char* smem) {
  const int lane = X.tid & 63, w = X.tid >> 6;
  const int mt = t % mtiles, nt = t / mtiles;
  const int m0 = mt * 128, n0 = nt * 256;
  f32x16 acc[2][4];
  GemmW::zero(acc);
  GemmW::run(X, (const bf16_t*)(X.ws + OFF_HBUF) + (size_t)m0 * 1024, 1024, (const bf16_t*)(X.ws + OFF_WFFN) + WF_IN + (size_t)n0 * 1024, 1024, 1024, smem, acc);
  bf16_t* act = (bf16_t*)(X.ws + OFF_ACT);
  const int row0 = m0 + (w >> 1) * 64;
#pragma unroll
  for (int jp = 0; jp < 2; ++jp) {
    const int hid = ((n0 + (w & 1) * 128 + jp * 64) >> 6) * 32 + (lane & 31);
#pragma unroll
    for (int i = 0; i < 2; ++i)
#pragma unroll
      for (int r = 0; r < 16; ++r) {
        float g = acc[i][2 * jp][r], u = acc[i][2 * jp + 1][r];
        act[(size_t)(row0 + i * 32 + ROW_OF(r)) * 2816 + hid] = f2bf(g / (1.f + __expf(-g)) * u);
      }
  }
}
__device__ __forceinline__ void f2_tile(const Params& P, const Cx& X, int layer, int t, int mtiles, char* smem) {
  const int lane = X.tid & 63, w = X.tid >> 6;
  const int mt = t % mtiles, nt = t / mtiles;
  const int m0 = mt * 128, n0 = nt * 128;
  f32x16 acc[2][2];
  G22::zero(acc);
  G22::run(X, (const bf16_t*)(X.ws + OFF_ACT) + (size_t)m0 * 2816, 2816, (const bf16_t*)(X.ws + OFF_WFFN) + WF_OUT + (size_t)n0 * 2816, 2816, 2816, smem, acc);
  const int row0 = m0 + (w >> 1) * 64, col0 = n0 + (w & 1) * 64;
  const float* modv = (const float*)(X.ws + OFF_MOD) + (size_t)(layer * 5 + mod_row(m0)) * 6144 + 5120;
  float* dst = (m0 < NX) ? X.out : (float*)(X.ws + OFF_CS) - (size_t)NX * 1024;
#pragma unroll
  for (int j = 0; j < 2; ++j) {
    const int col = col0 + j * 32 + (lane & 31);
    const float mg = modv[col];
#pragma unroll
    for (int i = 0; i < 2; ++i) {
      float t[16];
#pragma unroll
      for (int r = 0; r < 16; ++r) t[r] = dst[(size_t)(row0 + i * 32 + ROW_OF(r)) * 1024 + col];
#pragma unroll
      for (int r = 0; r < 16; ++r) dst[(size_t)(row0 + i * 32 + ROW_OF(r)) * 1024 + col] = t[r] + mg * acc[i][j][r];
    }
  }
}

__device__ __forceinline__ void run_p(const Params& P, const Cx& X, int layer, int p, char* smem) {
  const int G = gridDim.x, B = blockIdx.x;
  if (p < 0) {
    if (!PON(14)) return;
    for (int j = B; j < 192 + 55 + NCW1; j += G) {
      if (j < 192) job_mod(P, fresh(X), smem, j);
      else if (j < 247) job_tables(P, fresh(X), j - 192);
      else cw_mixer_job(P, fresh(X), 0, j - 247, smem);
    }
    return;
  }
  const int mtiles = layer == 0 ? 136 : 128;
  switch (p) {
    case 0: if (!PON(0)) break;
      if (layer == 0) { for (int j = B; j < 2176; j += G) norm_job(P, fresh(X), layer, 0, j); }
      else { for (int j = B; j < NCW1 + 2176; j += G) { if (j < NCW1) cw_mixer_job(P, fresh(X), layer, j, smem); else norm_job(P, fresh(X), layer, 0, j - NCW1); } }
      break;
    case 1: if (!PON(1)) break; for (int j = B; j < 136 * 15; j += G) g1a_tile(P, fresh(X), j, smem); break;
    case 2: if (!PON(2)) break; for (int j = B; j < NTOK / 8; j += G) r1a_job(P, fresh(X), layer, j); break;
    case 3: if (!PON(3)) break; for (int j = B; j < 136 * 20; j += G) r1b_tile(P, fresh(X), layer, j, smem); break;
    case 4: if (!PON(4)) break; {
      volatile int* sflag = (volatile int*)(smem + LDS_BYTES - 32);
      if (sflag[0]) {
        unsigned* ctr = (unsigned*)(X.ws + OFF_TICK) + 2048 + layer * 64 + sflag[2] * 8;
        for (;;) {
          __syncthreads();
          if (X.tid == 0) sflag[1] = (int)atomicAdd(ctr, 1u);
          __syncthreads();
          const int j = sflag[1];
          if (j >= 256) break;
          scan_job(P, fresh(X), layer, j, smem);
        }
      }
    } break;
    case 5: if (!PON(5)) break; for (int j = B; j < 4352; j += G) s2_job(P, fresh(X), layer, j); break;
    case 6: if (!PON(6)) break; for (int j = B; j < 136 * 9; j += G) g1b_tile(P, fresh(X), j, smem); break;
    case 7: if (!PON(7)) break;
      for (int j = B; j < 2176 + 1024; j += G) {
        if (j < 1088) q1_kv_tile(P, fresh(X), layer, j, smem);
        else if (j < 2176) { if (layer == 0 || (j - 1088) % 136 < 128) q1_q_tile(P, fresh(X), layer, j - 1088, smem); }
        else fft1_tile(P, fresh(X), j - 2176, smem);
      }
      break;
    case 8: if (!PON(8)) break; {
      const int nctx = layer == 0 ? 64 : 0;
      for (int j = B; j < 1024 + 1024 + 2 * nctx; j += G) {
        const bool isc = (j >= 2048 && j < 2048 + nctx);
        if (j < 1024 || isc) attn_item(P, fresh(X), isc ? j - 2048 : j, isc, smem);
        else if (j < 2048) fft2_tile(P, fresh(X), j - 1024, smem);
        else ctxdft_tile(P, fresh(X), j - 2048 - nctx, smem);
      }
    } break;
    case 9: if (!PON(9)) break; for (int j = B; j < mtiles * 8; j += G) mg_tile(P, fresh(X), j, mtiles, smem); break;
    case 10: if (!PON(10)) break;
      for (int j = B; j < mtiles * 8 + NCW2; j += G) { if (j < mtiles * 8) wo_tile(P, fresh(X), layer, j, mtiles, smem); else cw_ffn_job(P, fresh(X), layer, j - mtiles * 8, smem); }
      break;
    case 11: if (!PON(11)) break; for (int j = B; j < mtiles * 16; j += G) norm_job(P, fresh(X), layer, 1, j); break;
    case 12: if (!PON(12)) break; for (int j = B; j < mtiles * 22; j += G) f1_tile(P, fresh(X), j, mtiles, smem); break;
    case 13: if (!PON(13)) break; for (int j = B; j < mtiles * 8; j += G) f2_tile(P, fresh(X), layer, j, mtiles, smem); break;
  }
}

#if SINGLE
__global__ void __launch_bounds__(256, 2) fwd_kernel(Params P, int ph_lo, int ph_hi, int use_sync) {
  extern __shared__ __attribute__((aligned(16))) char smem[];
  volatile LAS unsigned* xst = (volatile LAS unsigned*)(smem + LDS_BYTES - 16);
  if (threadIdx.x == 0) { xst[0] = 0u; xst[1] = 0u; }
  __syncthreads();
  XcdBarrier xb = xcd_barrier_post((unsigned*)(P.ws + OFF_BAR), xst);
  if (threadIdx.x == 0) {
    const unsigned hwid = (unsigned)__builtin_amdgcn_s_getreg((31 << 11) | 4);
    const unsigned slot = ((xb_xcc_id() * 8u + ((hwid >> 13) & 7u)) * 2u + ((hwid >> 12) & 1u)) * 16u + ((hwid >> 8) & 15u);
    const unsigned t = atomicAdd((unsigned*)(P.ws + OFF_TICK) + slot, 1u);
    *(volatile int*)(smem + LDS_BYTES - 32) = (t == 0u) ? 1 : 0;
    *(volatile int*)(smem + LDS_BYTES - 24) = 0;
  }
  __syncthreads();
#pragma unroll 1
  for (int ph = ph_lo; ph < ph_hi; ++ph) {
    char* ws = P.ws; float* out = P.out; int tid = threadIdx.x;
    asm volatile("" : "+v"(tid));
    const Cx X{ws, out, tid};
    if (ph == 0) run_p(P, X, 0, -1, smem);
    else {
      run_p(P, X, (ph - 1) / 14, (ph - 1) % 14, smem);
      if (PROBE_P >= 0 && (ph - 1) % 14 == PROBE_P) {
#pragma unroll 1
        for (int rep = 0; rep < PROBE_N; ++rep) { xcd_barrier(xb); if (threadIdx.x == 0) *(volatile int*)(smem + LDS_BYTES - 24) = rep + 1; __syncthreads(); run_p(P, X, (ph - 1) / 14, PROBE_P, smem); }
        if (threadIdx.x == 0) *(volatile int*)(smem + LDS_BYTES - 24) = 0;
        __syncthreads();
      }
    }
    if (use_sync && ph + 1 < ph_hi) { if (use_sync == 2) cg::this_grid().sync(); else xcd_barrier(xb); }
  }
}

#else
template <int PP>
__global__ void __launch_bounds__(256) phase_kernel(Params P, int layer) {
  extern __shared__ __attribute__((aligned(16))) char smem[];
  const Cx X{P.ws, P.out, (int)threadIdx.x};
  run_p(P, X, layer, PP, smem);
}
#endif

extern "C" void kernel_launch(void* const* d_in, const int* in_sizes, int n_in, void* d_out, int out_size, void* d_ws,
                              size_t ws_size, hipStream_t stream) {
  static int grid = 0;
  if (grid == 0) {
    if (n_in != 33 || ws_size < OFF_END) { fprintf(stderr, "kernel_launch: unexpected n_in %d / ws_size %zu (need %zu)\n", n_in, ws_size, (size_t)OFF_END); grid = -1; return; }
    int dev = 0, cus = 0, per_cu = 0;
    hipGetDevice(&dev);
    hipDeviceGetAttribute(&cus, hipDeviceAttributeMultiprocessorCount, dev);
#if SINGLE
    hipFuncSetAttribute((const void*)fwd_kernel, hipFuncAttributeMaxDynamicSharedMemorySize, LDS_BYTES);
    hipOccupancyMaxActiveBlocksPerMultiprocessor(&per_cu, (const void*)fwd_kernel, 256, LDS_BYTES);
#else
#define SA(pp) hipFuncSetAttribute((const void*)phase_kernel<pp>, hipFuncAttributeMaxDynamicSharedMemorySize, LDS_BYTES)
    SA(-1); SA(0); SA(1); SA(2); SA(3); SA(4); SA(5); SA(6); SA(7); SA(8); SA(9); SA(10); SA(11); SA(12); SA(13);
    per_cu = 2;
#endif
    if (per_cu < 1) { fprintf(stderr, "kernel_launch: occupancy query returned %d\n", per_cu); grid = -1; return; }
    if (per_cu > 2) per_cu = 2;
    grid = cus * per_cu;
  }
  if (grid < 0) return;
  if (hipMemsetAsync((char*)d_ws + OFF_BAR, 0, 32768, stream) != hipSuccess) { fprintf(stderr, "kernel_launch: memset failed\n"); return; }
  Params P{};
  for (int i = 0; i < 33; ++i) P.in[i] = (const float*)d_in[i];
  P.out = (float*)d_out;
  P.ws = (char*)d_ws;
#if SINGLE
  int lo = 0, hi = NPH, us = 1;
  void* args[] = {&P, &lo, &hi, &us};
  hipError_t e = hipLaunchCooperativeKernel((const void*)fwd_kernel, dim3(grid), dim3(256), args, LDS_BYTES, stream);
  if (e != hipSuccess) fprintf(stderr, "cooperative launch failed: %s (grid %d)\n", hipGetErrorString(e), grid);
#else
#define LP(pp, ly) hipLaunchKernelGGL(phase_kernel<pp>, dim3(grid), dim3(256), LDS_BYTES, stream, P, ly)
  LP(-1, 0);
  for (int ly = 0; ly < 2; ++ly) {
    LP(0, ly); LP(1, ly); LP(2, ly); LP(3, ly); LP(4, ly); LP(5, ly); LP(6, ly); LP(7, ly); LP(8, ly); LP(9, ly); LP(10, ly); LP(11, ly); LP(12, ly); LP(13, ly);
  }
#endif
}
```
